# Optimizing an MI355X kernel written in HIP

```python
import math
import jax, jax.numpy as jnp
from jax import lax
import numpy as np

D_MODEL = 2048
BATCH = 2
SEQ = 8192
DEPTH = 1

EPS = 1e-5
SSD_HEADS = 32
SSD_HEAD_DIM = 64
SSD_INNER = SSD_HEADS * SSD_HEAD_DIM
SSD_GROUPS = 4
SSD_HEADS_PER_GROUP = SSD_HEADS // SSD_GROUPS
SSD_STATE = 128
SSD_CONV = 4
SSD_CHUNK = 128
SSD_CONV_DIM = SSD_INNER + 2 * SSD_GROUPS * SSD_STATE
ATTN_HEADS = 16
ATTN_HEAD_DIM = 128
ATTN_INNER = ATTN_HEADS * ATTN_HEAD_DIM
ROPE_THETA = 500000.0
ROT_DIM = ATTN_HEAD_DIM // 4
IDX_HEADS = 8
IDX_DIM = 64
IDX_ROT_DIM = IDX_DIM // 4
IDX_TOPK = 256
Q_BLOCK = 128
N_EXPERTS = 32
TOP_K = 4
D_EXPERT = 2048
SWIGLU_ALPHA = 1.702
SWIGLU_LIMIT = 7.0
IN_SPLIT_SIZES = (SSD_INNER, SSD_CONV_DIM, SSD_HEADS,
                  ATTN_INNER, ATTN_INNER, ATTN_INNER,
                  IDX_HEADS * IDX_DIM, IDX_DIM, IDX_HEADS,
                  D_MODEL, D_MODEL)
D_IN_PROJ = sum(IN_SPLIT_SIZES)

kernel_name = 'hybrid_ssd_dsa_moe_block'


def rmsnorm(x, w):
    xf = x.astype(jnp.float32)
    xf = xf * lax.rsqrt(jnp.mean(xf * xf, axis=-1, keepdims=True) + EPS)
    return xf.astype(x.dtype) * w


def split_cols(u, sizes):
    offs, acc = [], 0
    for s in sizes[:-1]:
        acc += s
        offs.append(acc)
    return jnp.split(u, offs, axis=-1)


def rope_tables(length, rot_dim):
    inv = ROPE_THETA ** (-jnp.arange(0, rot_dim, 2, dtype=jnp.float32) / rot_dim)
    ang = jnp.arange(length, dtype=jnp.float32)[:, None] * inv[None, :]
    return jnp.cos(ang), jnp.sin(ang)


def partial_rotary(x, cos, sin, rot_dim):
    half = rot_dim // 2
    x1, x2, rest = x[..., :half], x[..., half:rot_dim], x[..., rot_dim:]
    out = jnp.concatenate([x1 * cos - x2 * sin, x2 * cos + x1 * sin, rest], axis=-1)
    return out.astype(x.dtype)


def ssd_branch(xbc_raw, z, dt_raw, conv_w, conv_b, dt_bias, a_log, d_skip, norm_w):
    b, L, _ = xbc_raw.shape
    G, R, P, N, CH = SSD_GROUPS, SSD_HEADS_PER_GROUP, SSD_HEAD_DIM, SSD_STATE, SSD_CHUNK
    nc = L // CH
    xpad = jnp.pad(xbc_raw, ((0, 0), (SSD_CONV - 1, 0), (0, 0)))
    xbc = sum(xpad[:, j:j + L] * conv_w[j] for j in range(SSD_CONV)) + conv_b
    xbc = jax.nn.silu(xbc)
    xs, bm, cm = split_cols(xbc, (SSD_INNER, G * N, G * N))
    x = xs.reshape(b, nc, CH, G, R, P)
    bm = bm.reshape(b, nc, CH, G, N)
    cm = cm.reshape(b, nc, CH, G, N)
    dt = jax.nn.softplus((dt_raw + dt_bias).astype(jnp.float32)).reshape(b, nc, CH, G, R)
    a = -jnp.exp(a_log.astype(jnp.float32)).reshape(G, R)
    da_cs = jnp.cumsum(dt * a, axis=2)
    xdt = x * dt[..., None]
    causal = jnp.tril(jnp.ones((CH, CH), dtype=bool))[None, None, :, :, None, None]
    seg = da_cs[:, :, :, None] - da_cs[:, :, None, :]
    decay = jnp.exp(jnp.where(causal, seg, -jnp.inf))
    cb = jnp.einsum('bclgn,bcsgn->bclsg', cm, bm)
    y_diag = jnp.einsum('bclsg,bclsgr,bcsgrp->bclgrp', cb, decay, xdt)
    decay_to_end = jnp.exp(da_cs[:, :, -1:] - da_cs)
    states = jnp.einsum('bclgn,bclgr,bclgrp->bcgrpn', bm, decay_to_end, xdt)
    chunk_decay = jnp.exp(da_cs[:, :, -1])

    def step(h, inp):
        st, dec = inp
        return h * dec[..., None, None] + st, h

    _, prev = lax.scan(step, jnp.zeros_like(states[:, 0]),
                       (jnp.moveaxis(states, 1, 0), jnp.moveaxis(chunk_decay, 1, 0)))
    prev = jnp.moveaxis(prev, 0, 1)
    y_off = jnp.einsum('bclgn,bcgrpn,bclgr->bclgrp', cm, prev, jnp.exp(da_cs))
    y = y_diag + y_off + x * d_skip.reshape(G, R)[:, :, None]
    y = y.reshape(b, L, SSD_INNER).astype(xbc_raw.dtype)
    return rmsnorm(y * jax.nn.silu(z), norm_w)


def dsa_branch(q, k, v, q_idx, k_idx, w_idx):
    b, L, _ = q.shape
    q = q.reshape(b, L, ATTN_HEADS, ATTN_HEAD_DIM)
    k = k.reshape(b, L, ATTN_HEADS, ATTN_HEAD_DIM)
    v = v.reshape(b, L, ATTN_HEADS, ATTN_HEAD_DIM)
    q_idx = q_idx.reshape(b, L, IDX_HEADS, IDX_DIM)
    cos, sin = rope_tables(L, ROT_DIM)
    q = partial_rotary(q, cos[:, None, :], sin[:, None, :], ROT_DIM)
    k = partial_rotary(k, cos[:, None, :], sin[:, None, :], ROT_DIM)
    icos, isin = rope_tables(L, IDX_ROT_DIM)
    q_idx = partial_rotary(q_idx, icos[:, None, :], isin[:, None, :], IDX_ROT_DIM)
    k_idx = partial_rotary(k_idx, icos, isin, IDX_ROT_DIM)
    topk = min(IDX_TOPK, L // 4)
    scale = ATTN_HEAD_DIM ** -0.5
    idx_scale = (IDX_DIM ** -0.5) * (IDX_HEADS ** -0.5)
    key_pos = jnp.arange(L)
    bidx = jnp.arange(b)[:, None, None]

    def block(i):
        start = i * Q_BLOCK
        qb = lax.dynamic_slice_in_dim(q, start, Q_BLOCK, axis=1)
        qib = lax.dynamic_slice_in_dim(q_idx, start, Q_BLOCK, axis=1)
        wb = lax.dynamic_slice_in_dim(w_idx, start, Q_BLOCK, axis=1)
        qpos = start + jnp.arange(Q_BLOCK)
        rel = jax.nn.relu(jnp.einsum('bqhd,bsd->bqhs', qib, k_idx).astype(jnp.float32))
        score = jnp.einsum('bqh,bqhs->bqs', wb.astype(jnp.float32), rel) * idx_scale
        admissible = key_pos[None, :] <= qpos[:, None]
        score = jnp.where(admissible[None], score, -jnp.inf)
        _, sel = lax.top_k(score, topk)
        valid = sel <= qpos[None, :, None]
        ksel = k[bidx, sel]
        vsel = v[bidx, sel]
        logits = jnp.einsum('bqhd,bqjhd->bqhj', qb, ksel).astype(jnp.float32) * scale
        logits = jnp.where(valid[:, :, None, :], logits, -jnp.inf)
        p = jax.nn.softmax(logits, axis=-1).astype(v.dtype)
        return jnp.einsum('bqhj,bqjhd->bqhd', p, vsel)

    out = lax.map(block, jnp.arange(L // Q_BLOCK))
    return jnp.moveaxis(out, 0, 1).reshape(b, L, ATTN_INNER)


def mixer(xn, w_in, conv_w, conv_b, dt_bias, a_log, d_skip, ssd_norm_w,
          w_ssd_branch, w_attn_branch, w_out):
    u = xn @ w_in
    z, xbc, dt_raw, q, k, v, q_idx, k_idx, w_idx, g_ssd, g_attn = split_cols(u, IN_SPLIT_SIZES)
    y_ssd = ssd_branch(xbc, z, dt_raw, conv_w, conv_b, dt_bias, a_log, d_skip, ssd_norm_w) @ w_ssd_branch
    y_attn = dsa_branch(q, k, v, q_idx, k_idx, w_idx) @ w_attn_branch
    merged = jax.nn.sigmoid(g_ssd) * y_ssd + jax.nn.sigmoid(g_attn) * y_attn
    return merged @ w_out


def moe(xn, router_w, router_b, w1, b1, w2, b2):
    b, L, D = xn.shape
    t = xn.reshape(b * L, D)
    logits = (t @ router_w + router_b).astype(jnp.float32)
    vals, idx = lax.top_k(logits, TOP_K)
    wts = jax.nn.softmax(vals, axis=-1)
    gate = jnp.sum(jax.nn.one_hot(idx, N_EXPERTS, dtype=wts.dtype) * wts[..., None], axis=1)
    gate = gate.astype(t.dtype)
    out = jnp.zeros_like(t)
    for e in range(N_EXPERTS):
        h = t @ w1[e] + b1[e]
        glu = jnp.minimum(h[:, :D_EXPERT], SWIGLU_LIMIT)
        lin = jnp.clip(h[:, D_EXPERT:], -SWIGLU_LIMIT, SWIGLU_LIMIT)
        act = glu * jax.nn.sigmoid(SWIGLU_ALPHA * glu) * (lin + 1.0)
        out = out + gate[:, e:e + 1] * (act @ w2[e] + b2[e])
    return out.reshape(b, L, D)


def setup_inputs(seed: int = 0) -> dict:
    key = jax.random.key(seed)
    ks = jax.random.split(key, 20)
    f32 = jnp.float32

    def nrm(k, shape, scale):
        return jax.random.normal(k, shape, f32) * scale

    dt0 = jnp.exp(jax.random.uniform(ks[4], (DEPTH, SSD_HEADS), f32, math.log(1e-3), math.log(1e-1)))
    return {
        'x': nrm(ks[0], (BATCH, SEQ, D_MODEL), 1.0),
        'w_in': nrm(ks[1], (DEPTH, D_MODEL, D_IN_PROJ), D_MODEL ** -0.5),
        'conv_w': nrm(ks[2], (DEPTH, SSD_CONV, SSD_CONV_DIM), SSD_CONV ** -0.5),
        'conv_b': nrm(ks[3], (DEPTH, SSD_CONV_DIM), 0.01),
        'dt_bias': dt0 + jnp.log(-jnp.expm1(-dt0)),
        'a_log': jnp.log(jax.random.uniform(ks[5], (DEPTH, SSD_HEADS), f32, 1.0, 16.0)),
        'd_skip': 1.0 + nrm(ks[6], (DEPTH, SSD_HEADS), 0.01),
        'ssd_norm_w': 1.0 + nrm(ks[7], (DEPTH, SSD_INNER), 0.01),
        'w_ssd_branch': nrm(ks[8], (DEPTH, SSD_INNER, D_MODEL), SSD_INNER ** -0.5),
        'w_attn_branch': nrm(ks[9], (DEPTH, ATTN_INNER, D_MODEL), ATTN_INNER ** -0.5),
        'w_out': nrm(ks[10], (DEPTH, D_MODEL, D_MODEL), D_MODEL ** -0.5),
        'norm_mix_w': 1.0 + nrm(ks[11], (DEPTH, D_MODEL), 0.01),
        'norm_ffn_w': 1.0 + nrm(ks[12], (DEPTH, D_MODEL), 0.01),
        'router_w': nrm(ks[13], (DEPTH, D_MODEL, N_EXPERTS), D_MODEL ** -0.5),
        'router_b': nrm(ks[14], (DEPTH, N_EXPERTS), 0.01),
        'w_expert_in': nrm(ks[15], (DEPTH, N_EXPERTS, D_MODEL, 2 * D_EXPERT), D_MODEL ** -0.5),
        'b_expert_in': nrm(ks[16], (DEPTH, N_EXPERTS, 2 * D_EXPERT), 0.01),
        'w_expert_out': nrm(ks[17], (DEPTH, N_EXPERTS, D_EXPERT, D_MODEL), D_EXPERT ** -0.5),
        'b_expert_out': nrm(ks[18], (DEPTH, N_EXPERTS, D_MODEL), 0.01),
        'final_norm_w': 1.0 + nrm(ks[19], (D_MODEL,), 0.01),
    }


def reference(x, w_in, conv_w, conv_b, dt_bias, a_log, d_skip, ssd_norm_w, w_ssd_branch,
              w_attn_branch, w_out, norm_mix_w, norm_ffn_w, router_w, router_b,
              w_expert_in, b_expert_in, w_expert_out, b_expert_out, final_norm_w):
    h = x
    for l in range(DEPTH):
        h = h + mixer(rmsnorm(h, norm_mix_w[l]), w_in[l], conv_w[l], conv_b[l], dt_bias[l],
                      a_log[l], d_skip[l], ssd_norm_w[l], w_ssd_branch[l], w_attn_branch[l], w_out[l])
        h = h + moe(rmsnorm(h, norm_ffn_w[l]), router_w[l], router_b[l], w_expert_in[l],
                    b_expert_in[l], w_expert_out[l], b_expert_out[l])
    return rmsnorm(h, final_norm_w)
```

```cpp
#include <hip/hip_runtime.h>
#include <hip/hip_bf16.h>
#include <cstdio>
#include <cstdint>
namespace pg8 {
#define PG8_LAS __attribute__((address_space(3)))
typedef unsigned short bf16_t;
typedef short bf16x8 __attribute__((ext_vector_type(8)));
typedef float f32x4 __attribute__((ext_vector_type(4)));
typedef unsigned u32x4 __attribute__((ext_vector_type(4)));
constexpr int BM = 256, BK = 64, HALF = 128, HTB = HALF * BK * 2  , STAGE_BYTES = 8 * HTB, NXCD = 8, WGM = 8;

__host__ __device__ __forceinline__ int lds_byte(int r, int c) { const int st = (r >> 4) * 2 + (c >> 5), rr = r & 15, cc = c & 31, ob = rr * 64 + cc * 2; return st * 1024 + (ob ^ (((ob >> 9) & 1) << 5)); }
__host__ __device__ __forceinline__ void stage_rc(int b, int& R, int& C) { const int st = b / 1024, sb = b % 1024, swz = sb ^ (((sb >> 9) & 1) << 5); R = (st >> 1) * 16 + swz / 64; C = (st & 1) * 32 + (swz % 64) / 2; }
__host__ __device__ __forceinline__ int perm32(int rho) { const int n = rho >> 4, i = rho & 15; return 8 * (i >> 2) + 4 * n + (i & 3); }

struct Unit { int pm, pn, pb; };
struct Gemm { const bf16_t* A; const bf16_t* Bt; int M, N, K; };

struct StaticOrder {
    int nM, nN, nwg, G, c;
    __host__ __device__ void init(int M, int N, int G_, int c_) { nM = M / BM; nN = N / BM; nwg = nM * nN; G = G_; c = c_; }
    __host__ __device__ bool next(int i, Unit& u) const {
        const long L = (long)i * G + c; if (L >= nwg) return false;
        int wgid = (int)L; { const int q = nwg / NXCD, r = nwg % NXCD, xcd = wgid % NXCD, off = wgid / NXCD; wgid = (xcd < r ? xcd * (q + 1) : r * (q + 1) + (xcd - r) * q) + off; }
        const int nig = WGM * nN, gid = wgid / nig, fm = gid * WGM, gsz = (nM - fm) < WGM ? (nM - fm) : WGM;
        u.pm = fm + ((wgid % nig) % gsz); u.pn = (wgid % nig) / gsz; u.pb = u.pn; return true;
    }
    __device__ __forceinline__ void a_ready(const Unit&) const {}
    __device__ __forceinline__ void done(const Unit&) const {}
};


template <class Epi, class Sched, bool ALIGN_EPI = false, bool SP2 = false>
__device__ __forceinline__ void gemm_phase(PG8_LAS unsigned char* lds, const Gemm g, const Sched& S, const Epi& E) {
    const int tid = threadIdx.x, wid = __builtin_amdgcn_readfirstlane(tid >> 6), lane = tid & 63, wr = wid >> 2, wc = wid & 3, fr = lane & 15, fq = lane >> 4;
    const int K = g.K, nt = K / BK;
    unsigned voffA[2], voffB[2];
#pragma unroll
    for (int i = 0; i < 2; ++i) { int R, C; stage_rc(tid * 16 + i * 8192, R, C); const int Rb = Epi::PERM ? ((R & ~31) + perm32(R & 31)) : R;
        voffA[i] = (unsigned)(R * K + C) * 2u; voffB[i] = (unsigned)(Rb * K + C) * 2u; }
    const size_t kstep = (size_t)(BK * 2);
    const size_t hstep = (size_t)HALF * K * 2;
    const size_t tstep = 2 * hstep;
    const unsigned ldsw = (unsigned)wid * 1024u;
    const int aoff = lds_byte(wr * 64 + fr, fq * 8), boff = lds_byte(wc * 32 + fr, fq * 8);
#define PG8_SA(b, h) (((b) * 2 + (h)) * HTB)
#define PG8_SB(b, h) ((4 + (b) * 2 + (h)) * HTB)
#define PG8_STAGE(bufoff, gbase, voff) do { _Pragma("unroll") for (int _i = 0; _i < 2; ++_i) \
        __builtin_amdgcn_global_load_lds((const unsigned*)((const char*)(gbase) + (voff)[_i]), (PG8_LAS unsigned*)(lds + (bufoff) + ldsw + _i * 8192), 16, 0, 0); } while (0)
#define PG8_LDA(dst, b, h) do { _Pragma("unroll") for (int m = 0; m < 4; ++m) _Pragma("unroll") for (int k = 0; k < 2; ++k) dst[m][k] = *(const PG8_LAS bf16x8*)(lds + PG8_SA(b, h) + aoff + m * 2048 + k * 1024); } while (0)
#define PG8_LDB(dst, b, h) do { _Pragma("unroll") for (int n = 0; n < 2; ++n) _Pragma("unroll") for (int k = 0; k < 2; ++k) dst[n][k] = *(const PG8_LAS bf16x8*)(lds + PG8_SB(b, h) + boff + n * 2048 + k * 1024); } while (0)
#define PG8_MMA(ai, bj, At, Bt) do { __builtin_amdgcn_s_setprio(1); _Pragma("unroll") for (int m = 0; m < 4; ++m) _Pragma("unroll") for (int n = 0; n < 2; ++n) _Pragma("unroll") for (int k = 0; k < 2; ++k) \
        acc[ai][bj][m][n] = __builtin_amdgcn_mfma_f32_16x16x32_bf16(Bt[n][k], At[m][k], acc[ai][bj][m][n], 0, 0, 0); __builtin_amdgcn_s_setprio(0); } while (0)
#define PG8_WAIT_V(n) asm volatile("s_waitcnt vmcnt(" #n ")" ::: "memory")
#define PG8_WAIT_L(n) asm volatile("s_waitcnt lgkmcnt(" #n ")" ::: "memory")
#define PG8_BAR __builtin_amdgcn_s_barrier()
#define PG8_SCHED __builtin_amdgcn_sched_barrier(0)
    Unit cur, nxt; int ui = 0;
    if (!S.next(0, cur)) return;
    f32x4 acc[2][2][4][2];
#pragma unroll
    for (int a = 0; a < 2; ++a)
#pragma unroll
        for (int b = 0; b < 2; ++b)
#pragma unroll
            for (int m = 0; m < 4; ++m)
#pragma unroll
                for (int n = 0; n < 2; ++n) acc[a][b][m][n] = (f32x4){0.f, 0.f, 0.f, 0.f};
    bf16x8 At[4][2], B0[2][2], B1[2][2];
    const char* cA = (const char*)g.A + (size_t)cur.pm * tstep; const char* cB = (const char*)g.Bt + (size_t)cur.pb * tstep;
    S.a_ready(cur);
    if constexpr (SP2) {
        PG8_STAGE(PG8_SB(0, 0), cB, voffB); PG8_STAGE(PG8_SB(0, 1), cB + hstep, voffB); PG8_STAGE(PG8_SA(0, 0), cA, voffA); PG8_STAGE(PG8_SA(0, 1), cA + hstep, voffA);
        if (wr == 1) PG8_BAR;
        PG8_WAIT_V(2); PG8_BAR;
        PG8_STAGE(PG8_SB(1, 0), cB + kstep, voffB); PG8_STAGE(PG8_SA(1, 0), cA + kstep, voffA); PG8_STAGE(PG8_SB(1, 1), cB + hstep + kstep, voffB);
        PG8_WAIT_V(6); PG8_BAR;
    } else {
        PG8_STAGE(PG8_SB(0, 0), cB, voffB); PG8_STAGE(PG8_SA(0, 0), cA, voffA); PG8_STAGE(PG8_SB(0, 1), cB + hstep, voffB); PG8_STAGE(PG8_SA(0, 1), cA + hstep, voffA);
        if (wr == 1) PG8_BAR;
        PG8_WAIT_V(4); PG8_BAR;
        PG8_STAGE(PG8_SB(1, 0), cB + kstep, voffB); PG8_STAGE(PG8_SA(1, 0), cA + kstep, voffA); PG8_STAGE(PG8_SB(1, 1), cB + hstep + kstep, voffB);
        PG8_WAIT_V(6); PG8_BAR;
    }
    for (;;) {
        const bool has_next = S.next(ui + 1, nxt);
        const char* nA = has_next ? (const char*)g.A + (size_t)nxt.pm * tstep : cA; const char* nB = has_next ? (const char*)g.Bt + (size_t)nxt.pb * tstep : cB;
        for (int t = 0; t < nt; t += 2) {
            const bool last = (t == nt - 2);
            const char* a1 = cA + (size_t)(t + 1) * kstep;
            const char* a2 = last ? nA : cA + (size_t)(t + 2) * kstep; const char* b2 = last ? nB : cB + (size_t)(t + 2) * kstep;
            const char* a3 = a2 + kstep; const char* b3 = b2 + kstep;
            if (last && has_next) S.a_ready(nxt);
            if constexpr (SP2) {
            PG8_LDB(B0, 0, 0); PG8_LDB(B1, 0, 1); PG8_SCHED; PG8_LDA(At, 0, 0); PG8_STAGE(PG8_SA(1, 1), a1 + hstep, voffA);
            PG8_WAIT_V(8); PG8_WAIT_L(0); PG8_BAR; PG8_MMA(0, 0, At, B0); PG8_MMA(0, 1, At, B1); PG8_BAR; PG8_SCHED;
            PG8_LDA(At, 0, 1); PG8_STAGE(PG8_SB(0, 0), b2, voffB); PG8_STAGE(PG8_SB(0, 1), b2 + hstep, voffB); PG8_STAGE(PG8_SA(0, 0), a2, voffA);
            PG8_WAIT_V(8); PG8_WAIT_L(0); PG8_BAR; PG8_MMA(1, 0, At, B0); PG8_MMA(1, 1, At, B1); PG8_BAR; PG8_SCHED;
            PG8_LDB(B0, 1, 0); PG8_LDB(B1, 1, 1); PG8_SCHED; PG8_LDA(At, 1, 0); PG8_STAGE(PG8_SA(0, 1), a2 + hstep, voffA);
            PG8_WAIT_V(8); PG8_WAIT_L(0); PG8_BAR; PG8_MMA(0, 0, At, B0); PG8_MMA(0, 1, At, B1); PG8_BAR; PG8_SCHED;
            PG8_LDA(At, 1, 1); PG8_STAGE(PG8_SB(1, 0), b3, voffB); PG8_STAGE(PG8_SB(1, 1), b3 + hstep, voffB); PG8_STAGE(PG8_SA(1, 0), a3, voffA);
            PG8_WAIT_V(8); PG8_WAIT_L(0); PG8_BAR; PG8_MMA(1, 0, At, B0); PG8_MMA(1, 1, At, B1); PG8_BAR; PG8_SCHED;
            } else {
            PG8_LDB(B0, 0, 0); PG8_SCHED; PG8_LDA(At, 0, 0); PG8_STAGE(PG8_SA(1, 1), a1 + hstep, voffA);
            PG8_WAIT_L(8); PG8_BAR; PG8_WAIT_L(0); PG8_MMA(0, 0, At, B0); PG8_BAR; PG8_SCHED;
            PG8_LDB(B1, 0, 1); PG8_STAGE(PG8_SB(0, 0), b2, voffB);
            PG8_BAR; PG8_WAIT_L(0); PG8_MMA(0, 1, At, B1); PG8_BAR;
            PG8_LDA(At, 0, 1); PG8_STAGE(PG8_SA(0, 0), a2, voffA);
            PG8_BAR; PG8_WAIT_L(0); PG8_MMA(1, 0, At, B0); PG8_BAR; PG8_SCHED;
            PG8_STAGE(PG8_SB(0, 1), b2 + hstep, voffB);
            PG8_WAIT_V(6); PG8_BAR; PG8_MMA(1, 1, At, B1); PG8_BAR;
            PG8_LDB(B0, 1, 0); PG8_SCHED; PG8_LDA(At, 1, 0); PG8_STAGE(PG8_SA(0, 1), a2 + hstep, voffA);
            PG8_WAIT_L(8); PG8_BAR; PG8_WAIT_L(0); PG8_MMA(0, 0, At, B0); PG8_BAR; PG8_SCHED;
            PG8_LDB(B1, 1, 1); PG8_STAGE(PG8_SB(1, 0), b3, voffB);
            PG8_BAR; PG8_WAIT_L(0); PG8_MMA(0, 1, At, B1); PG8_BAR;
            PG8_LDA(At, 1, 1); PG8_STAGE(PG8_SA(1, 0), a3, voffA);
            PG8_BAR; PG8_WAIT_L(0); PG8_MMA(1, 0, At, B0); PG8_BAR; PG8_SCHED;
            PG8_STAGE(PG8_SB(1, 1), b3 + hstep, voffB);
            PG8_WAIT_V(6); PG8_BAR; PG8_MMA(1, 1, At, B1); PG8_BAR;
            }
        }
        if constexpr (ALIGN_EPI) { if (wr == 0) PG8_BAR; }
        if constexpr (!Epi::AFTER_DRAIN) { E(acc, cur, wr, wc, fr, fq); S.done(cur); }
        if (!has_next) break;
#pragma unroll
        for (int a = 0; a < 2; ++a)
#pragma unroll
            for (int b = 0; b < 2; ++b)
#pragma unroll
                for (int m = 0; m < 4; ++m)
#pragma unroll
                    for (int n = 0; n < 2; ++n) acc[a][b][m][n] = (f32x4){0.f, 0.f, 0.f, 0.f};
        cur = nxt; cA = nA; cB = nB; ++ui;
        if constexpr (ALIGN_EPI) { if (wr == 1) PG8_BAR; }
    }
    PG8_WAIT_V(0);
    if constexpr (!ALIGN_EPI) { if (wr == 0) PG8_BAR; }
    PG8_BAR;
    if constexpr (Epi::AFTER_DRAIN) { E.fused(acc, cur, wr, wc, fr, fq, lds, wid, lane); S.done(cur); }
#undef PG8_SA
#undef PG8_SB
#undef PG8_STAGE
#undef PG8_LDA
#undef PG8_LDB
#undef PG8_MMA
#undef PG8_WAIT_V
#undef PG8_WAIT_L
#undef PG8_BAR
#undef PG8_SCHED
}
}

namespace pg8 {
typedef unsigned u32x2 __attribute__((ext_vector_type(2)));
__device__ __forceinline__ unsigned cvt_pk_bf16(float lo, float hi) { unsigned r; asm volatile("v_cvt_pk_bf16_f32 %0, %1, %2" : "=v"(r) : "v"(lo), "v"(hi)); return r; }
__device__ __forceinline__ float bf_lo(unsigned w) { return __uint_as_float(w << 16); }
__device__ __forceinline__ float bf_hi(unsigned w) { return __uint_as_float(w & 0xffff0000u); }
__device__ __forceinline__ float sigm(float x) { return 1.f / (1.f + __expf(-x)); }

struct GroupedOrder {
    int nM, nN, nwg, G, c; const PG8_LAS int* tile_e;
    __device__ void init(int ntiles, int nN_, int G_, int c_, const PG8_LAS int* te) { nM = ntiles; nN = nN_; nwg = nM * nN; G = G_; c = c_; tile_e = te; }
    __device__ bool next(int i, Unit& u) const {
        const long L = (long)i * G + c; if (L >= nwg) return false;
        int wgid = (int)L; { const int q = nwg / NXCD, r = nwg % NXCD, xcd = wgid % NXCD, off = wgid / NXCD; wgid = (xcd < r ? xcd * (q + 1) : r * (q + 1) + (xcd - r) * q) + off; }
        const int nig = WGM * nN, gid = wgid / nig, fm = gid * WGM, gsz = (nM - fm) < WGM ? (nM - fm) : WGM;
        u.pm = fm + ((wgid % nig) % gsz); u.pn = (wgid % nig) / gsz; u.pb = tile_e[u.pm] * nN + u.pn; return true;
    }
    __device__ __forceinline__ void a_ready(const Unit&) const {}
    __device__ __forceinline__ void done(const Unit&) const {}
};

struct EpiU {
    static constexpr bool PERM = true, AFTER_DRAIN = false;
    bf16_t* O; int ldc;
    __device__ __forceinline__ void operator()(const f32x4 (&acc)[2][2][4][2], const Unit& u, int wr, int wc, int fr, int fq) const {
        const int row0 = u.pm * BM + wr * 64 + fr, col0 = u.pn * BM + wc * 32 + 8 * fq;
#pragma unroll
        for (int ai = 0; ai < 2; ++ai)
#pragma unroll
            for (int m = 0; m < 4; ++m) { bf16_t* rowp = O + (size_t)(row0 + ai * HALF + m * 16) * ldc + col0;
#pragma unroll
                for (int bj = 0; bj < 2; ++bj) { const f32x4 v0 = acc[ai][bj][m][0], v1 = acc[ai][bj][m][1];
                    u32x4 w; w.x = cvt_pk_bf16(v0[0], v0[1]); w.y = cvt_pk_bf16(v0[2], v0[3]); w.z = cvt_pk_bf16(v1[0], v1[1]); w.w = cvt_pk_bf16(v1[2], v1[3]);
                    *(u32x4*)(rowp + bj * HALF) = w; } }
    }
};
struct EpiSsd {
    static constexpr bool PERM = false, AFTER_DRAIN = false;
    float* TMP; const bf16_t* G; int ldg; const float* ssq;
    __device__ __forceinline__ void operator()(const f32x4 (&acc)[2][2][4][2], const Unit& u, int wr, int wc, int fr, int fq) const {
        const int row0 = u.pm * BM + wr * 64 + fr, col0 = u.pn * BM + wc * 32 + 4 * fq;
#pragma unroll
        for (int ai = 0; ai < 2; ++ai)
#pragma unroll
            for (int m = 0; m < 4; ++m) { const int row = row0 + ai * HALF + m * 16; const float rs = 1.0f / sqrtf(ssq[row] * (1.0f / 2048.0f) + 1e-5f);
#pragma unroll
                for (int bj = 0; bj < 2; ++bj)
#pragma unroll
                    for (int n = 0; n < 2; ++n) { const int c = col0 + bj * HALF + n * 16; const u32x2 g = *(const u32x2*)(G + (size_t)row * ldg + c);
                        const f32x4 a = acc[ai][bj][m][n]; f32x4 o;
                        o[0] = a[0] * rs * sigm(bf_lo(g.x)); o[1] = a[1] * rs * sigm(bf_hi(g.x)); o[2] = a[2] * rs * sigm(bf_lo(g.y)); o[3] = a[3] * rs * sigm(bf_hi(g.y));
                        *(f32x4*)(TMP + (size_t)row * 2048 + c) = o; } }
    }
};
struct EpiAttn {
    static constexpr bool PERM = true, AFTER_DRAIN = false;
    bf16_t* MG; const float* TMP; const bf16_t* G; int ldg;
    __device__ __forceinline__ void operator()(const f32x4 (&acc)[2][2][4][2], const Unit& u, int wr, int wc, int fr, int fq) const {
        const int row0 = u.pm * BM + wr * 64 + fr, col0 = u.pn * BM + wc * 32 + 8 * fq;
#pragma unroll
        for (int ai = 0; ai < 2; ++ai)
#pragma unroll
            for (int m = 0; m < 4; ++m) { const int row = row0 + ai * HALF + m * 16;
#pragma unroll
                for (int bj = 0; bj < 2; ++bj) { const int c = col0 + bj * HALF; const u32x4 g = *(const u32x4*)(G + (size_t)row * ldg + c);
                    const f32x4 t0 = *(const f32x4*)(TMP + (size_t)row * 2048 + c), t1 = *(const f32x4*)(TMP + (size_t)row * 2048 + c + 4);
                    const f32x4 a0 = acc[ai][bj][m][0], a1 = acc[ai][bj][m][1];
                    u32x4 w;
                    w.x = cvt_pk_bf16(t0[0] + a0[0] * sigm(bf_lo(g.x)), t0[1] + a0[1] * sigm(bf_hi(g.x)));
                    w.y = cvt_pk_bf16(t0[2] + a0[2] * sigm(bf_lo(g.y)), t0[3] + a0[3] * sigm(bf_hi(g.y)));
                    w.z = cvt_pk_bf16(t1[0] + a1[0] * sigm(bf_lo(g.z)), t1[1] + a1[1] * sigm(bf_hi(g.z)));
                    w.w = cvt_pk_bf16(t1[2] + a1[2] * sigm(bf_lo(g.w)), t1[3] + a1[3] * sigm(bf_hi(g.w)));
                    *(u32x4*)(MG + (size_t)row * 2048 + c) = w; } }
    }
};
struct EpiOut {
    static constexpr bool PERM = false, AFTER_DRAIN = false;
    float* H1; const float* X;
    __device__ __forceinline__ void operator()(const f32x4 (&acc)[2][2][4][2], const Unit& u, int wr, int wc, int fr, int fq) const {
        const int row0 = u.pm * BM + wr * 64 + fr, col0 = u.pn * BM + wc * 32 + 4 * fq;
#pragma unroll
        for (int ai = 0; ai < 2; ++ai)
#pragma unroll
            for (int m = 0; m < 4; ++m) { const size_t ro = (size_t)(row0 + ai * HALF + m * 16) * 2048;
#pragma unroll
                for (int bj = 0; bj < 2; ++bj)
#pragma unroll
                    for (int n = 0; n < 2; ++n) { const int c = col0 + bj * HALF + n * 16; *(f32x4*)(H1 + ro + c) = *(const f32x4*)(X + ro + c) + acc[ai][bj][m][n]; } }
    }
};
__device__ __forceinline__ float swiglu1(float g, float l) { g = fminf(g, 7.0f); l = fminf(fmaxf(l, -7.0f), 7.0f); return g * sigm(1.702f * g) * (l + 1.0f); }
struct EpiSwiglu {
    static constexpr bool PERM = true, AFTER_DRAIN = false;
    bf16_t* ACT; const float* b1;
    __device__ __forceinline__ void operator()(const f32x4 (&acc)[2][2][4][2], const Unit& u, int wr, int wc, int fr, int fq) const {
        const int row0 = u.pm * BM + wr * 64 + fr, e = u.pb >> 4, j0 = u.pn * 128 + wc * 32 + 8 * fq;
        const float* bg = b1 + (size_t)e * 4096 + j0; const float* bl = bg + 2048;
        const f32x4 bg0 = *(const f32x4*)bg, bg1 = *(const f32x4*)(bg + 4), bl0 = *(const f32x4*)bl, bl1 = *(const f32x4*)(bl + 4);
#pragma unroll
        for (int ai = 0; ai < 2; ++ai)
#pragma unroll
            for (int m = 0; m < 4; ++m) { const int row = row0 + ai * HALF + m * 16;
                const f32x4 g0 = acc[ai][0][m][0] + bg0, g1 = acc[ai][0][m][1] + bg1, l0 = acc[ai][1][m][0] + bl0, l1 = acc[ai][1][m][1] + bl1;
                u32x4 w;
                w.x = cvt_pk_bf16(swiglu1(g0[0], l0[0]), swiglu1(g0[1], l0[1])); w.y = cvt_pk_bf16(swiglu1(g0[2], l0[2]), swiglu1(g0[3], l0[3]));
                w.z = cvt_pk_bf16(swiglu1(g1[0], l1[0]), swiglu1(g1[1], l1[1])); w.w = cvt_pk_bf16(swiglu1(g1[2], l1[2]), swiglu1(g1[3], l1[3]));
                *(u32x4*)(ACT + (size_t)row * 2048 + j0) = w; }
    }
};
struct EpiMoeOut {
    static constexpr bool PERM = true, AFTER_DRAIN = false;
    bf16_t* OS; const float* b2; const float* rowgate;
    __device__ __forceinline__ void operator()(const f32x4 (&acc)[2][2][4][2], const Unit& u, int wr, int wc, int fr, int fq) const {
        const int row0 = u.pm * BM + wr * 64 + fr, e = u.pb >> 3, col0 = u.pn * BM + wc * 32 + 8 * fq;
#pragma unroll
        for (int bj = 0; bj < 2; ++bj) { const int c = col0 + bj * HALF; const float* bp = b2 + (size_t)e * 2048 + c;
            const f32x4 b0 = *(const f32x4*)bp, b1v = *(const f32x4*)(bp + 4);
#pragma unroll
            for (int ai = 0; ai < 2; ++ai)
#pragma unroll
                for (int m = 0; m < 4; ++m) { const int row = row0 + ai * HALF + m * 16; const float gw = rowgate[row];
                    const f32x4 v0 = (acc[ai][bj][m][0] + b0) * gw, v1 = (acc[ai][bj][m][1] + b1v) * gw;
                    u32x4 w; w.x = cvt_pk_bf16(v0[0], v0[1]); w.y = cvt_pk_bf16(v0[2], v0[3]); w.z = cvt_pk_bf16(v1[0], v1[1]); w.w = cvt_pk_bf16(v1[2], v1[3]);
                    *(u32x4*)(OS + (size_t)row * 2048 + c) = w; } }
    }
};
}
namespace att {
constexpr int D = 128;
constexpr int KVP = 16128, QP = 16128, OP = 2048, MKSTRIDE = 8192;
constexpr float THR = 8.f;
constexpr bool WSKIP = false;
constexpr float SCALE = 0.08838834764831845f;
constexpr int NW = 8, QBLK = 32, KVBLK = 64, QB = NW * QBLK;
constexpr int SHM_V = KVBLK * D * 2, SHM_K = KVBLK * D * 2;
constexpr int LDS_BYTES = 2 * SHM_V + 2 * SHM_K + NW * 64 * 4 + 2 * 2048;
using bf16 = __hip_bfloat16;
typedef short bf16x8 __attribute__((ext_vector_type(8)));
typedef short s16x4 __attribute__((ext_vector_type(4)));
typedef float f32x16 __attribute__((ext_vector_type(16)));
typedef float f32x4 __attribute__((ext_vector_type(4)));
typedef unsigned u32x4 __attribute__((ext_vector_type(4)));
template <class A, class Bt> struct same_t { static constexpr bool v = false; };
template <class A> struct same_t<A, A> { static constexpr bool v = true; };
#define KSWZ(row, colB) ((row) * 256 + ((colB) ^ (((row) & 7) << 4)))
#define SBAR() __builtin_amdgcn_sched_barrier(0)
__device__ __forceinline__ int v_st(int k, int c) { const int kk = (k & ~0xC) | ((k & 4) << 1) | ((k & 8) >> 1); return ((kk >> 3) * 4 + (c >> 5)) * 512 + ((kk & 7) * 32 + (c & 31)) * 2; }
__device__ __forceinline__ int v_rd_base(int lane) { return ((lane & 3) << 3) | (((lane >> 2) & 3) << 6) | (((lane >> 4) & 1) << 5) | (((lane >> 5) & 1) << 8); }
constexpr int v_rd_off(int d0, int ks, int half) { return d0 * 512 + ks * 4096 + half * 2048; }
__device__ __forceinline__ int crow(int r, int hi) { return (r & 3) + 8 * (r >> 2) + 4 * hi; }
__device__ __forceinline__ unsigned cvtpk(float lo, float hi) {
    unsigned r; asm volatile("v_cvt_pk_bf16_f32 %0, %1, %2" : "=v"(r) : "v"(lo), "v"(hi)); return r;
}
__device__ __forceinline__ bf16x8 pack8(f32x4 a, f32x4 b) {
    u32x4 w = {cvtpk(a[0], a[1]), cvtpk(a[2], a[3]), cvtpk(b[0], b[1]), cvtpk(b[2], b[3])};
    return *reinterpret_cast<bf16x8*>(&w);
}
template <class T> __device__ __forceinline__ bf16x8 load8(const T* p) {
    if constexpr (same_t<T, float>::v) { return pack8(*(const f32x4*)p, *(const f32x4*)(p + 4)); }
    else { return *reinterpret_cast<const bf16x8*>(p); }
}
__device__ __forceinline__ void mask_bits(f32x16& p0, f32x16& p1, unsigned lo, unsigned hw, int hi) {
    const float NEG = -__builtin_inff();
    lo >>= 4 * hi; hw >>= 4 * hi;
#define MB1(P, W, C) do { float pv_ = P; unsigned t_; asm volatile("v_bfe_i32 %1, %2, %3, 1\n\tv_bfi_b32 %0, %1, %0, %4" : "+v"(pv_), "=&v"(t_) : "v"(W), "n"(C), "s"(NEG)); P = pv_; } while (0)
#define MB4(G) do { MB1(p0[4 * G + 0], lo, 8 * G + 0); MB1(p0[4 * G + 1], lo, 8 * G + 1); MB1(p0[4 * G + 2], lo, 8 * G + 2); MB1(p0[4 * G + 3], lo, 8 * G + 3); \
                    MB1(p1[4 * G + 0], hw, 8 * G + 0); MB1(p1[4 * G + 1], hw, 8 * G + 1); MB1(p1[4 * G + 2], hw, 8 * G + 2); MB1(p1[4 * G + 3], hw, 8 * G + 3); } while (0)
    MB4(0); MB4(1); MB4(2); MB4(3);
#undef MB4
#undef MB1
}
__device__ __forceinline__ void partialSM(f32x16& p0, f32x16& p1, float& m_reg, float& mn, float& alpha) {
    float pmax = p0[0]; for (int r = 1; r < 16; ++r) pmax = fmaxf(pmax, p0[r]); for (int r = 0; r < 16; ++r) pmax = fmaxf(pmax, p1[r]);
    { auto rr = __builtin_amdgcn_permlane32_swap(__float_as_uint(pmax), __float_as_uint(pmax), false, false);
      pmax = fmaxf(__uint_as_float(rr[0]), __uint_as_float(rr[1])); }
    constexpr float C2 = 1.4426950408889634f * SCALE;
    if (__builtin_expect(__all((pmax - m_reg) * SCALE <= THR), 1)) { mn = m_reg; alpha = 1.f; }
    else { mn = fmaxf(m_reg, pmax); alpha = __builtin_amdgcn_exp2f((m_reg - mn) * C2); m_reg = mn; }
    const float mnL = -mn * C2;
    for (int r = 0; r < 16; ++r) p0[r] = fmaf(p0[r], C2, mnL); for (int r = 0; r < 16; ++r) p1[r] = fmaf(p1[r], C2, mnL);
    for (int r = 0; r < 16; ++r) p0[r] = __builtin_amdgcn_exp2f(p0[r]);
}
__device__ __forceinline__ void finishSM(f32x16& p0, f32x16& p1, float alpha, float& l_reg, bf16x8& pa0, bf16x8& pa1, bf16x8& pa2, bf16x8& pa3) {
    for (int r = 0; r < 16; ++r) p1[r] = __builtin_amdgcn_exp2f(p1[r]);
    float ps = 0; for (int r = 0; r < 16; ++r) ps += p0[r]; for (int r = 0; r < 16; ++r) ps += p1[r];
    { auto rr = __builtin_amdgcn_permlane32_swap(__float_as_uint(ps), __float_as_uint(ps), false, false);
      ps = __uint_as_float(rr[0]) + __uint_as_float(rr[1]); }
    l_reg = l_reg * alpha + ps;
#define PK4(P, B_, OUT) do { unsigned a0 = cvtpk(P[B_+0], P[B_+1]), a1 = cvtpk(P[B_+2], P[B_+3]);                          \
        unsigned b0 = cvtpk(P[B_+4], P[B_+5]), b1 = cvtpk(P[B_+6], P[B_+7]);                                             \
        auto r0 = __builtin_amdgcn_permlane32_swap(a0, b0, false, false); auto r1 = __builtin_amdgcn_permlane32_swap(a1, b1, false, false); \
        u32x4 w = {r0[0], r1[0], r0[1], r1[1]}; OUT = *reinterpret_cast<bf16x8*>(&w); } while (0)
    PK4(p0, 0, pa0); PK4(p0, 8, pa1); PK4(p1, 0, pa2); PK4(p1, 8, pa3);
#undef PK4
}
template <int KB, bool SK>
__device__ __forceinline__ void qkt(f32x16& p0, f32x16& p1, const char* K_lds, int r32, int hi, const bf16x8* qr, bool act) {
    if (SK && !act) { const float NEG = -__builtin_inff();
#pragma unroll
        for (int r = 0; r < 16; ++r) { p0[r] = NEG; p1[r] = NEG; } return; }
    p0 = f32x16{}; p1 = f32x16{};
    const char* kb[4];
#pragma unroll
    for (int dd = 0; dd < 4; ++dd) kb[dd] = K_lds + KB * SHM_K + KSWZ(r32, (dd * 16 + hi * 8) * 2);
#pragma unroll
    for (int d0 = 0; d0 < 8; ++d0) { const char* a = kb[d0 & 3] + (d0 >> 2) * 128;
        bf16x8 b0 = *reinterpret_cast<const bf16x8*>(a);
        bf16x8 b1 = *reinterpret_cast<const bf16x8*>(a + 32 * 256);
        p0 = __builtin_amdgcn_mfma_f32_32x32x16_bf16(b0, qr[d0], p0, 0, 0, 0);
        p1 = __builtin_amdgcn_mfma_f32_32x32x16_bf16(b1, qr[d0], p1, 0, 0, 0); }
}
template <int VB, bool SK>
__device__ __forceinline__ void pv_tile(f32x16* o, int vb0, bf16x8 pa0, bf16x8 pa1, bf16x8 pa2, bf16x8 pa3, bool act) {
    if (SK && !act) return;
#define TRRD(dst, off) asm volatile("ds_read_b64_tr_b16 %0, %1 offset:%2" : "=&v"(dst) : "v"(vb0), "i"(off) : "memory")
#define PV_D0(d0) do { s16x4 l0, l1, l2, l3, h0, h1, h2, h3; constexpr int b_ = VB * SHM_V + v_rd_off(d0, 0, 0);     \
        TRRD(l0, b_); TRRD(h0, b_ + 2048); TRRD(l1, b_ + 4096); TRRD(h1, b_ + 6144); TRRD(l2, b_ + 8192); TRRD(h2, b_ + 10240); TRRD(l3, b_ + 12288); TRRD(h3, b_ + 14336); \
        asm volatile("s_waitcnt lgkmcnt(0)" ::: "memory"); SBAR();                 \
        o[d0] = __builtin_amdgcn_mfma_f32_32x32x16_bf16(pa0, (bf16x8){l0[0], l0[1], l0[2], l0[3], h0[0], h0[1], h0[2], h0[3]}, o[d0], 0, 0, 0);   \
        o[d0] = __builtin_amdgcn_mfma_f32_32x32x16_bf16(pa1, (bf16x8){l1[0], l1[1], l1[2], l1[3], h1[0], h1[1], h1[2], h1[3]}, o[d0], 0, 0, 0);   \
        o[d0] = __builtin_amdgcn_mfma_f32_32x32x16_bf16(pa2, (bf16x8){l2[0], l2[1], l2[2], l2[3], h2[0], h2[1], h2[2], h2[3]}, o[d0], 0, 0, 0);   \
        o[d0] = __builtin_amdgcn_mfma_f32_32x32x16_bf16(pa3, (bf16x8){l3[0], l3[1], l3[2], l3[3], h3[0], h3[1], h3[2], h3[3]}, o[d0], 0, 0, 0); } while (0)
    PV_D0(0); PV_D0(1); PV_D0(2); PV_D0(3);
#undef PV_D0
#undef TRRD
}

template <class TIn, class TOut> struct BlockRef { const TIn* Q; const TIn* K; const TIn* V; TOut* O; const unsigned long long* MK; int P0; };
template <class TIn> struct Seam {
    bf16x8 qr[8];
    bf16x8 st_v0, st_v1, st_k0, st_k1; unsigned st_m; f32x4 sf0, sf1, sf2, sf3;
    f32x4 tq[16];
};
__device__ __forceinline__ int swa_jlo(int P0, int W) { const int lowk = P0 - W + 1; return lowk > 0 ? lowk / KVBLK : 0; }
#define ROW(p, k0, rr) ((p) + (size_t)(k0) * KVP + (unsigned)((rr) * KVP + sc))
#define VMW() asm volatile("s_waitcnt vmcnt(0)" ::: "memory")
#define VMWN(n) asm volatile("s_waitcnt vmcnt(%0)" :: "i"(n) : "memory")
#define SLOAD_H(Kp, Vp, Mp, k0) do { S.st_v0 = load8<TIn>(ROW(Vp, k0, sr)); S.st_v1 = load8<TIn>(ROW(Vp, k0, 32 + sr)); S.st_m = ((const unsigned*)((Mp) + (size_t)((k0) >> 6) * MKSTRIDE))[tid]; \
                         S.st_k0 = load8<TIn>(ROW(Kp, k0, sr)); S.st_k1 = load8<TIn>(ROW(Kp, k0, 32 + sr)); } while (0)
#define SWRITE_HK(bf) do { *(bf16x8*)(K_lds + (bf) * SHM_K + kws) = S.st_k0; *(bf16x8*)(K_lds + (bf) * SHM_K + kws + 32 * 256) = S.st_k1; *(unsigned*)(K_lds + 2 * SHM_K + NW * 64 * 4 + (bf) * 2048 + tid * 4) = S.st_m; } while (0)
#define SWRITE_HV(bf) do { *(bf16x8*)(V_lds + (bf) * SHM_V + vst0) = S.st_v0; *(bf16x8*)(V_lds + (bf) * SHM_V + vst1) = S.st_v1; } while (0)
#define SWRITE_H(bf) do { SWRITE_HV(bf); SWRITE_HK(bf); } while (0)
#define SLOAD_F(p, k0) do { S.sf0 = *(const f32x4*)ROW(p, k0, sr); S.sf1 = *(const f32x4*)(ROW(p, k0, sr) + 4);                \
                            S.sf2 = *(const f32x4*)ROW(p, k0, 32 + sr); S.sf3 = *(const f32x4*)(ROW(p, k0, 32 + sr) + 4); } while (0)
#define SWRITE_KF(bf) do { *(bf16x8*)(K_lds + (bf) * SHM_K + kws) = pack8(S.sf0, S.sf1); *(bf16x8*)(K_lds + (bf) * SHM_K + kws + 32 * 256) = pack8(S.sf2, S.sf3); } while (0)
#define SWRITE_VF(bf) do { *(bf16x8*)(V_lds + (bf) * SHM_V + vst0) = pack8(S.sf0, S.sf1); *(bf16x8*)(V_lds + (bf) * SHM_V + vst1) = pack8(S.sf2, S.sf3); } while (0)
template <class TIn, class TOut>
__device__ __forceinline__ void causal_swa_prime(const BlockRef<TIn, TOut>& cur, int W, char* lds, Seam<TIn>& S) {
    constexpr bool F32 = same_t<TIn, float>::v;
    const int tid = threadIdx.x, wid = __builtin_amdgcn_readfirstlane(tid >> 6), lane = tid & 63, r32 = lane & 31, hi = lane >> 5;
    const int sr = tid >> 4, sc = (tid & 15) * 8, kws = KSWZ(sr, sc * 2); char* K_lds = lds + 2 * SHM_V;
    const int kb0 = swa_jlo(cur.P0, W) * KVBLK;
    for (int d0 = 0; d0 < 8; ++d0) S.qr[d0] = load8<TIn>(cur.Q + (size_t)(wid * QBLK) * QP + (unsigned)(r32 * QP + hi * 8) + d0 * 16);
    if constexpr (F32) { SLOAD_F((const float*)cur.K, kb0); VMW(); SWRITE_KF(0); SBAR(); SLOAD_F((const float*)cur.V, kb0); }
    else { SLOAD_H(cur.K, cur.V, cur.MK, kb0); VMW(); SWRITE_HK(0); }
    __syncthreads();
}
template <class TIn, class TOut>
__device__ __forceinline__ void causal_swa_block(const BlockRef<TIn, TOut>& cur, const BlockRef<TIn, TOut>& nxt, int skv, int W, char* lds, Seam<TIn>& S) {
    constexpr bool F32 = same_t<TIn, float>::v;
    const int tid = threadIdx.x, wid = __builtin_amdgcn_readfirstlane(tid >> 6), lane = tid & 63, r32 = lane & 31, hi = lane >> 5;
    const int j_lo = swa_jlo(cur.P0, W);
    int j_hi = (cur.P0 + QB - 1) / KVBLK + 1; if (j_hi > skv / KVBLK) j_hi = skv / KVBLK;
    const int NT = j_hi - j_lo;
    const int kbn = swa_jlo(nxt.P0, W) * KVBLK;
    const int qlo = cur.P0 + wid * QBLK, qm = qlo + r32 - 4 * hi;
    char* V_lds = lds; char* K_lds = lds + 2 * SHM_V;
    float* ws = (float*)(lds + 2 * SHM_V + 2 * SHM_K) + wid * 64; float* li_l = ws, * al_l = ws + 32;
    float m_reg = -1e30f, l_reg = 0; f32x16 o[4] = {};
    const int sr = tid >> 4, sc = (tid & 15) * 8, vst0 = v_st(sr, sc), vst1 = v_st(32 + sr, sc), kws = KSWZ(sr, sc * 2);
    const int vb0 = (int)(uintptr_t)V_lds + v_rd_base(lane);
    const TIn* Kh = cur.K; const TIn* Vh = cur.V;
#define RESC(a) do { if (__any((a) < 1.f)) { if (hi == 0) al_l[r32] = (a); asm volatile("s_waitcnt lgkmcnt(0)" ::: "memory");              \
                     for (int d_ = 0; d_ < 4; ++d_) for (int r = 0; r < 16; ++r) o[d_][r] *= al_l[crow(r, hi)]; } } while (0)
#define KBASE(t) ((j_lo + (t)) * KVBLK)
#define ACT(t) (KBASE(t) <= qlo + QBLK - 1 && KBASE(t) + KVBLK - 1 >= qlo - W + 1)
#define MASKT(P0_, P1_, KB_) do { const uint2 mw_ = *(const uint2*)(K_lds + 2 * SHM_K + NW * 64 * 4 + (KB_) * 2048 + (wid * QBLK + r32) * 8); mask_bits(P0_, P1_, mw_.x, mw_.y, hi); } while (0)
    constexpr int NQL = F32 ? 16 : 8;
    constexpr bool SK = WSKIP && !F32;
#define SEAM_K0() do { VMWN(NQL); if constexpr (F32) { SWRITE_KF(0); SBAR(); SLOAD_F((const float*)nxt.V, kbn); } else { SWRITE_HK(0); } SBAR(); } while (0)
    f32x16 pA0, pA1, pB0, pB1; float mnA, mnB, alA, alB; bf16x8 pa0, pa1, pa2, pa3;
    if constexpr (F32) { VMW(); SWRITE_VF(0); SBAR(); } else { SWRITE_HV(0); SBAR(); }
    if (NT > 1) { if constexpr (F32) SLOAD_F((const float*)Kh, KBASE(1)); else SLOAD_H(Kh, Vh, cur.MK, KBASE(1)); }
    SBAR(); qkt<0, SK>(pA0, pA1, K_lds, r32, hi, S.qr, ACT(0));
    if constexpr (F32) { if (NT > 1) { VMW(); SWRITE_KF(1); SBAR(); SLOAD_F((const float*)Vh, KBASE(1)); } }
    MASKT(pA0, pA1, 0); partialSM(pA0, pA1, m_reg, mnA, alA);
    if (NT > 1) { VMW(); if constexpr (F32) { SWRITE_VF(1); SBAR(); if (NT > 2) SLOAD_F((const float*)Kh, KBASE(2)); } else SWRITE_H(1); }
    __syncthreads();
#define HALF_STEP(PX0, PX1, mnX, alX, PY0, PY1, alY, t, KB, VB, SB) do {                                                      \
        SBAR(); qkt<KB, SK>(PX0, PX1, K_lds, r32, hi, S.qr, ACT(t));                                             \
        finishSM(PY0, PY1, alY, l_reg, pa0, pa1, pa2, pa3); SBAR();                                                           \
        if ((t) + 1 < NT) { if constexpr (F32) { VMW(); SWRITE_KF(SB); SBAR(); SLOAD_F((const float*)Vh, KBASE((t) + 1)); }  \
                            else { SLOAD_H(Kh, Vh, cur.MK, KBASE((t) + 1)); } SBAR(); }                                               \
        pv_tile<VB, SK>(o, vb0, pa0, pa1, pa2, pa3, ACT((t) - 1)); MASKT(PX0, PX1, KB); partialSM(PX0, PX1, m_reg, mnX, alX);                                        \
        __syncthreads();                                                                                                      \
        if ((t) + 1 < NT) { VMW(); if constexpr (F32) { SWRITE_VF(SB); SBAR(); if ((t) + 2 < NT) SLOAD_F((const float*)Kh, KBASE((t) + 2)); } \
                            else { SWRITE_H(SB); } }                                                                          \
        RESC(alX); __syncthreads(); } while (0)
    for (int t = 1; t + 1 < NT; t += 2) {
        HALF_STEP(pB0, pB1, mnB, alB, pA0, pA1, alA, t, 1, 0, 0);
        HALF_STEP(pA0, pA1, mnA, alA, pB0, pB1, alB, t + 1, 0, 1, 1);
    }
    const bool even = (NT & 1) == 0;
    if (even) { SBAR(); qkt<1, SK>(pB0, pB1, K_lds, r32, hi, S.qr, ACT(NT - 1)); SBAR(); }
#define QROW(e) (nxt.Q + (size_t)(wid * QBLK + r32) * QP + ((e) >> 1) * 16 + hi * 8 + ((e) & 1) * 4)
    if constexpr (F32) { SLOAD_F((const float*)nxt.K, kbn); SBAR();
#pragma unroll
        for (int e = 0; e < 8; ++e) S.tq[e] = *(const f32x4*)QROW(e); }
    else { SLOAD_H(nxt.K, nxt.V, nxt.MK, kbn); SBAR();
#pragma unroll
        for (int d0 = 0; d0 < 8; ++d0) S.qr[d0] = load8<TIn>(nxt.Q + (size_t)(wid * QBLK) * QP + (unsigned)(r32 * QP + hi * 8) + d0 * 16); }
    SBAR();
    finishSM(pA0, pA1, alA, l_reg, pa0, pa1, pa2, pa3); SBAR();
    if constexpr (F32) {
#pragma unroll
        for (int e = 8; e < 16; ++e) S.tq[e] = *(const f32x4*)QROW(e); SBAR(); }
#undef QROW
    pv_tile<0, SK>(o, vb0, pa0, pa1, pa2, pa3, ACT(even ? NT - 2 : NT - 1));
    if (even) { MASKT(pB0, pB1, 1); partialSM(pB0, pB1, m_reg, mnB, alB); __syncthreads(); RESC(alB);
        finishSM(pB0, pB1, alB, l_reg, pa0, pa1, pa2, pa3); SBAR(); pv_tile<1, SK>(o, vb0, pa0, pa1, pa2, pa3, ACT(NT - 1)); }
    SBAR(); SEAM_K0();
    if (hi == 0) li_l[r32] = l_reg; asm volatile("s_waitcnt lgkmcnt(0)" ::: "memory");
    float rli[16];
#pragma unroll
    for (int r = 0; r < 16; ++r) rli[r] = __builtin_amdgcn_rcpf(li_l[crow(r, hi)]);
    TOut* Ow = cur.O + (size_t)(wid * QBLK) * OP;
    unsigned olane = (unsigned)(4 * hi * OP + r32) * 2u; asm volatile("" : "+v"(olane));
#pragma unroll
    for (int r = 0; r < 16; ++r) { const int orow = crow(r, hi);
#pragma unroll
        for (int d0 = 0; d0 < 4; ++d0) { const float v = o[d0][r] * rli[r];
            if constexpr (same_t<TOut, float>::v) { Ow[(size_t)orow * OP + d0 * 32 + r32] = v; }
            else { const float vn = __shfl_xor(v, 1);
                   if ((r32 & 1) == 0) *(unsigned*)((char*)Ow + (size_t)((((r & 3) + 8 * (r >> 2)) * OP + d0 * 32) * 2) + olane) = cvtpk(v, vn); } } }
    if constexpr (F32) {
#pragma unroll
        for (int d0 = 0; d0 < 8; ++d0) S.qr[d0] = pack8(S.tq[2 * d0], S.tq[2 * d0 + 1]); }
    __syncthreads();
#undef RESC
#undef KBASE
#undef ACT
#undef MASKT
#undef SEAM_K0
#undef HALF_STEP
}
#undef ROW
#undef VMW
#undef VMWN
#undef SLOAD_H
#undef SWRITE_HK
#undef SWRITE_HV
#undef SWRITE_H
#undef SLOAD_F
#undef SWRITE_KF
#undef SWRITE_VF

#undef KSWZ
#undef SBAR
}
constexpr int NWAVES = 8;
constexpr int T = 16384, SEQ = 8192, DM = 2048, NU = 16128, NEXP = 32;
constexpr int UC_Z = 0, UC_XBC = 2048, UC_Q = 5120, UC_K = 7168, UC_V = 9216, UC_GS = 11264, UC_GA = 13312, UC_QI = 15360, UC_KI = 15872, UC_DT = 15936, UC_WI = 15968, UC_END = 15976;
constexpr int NIN = 15976;
constexpr float EPS = 1e-5f;
constexpr int RMAX = 65536 + 32 * 256;

constexpr size_t MiB = 1u << 20;
constexpr size_t WS_CTL = 0, CTL_ZERO_BYTES = 1 * MiB;
constexpr size_t WS_WIN = 2 * MiB;
constexpr size_t WS_WSSD = 65 * MiB, WS_WATT = 73 * MiB, WS_WOUT = 81 * MiB;
constexpr size_t WS_RWT = 89 * MiB;
constexpr size_t WS_W1 = 96 * MiB;
constexpr size_t WS_W2 = 608 * MiB;
constexpr size_t WS_XN = 864 * MiB;
constexpr size_t WS_U = 928 * MiB;
constexpr size_t WS_XBC = 1432 * MiB;
constexpr size_t WS_DT = 1528 * MiB, WS_DACS = 1530 * MiB;
constexpr size_t WS_YD = 1532 * MiB;
constexpr size_t WS_STATES = 1596 * MiB;
constexpr size_t WS_PREV = 1724 * MiB;
constexpr size_t WS_S = 1788 * MiB;
constexpr size_t WS_MASK = 2300 * MiB;
constexpr size_t WS_YG = 2316 * MiB, WS_AO = 2380 * MiB;
constexpr size_t WS_TMP = 2444 * MiB;
constexpr size_t WS_MG = 2572 * MiB;
constexpr size_t WS_H1 = 2636 * MiB;
constexpr size_t WS_ROUTE = 2764 * MiB;
constexpr size_t WS_OS = 2768 * MiB;
constexpr size_t WS_END = 3056 * MiB;
constexpr size_t WS_ACT = WS_U, WS_AS = WS_S;
constexpr int CW_TMO = 0, CW_CODE = 1;
constexpr int CW_BAR = 4096;
constexpr int CW_CNT = 8192;
constexpr int CW_SSQ = 16384;
static_assert((CW_SSQ + T) * 4 <= (int)CTL_ZERO_BYTES, "CTL words inside the memset region");
constexpr int RING_OFF = 0, RING_BYTES = 131072;
constexpr int LDSCTL_OFF = RING_BYTES, MISC_OFF = LDSCTL_OFF + 320;
constexpr int TILE_E_OFF = MISC_OFF + 128;
constexpr int EOFF_OFF = TILE_E_OFF + 1280;
constexpr int HIST_OFF = EOFF_OFF + 256;
constexpr int LDS_BYTES = 147456;
static_assert(HIST_OFF + 256 <= LDS_BYTES, "LDS map");

#define GAS __attribute__((address_space(1)))
#define LAS __attribute__((address_space(3)))
typedef unsigned short bf16;
typedef unsigned v4u __attribute__((ext_vector_type(4)));
typedef unsigned v2u __attribute__((ext_vector_type(2)));
typedef float f32x4 __attribute__((ext_vector_type(4)));
typedef float f32x16 __attribute__((ext_vector_type(16)));
typedef short bf16x8 __attribute__((ext_vector_type(8)));
typedef short s16x4 __attribute__((ext_vector_type(4)));
typedef GAS unsigned gu32;
#define RLX_AGENT __ATOMIC_RELAXED, __HIP_MEMORY_SCOPE_AGENT
#define LDS_WAIT() asm volatile("s_waitcnt lgkmcnt(0)" ::: "memory")
#define VM_WAIT() asm volatile("s_waitcnt vmcnt(0)" ::: "memory")
__device__ __forceinline__ unsigned f2bf(float f) { unsigned u = __builtin_bit_cast(unsigned, f); return (u + 0x7fffu + ((u >> 16) & 1u)) >> 16; }
__device__ __forceinline__ unsigned pk2(float lo, float hi) { return f2bf(lo) | (f2bf(hi) << 16); }
__device__ __forceinline__ float bf2f(bf16 b) { return __uint_as_float(((unsigned)b) << 16); }
__device__ __forceinline__ float bflo(unsigned w) { return __uint_as_float(w << 16); }
__device__ __forceinline__ float bfhi(unsigned w) { return __uint_as_float(w & 0xffff0000u); }
__device__ __forceinline__ float siluf(float x) { return x / (1.f + __expf(-x)); }
#define XB_TMO      128
#define XB_XCNT(j)  (256  + 64 * (j))
#define XB_XSUB(j)  (1280 + 64 * (j))
#define XB_XGEN(j)  (2304 + 64 * (j))
#define XB_TOP      3328
#define XB_TOPGEN   3392
#define XCD_BAR_WORDS 3456
#define XB_SPIN_CAP (1u << 18)

__device__ __forceinline__ unsigned xb_ld(unsigned* p)              { return __hip_atomic_load(p, __ATOMIC_RELAXED, __HIP_MEMORY_SCOPE_AGENT); }
__device__ __forceinline__ unsigned xb_add(unsigned* p, unsigned v) { return __hip_atomic_fetch_add(p, v, __ATOMIC_RELAXED, __HIP_MEMORY_SCOPE_AGENT); }
__device__ __forceinline__ unsigned xb_xcc_id() { return (unsigned)__builtin_amdgcn_s_getreg((3 << 11) | 20) & 0xFu; }
#define XB_SPIN(cond, bar) do { unsigned _sp = 0; while (cond) { __builtin_amdgcn_s_sleep(1); \
    if ((++_sp & 255u) == 0u) { if (xb_ld(&(bar)[XB_TMO])) break; if (_sp > XB_SPIN_CAP) { atomicAdd(&(bar)[XB_TMO], 1u); break; } } } } while (0)

struct XcdBarrier {
    unsigned* bar; unsigned x;
    volatile LAS unsigned* st;
};

__device__ __forceinline__ XcdBarrier xcd_barrier_post(unsigned* bar, volatile LAS unsigned* st) {
    XcdBarrier b; b.bar = bar; b.x = xb_xcc_id(); b.st = st;
    if (threadIdx.x == 0) (void)xb_add(&bar[XB_XCNT(b.x)], 1u);
    return b;
}
__device__ __forceinline__ void xcd_barrier_complete(unsigned* bar, unsigned x, unsigned& nloc, unsigned& nx) {
    const unsigned G = gridDim.x * gridDim.y * gridDim.z;
    unsigned sum, cnt, mine, sp = 0u;
    for (;;) {
        sum = 0u; cnt = 0u; mine = 0u;
#pragma unroll
        for (unsigned j = 0; j < 16; ++j) { const unsigned c = xb_ld(&bar[XB_XCNT(j)]); sum += c; cnt += (c > 0u) ? 1u : 0u; mine = (j == x) ? c : mine; }
        if (sum == G) break;
        __builtin_amdgcn_s_sleep(1);
        if ((++sp & 255u) == 0u) { if (xb_ld(&bar[XB_TMO])) break; if (sp > XB_SPIN_CAP) { atomicAdd(&bar[XB_TMO], 1u); break; } }
    }
    nloc = mine > 0u ? mine : 1u; nx = cnt > 0u ? cnt : 1u;
}

__device__ __forceinline__ void xcd_barrier(const XcdBarrier& b) {
    asm volatile("s_waitcnt vmcnt(0)" ::: "memory");
    __syncthreads();
    if (threadIdx.x == 0) {
        unsigned* bar = b.bar;
        __builtin_amdgcn_s_waitcnt(0);
        unsigned nloc = b.st[0], nx = b.st[1];
        if (nloc == 0u) { xcd_barrier_complete(bar, b.x, nloc, nx); b.st[0] = nloc; b.st[1] = nx; }
        const unsigned old = xb_add(&bar[XB_XSUB(b.x)], 1u);
        const unsigned gen = old / nloc;
        if (old + 1u == (gen + 1u) * nloc) {
            __builtin_amdgcn_fence(__ATOMIC_RELEASE, "agent");
            asm volatile("s_waitcnt vmcnt(0)" ::: "memory");
            const unsigned og = xb_add(&bar[XB_TOP], 1u);
            const unsigned tg = og / nx;
            if (og + 1u == (tg + 1u) * nx) xb_add(&bar[XB_TOPGEN], 1u);
            else XB_SPIN(xb_ld(&bar[XB_TOPGEN]) == tg, bar);
            __builtin_amdgcn_fence(__ATOMIC_ACQUIRE, "agent");
            xb_add(&bar[XB_XGEN(b.x)], 1u);
            asm volatile("s_waitcnt vmcnt(0)" ::: "memory");
        } else {
            XB_SPIN(xb_ld(&bar[XB_XGEN(b.x)]) == gen, bar);
            __builtin_amdgcn_fence(__ATOMIC_ACQUIRE, "agent");
            asm volatile("s_waitcnt vmcnt(0)" ::: "memory");
        }
    }
    __syncthreads();
}


typedef const float* const __attribute__((address_space(4))) * karg_fpp;
#define INP(i) (((karg_fpp)__builtin_amdgcn_kernarg_segment_ptr())[i])
#define OUTP() ((float*)(((karg_fpp)__builtin_amdgcn_kernarg_segment_ptr())[20]))
#define WSB() ((unsigned char*)(((karg_fpp)__builtin_amdgcn_kernarg_segment_ptr())[21]))
#define WSP(type, off) ((type*)(WSB() + (off)))
#define CTLP() ((gu32*)(WSB() + WS_CTL))
struct Frame {
    LAS unsigned char* lds;
    int tid, lane, wave, vcu, G;
};

__device__ __forceinline__ float wave_sum(float v) {
#pragma unroll
    for (int o = 1; o < 64; o <<= 1) v += __shfl_xor(v, o);
    return v;
}

__device__ __forceinline__ int ucol_of_src(int n) {
    if (n < 5120) return n;
    if (n < 5152) return n - 5120 + UC_DT;
    if (n < 11296) return n - 5152 + UC_Q;
    if (n < 11808) return n - 11296 + UC_QI;
    if (n < 11872) return n - 11808 + UC_KI;
    if (n < 11880) return n - 11872 + UC_WI;
    return n - 11880 + UC_GS;
}
struct RmId { __device__ __forceinline__ int operator()(int n) const { return n; } };
struct RmIn { __device__ __forceinline__ int operator()(int n) const { return ucol_of_src(n); } };
struct RmW1 { __device__ __forceinline__ int operator()(int n) const { const int m = n & 2047; return ((m >> 7) << 8) + ((n >> 11) << 7) + (m & 127); } };
template <class RowMap>
__device__ __forceinline__ void transpose_item(const float* W, int K, int N, bf16* WT, const RowMap rm, const float* kscale, LAS float* scr, int item, int lane) {
    const int nblk = (N + 31) >> 5, kb = item / nblk, nb = item - kb * nblk, k0 = 64 * kb, n0 = 32 * nb;
    const int nl = n0 + (lane & 31); const bool nok = nl < N;
#pragma unroll 8
    for (int i = 0; i < 32; ++i) { const int kk = 2 * i + (lane >> 5); scr[kk * 33 + (lane & 31)] = nok ? W[(size_t)(k0 + kk) * N + nl] : 0.f; }
    LDS_WAIT(); asm volatile("" ::: "memory");
    const int c = lane & 7;
    float ks[8];
#pragma unroll
    for (int i = 0; i < 8; ++i) ks[i] = kscale ? kscale[k0 + 8 * c + i] : 1.f;
#pragma unroll
    for (int j = 0; j < 4; ++j) { const int n = (lane >> 3) + 8 * j; const LAS float* s = scr + (8 * c) * 33 + n;
        v4u o; o.x = pk2(s[0 * 33] * ks[0], s[1 * 33] * ks[1]); o.y = pk2(s[2 * 33] * ks[2], s[3 * 33] * ks[3]); o.z = pk2(s[4 * 33] * ks[4], s[5 * 33] * ks[5]); o.w = pk2(s[6 * 33] * ks[6], s[7 * 33] * ks[7]);
        if (n0 + n < N) *(v4u*)(WT + (size_t)rm(n0 + n) * K + k0 + 8 * c) = o; }
    LDS_WAIT(); asm volatile("" ::: "memory");
}
__device__ __forceinline__ void rms_row_to_bf16(const float* xrow, const float* w, bf16* orow, int lane) {
    const f32x4* xr = (const f32x4*)xrow + lane;
    f32x4 v[8]; float s = 0.f;
#pragma unroll
    for (int j = 0; j < 8; ++j) { v[j] = xr[64 * j]; s += (v[j].x * v[j].x + v[j].y * v[j].y) + (v[j].z * v[j].z + v[j].w * v[j].w); }
    const float rstd = 1.f / sqrtf(wave_sum(s) * (1.f / DM) + EPS);
    v2u* o8 = (v2u*)orow + lane;
#pragma unroll
    for (int j = 0; j < 8; ++j) { const f32x4 wv = ((const f32x4*)w)[lane + 64 * j]; v2u o; o.x = pk2(v[j].x * rstd * wv.x, v[j].y * rstd * wv.y); o.y = pk2(v[j].z * rstd * wv.z, v[j].w * rstd * wv.w); o8[64 * j] = o; }
}
__device__ __forceinline__ void p0_prologue(Frame& F) {
    LAS float* scr = (LAS float*)(F.lds + RING_OFF + F.wave * 16384);
    const int gw = F.vcu * NWAVES + F.wave, NGW = F.G * NWAVES;
    constexpr int I_IN = 32 * 500, I_SQ = 32 * 64, I_W1 = 32 * 128, I_W2 = 32 * 64;
    constexpr int NITEMS = I_IN + 3 * I_SQ + NEXP * I_W1 + NEXP * I_W2;
    for (int it = gw; it < NITEMS; it += NGW) {
        int r = it;
        if (r < I_IN) { transpose_item(INP(1), DM, NIN, WSP(bf16, WS_WIN), RmIn(), nullptr, scr, r, F.lane); continue; } r -= I_IN;
        if (r < I_SQ) { transpose_item(INP(8), DM, DM, WSP(bf16, WS_WSSD), RmId(), INP(7), scr, r, F.lane); continue; } r -= I_SQ;
        if (r < I_SQ) { transpose_item(INP(9), DM, DM, WSP(bf16, WS_WATT), RmId(), nullptr, scr, r, F.lane); continue; } r -= I_SQ;
        if (r < I_SQ) { transpose_item(INP(10), DM, DM, WSP(bf16, WS_WOUT), RmId(), nullptr, scr, r, F.lane); continue; } r -= I_SQ;
        if (r < NEXP * I_W1) { const int e = r / I_W1; transpose_item(INP(15) + (size_t)e * DM * 4096, DM, 4096, WSP(bf16, WS_W1) + (size_t)e * 4096 * DM, RmW1(), nullptr, scr, r - e * I_W1, F.lane); continue; } r -= NEXP * I_W1;
        { const int e = r / I_W2; transpose_item(INP(17) + (size_t)e * DM * DM, DM, DM, WSP(bf16, WS_W2) + (size_t)e * DM * DM, RmId(), nullptr, scr, r - e * I_W2, F.lane); }
    }
    { const int gt = F.vcu * (NWAVES * 64) + F.tid, NT = F.G * NWAVES * 64; v4u z = {0u, 0u, 0u, 0u};
      for (int i = gt; i < (NU - UC_END) * DM / 8; i += NT) ((v4u*)(WSP(bf16, WS_WIN) + (size_t)UC_END * DM))[i] = z;
      for (int i = gt; i < NEXP * DM; i += NT) { const int e = i >> 11, k = i & 2047; WSP(float, WS_RWT)[i] = INP(13)[(size_t)k * NEXP + e]; } }
    for (int m = gw; m < T; m += NGW) rms_row_to_bf16(INP(0) + (size_t)m * DM, INP(11), WSP(bf16, WS_XN) + (size_t)m * DM, F.lane);
}

__device__ __forceinline__ float softplusf(float x) { return x > 20.f ? x : log1pf(expf(x)); }
__device__ __forceinline__ void p2_prep(Frame& F) {
    const int gt = F.vcu * (NWAVES * 64) + F.tid, NT = F.G * NWAVES * 64;
    const int gw = F.vcu * NWAVES + F.wave, NGW = F.G * NWAVES, lane = F.lane;
    for (int it = gt; it < (T / 32) * 384; it += NT) {
        const int ch = it % 384, seg = it / 384, t0 = seg * 32, c0 = ch * 8;
        float w[4][8], cb[8], h0[8], h1[8], h2[8];
#pragma unroll
        for (int j = 0; j < 4; ++j) { const f32x4 a = *(const f32x4*)(INP(2) + j * 3072 + c0), b = *(const f32x4*)(INP(2) + j * 3072 + c0 + 4);
            w[j][0] = a.x; w[j][1] = a.y; w[j][2] = a.z; w[j][3] = a.w; w[j][4] = b.x; w[j][5] = b.y; w[j][6] = b.z; w[j][7] = b.w; }
        { const f32x4 a = *(const f32x4*)(INP(3) + c0), b = *(const f32x4*)(INP(3) + c0 + 4); cb[0] = a.x; cb[1] = a.y; cb[2] = a.z; cb[3] = a.w; cb[4] = b.x; cb[5] = b.y; cb[6] = b.z; cb[7] = b.w; }
        const bool first = (t0 % SEQ) == 0;
        const bf16* src = WSP(bf16, WS_U) + (size_t)t0 * NU + UC_XBC + c0;
        v4u r0 = {0u, 0u, 0u, 0u}, r1 = r0, r2 = r0;
        if (!first) { r0 = *(const v4u*)(src - 3 * (size_t)NU); r1 = *(const v4u*)(src - 2 * (size_t)NU); r2 = *(const v4u*)(src - (size_t)NU); }
#define UNPK(dst, r) do { dst[0] = bflo(r.x); dst[1] = bfhi(r.x); dst[2] = bflo(r.y); dst[3] = bfhi(r.y); dst[4] = bflo(r.z); dst[5] = bfhi(r.z); dst[6] = bflo(r.w); dst[7] = bfhi(r.w); } while (0)
        UNPK(h0, r0); UNPK(h1, r1); UNPK(h2, r2);
        bf16* dst = WSP(bf16, WS_XBC) + (size_t)t0 * 3072 + c0;
#pragma unroll 4
        for (int t = 0; t < 32; ++t) {
            const v4u rc = *(const v4u*)(src + (size_t)t * NU); float cur[8], o[8]; UNPK(cur, rc);
#pragma unroll
            for (int i = 0; i < 8; ++i) { const float a = cb[i] + w[0][i] * h0[i] + w[1][i] * h1[i] + w[2][i] * h2[i] + w[3][i] * cur[i]; o[i] = siluf(a); h0[i] = h1[i]; h1[i] = h2[i]; h2[i] = cur[i]; }
            v4u ov; ov.x = pk2(o[0], o[1]); ov.y = pk2(o[2], o[3]); ov.z = pk2(o[4], o[5]); ov.w = pk2(o[6], o[7]);
            *(v4u*)(dst + (size_t)t * 3072) = ov;
        }
#undef UNPK
    }
    for (int ck = gw; ck < T / 128; ck += NGW) {
        const int h = lane & 31, half = lane >> 5; const float bias = INP(4)[h], a = -expf(INP(5)[h]);
        const int t0 = ck * 128 + half * 64; float tot = 0.f;
#pragma unroll 8
        for (int i = 0; i < 64; ++i) { const float dt = softplusf(bf2f(WSP(bf16, WS_U)[(size_t)(t0 + i) * NU + UC_DT + h]) + bias); tot += dt * a; }
        const float tot0 = __shfl(tot, h);
        float run = half ? tot0 : 0.f;
#pragma unroll 8
        for (int i = 0; i < 64; ++i) { const float dt = softplusf(bf2f(WSP(bf16, WS_U)[(size_t)(t0 + i) * NU + UC_DT + h]) + bias); run += dt * a; WSP(float, WS_DT)[(size_t)(t0 + i) * 32 + h] = dt; WSP(float, WS_DACS)[(size_t)(t0 + i) * 32 + h] = run; }
    }
    for (int t = gw; t < T; t += NGW) {
        const float pos = (float)(t % SEQ);
        bf16* row = WSP(bf16, WS_U) + (size_t)t * NU;
        { const int i = lane & 15; const float inv = powf(500000.0f, -(float)i * (1.0f / 16.0f)); float sn, cs; sincosf(pos * inv, &sn, &cs);
#pragma unroll
          for (int j = 0; j < 8; ++j) { const int hd = (lane >> 4) + 4 * j;
              bf16* p = row + (hd < 16 ? UC_Q + hd * 128 : UC_K + (hd - 16) * 128) + i;
              const float x1 = bf2f(p[0]), x2 = bf2f(p[16]); p[0] = (bf16)f2bf(x1 * cs - x2 * sn); p[16] = (bf16)f2bf(x2 * cs + x1 * sn); } }
        { const int i = lane & 7; const float inv = powf(500000.0f, -(float)i * (1.0f / 8.0f)); float sn, cs; sincosf(pos * inv, &sn, &cs);
          { bf16* p = row + UC_QI + (lane >> 3) * 64 + i; const float x1 = bf2f(p[0]), x2 = bf2f(p[8]); p[0] = (bf16)f2bf(x1 * cs - x2 * sn); p[8] = (bf16)f2bf(x2 * cs + x1 * sn); }
          if (lane < 8) { bf16* p = row + UC_KI + i; const float x1 = bf2f(p[0]), x2 = bf2f(p[8]); p[0] = (bf16)f2bf(x1 * cs - x2 * sn); p[8] = (bf16)f2bf(x2 * cs + x1 * sn); } }
    }
}

__device__ __forceinline__ int crow16(int r, int hi) { return (r & 3) + 8 * (r >> 2) + 4 * hi; }
__device__ __forceinline__ bf16x8 lds_b128(const LAS unsigned char* p) { return *(const LAS bf16x8*)p; }
__device__ __forceinline__ bf16x8 lds_tr8(const LAS unsigned char* p, int rowstep4) {
    typedef short v4i16_t __attribute__((ext_vector_type(4)));
    const v4i16_t a = __builtin_amdgcn_ds_read_tr16_b64_v4i16((LAS v4i16_t*)p);
    const v4i16_t b = __builtin_amdgcn_ds_read_tr16_b64_v4i16((LAS v4i16_t*)(p + rowstep4));
    return (bf16x8){a[0], a[1], a[2], a[3], b[0], b[1], b[2], b[3]};
}
constexpr int SP_C = 272, SP_X = 144;
constexpr int S_CS = 0, S_BS = 34816, S_XS = 69632, S_XW = 88064, S_VEC = 106496;
__device__ __forceinline__ void p3_ssd_unit(Frame& F, int u) {
    const int tid = F.tid, lane = F.lane, w = F.wave, r32 = lane & 31, hh = lane >> 5;
    const int h = u & 31, bc = u >> 5, g = h >> 3; const size_t t0 = (size_t)bc * 128;
    LAS unsigned char* L = F.lds + RING_OFF;
    LAS float* dacs = (LAS float*)(L + S_VEC); LAS float* dtv = dacs + 128;
    const float da_last = WSP(float, WS_DACS)[(t0 + 127) * 32 + h];
#pragma unroll
    for (int i = 0; i < 4; ++i) { const int idx = tid + 512 * i, row = idx >> 4, ch = idx & 15; const bf16* src = WSP(bf16, WS_XBC) + (t0 + row) * 3072 + 2048 + g * 128 + ch * 8;
        *(LAS v4u*)(L + S_BS + row * SP_C + ch * 16) = *(const v4u*)src; *(LAS v4u*)(L + S_CS + row * SP_C + ch * 16) = *(const v4u*)(src + 512); }
#pragma unroll
    for (int i = 0; i < 2; ++i) { const int idx = tid + 512 * i, row = idx >> 3, ch = idx & 7; const v4u xv = *(const v4u*)(WSP(bf16, WS_XBC) + (t0 + row) * 3072 + h * 64 + ch * 8);
        const float wl = WSP(float, WS_DT)[(t0 + row) * 32 + h] * __expf(da_last - WSP(float, WS_DACS)[(t0 + row) * 32 + h]);
        *(LAS v4u*)(L + S_XS + row * SP_X + ch * 16) = xv;
        v4u xw; xw.x = pk2(bflo(xv.x) * wl, bfhi(xv.x) * wl); xw.y = pk2(bflo(xv.y) * wl, bfhi(xv.y) * wl); xw.z = pk2(bflo(xv.z) * wl, bfhi(xv.z) * wl); xw.w = pk2(bflo(xv.w) * wl, bfhi(xv.w) * wl);
        *(LAS v4u*)(L + S_XW + row * SP_X + ch * 16) = xw; }
    if (tid < 128) { dacs[tid] = WSP(float, WS_DACS)[(t0 + tid) * 32 + h]; dtv[tid] = WSP(float, WS_DT)[(t0 + tid) * 32 + h]; }
    __syncthreads();
    const int li = w >> 1;
    f32x16 acc0 = {}, acc1 = {};
    { const int j0 = (w & 1) * 2;
      const LAS unsigned char* cp = L + S_CS + (32 * li + r32) * SP_C + hh * 16;
      if (j0 <= li) { const LAS unsigned char* bp = L + S_BS + (32 * j0 + r32) * SP_C + hh * 16;
#pragma unroll
          for (int ks = 0; ks < 8; ++ks) acc0 = __builtin_amdgcn_mfma_f32_32x32x16_bf16(lds_b128(bp + ks * 32), lds_b128(cp + ks * 32), acc0, 0, 0, 0); }
      if (j0 + 1 <= li) { const LAS unsigned char* bp = L + S_BS + (32 * (j0 + 1) + r32) * SP_C + hh * 16;
#pragma unroll
          for (int ks = 0; ks < 8; ++ks) acc1 = __builtin_amdgcn_mfma_f32_32x32x16_bf16(lds_b128(bp + ks * 32), lds_b128(cp + ks * 32), acc1, 0, 0, 0); } }
    __syncthreads();
    { const int j0 = (w & 1) * 2, l = 32 * li + r32; const float dl = dacs[l];
#pragma unroll
      for (int jj = 0; jj < 2; ++jj) { const int sj = j0 + jj; if (sj <= li) {
#pragma unroll
          for (int q = 0; q < 4; ++q) { float gv[4];
#pragma unroll
              for (int e = 0; e < 4; ++e) { const int s = 32 * sj + 8 * q + 4 * hh + e; const float a = jj ? acc1[4 * q + e] : acc0[4 * q + e];
                  gv[e] = (s <= l) ? a * __expf(dl - dacs[s]) * dtv[s] : 0.f; }
              v2u o; o.x = pk2(gv[0], gv[1]); o.y = pk2(gv[2], gv[3]);
              *(LAS v2u*)(L + S_CS + l * SP_C + (32 * sj + 8 * q + 4 * hh) * 2) = o; } } } }
    __syncthreads();
    { const int pb = w & 1; f32x16 acc = {};
      const LAS unsigned char* gp = L + S_CS + (32 * li + r32) * SP_C + hh * 16;
      const LAS unsigned char* xp = L + S_XS + (8 * hh + ((lane & 15) >> 2)) * SP_X + (32 * pb + 16 * ((lane >> 4) & 1) + 4 * (lane & 3)) * 2;
      for (int ks = 0; ks < 2 * (li + 1); ++ks) acc = __builtin_amdgcn_mfma_f32_32x32x16_bf16(lds_b128(gp + ks * 32), lds_tr8(xp + ks * 16 * SP_X, 4 * SP_X), acc, 0, 0, 0);
      bf16* yd = WSP(bf16, WS_YD) + (t0 + 32 * li) * 2048 + h * 64 + 32 * pb + r32;
#pragma unroll
      for (int r = 0; r < 16; ++r) yd[(size_t)crow16(r, hh) * 2048] = (bf16)f2bf(acc[r]); }
    { const int pb = w >> 2, nb = w & 3; f32x16 acc = {};
      const int trow = 8 * hh + ((lane & 15) >> 2), tcol = 16 * ((lane >> 4) & 1) + 4 * (lane & 3);
      const LAS unsigned char* ap = L + S_XW + trow * SP_X + (32 * pb + tcol) * 2;
      const LAS unsigned char* bp = L + S_BS + trow * SP_C + (32 * nb + tcol) * 2;
#pragma unroll
      for (int ks = 0; ks < 8; ++ks) acc = __builtin_amdgcn_mfma_f32_32x32x16_bf16(lds_tr8(ap + ks * 16 * SP_X, 4 * SP_X), lds_tr8(bp + ks * 16 * SP_C, 4 * SP_C), acc, 0, 0, 0);
      float* st = WSP(float, WS_STATES) + ((size_t)u * 64 + 32 * pb) * 128 + 32 * nb + r32;
#pragma unroll
      for (int r = 0; r < 16; ++r) st[(size_t)crow16(r, hh) * 128] = acc[r]; }
    __syncthreads();
}
constexpr int IX_Q = 0, IX_W = 32768;
__device__ __forceinline__ void p3_index_group(Frame& F, int b, int qg) {
    const int tid = F.tid, lane = F.lane, r32 = lane & 31, hh = lane >> 5;
    LAS unsigned char* L = F.lds + RING_OFF; LAS float* wl = (LAS float*)(L + IX_W);
    const bf16* Ub = WSP(bf16, WS_U) + ((size_t)b * SEQ) * NU;
#pragma unroll
    for (int i = 0; i < 4; ++i) { const int pc = tid + 512 * i, ln = pc & 63, ks = (pc >> 6) & 3, h8 = pc >> 8;
        *(LAS v4u*)(L + IX_Q + pc * 16) = *(const v4u*)(Ub + (size_t)(qg * 32 + (ln & 31)) * NU + UC_QI + h8 * 64 + ks * 16 + 8 * (ln >> 5)); }
    if (tid < 256) { const int h8 = tid >> 5, q = tid & 31; wl[tid] = bf2f(Ub[(size_t)(qg * 32 + q) * NU + UC_WI + h8]) * 0.044194173824159216f; }
    __syncthreads();
    float wq[8];
#pragma unroll
    for (int h8 = 0; h8 < 8; ++h8) wq[h8] = wl[h8 * 32 + r32];
    for (int kt = F.wave; kt <= qg; kt += NWAVES) {
        const bf16* krow = Ub + (size_t)(kt * 32 + r32) * NU + UC_KI + 8 * hh;
        bf16x8 kf[4];
#pragma unroll
        for (int ks = 0; ks < 4; ++ks) kf[ks] = *(const bf16x8*)(krow + ks * 16);
        f32x16 sc = {};
        int qoff = lane * 16; asm volatile("" : "+v"(qoff));
#pragma unroll
        for (int h8 = 0; h8 < 8; ++h8) { f32x16 a = {};
#pragma unroll
            for (int ks = 0; ks < 4; ++ks) a = __builtin_amdgcn_mfma_f32_32x32x16_bf16(kf[ks], lds_b128(L + IX_Q + (h8 * 4 + ks) * 1024 + qoff), a, 0, 0, 0);
#pragma unroll
            for (int e = 0; e < 16; ++e) sc[e] += wq[h8] * fmaxf(a[e], 0.f); }
        float* srow = WSP(float, WS_S) + ((size_t)b * SEQ + qg * 32 + r32) * SEQ + kt * 32 + 4 * hh;
#pragma unroll
        for (int q = 0; q < 4; ++q) *(f32x4*)(srow + 8 * q) = (f32x4){sc[4 * q], sc[4 * q + 1], sc[4 * q + 2], sc[4 * q + 3]};
    }
    __syncthreads();
}
__device__ __forceinline__ void p3_phase(Frame& F) {
#ifndef NO_P3A
    for (int u = F.vcu; u < 2 * 64 * 32; u += F.G) p3_ssd_unit(F, u);
#endif
#ifndef NO_P3B
    for (int it = F.vcu; it < 256; it += F.G) { const int b = it >> 7, x = it & 127; p3_index_group(F, b, x); p3_index_group(F, b, 255 - x); }
#endif
}

__device__ __forceinline__ unsigned fkey(float v) { if (v == 0.f) v = 0.f; const unsigned u = __float_as_uint(v); return (u & 0x80000000u) ? ~u : (u | 0x80000000u); }
__device__ __forceinline__ int wave_sum_i(int v) {
#pragma unroll
    for (int o = 1; o < 64; o <<= 1) v += __shfl_xor(v, o);
    return v;
}
template <int NI>
__device__ __forceinline__ void select_row(const float* Srow, int pos, unsigned long long* Mq, int ntw, int lane) {
    const int ni = (pos >> 6) + 1;
    unsigned key[NI];
#pragma unroll
    for (int i = 0; i < NI; ++i) { key[i] = 0u; if (i < ni) { const int kidx = i * 64 + lane; key[i] = (kidx <= pos) ? fkey(Srow[kidx]) : 0u; } if ((i & 15) == 15) __builtin_amdgcn_sched_barrier(0); }
    unsigned lo = 0u, hi = 0xFFFFFFFFu; int clo = 0x7fffffff;
    while (hi - lo > 1u) {
        const unsigned mid = lo + ((hi - lo) >> 1); int cl = 0;
#pragma unroll
        for (int i = 0; i < NI; ++i) cl += (key[i] >= mid) ? 1 : 0;
        const int c = wave_sum_i(cl);
        if (c >= 256) { lo = mid; clo = c; if (c == 256) break; } else hi = mid;
    }
    int need = 0x7fffffff;
    if (clo != 256) { int cl = 0;
#pragma unroll
        for (int i = 0; i < NI; ++i) cl += (key[i] > lo) ? 1 : 0;
        need = 256 - wave_sum_i(cl); }
    int run = 0;
#pragma unroll
    for (int i = 0; i < NI; ++i) {
        const bool eq = key[i] == lo; const unsigned long long be = __ballot(eq);
        const int pre = run + __popcll(be & ((1ull << lane) - 1ull)); run += __popcll(be);
        const unsigned long long bal = __ballot((key[i] > lo) || (eq && pre < need));
        if (i < ntw && lane == 0) Mq[(size_t)i * SEQ] = bal;
        __builtin_amdgcn_sched_barrier(0);
    }
}
__device__ __forceinline__ void p4_phase(Frame& F) {
    const int gt = F.vcu * (NWAVES * 64) + F.tid, NT = F.G * NWAVES * 64;
    const int gw = F.vcu * NWAVES + F.wave, NGW = F.G * NWAVES, lane = F.lane;
#ifndef NO_P4A
    for (int it = gt; it < 2 * 32 * 64 * 32; it += NT) {
        const int n4 = it & 31, p = (it >> 5) & 63, h = (it >> 11) & 31, b = it >> 16;
        f32x4 hs = {0.f, 0.f, 0.f, 0.f};
#pragma unroll 8
        for (int c = 0; c < 64; ++c) { const size_t idx = ((size_t)(b * 64 + c) * 32 + h), off = (idx * 64 + p) * 128 + n4 * 4;
            const f32x4 st = *(const f32x4*)(WSP(float, WS_STATES) + off); const float dec = __expf(WSP(float, WS_DACS)[((size_t)(b * 64 + c) * 128 + 127) * 32 + h]);
            v2u o; o.x = pk2(hs.x, hs.y); o.y = pk2(hs.z, hs.w); *(v2u*)(WSP(bf16, WS_PREV) + off) = o;
            hs = hs * dec + st; }
    }
#endif
    for (int q = gw; q < T; q += NGW) {
        const int b = q >> 13, pos = q & (SEQ - 1), ntw = 4 * ((pos >> 8) + 1);
        unsigned long long* Mq = WSP(unsigned long long, WS_MASK) + (size_t)b * 128 * SEQ + pos;
        if (pos < 256) { if (lane < ntw) { const int d = pos - 64 * lane; Mq[(size_t)lane * SEQ] = d >= 63 ? ~0ull : (d < 0 ? 0ull : ((2ull << d) - 1ull)); } }
        else { const float* Srow = WSP(float, WS_S) + (size_t)q * SEQ; const int ni = (pos >> 6) + 1;
            if (ni <= 32) select_row<32>(Srow, pos, Mq, ntw, lane); else if (ni <= 64) select_row<64>(Srow, pos, Mq, ntw, lane);
            else if (ni <= 96) select_row<96>(Srow, pos, Mq, ntw, lane); else select_row<128>(Srow, pos, Mq, ntw, lane); }
    }
}

constexpr int S5_CS = 0, S5_PS = 34816, S5_VEC = 52224;
__device__ __forceinline__ void p5_ssd_unit(Frame& F, int u) {
    const int tid = F.tid, lane = F.lane, w = F.wave, r32 = lane & 31, hh = lane >> 5;
    const int h = u & 31, bc = u >> 5, g = h >> 3; const size_t t0 = (size_t)bc * 128;
    LAS unsigned char* L = F.lds + RING_OFF; LAS float* dacs = (LAS float*)(L + S5_VEC);
#pragma unroll
    for (int i = 0; i < 4; ++i) { const int idx = tid + 512 * i, row = idx >> 4, ch = idx & 15;
        *(LAS v4u*)(L + S5_CS + row * SP_C + ch * 16) = *(const v4u*)(WSP(bf16, WS_XBC) + (t0 + row) * 3072 + 2560 + g * 128 + ch * 8); }
#pragma unroll
    for (int i = 0; i < 2; ++i) { const int idx = tid + 512 * i, row = idx >> 4, ch = idx & 15;
        *(LAS v4u*)(L + S5_PS + row * SP_C + ch * 16) = *(const v4u*)(WSP(bf16, WS_PREV) + ((size_t)u * 64 + row) * 128 + ch * 8); }
    if (tid < 128) dacs[tid] = WSP(float, WS_DACS)[(t0 + tid) * 32 + h];
    __syncthreads();
    const int li = w >> 1, pb = w & 1; f32x16 acc = {};
    { const LAS unsigned char* cp = L + S5_CS + (32 * li + r32) * SP_C + hh * 16; const LAS unsigned char* pp = L + S5_PS + (32 * pb + r32) * SP_C + hh * 16;
#pragma unroll
      for (int ks = 0; ks < 8; ++ks) acc = __builtin_amdgcn_mfma_f32_32x32x16_bf16(lds_b128(cp + ks * 32), lds_b128(pp + ks * 32), acc, 0, 0, 0); }
    const float dsk = INP(6)[h]; const int col = h * 64 + 32 * pb + r32;
#pragma unroll
    for (int r = 0; r < 16; ++r) { const int l = 32 * li + crow16(r, hh); const size_t t = t0 + l;
        const float y = bf2f(WSP(bf16, WS_YD)[t * 2048 + col]) + acc[r] * __expf(dacs[l]) + bf2f(WSP(bf16, WS_XBC)[t * 3072 + col]) * dsk;
        const float yg = y * siluf(bf2f(WSP(bf16, WS_U)[t * NU + UC_Z + col]));
        WSP(bf16, WS_YG)[t * 2048 + col] = (bf16)f2bf(yg);
        float ss = yg * yg;
#pragma unroll
        for (int o = 1; o < 32; o <<= 1) ss += __shfl_xor(ss, o);
        if (r32 == 0) atomicAdd((WSP(float, WS_CTL) + CW_SSQ) + t, ss); }
    __syncthreads();
}

typedef att::BlockRef<att::bf16, att::bf16> ABlk;
__device__ __forceinline__ ABlk att_ref(const bf16* U, bf16* AO, const unsigned long long* MASK, int L, int pass) {
    const int bh = L >> 4, x = L & 15, qb = pass ? 31 - x : x, b = bh >> 4, hd = bh & 15;
    ABlk r;
    r.Q = (const att::bf16*)(U + ((size_t)b * SEQ + qb * 256) * NU + UC_Q + hd * 128);
    r.K = (const att::bf16*)(U + ((size_t)b * SEQ) * NU + UC_K + hd * 128);
    r.V = (const att::bf16*)(U + ((size_t)b * SEQ) * NU + UC_V + hd * 128);
    r.O = (att::bf16*)(AO + ((size_t)b * SEQ + qb * 256) * 2048 + hd * 128);
    r.MK = MASK + (size_t)b * 128 * SEQ + qb * 256;
    r.P0 = qb * 256;
    return r;
}
__device__ __forceinline__ void p5_attention(Frame& F) {
    constexpr int NITEM = 512;
    int L = F.vcu; if (L >= NITEM) return;
    const bf16* U = WSP(bf16, WS_U); bf16* AO = WSP(bf16, WS_AO); const unsigned long long* MK = WSP(unsigned long long, WS_MASK); const int stride = F.G;
    char* lds = (char*)(F.lds + RING_OFF);
    int pass = 0;
    ABlk cur = att_ref(U, AO, MK, L, 0);
    att::Seam<att::bf16> S;
    att::causal_swa_prime<att::bf16, att::bf16>(cur, SEQ, lds, S);
    for (;;) {
        const bool more_pass = pass == 0, more_item = L + stride < NITEM, last = !more_pass && !more_item;
        int passn = pass + 1, Ln = L;
        if (!more_pass) { passn = 0; Ln = more_item ? L + stride : L; }
        const ABlk nxt = last ? cur : att_ref(U, AO, MK, Ln, passn);
        att::causal_swa_block<att::bf16, att::bf16>(cur, nxt, SEQ, SEQ, lds, S);
        if (last) break;
        cur = nxt; pass = passn; L = Ln;
    }
}

__device__ __forceinline__ void p9_route(Frame& F) {
    const int lane = F.lane, wave = F.wave, tid = F.tid;
    LAS int* hist = (LAS int*)(F.lds + HIST_OFF); LAS int* base = hist + 32;
    const int ngrp = T / 4, nrounds = (ngrp + F.G * NWAVES - 1) / (F.G * NWAVES);
    for (int rd = 0; rd < nrounds; ++rd) {
        const int grp = (rd * F.G + F.vcu) * NWAVES + wave; const bool valid = grp < ngrp;
        if (tid < 32) hist[tid] = 0;
        __syncthreads();
        if (valid) {
            f32x4 xn[4][8];
#pragma unroll
            for (int tk = 0; tk < 4; ++tk) { const size_t tok = (size_t)grp * 4 + tk; const f32x4* xr = (const f32x4*)(WSP(float, WS_H1) + tok * DM) + lane; float s = 0.f;
#pragma unroll
                for (int j = 0; j < 8; ++j) { xn[tk][j] = xr[64 * j]; s += (xn[tk][j].x * xn[tk][j].x + xn[tk][j].y * xn[tk][j].y) + (xn[tk][j].z * xn[tk][j].z + xn[tk][j].w * xn[tk][j].w); }
                const float rstd = 1.f / sqrtf(wave_sum(s) * (1.f / DM) + EPS);
                v2u* o8 = (v2u*)(WSP(bf16, WS_XN) + tok * DM) + lane;
#pragma unroll
                for (int j = 0; j < 8; ++j) { const f32x4 wv = ((const f32x4*)INP(12))[lane + 64 * j]; xn[tk][j] = xn[tk][j] * rstd * wv;
                    v2u o; o.x = pk2(xn[tk][j].x, xn[tk][j].y); o.y = pk2(xn[tk][j].z, xn[tk][j].w); o8[64 * j] = o; } }
            float lg[2] = {0.f, 0.f};
            for (int e = 0; e < NEXP; ++e) {
                float p0 = 0.f, p1 = 0.f, p2 = 0.f, p3 = 0.f; const f32x4* rw = (const f32x4*)(WSP(float, WS_RWT) + (size_t)e * DM) + lane;
#pragma unroll
                for (int j = 0; j < 8; ++j) { const f32x4 r = rw[64 * j];
                    p0 += (xn[0][j].x * r.x + xn[0][j].y * r.y) + (xn[0][j].z * r.z + xn[0][j].w * r.w); p1 += (xn[1][j].x * r.x + xn[1][j].y * r.y) + (xn[1][j].z * r.z + xn[1][j].w * r.w);
                    p2 += (xn[2][j].x * r.x + xn[2][j].y * r.y) + (xn[2][j].z * r.z + xn[2][j].w * r.w); p3 += (xn[3][j].x * r.x + xn[3][j].y * r.y) + (xn[3][j].z * r.z + xn[3][j].w * r.w); }
                p0 = wave_sum(p0); p1 = wave_sum(p1); p2 = wave_sum(p2); p3 = wave_sum(p3);
                const float bb = INP(14)[e];
                if ((lane & 31) == e) { lg[0] = ((lane >> 5) ? p1 : p0) + bb; lg[1] = ((lane >> 5) ? p3 : p2) + bb; }
            }
#pragma unroll
            for (int jj = 0; jj < 2; ++jj) {
                float v = lg[jj]; float tv[4]; int ti[4];
#pragma unroll
                for (int k = 0; k < 4; ++k) { float bv = v; int bi = lane & 31;
#pragma unroll
                    for (int o = 1; o < 32; o <<= 1) { const float ov = __shfl_xor(bv, o); const int oi = __shfl_xor(bi, o); if (ov > bv || (ov == bv && oi < bi)) { bv = ov; bi = oi; } }
                    tv[k] = bv; ti[k] = bi; if ((lane & 31) == bi) v = -__builtin_inff(); }
                const float e0 = 1.f, e1 = expf(tv[1] - tv[0]), e2 = expf(tv[2] - tv[0]), e3 = expf(tv[3] - tv[0]); const float inv = 1.f / (e0 + e1 + e2 + e3);
                const int slot = lane & 31;
                if (slot < 4) { const int ee = slot == 0 ? ti[0] : slot == 1 ? ti[1] : slot == 2 ? ti[2] : ti[3]; const float ww = (slot == 0 ? e0 : slot == 1 ? e1 : slot == 2 ? e2 : e3) * inv;
                    const int lr = __hip_atomic_fetch_add(hist + ee, 1, __ATOMIC_RELAXED, __HIP_MEMORY_SCOPE_WORKGROUP);
                    const int tok = grp * 4 + 2 * jj + (lane >> 5);
                    WSP(int, WS_ROUTE)[tok * 4 + slot] = ee; WSP(float, WS_ROUTE + 256 * 1024)[tok * 4 + slot] = ww; WSP(int, WS_ROUTE + 512 * 1024)[tok * 4 + slot] = lr; }
            }
        }
        VM_WAIT();
        __syncthreads();
        if (tid < 32) { const int c = hist[tid]; base[tid] = c ? (int)__hip_atomic_fetch_add((unsigned*)(CTLP() + CW_CNT + 64 * tid), (unsigned)c, RLX_AGENT) : 0; }
        __syncthreads();
        if (valid && (lane & 31) < 4) {
#pragma unroll
            for (int jj = 0; jj < 2; ++jj) { const int tok = grp * 4 + 2 * jj + (lane >> 5), i = tok * 4 + (lane & 31); WSP(int, WS_ROUTE + 512 * 1024)[i] = WSP(int, WS_ROUTE + 512 * 1024)[i] + base[WSP(int, WS_ROUTE)[i]]; } }
        __syncthreads();
    }
}

__device__ __forceinline__ void moe_offsets(Frame& F) {
    LAS int* eoff = (LAS int*)(F.lds + EOFF_OFF); LAS int* tile_e = (LAS int*)(F.lds + TILE_E_OFF);
    __syncthreads();
    if (F.tid == 0) { int o = 0; for (int e = 0; e < NEXP; ++e) { eoff[e] = o; const int c = (int)__hip_atomic_load((unsigned*)(CTLP() + CW_CNT + 64 * e), RLX_AGENT); o += (c + 255) & ~255; } eoff[32] = o; eoff[33] = o >> 8; }
    __syncthreads();
    if (F.tid < NEXP) { for (int t = eoff[F.tid] >> 8; t < (eoff[F.tid + 1] >> 8); ++t) tile_e[t] = F.tid; }
    __syncthreads();
}
__device__ __forceinline__ void p10_sort(Frame& F) {
    const int gw = F.vcu * NWAVES + F.wave, NGW = F.G * NWAVES, lane = F.lane;
    LAS int* eoff = (LAS int*)(F.lds + EOFF_OFF);
    moe_offsets(F);
    for (int tok = gw; tok < T; tok += NGW) {
        const v4u* src = (const v4u*)(WSP(bf16, WS_XN) + (size_t)tok * DM) + lane; v4u v[4];
#pragma unroll
        for (int j = 0; j < 4; ++j) v[j] = src[64 * j];
#pragma unroll
        for (int s = 0; s < 4; ++s) { const int e = WSP(int, WS_ROUTE)[tok * 4 + s], row = eoff[e] + WSP(int, WS_ROUTE + 512 * 1024)[tok * 4 + s];
            v4u* dst = (v4u*)(WSP(bf16, WS_AS) + (size_t)row * DM) + lane;
#pragma unroll
            for (int j = 0; j < 4; ++j) dst[64 * j] = v[j];
            if (lane == 0) { WSP(float, WS_ROUTE + 1024 * 1024)[row] = WSP(float, WS_ROUTE + 256 * 1024)[tok * 4 + s]; WSP(int, WS_ROUTE + 768 * 1024)[tok * 4 + s] = row; } }
    }
    for (int e = 0; e < NEXP; ++e) { const int cnt = (int)__hip_atomic_load((unsigned*)(CTLP() + CW_CNT + 64 * e), RLX_AGENT), r0 = eoff[e] + cnt, npad = eoff[e + 1] - r0; const v4u z = {0u, 0u, 0u, 0u};
        for (int r = gw; r < npad; r += NGW) { v4u* dst = (v4u*)(WSP(bf16, WS_AS) + (size_t)(r0 + r) * DM) + lane;
#pragma unroll
            for (int j = 0; j < 4; ++j) dst[64 * j] = z;
            if (lane == 0) WSP(float, WS_ROUTE + 1024 * 1024)[r0 + r] = 0.f; } }
}

__device__ __forceinline__ void p13_final(Frame& F) {
    const int gw = F.vcu * NWAVES + F.wave, NGW = F.G * NWAVES, lane = F.lane;
    for (int tok = gw; tok < T; tok += NGW) {
        const f32x4* hr = (const f32x4*)(WSP(float, WS_H1) + (size_t)tok * DM) + lane; f32x4 v[8];
#pragma unroll
        for (int j = 0; j < 8; ++j) v[j] = hr[64 * j];
#pragma unroll
        for (int s = 0; s < 4; ++s) { const int row = WSP(int, WS_ROUTE + 768 * 1024)[tok * 4 + s]; const v2u* orow = (const v2u*)(WSP(bf16, WS_OS) + (size_t)row * DM) + lane;
#pragma unroll
            for (int j = 0; j < 8; ++j) { const v2u o = orow[64 * j]; v[j].x += bflo(o.x); v[j].y += bfhi(o.x); v[j].z += bflo(o.y); v[j].w += bfhi(o.y); } }
        float ssum = 0.f;
#pragma unroll
        for (int j = 0; j < 8; ++j) ssum += (v[j].x * v[j].x + v[j].y * v[j].y) + (v[j].z * v[j].z + v[j].w * v[j].w);
        const float rstd = 1.f / sqrtf(wave_sum(ssum) * (1.f / DM) + EPS);
        f32x4* orow = (f32x4*)(OUTP() + (size_t)tok * DM) + lane;
#pragma unroll
        for (int j = 0; j < 8; ++j) orow[64 * j] = v[j] * rstd * ((const f32x4*)INP(19))[lane + 64 * j];
    }
}

constexpr int NPHASE = 14;
struct Args { const float* in[20]; float* out; unsigned char* ws; int ph_lo, ph_hi, li, pad; };
__global__ void __launch_bounds__(NWAVES * 64, 2) hybrid_fwd(Args args) {
    extern __shared__ __attribute__((aligned(16))) unsigned char lds[];
    Frame F;
    F.lds = (LAS unsigned char*)lds;
    F.tid = threadIdx.x; F.lane = F.tid & 63; F.wave = __builtin_amdgcn_readfirstlane(F.tid >> 6);
    F.G = gridDim.x; { const int bx = blockIdx.x; F.vcu = (F.G % 8 == 0) ? (bx % 8) * (F.G / 8) + bx / 8 : bx; }
    for (int u = F.tid; u < (LDS_BYTES - LDSCTL_OFF) / 4; u += NWAVES * 64) ((LAS unsigned*)(F.lds + LDSCTL_OFF))[u] = 0u;
    __syncthreads();
    XcdBarrier bar = xcd_barrier_post((unsigned*)(CTLP() + CW_BAR) + args.li * XCD_BAR_WORDS, (volatile LAS unsigned*)(F.lds + MISC_OFF) + 8);
    const int lo = args.ph_lo, hi = args.ph_hi;
#ifndef PH_MASK
#define PH_MASK 0xFFFFFFFFu
#endif
#define IN(k) (((PH_MASK >> (k)) & 1u) && lo <= (k) && (k) < hi)
#define SEAM(k) do { if (IN(k) && IN((k) + 1)) xcd_barrier(bar); } while (0)

    if (IN(0)) { p0_prologue(F); } SEAM(0);
    if (IN(1)) { pg8::Gemm g{WSP(bf16, WS_XN), WSP(bf16, WS_WIN), T, NU, DM}; pg8::StaticOrder S; S.init(T, NU, F.G, (int)blockIdx.x); pg8::EpiU E{WSP(bf16, WS_U), NU};
        pg8::gemm_phase<pg8::EpiU, pg8::StaticOrder, true, true>(F.lds + RING_OFF, g, S, E); } SEAM(1);
    if (IN(2)) { p2_prep(F); } SEAM(2);
    if (IN(3)) { p3_phase(F); } SEAM(3);
    if (IN(4)) { p4_phase(F); } SEAM(4);
    if (IN(5)) {
#ifndef NO_P5A
        for (int u = F.vcu; u < 2 * 64 * 32; u += F.G) p5_ssd_unit(F, u);
#endif
#ifndef NO_P5B
        p5_attention(F);
#endif
    } SEAM(5);
    if (IN(6)) { pg8::Gemm g{WSP(bf16, WS_YG), WSP(bf16, WS_WSSD), T, DM, DM}; pg8::StaticOrder S; S.init(T, DM, F.G, (int)blockIdx.x); pg8::EpiSsd E{WSP(float, WS_TMP), WSP(bf16, WS_U) + UC_GS, NU, (WSP(float, WS_CTL) + CW_SSQ)};
        pg8::gemm_phase<pg8::EpiSsd, pg8::StaticOrder, true, true>(F.lds + RING_OFF, g, S, E); } SEAM(6);
    if (IN(7)) { pg8::Gemm g{WSP(bf16, WS_AO), WSP(bf16, WS_WATT), T, DM, DM}; pg8::StaticOrder S; S.init(T, DM, F.G, (int)blockIdx.x); pg8::EpiAttn E{WSP(bf16, WS_MG), WSP(float, WS_TMP), WSP(bf16, WS_U) + UC_GA, NU};
        pg8::gemm_phase<pg8::EpiAttn, pg8::StaticOrder, true, true>(F.lds + RING_OFF, g, S, E); } SEAM(7);
    if (IN(8)) { pg8::Gemm g{WSP(bf16, WS_MG), WSP(bf16, WS_WOUT), T, DM, DM}; pg8::StaticOrder S; S.init(T, DM, F.G, (int)blockIdx.x); pg8::EpiOut E{WSP(float, WS_H1), INP(0)};
        pg8::gemm_phase<pg8::EpiOut, pg8::StaticOrder, true, true>(F.lds + RING_OFF, g, S, E); } SEAM(8);
    if (IN(9)) { p9_route(F); } SEAM(9);
    if (IN(10)) { p10_sort(F); } SEAM(10);
    if (IN(11)) { moe_offsets(F); const int ntiles = ((LAS int*)(F.lds + EOFF_OFF))[33];
        pg8::Gemm g{WSP(bf16, WS_AS), WSP(bf16, WS_W1), ntiles * 256, 4096, DM}; pg8::GroupedOrder S; S.init(ntiles, 16, F.G, (int)blockIdx.x, (const LAS int*)(F.lds + TILE_E_OFF)); pg8::EpiSwiglu E{WSP(bf16, WS_ACT), INP(16)};
        pg8::gemm_phase<pg8::EpiSwiglu, pg8::GroupedOrder, true, true>(F.lds + RING_OFF, g, S, E); } SEAM(11);
    if (IN(12)) { moe_offsets(F); const int ntiles = ((LAS int*)(F.lds + EOFF_OFF))[33];
        pg8::Gemm g{WSP(bf16, WS_ACT), WSP(bf16, WS_W2), ntiles * 256, DM, DM}; pg8::GroupedOrder S; S.init(ntiles, 8, F.G, (int)blockIdx.x, (const LAS int*)(F.lds + TILE_E_OFF)); pg8::EpiMoeOut E{WSP(bf16, WS_OS), INP(18), WSP(float, WS_ROUTE + 1024 * 1024)};
        pg8::gemm_phase<pg8::EpiMoeOut, pg8::GroupedOrder, true, true>(F.lds + RING_OFF, g, S, E); } SEAM(12);
    if (IN(13)) { p13_final(F); }
#undef IN
#undef SEAM
}

#ifndef MK_CUTS
#define MK_CUTS 0
#endif
extern "C" void kernel_launch(void* const* d_in, const int* in_sizes, int n_in, void* d_out, int out_size, void* d_ws, size_t ws_size, hipStream_t stream) {
    static int grid = 0;
    if (grid == 0) {
        if (n_in != 20 || in_sizes[0] != T * DM || out_size != T * DM || ws_size < WS_END) { fprintf(stderr, "kernel_launch: unexpected shapes (n_in %d, in0 %d, out %d, ws %zu); nothing launched\n", n_in, n_in > 0 ? in_sizes[0] : -1, out_size, ws_size); grid = -1; return; }
        int dev = 0, cus = 0, per_cu = 0;
        if (hipGetDevice(&dev) != hipSuccess || hipDeviceGetAttribute(&cus, hipDeviceAttributeMultiprocessorCount, dev) != hipSuccess) { grid = -1; return; }
        if (hipFuncSetAttribute((const void*)hybrid_fwd, hipFuncAttributeMaxDynamicSharedMemorySize, LDS_BYTES) != hipSuccess) { fprintf(stderr, "kernel_launch: hipFuncSetAttribute failed\n"); grid = -1; return; }
        if (hipOccupancyMaxActiveBlocksPerMultiprocessor(&per_cu, (const void*)hybrid_fwd, NWAVES * 64, LDS_BYTES) != hipSuccess || per_cu < 1) fprintf(stderr, "kernel_launch: occupancy query reports %d\n", per_cu);
        (void)hipGetLastError();
        grid = cus;
    }
    if (grid < 0) return;
    if (hipMemsetAsync((char*)d_ws + WS_CTL, 0, CTL_ZERO_BYTES, stream) != hipSuccess) { fprintf(stderr, "kernel_launch: memset failed\n"); return; }
    Args a{};
    for (int i = 0; i < 20; ++i) a.in[i] = (const float*)d_in[i];
    a.out = (float*)d_out; a.ws = (unsigned char*)d_ws; a.pad = 0;
#if MK_CUTS
    for (int p = 0; p < NPHASE; ++p) { a.ph_lo = p; a.ph_hi = p + 1; a.li = 0; hipLaunchKernelGGL(hybrid_fwd, dim3(grid), dim3(NWAVES * 64), LDS_BYTES, stream, a); }
#else
    a.ph_lo = 0; a.ph_hi = NPHASE; a.li = 0;
    hipLaunchKernelGGL(hybrid_fwd, dim3(grid), dim3(NWAVES * 64), LDS_BYTES, stream, a);
#endif
    const hipError_t le = hipPeekAtLastError();
    if (le != hipSuccess) fprintf(stderr, "kernel_launch: launch failed: %s\n", hipGetErrorName(le));
}
```

```cpp
#include <hip/hip_runtime.h>
#include <hip/hip_bf16.h>
#include <cstdio>
#include <cstdint>
namespace pg8 {
#define PG8_LAS __attribute__((address_space(3)))
typedef unsigned short bf16_t;
typedef short bf16x8 __attribute__((ext_vector_type(8)));
typedef float f32x4 __attribute__((ext_vector_type(4)));
typedef unsigned u32x4 __attribute__((ext_vector_type(4)));
constexpr int BM = 256, BK = 64, HALF = 128, HTB = HALF * BK * 2  , STAGE_BYTES = 8 * HTB, NXCD = 8, WGM = 8;

__host__ __device__ __forceinline__ int lds_byte(int r, int c) { const int st = (r >> 4) * 2 + (c >> 5), rr = r & 15, cc = c & 31, ob = rr * 64 + cc * 2; return st * 1024 + (ob ^ (((ob >> 9) & 1) << 5)); }
__host__ __device__ __forceinline__ void stage_rc(int b, int& R, int& C) { const int st = b / 1024, sb = b % 1024, swz = sb ^ (((sb >> 9) & 1) << 5); R = (st >> 1) * 16 + swz / 64; C = (st & 1) * 32 + (swz % 64) / 2; }
__host__ __device__ __forceinline__ int perm32(int rho) { const int n = rho >> 4, i = rho & 15; return 8 * (i >> 2) + 4 * n + (i & 3); }

struct Unit { int pm, pn, pb, src; };
struct Gemm { const bf16_t* A; const bf16_t* Bt; int M, N, K; const bf16_t* A2; const bf16_t* Bt2; };

struct StaticOrder {
    int nM, nN, nwg, G, c;
    __host__ __device__ void init(int M, int N, int G_, int c_) { nM = M / BM; nN = N / BM; nwg = nM * nN; G = G_; c = c_; }
    __host__ __device__ __forceinline__ bool next(int i, Unit& u) const {
        const long L = (long)i * G + c; if (L >= nwg) return false;
        int wgid = (int)L; { const int q = nwg / NXCD, r = nwg % NXCD, xcd = wgid % NXCD, off = wgid / NXCD; wgid = (xcd < r ? xcd * (q + 1) : r * (q + 1) + (xcd - r) * q) + off; }
        const int nig = WGM * nN, gid = wgid / nig, fm = gid * WGM, gsz = (nM - fm) < WGM ? (nM - fm) : WGM;
        u.pm = fm + ((wgid % nig) % gsz); u.pn = (wgid % nig) / gsz; u.pb = u.pn; u.src = 0; return true;
    }
    __device__ __forceinline__ void a_ready(const Unit&) const {}
    __device__ __forceinline__ void done(const Unit&) const {}
};


typedef int v8i32 __attribute__((ext_vector_type(8)));
__device__ __forceinline__ bf16x8 lo8(v8i32 v) { typedef int v4i32 __attribute__((ext_vector_type(4))); return __builtin_bit_cast(bf16x8, (v4i32){v[0], v[1], v[2], v[3]}); }
__device__ __forceinline__ bf16x8 hi8(v8i32 v) { typedef int v4i32 __attribute__((ext_vector_type(4))); return __builtin_bit_cast(bf16x8, (v4i32){v[4], v[5], v[6], v[7]}); }
__device__ __forceinline__ v8i32 cat8(bf16x8 a, bf16x8 b) { typedef int v4i32 __attribute__((ext_vector_type(4))); const v4i32 x = __builtin_bit_cast(v4i32, a), y = __builtin_bit_cast(v4i32, b); return (v8i32){x[0], x[1], x[2], x[3], y[0], y[1], y[2], y[3]}; }
template <class Epi, class Sched, bool ALIGN_EPI = false, bool SP2 = false, bool F8 = false>
__device__ __forceinline__ void gemm_phase(PG8_LAS unsigned char* lds, const Gemm g, const Sched& S, const Epi& E) {
    const int tid = threadIdx.x, wid = __builtin_amdgcn_readfirstlane(tid >> 6), lane = tid & 63, wr = wid >> 2, wc = wid & 3, fr = lane & 15, fq = lane >> 4;
    const int K = g.K, nt = K / BK;
    unsigned voffA[2], voffB[2];
#pragma unroll
    for (int i = 0; i < 2; ++i) { int R, C; stage_rc(tid * 16 + i * 8192, R, C); const int Rb = Epi::PERM ? ((R & ~31) + perm32(R & 31)) : R;
        voffA[i] = (unsigned)(R * K + C) * 2u; voffB[i] = (unsigned)(Rb * K + C) * 2u; }
    const size_t kstep = (size_t)(BK * 2);
    const size_t hstep = (size_t)HALF * K * 2;
    const size_t tstep = 2 * hstep;
    const unsigned ldsw = (unsigned)wid * 1024u;
    const int aoff = lds_byte(wr * 64 + fr, fq * 8), boff = lds_byte(wc * 32 + fr, fq * 8);
#define PG8_SA(b, h) (((b) * 2 + (h)) * HTB)
#define PG8_SB(b, h) ((4 + (b) * 2 + (h)) * HTB)
#define PG8_STAGE(bufoff, gbase, voff) do { _Pragma("unroll") for (int _i = 0; _i < 2; ++_i) \
        __builtin_amdgcn_global_load_lds((const unsigned*)((const char*)(gbase) + (voff)[_i]), (PG8_LAS unsigned*)(lds + (bufoff) + ldsw + _i * 8192), 16, 0, 0); } while (0)
#define PG8_LDA(dst, b, h) do { _Pragma("unroll") for (int m = 0; m < 4; ++m) dst[m] = cat8(*(const PG8_LAS bf16x8*)(lds + PG8_SA(b, h) + aoff + m * 2048), *(const PG8_LAS bf16x8*)(lds + PG8_SA(b, h) + aoff + m * 2048 + 1024)); } while (0)
#define PG8_LDB(dst, b, h) do { _Pragma("unroll") for (int n = 0; n < 2; ++n) dst[n] = cat8(*(const PG8_LAS bf16x8*)(lds + PG8_SB(b, h) + boff + n * 2048), *(const PG8_LAS bf16x8*)(lds + PG8_SB(b, h) + boff + n * 2048 + 1024)); } while (0)
#define PG8_MMA(ai, bj, At, Bt) do { __builtin_amdgcn_s_setprio(1); _Pragma("unroll") for (int m = 0; m < 4; ++m) _Pragma("unroll") for (int n = 0; n < 2; ++n) { \
        if constexpr (F8) asm volatile("v_mfma_scale_f32_16x16x128_f8f6f4 %0, %1, %2, %0, %3, %3 op_sel_hi:[0,0,0]" : "+v"(acc[ai][bj][m][n]) : "v"(Bt[n]), "v"(At[m]), "v"(f8scale)); \
        else { acc[ai][bj][m][n] = __builtin_amdgcn_mfma_f32_16x16x32_bf16(lo8(Bt[n]), lo8(At[m]), acc[ai][bj][m][n], 0, 0, 0); acc[ai][bj][m][n] = __builtin_amdgcn_mfma_f32_16x16x32_bf16(hi8(Bt[n]), hi8(At[m]), acc[ai][bj][m][n], 0, 0, 0); } } __builtin_amdgcn_s_setprio(0); } while (0)
#define PG8_WAIT_V(n) asm volatile("s_waitcnt vmcnt(" #n ")" ::: "memory")
#define PG8_WAIT_L(n) asm volatile("s_waitcnt lgkmcnt(" #n ")" ::: "memory")
#define PG8_BAR __builtin_amdgcn_s_barrier()
#define PG8_SCHED __builtin_amdgcn_sched_barrier(0)
    Unit cur, nxt; int ui = 0;
    if (!S.next(0, cur)) return;
    f32x4 acc[2][2][4][2];
#pragma unroll
    for (int a = 0; a < 2; ++a)
#pragma unroll
        for (int b = 0; b < 2; ++b)
#pragma unroll
            for (int m = 0; m < 4; ++m)
#pragma unroll
                for (int n = 0; n < 2; ++n) { acc[a][b][m][n] = (f32x4){0.f, 0.f, 0.f, 0.f}; if constexpr (F8) asm volatile("" : "+v"(acc[a][b][m][n])); }
    int f8scale = 0x7f7f7f7f; if constexpr (F8) asm volatile("" : "+v"(f8scale));
    v8i32 At[4], B0[2], B1[2];
    const char* cA = (const char*)(cur.src ? g.A2 : g.A) + (size_t)cur.pm * tstep; const char* cB = (const char*)(cur.src ? g.Bt2 : g.Bt) + (size_t)cur.pb * tstep;
    S.a_ready(cur);
    if constexpr (SP2) {
        PG8_STAGE(PG8_SB(0, 0), cB, voffB); PG8_STAGE(PG8_SB(0, 1), cB + hstep, voffB); PG8_STAGE(PG8_SA(0, 0), cA, voffA); PG8_STAGE(PG8_SA(0, 1), cA + hstep, voffA);
        if (wr == 1) PG8_BAR;
        PG8_WAIT_V(2); PG8_BAR;
        PG8_STAGE(PG8_SB(1, 0), cB + kstep, voffB); PG8_STAGE(PG8_SA(1, 0), cA + kstep, voffA); PG8_STAGE(PG8_SB(1, 1), cB + hstep + kstep, voffB);
        PG8_WAIT_V(6); PG8_BAR;
    } else {
        PG8_STAGE(PG8_SB(0, 0), cB, voffB); PG8_STAGE(PG8_SA(0, 0), cA, voffA); PG8_STAGE(PG8_SB(0, 1), cB + hstep, voffB); PG8_STAGE(PG8_SA(0, 1), cA + hstep, voffA);
        if (wr == 1) PG8_BAR;
        PG8_WAIT_V(4); PG8_BAR;
        PG8_STAGE(PG8_SB(1, 0), cB + kstep, voffB); PG8_STAGE(PG8_SA(1, 0), cA + kstep, voffA); PG8_STAGE(PG8_SB(1, 1), cB + hstep + kstep, voffB);
        PG8_WAIT_V(6); PG8_BAR;
    }
    for (;;) {
        const bool has_next = S.next(ui + 1, nxt);
        const char* nA = has_next ? (const char*)(nxt.src ? g.A2 : g.A) + (size_t)nxt.pm * tstep : cA; const char* nB = has_next ? (const char*)(nxt.src ? g.Bt2 : g.Bt) + (size_t)nxt.pb * tstep : cB;
        for (int t = 0; t < nt; t += 2) {
            const bool last = (t == nt - 2);
            const char* a1 = cA + (size_t)(t + 1) * kstep;
            const char* a2 = last ? nA : cA + (size_t)(t + 2) * kstep; const char* b2 = last ? nB : cB + (size_t)(t + 2) * kstep;
            const char* a3 = a2 + kstep; const char* b3 = b2 + kstep;
            if (last && has_next) S.a_ready(nxt);
            if constexpr (SP2) {
            PG8_LDB(B0, 0, 0); PG8_LDB(B1, 0, 1); PG8_SCHED; PG8_LDA(At, 0, 0); PG8_STAGE(PG8_SA(1, 1), a1 + hstep, voffA);
            PG8_WAIT_V(8); PG8_WAIT_L(0); PG8_BAR; PG8_MMA(0, 0, At, B0); PG8_MMA(0, 1, At, B1); PG8_BAR; PG8_SCHED;
            PG8_LDA(At, 0, 1); PG8_STAGE(PG8_SB(0, 0), b2, voffB); PG8_STAGE(PG8_SB(0, 1), b2 + hstep, voffB); PG8_STAGE(PG8_SA(0, 0), a2, voffA);
            PG8_WAIT_V(8); PG8_WAIT_L(0); PG8_BAR; PG8_MMA(1, 0, At, B0); PG8_MMA(1, 1, At, B1); PG8_BAR; PG8_SCHED;
            PG8_LDB(B0, 1, 0); PG8_LDB(B1, 1, 1); PG8_SCHED; PG8_LDA(At, 1, 0); PG8_STAGE(PG8_SA(0, 1), a2 + hstep, voffA);
            PG8_WAIT_V(8); PG8_WAIT_L(0); PG8_BAR; PG8_MMA(0, 0, At, B0); PG8_MMA(0, 1, At, B1); PG8_BAR; PG8_SCHED;
            PG8_LDA(At, 1, 1); PG8_STAGE(PG8_SB(1, 0), b3, voffB); PG8_STAGE(PG8_SB(1, 1), b3 + hstep, voffB); PG8_STAGE(PG8_SA(1, 0), a3, voffA);
            PG8_WAIT_V(8); PG8_WAIT_L(0); PG8_BAR; PG8_MMA(1, 0, At, B0); PG8_MMA(1, 1, At, B1); PG8_BAR; PG8_SCHED;
            } else {
            PG8_LDB(B0, 0, 0); PG8_SCHED; PG8_LDA(At, 0, 0); PG8_STAGE(PG8_SA(1, 1), a1 + hstep, voffA);
            PG8_WAIT_L(8); PG8_BAR; PG8_WAIT_L(0); PG8_MMA(0, 0, At, B0); PG8_BAR; PG8_SCHED;
            PG8_LDB(B1, 0, 1); PG8_STAGE(PG8_SB(0, 0), b2, voffB);
            PG8_BAR; PG8_WAIT_L(0); PG8_MMA(0, 1, At, B1); PG8_BAR;
            PG8_LDA(At, 0, 1); PG8_STAGE(PG8_SA(0, 0), a2, voffA);
            PG8_BAR; PG8_WAIT_L(0); PG8_MMA(1, 0, At, B0); PG8_BAR; PG8_SCHED;
            PG8_STAGE(PG8_SB(0, 1), b2 + hstep, voffB);
            PG8_WAIT_V(6); PG8_BAR; PG8_MMA(1, 1, At, B1); PG8_BAR;
            PG8_LDB(B0, 1, 0); PG8_SCHED; PG8_LDA(At, 1, 0); PG8_STAGE(PG8_SA(0, 1), a2 + hstep, voffA);
            PG8_WAIT_L(8); PG8_BAR; PG8_WAIT_L(0); PG8_MMA(0, 0, At, B0); PG8_BAR; PG8_SCHED;
            PG8_LDB(B1, 1, 1); PG8_STAGE(PG8_SB(1, 0), b3, voffB);
            PG8_BAR; PG8_WAIT_L(0); PG8_MMA(0, 1, At, B1); PG8_BAR;
            PG8_LDA(At, 1, 1); PG8_STAGE(PG8_SA(1, 0), a3, voffA);
            PG8_BAR; PG8_WAIT_L(0); PG8_MMA(1, 0, At, B0); PG8_BAR; PG8_SCHED;
            PG8_STAGE(PG8_SB(1, 1), b3 + hstep, voffB);
            PG8_WAIT_V(6); PG8_BAR; PG8_MMA(1, 1, At, B1); PG8_BAR;
            }
        }
        if constexpr (ALIGN_EPI) { if (wr == 0) PG8_BAR; }
        if constexpr (F8) asm volatile("s_nop 15\n\ts_nop 15" ::: "memory");
#ifdef DOUBLE_EPI
        if constexpr (!Epi::AFTER_DRAIN && !Epi::CHAIN && Epi::ID == DOUBLE_EPI) { E(acc, cur, wr, wc, fr, fq); asm volatile("" ::: "memory"); }
#endif
        if constexpr (!Epi::AFTER_DRAIN) { E(acc, cur, wr, wc, fr, fq); S.done(cur); }
        if (!has_next) break;
        if (!(Epi::CHAIN && cur.src == 0))
#pragma unroll
        for (int a = 0; a < 2; ++a)
#pragma unroll
            for (int b = 0; b < 2; ++b)
#pragma unroll
                for (int m = 0; m < 4; ++m)
#pragma unroll
                    for (int n = 0; n < 2; ++n) { acc[a][b][m][n] = (f32x4){0.f, 0.f, 0.f, 0.f}; if constexpr (F8) asm volatile("" : "+v"(acc[a][b][m][n])); }
        cur = nxt; cA = nA; cB = nB; ++ui;
        if constexpr (ALIGN_EPI) { if (wr == 1) PG8_BAR; }
    }
    PG8_WAIT_V(0);
    if constexpr (!ALIGN_EPI) { if (wr == 0) PG8_BAR; }
    PG8_BAR;
    if constexpr (Epi::AFTER_DRAIN) { E.fused(acc, cur, wr, wc, fr, fq, lds, wid, lane); S.done(cur); }
#undef PG8_SA
#undef PG8_SB
#undef PG8_STAGE
#undef PG8_LDA
#undef PG8_LDB
#undef PG8_MMA
#undef PG8_WAIT_V
#undef PG8_WAIT_L
#undef PG8_BAR
#undef PG8_SCHED
}
}

#ifdef NANCHK_ON
#define NANCHK(cond, id) do { if (cond) atomicAdd((unsigned*)(((const float* const __attribute__((address_space(4)))*)__builtin_amdgcn_kernarg_segment_ptr())[21]) + 12288 + 64 * (id), 1u); } while (0)
#else
#define NANCHK(cond, id) do { } while (0)
#endif
namespace pg8 {
typedef unsigned u32x2 __attribute__((ext_vector_type(2)));
__device__ __forceinline__ unsigned cvt_pk_bf16(float lo, float hi) { unsigned r; asm volatile("v_cvt_pk_bf16_f32 %0, %1, %2" : "=v"(r) : "v"(lo), "v"(hi)); return r; }
__device__ __forceinline__ float bf_lo(unsigned w) { return __uint_as_float(w << 16); }
__device__ __forceinline__ float bf_hi(unsigned w) { return __uint_as_float(w & 0xffff0000u); }
__device__ __forceinline__ float frcp(float x) { return __builtin_amdgcn_rcpf(x); }
__device__ __forceinline__ float sigm(float x) { return frcp(1.f + __expf(-x)); }

struct GroupedOrder {
    int nM, nN, nwg, G, c; const PG8_LAS int* tile_e;
    __device__ void init(int ntiles, int nN_, int G_, int c_, const PG8_LAS int* te) { nM = ntiles; nN = nN_; nwg = nM * nN; G = G_; c = c_; tile_e = te; }
    __device__ __forceinline__ bool next(int i, Unit& u) const {
        const long L = (long)i * G + c; if (L >= nwg) return false;
        int wgid = (int)L; { const int q = nwg / NXCD, r = nwg % NXCD, xcd = wgid % NXCD, off = wgid / NXCD; wgid = (xcd < r ? xcd * (q + 1) : r * (q + 1) + (xcd - r) * q) + off; }
        const int nig = WGM * nN, gid = wgid / nig, fm = gid * WGM, gsz = (nM - fm) < WGM ? (nM - fm) : WGM;
        u.pm = fm + ((wgid % nig) % gsz); u.pn = (wgid % nig) / gsz; u.pb = tile_e[u.pm] * nN + u.pn; u.src = 0; return true;
    }
    __device__ __forceinline__ void a_ready(const Unit&) const {}
    __device__ __forceinline__ void done(const Unit&) const {}
};

struct EpiU {
    static constexpr bool PERM = true, AFTER_DRAIN = false, CHAIN = false; static constexpr int ID = 1;
    bf16_t* O; int ldc;
    __device__ __forceinline__ void operator()(const f32x4 (&acc)[2][2][4][2], const Unit& u, int wr, int wc, int fr, int fq) const {
        NANCHK((acc[0][0][0][0][0] != acc[0][0][0][0][0]) || (acc[1][1][3][1][3] != acc[1][1][3][1][3]) || (acc[0][1][2][0][1] != acc[0][1][2][0][1]) || (acc[1][0][1][1][2] != acc[1][0][1][1][2]), 2);
        const int row0 = u.pm * BM + wr * 64 + fr, col0 = u.pn * BM + wc * 32 + 8 * fq;
#pragma unroll
        for (int ai = 0; ai < 2; ++ai)
#pragma unroll
            for (int m = 0; m < 4; ++m) { bf16_t* rowp = O + (size_t)(row0 + ai * HALF + m * 16) * ldc + col0;
#pragma unroll
                for (int bj = 0; bj < 2; ++bj) { const f32x4 v0 = acc[ai][bj][m][0], v1 = acc[ai][bj][m][1];
                    u32x4 w; w.x = cvt_pk_bf16(v0[0], v0[1]); w.y = cvt_pk_bf16(v0[2], v0[3]); w.z = cvt_pk_bf16(v1[0], v1[1]); w.w = cvt_pk_bf16(v1[2], v1[3]);
                    *(u32x4*)(rowp + bj * HALF) = w; } }
    }
};
struct EpiSsd {
    static constexpr bool PERM = false, AFTER_DRAIN = false, CHAIN = false; static constexpr int ID = 90;
    float* TMP; const bf16_t* G; int ldg; const PG8_LAS float* tab; const PG8_LAS int* tpm;
    __device__ __forceinline__ void operator()(const f32x4 (&acc)[2][2][4][2], const Unit& u, int wr, int wc, int fr, int fq) const {
        NANCHK((acc[0][0][0][0][0] != acc[0][0][0][0][0]) || (acc[1][1][3][1][3] != acc[1][1][3][1][3]) || (acc[0][1][2][0][1] != acc[0][1][2][0][1]) || (acc[1][0][1][1][2] != acc[1][0][1][1][2]), 3);
        const int row0 = u.pm * BM + wr * 64 + fr, col0 = u.pn * BM + wc * 32 + 4 * fq;
        const int slot = tpm[0] == u.pm ? 0 : (tpm[1] == u.pm ? 1 : (tpm[2] == u.pm ? 2 : 3));
#pragma unroll
        for (int ai = 0; ai < 2; ++ai)
#pragma unroll
            for (int m = 0; m < 4; ++m) { const int row = row0 + ai * HALF + m * 16; const float rs = tab[slot * 256 + (row & 255)];
#pragma unroll
                for (int bj = 0; bj < 2; ++bj)
#pragma unroll
                    for (int n = 0; n < 2; ++n) { const int c = col0 + bj * HALF + n * 16; const u32x2 g = *(const u32x2*)(G + (size_t)row * ldg + c);
                        const f32x4 a = acc[ai][bj][m][n]; f32x4 o;
                        o[0] = a[0] * rs * sigm(bf_lo(g.x)); o[1] = a[1] * rs * sigm(bf_hi(g.x)); o[2] = a[2] * rs * sigm(bf_lo(g.y)); o[3] = a[3] * rs * sigm(bf_hi(g.y));
                        *(f32x4*)(TMP + (size_t)row * 2048 + c) = o; } }
    }
};
struct EpiAttn {
    static constexpr bool PERM = true, AFTER_DRAIN = false, CHAIN = false; static constexpr int ID = 91;
    bf16_t* MG; const float* TMP; const bf16_t* G; int ldg;
    __device__ __forceinline__ void operator()(const f32x4 (&acc)[2][2][4][2], const Unit& u, int wr, int wc, int fr, int fq) const {
        NANCHK((acc[0][0][0][0][0] != acc[0][0][0][0][0]) || (acc[1][1][3][1][3] != acc[1][1][3][1][3]) || (acc[0][1][2][0][1] != acc[0][1][2][0][1]) || (acc[1][0][1][1][2] != acc[1][0][1][1][2]), 4);
        const int row0 = u.pm * BM + wr * 64 + fr, col0 = u.pn * BM + wc * 32 + 8 * fq;
#pragma unroll
        for (int ai = 0; ai < 2; ++ai)
#pragma unroll
            for (int m = 0; m < 4; ++m) { const int row = row0 + ai * HALF + m * 16;
#pragma unroll
                for (int bj = 0; bj < 2; ++bj) { const int c = col0 + bj * HALF; const u32x4 g = *(const u32x4*)(G + (size_t)row * ldg + c);
                    const f32x4 t0 = *(const f32x4*)(TMP + (size_t)row * 2048 + c), t1 = *(const f32x4*)(TMP + (size_t)row * 2048 + c + 4);
                    const f32x4 a0 = acc[ai][bj][m][0], a1 = acc[ai][bj][m][1];
                    u32x4 w;
                    w.x = cvt_pk_bf16(t0[0] + a0[0] * sigm(bf_lo(g.x)), t0[1] + a0[1] * sigm(bf_hi(g.x)));
                    w.y = cvt_pk_bf16(t0[2] + a0[2] * sigm(bf_lo(g.y)), t0[3] + a0[3] * sigm(bf_hi(g.y)));
                    w.z = cvt_pk_bf16(t1[0] + a1[0] * sigm(bf_lo(g.z)), t1[1] + a1[1] * sigm(bf_hi(g.z)));
                    w.w = cvt_pk_bf16(t1[2] + a1[2] * sigm(bf_lo(g.w)), t1[3] + a1[3] * sigm(bf_hi(g.w)));
                    *(u32x4*)(MG + (size_t)row * 2048 + c) = w; } }
    }
};
struct ChainOrder {
    StaticOrder base;
    __device__ __forceinline__ bool next(int i, Unit& u) const { if (!base.next(i >> 1, u)) return false; u.src = i & 1; return true; }
    __device__ __forceinline__ void a_ready(const Unit&) const {}
    __device__ __forceinline__ void done(const Unit&) const {}
};
struct EpiMerge {
    static constexpr bool PERM = true, AFTER_DRAIN = false, CHAIN = true; static constexpr int ID = 6;
    bf16_t* MG; const bf16_t* GS; const bf16_t* GA; int ldg; const PG8_LAS float* tab; const PG8_LAS int* tpm;
    __device__ __forceinline__ void operator()(f32x4 (&acc)[2][2][4][2], const Unit& u, int wr, int wc, int fr, int fq) const {
        const int row0 = u.pm * BM + wr * 64 + fr, col0 = u.pn * BM + wc * 32 + 8 * fq;
        const int slot = tpm[0] == u.pm ? 0 : (tpm[1] == u.pm ? 1 : (tpm[2] == u.pm ? 2 : 3));
#pragma unroll
        for (int ai = 0; ai < 2; ++ai) {
            u32x4 gav[4][2], gsv[4][2];
#pragma unroll
            for (int m = 0; m < 4; ++m)
#pragma unroll
                for (int bj = 0; bj < 2; ++bj) { const size_t o = (size_t)(row0 + ai * HALF + m * 16) * ldg + col0 + bj * HALF; gav[m][bj] = *(const u32x4*)(GA + o); gsv[m][bj] = (u32x4){0u, 0u, 0u, 0u}; }
            if (u.src == 0) {
#pragma unroll
                for (int m = 0; m < 4; ++m)
#pragma unroll
                    for (int bj = 0; bj < 2; ++bj) gsv[m][bj] = *(const u32x4*)(GS + (size_t)(row0 + ai * HALF + m * 16) * ldg + col0 + bj * HALF); }
            __builtin_amdgcn_sched_barrier(0);
#pragma unroll
            for (int m = 0; m < 4; ++m) { const int row = row0 + ai * HALF + m * 16;
#pragma unroll
                for (int bj = 0; bj < 2; ++bj) { const int c = col0 + bj * HALF; const u32x4 ga = gav[m][bj];
                    float ea[8] = {1.f + __expf(-bf_lo(ga.x)), 1.f + __expf(-bf_hi(ga.x)), 1.f + __expf(-bf_lo(ga.y)), 1.f + __expf(-bf_hi(ga.y)), 1.f + __expf(-bf_lo(ga.z)), 1.f + __expf(-bf_hi(ga.z)), 1.f + __expf(-bf_lo(ga.w)), 1.f + __expf(-bf_hi(ga.w))};
                    f32x4& a0 = acc[ai][bj][m][0]; f32x4& a1 = acc[ai][bj][m][1];
                    if (u.src == 0) { const float rs = tab[slot * 256 + (row & 255)]; const u32x4 gs = gsv[m][bj];
                        a0[0] *= rs * ea[0] * sigm(bf_lo(gs.x)); a0[1] *= rs * ea[1] * sigm(bf_hi(gs.x)); a0[2] *= rs * ea[2] * sigm(bf_lo(gs.y)); a0[3] *= rs * ea[3] * sigm(bf_hi(gs.y));
                        a1[0] *= rs * ea[4] * sigm(bf_lo(gs.z)); a1[1] *= rs * ea[5] * sigm(bf_hi(gs.z)); a1[2] *= rs * ea[6] * sigm(bf_lo(gs.w)); a1[3] *= rs * ea[7] * sigm(bf_hi(gs.w)); }
                    else { u32x4 w; w.x = cvt_pk_bf16(a0[0] * frcp(ea[0]), a0[1] * frcp(ea[1])); w.y = cvt_pk_bf16(a0[2] * frcp(ea[2]), a0[3] * frcp(ea[3])); w.z = cvt_pk_bf16(a1[0] * frcp(ea[4]), a1[1] * frcp(ea[5])); w.w = cvt_pk_bf16(a1[2] * frcp(ea[6]), a1[3] * frcp(ea[7]));
                        *(u32x4*)(MG + (size_t)row * 2048 + c) = w; } } } }
    }
};
struct EpiOut {
    static constexpr bool PERM = false, AFTER_DRAIN = false, CHAIN = false; static constexpr int ID = 8;
    float* H1; const float* X;
    __device__ __forceinline__ void operator()(const f32x4 (&acc)[2][2][4][2], const Unit& u, int wr, int wc, int fr, int fq) const {
        NANCHK((acc[0][0][0][0][0] != acc[0][0][0][0][0]) || (acc[1][1][3][1][3] != acc[1][1][3][1][3]) || (acc[0][1][2][0][1] != acc[0][1][2][0][1]) || (acc[1][0][1][1][2] != acc[1][0][1][1][2]), 5);
        const int row0 = u.pm * BM + wr * 64 + fr, col0 = u.pn * BM + wc * 32 + 4 * fq;
#pragma unroll
        for (int ai = 0; ai < 2; ++ai) {
            f32x4 xv[4][2][2];
#pragma unroll
            for (int m = 0; m < 4; ++m) { const size_t ro = (size_t)(row0 + ai * HALF + m * 16) * 2048;
#pragma unroll
                for (int bj = 0; bj < 2; ++bj)
#pragma unroll
                    for (int n = 0; n < 2; ++n) xv[m][bj][n] = *(const f32x4*)(X + ro + col0 + bj * HALF + n * 16); }
            __builtin_amdgcn_sched_barrier(0);
#pragma unroll
            for (int m = 0; m < 4; ++m) { const size_t ro = (size_t)(row0 + ai * HALF + m * 16) * 2048;
#pragma unroll
                for (int bj = 0; bj < 2; ++bj)
#pragma unroll
                    for (int n = 0; n < 2; ++n) { const int c = col0 + bj * HALF + n * 16; *(f32x4*)(H1 + ro + c) = xv[m][bj][n] + acc[ai][bj][m][n]; } } }
    }
};
__device__ __forceinline__ unsigned pk4_fp8(float a, float b, float c, float d) {
    a = fminf(fmaxf(a, -448.f), 448.f); b = fminf(fmaxf(b, -448.f), 448.f); c = fminf(fmaxf(c, -448.f), 448.f); d = fminf(fmaxf(d, -448.f), 448.f);
    int w = 0; w = __builtin_amdgcn_cvt_pk_fp8_f32(a, b, w, false); w = __builtin_amdgcn_cvt_pk_fp8_f32(c, d, w, true); return (unsigned)w; }
constexpr float F8_SX = 16.f, F8_SW = 1024.f, F8_SA = 4.f;
__device__ __forceinline__ float swiglu1(float g, float l) { g = fminf(g, 7.0f); l = fminf(fmaxf(l, -7.0f), 7.0f); return g * sigm(1.702f * g) * (l + 1.0f); }
struct EpiSwiglu {
    static constexpr bool PERM = true, AFTER_DRAIN = false, CHAIN = false; static constexpr int ID = 11;
    bf16_t* ACT; const float* b1;
    __device__ __forceinline__ void operator()(const f32x4 (&acc)[2][2][4][2], const Unit& u, int wr, int wc, int fr, int fq) const {
        NANCHK((acc[0][0][0][0][0] != acc[0][0][0][0][0]) || (acc[1][1][3][1][3] != acc[1][1][3][1][3]) || (acc[0][1][2][0][1] != acc[0][1][2][0][1]) || (acc[1][0][1][1][2] != acc[1][0][1][1][2]), 6);
        const int row0 = u.pm * BM + wr * 64 + fr, e = u.pb >> 4, j0 = u.pn * 128 + wc * 32 + 8 * fq;
        constexpr float DS = 1.0f / (F8_SX * F8_SW);
        const float* bg0 = b1 + (size_t)e * 4096 + j0; const f32x4 bg_[2] = {*(const f32x4*)bg0, *(const f32x4*)(bg0 + 4)}, bl_[2] = {*(const f32x4*)(bg0 + 2048), *(const f32x4*)(bg0 + 2052)};
        __builtin_amdgcn_sched_barrier(0);
        unsigned roff = (unsigned)row0 * 2048u + (unsigned)j0; asm volatile("" : "+v"(roff));
#pragma unroll
        for (int ai = 0; ai < 2; ++ai)
#pragma unroll
            for (int m = 0; m < 4; ++m) { unsigned w2[2];
#pragma unroll
                for (int n = 0; n < 2; ++n) { const f32x4 bgv = bg_[n], blv = bl_[n];
                    f32x4 g = acc[ai][0][m][n] * DS + bgv, l = acc[ai][1][m][n] * DS + blv;
                    g[0] = fminf(g[0], 7.0f); g[1] = fminf(g[1], 7.0f); g[2] = fminf(g[2], 7.0f); g[3] = fminf(g[3], 7.0f);
                    l[0] = fminf(fmaxf(l[0], -7.0f), 7.0f); l[1] = fminf(fmaxf(l[1], -7.0f), 7.0f); l[2] = fminf(fmaxf(l[2], -7.0f), 7.0f); l[3] = fminf(fmaxf(l[3], -7.0f), 7.0f);
                    const f32x4 t = g * (-1.702f * 1.4426950408889634f);
                    f32x4 e = {__builtin_amdgcn_exp2f(t[0]), __builtin_amdgcn_exp2f(t[1]), __builtin_amdgcn_exp2f(t[2]), __builtin_amdgcn_exp2f(t[3])};
                    e = e + 1.0f;
                    const f32x4 r = {frcp(e[0]), frcp(e[1]), frcp(e[2]), frcp(e[3])};
                    const f32x4 o = (g * r) * (l * F8_SA + F8_SA);
                    int w = 0; w = __builtin_amdgcn_cvt_pk_fp8_f32(o[0], o[1], w, false); w = __builtin_amdgcn_cvt_pk_fp8_f32(o[2], o[3], w, true); w2[n] = (unsigned)w; }
                *(u32x2*)((unsigned char*)ACT + (roff + (unsigned)(ai * HALF + m * 16) * 2048u)) = (u32x2){w2[0], w2[1]};
                __builtin_amdgcn_sched_barrier(0); }
    }
};
constexpr float F8_SH = 32.f;
#ifndef PK4TEST
#define PK4TEST pk4_fp8
#endif
struct EpiUp8 {
    static constexpr bool PERM = true, AFTER_DRAIN = false, CHAIN = false; static constexpr int ID = 92;
    unsigned char* H8; const float* b1;
    __device__ __forceinline__ void operator()(const f32x4 (&acc)[2][2][4][2], const Unit& u, int wr, int wc, int fr, int fq) const {
        const int row0 = u.pm * BM + wr * 64 + fr, e = u.pb >> 4, col0 = u.pn * BM + wc * 32 + 8 * fq;
#pragma unroll
        for (int bj = 0; bj < 2; ++bj) { const int c = col0 + bj * HALF; const float* bp = b1 + (size_t)e * 4096 + bj * 2048 + u.pn * 128 + wc * 32 + 8 * fq;
            const f32x4 b0 = *(const f32x4*)bp, b1v = *(const f32x4*)(bp + 4);
#pragma unroll
            for (int ai = 0; ai < 2; ++ai)
#pragma unroll
                for (int m = 0; m < 4; ++m) { const int row = row0 + ai * HALF + m * 16;
                    constexpr float DS = 1.0f / (F8_SX * F8_SW);
                    const f32x4 v0 = (acc[ai][bj][m][0] * DS + b0) * F8_SH, v1 = (acc[ai][bj][m][1] * DS + b1v) * F8_SH;
                    u32x2 w; w.x = PK4TEST(v0[0], v0[1], v0[2], v0[3]); w.y = PK4TEST(v1[0], v1[1], v1[2], v1[3]);
                    *(u32x2*)(H8 + (size_t)row * 4096 + c) = w; } }
    }
};
struct EpiMoeOut {
    static constexpr bool PERM = true, AFTER_DRAIN = false, CHAIN = false; static constexpr int ID = 13;
    bf16_t* OS; const float* b2;
    __device__ __forceinline__ void operator()(const f32x4 (&acc)[2][2][4][2], const Unit& u, int wr, int wc, int fr, int fq) const {
        NANCHK((acc[0][0][0][0][0] != acc[0][0][0][0][0]) || (acc[1][1][3][1][3] != acc[1][1][3][1][3]) || (acc[0][1][2][0][1] != acc[0][1][2][0][1]) || (acc[1][0][1][1][2] != acc[1][0][1][1][2]), 7);
        const int row0 = u.pm * BM + wr * 64 + fr, e = u.pb >> 3, col0 = u.pn * BM + wc * 32 + 8 * fq;
#pragma unroll
        for (int bj = 0; bj < 2; ++bj) { const int c = col0 + bj * HALF; const float* bp = b2 + (size_t)e * 2048 + c;
            const f32x4 b0 = *(const f32x4*)bp, b1v = *(const f32x4*)(bp + 4);
#pragma unroll
            for (int ai = 0; ai < 2; ++ai)
#pragma unroll
                for (int m = 0; m < 4; ++m) { const int row = row0 + ai * HALF + m * 16;
                    constexpr float DS = 1.0f / (F8_SA * F8_SW);
                    const f32x4 v0 = acc[ai][bj][m][0] * DS + b0, v1 = acc[ai][bj][m][1] * DS + b1v;
                    u32x4 w; w.x = cvt_pk_bf16(v0[0], v0[1]); w.y = cvt_pk_bf16(v0[2], v0[3]); w.z = cvt_pk_bf16(v1[0], v1[1]); w.w = cvt_pk_bf16(v1[2], v1[3]);
                    *(u32x4*)(OS + (size_t)row * 2048 + c) = w; } }
    }
};
}
namespace att {
constexpr int D = 128;
constexpr int KP = 2048, VP = 16128, QP = 2048, OP = 2048, MKSTRIDE = 8192;
constexpr float THR = 8.f;
constexpr bool WSKIP = false;
constexpr float SCALE = 0.08838834764831845f;
constexpr int NW = 8, QBLK = 32, KVBLK = 64, QB = NW * QBLK;
constexpr int SHM_V = KVBLK * D * 2, SHM_K = KVBLK * D * 2;
constexpr int LDS_BYTES = 2 * SHM_V + 2 * SHM_K + NW * 64 * 4 + 2 * 2048;
using bf16 = __hip_bfloat16;
typedef short bf16x8 __attribute__((ext_vector_type(8)));
typedef short s16x4 __attribute__((ext_vector_type(4)));
typedef float f32x16 __attribute__((ext_vector_type(16)));
typedef float f32x4 __attribute__((ext_vector_type(4)));
typedef unsigned u32x4 __attribute__((ext_vector_type(4)));
template <class A, class Bt> struct same_t { static constexpr bool v = false; };
template <class A> struct same_t<A, A> { static constexpr bool v = true; };
#define KSWZ(row, colB) ((row) * 256 + ((colB) ^ (((row) & 7) << 4)))
#define SBAR() __builtin_amdgcn_sched_barrier(0)
__device__ __forceinline__ int v_st(int k, int c) { const int kk = (k & ~0xC) | ((k & 4) << 1) | ((k & 8) >> 1); return ((kk >> 3) * 4 + (c >> 5)) * 512 + ((kk & 7) * 32 + (c & 31)) * 2; }
__device__ __forceinline__ int v_rd_base(int lane) { return ((lane & 3) << 3) | (((lane >> 2) & 3) << 6) | (((lane >> 4) & 1) << 5) | (((lane >> 5) & 1) << 8); }
constexpr int v_rd_off(int d0, int ks, int half) { return d0 * 512 + ks * 4096 + half * 2048; }
__device__ __forceinline__ int crow(int r, int hi) { return (r & 3) + 8 * (r >> 2) + 4 * hi; }
__device__ __forceinline__ unsigned cvtpk(float lo, float hi) {
    unsigned r; asm volatile("v_cvt_pk_bf16_f32 %0, %1, %2" : "=v"(r) : "v"(lo), "v"(hi)); return r;
}
__device__ __forceinline__ bf16x8 pack8(f32x4 a, f32x4 b) {
    u32x4 w = {cvtpk(a[0], a[1]), cvtpk(a[2], a[3]), cvtpk(b[0], b[1]), cvtpk(b[2], b[3])};
    return *reinterpret_cast<bf16x8*>(&w);
}
template <class T> __device__ __forceinline__ bf16x8 load8(const T* p) {
    if constexpr (same_t<T, float>::v) { return pack8(*(const f32x4*)p, *(const f32x4*)(p + 4)); }
    else { return *reinterpret_cast<const bf16x8*>(p); }
}
__device__ __forceinline__ void mask_bits(f32x16& p0, f32x16& p1, unsigned lo, unsigned hw, int hi) {
    const float NEG = -__builtin_inff();
    lo >>= 4 * hi; hw >>= 4 * hi;
#pragma unroll
    for (int r = 0; r < 16; ++r) {
        const int c = (r & 3) + 8 * (r >> 2);
        const unsigned m0 = (unsigned)((int)(lo << (31 - c)) >> 31), m1 = (unsigned)((int)(hw << (31 - c)) >> 31);
        p0[r] = __uint_as_float((__float_as_uint(p0[r]) & m0) | (~m0 & 0xff800000u));
        p1[r] = __uint_as_float((__float_as_uint(p1[r]) & m1) | (~m1 & 0xff800000u));
    }
}
__device__ __forceinline__ void partialSM(f32x16& p0, f32x16& p1, float& m_reg, float& mn, float& alpha) {
    float pmax = p0[0]; for (int r = 1; r < 16; ++r) pmax = fmaxf(pmax, p0[r]); for (int r = 0; r < 16; ++r) pmax = fmaxf(pmax, p1[r]);
    { auto rr = __builtin_amdgcn_permlane32_swap(__float_as_uint(pmax), __float_as_uint(pmax), false, false);
      pmax = fmaxf(__uint_as_float(rr[0]), __uint_as_float(rr[1])); }
    constexpr float C2 = 1.4426950408889634f * SCALE;
    if (__builtin_expect(__all((pmax - m_reg) * SCALE <= THR), 1)) { mn = m_reg; alpha = 1.f; }
    else { mn = fmaxf(m_reg, pmax); alpha = __builtin_amdgcn_exp2f((m_reg - mn) * C2); m_reg = mn; }
    const float mnL = -mn * C2;
    for (int r = 0; r < 16; ++r) p0[r] = fmaf(p0[r], C2, mnL); for (int r = 0; r < 16; ++r) p1[r] = fmaf(p1[r], C2, mnL);
    for (int r = 0; r < 16; ++r) p0[r] = __builtin_amdgcn_exp2f(p0[r]);
}
__device__ __forceinline__ void finishSM(f32x16& p0, f32x16& p1, float alpha, float& l_reg, bf16x8& pa0, bf16x8& pa1, bf16x8& pa2, bf16x8& pa3) {
    for (int r = 0; r < 16; ++r) p1[r] = __builtin_amdgcn_exp2f(p1[r]);
    float ps = 0; for (int r = 0; r < 16; ++r) ps += p0[r]; for (int r = 0; r < 16; ++r) ps += p1[r];
    { auto rr = __builtin_amdgcn_permlane32_swap(__float_as_uint(ps), __float_as_uint(ps), false, false);
      ps = __uint_as_float(rr[0]) + __uint_as_float(rr[1]); }
    l_reg = l_reg * alpha + ps;
#define PK4(P, B_, OUT) do { unsigned a0 = cvtpk(P[B_+0], P[B_+1]), a1 = cvtpk(P[B_+2], P[B_+3]);                          \
        unsigned b0 = cvtpk(P[B_+4], P[B_+5]), b1 = cvtpk(P[B_+6], P[B_+7]);                                             \
        auto r0 = __builtin_amdgcn_permlane32_swap(a0, b0, false, false); auto r1 = __builtin_amdgcn_permlane32_swap(a1, b1, false, false); \
        u32x4 w = {r0[0], r1[0], r0[1], r1[1]}; OUT = *reinterpret_cast<bf16x8*>(&w); } while (0)
    PK4(p0, 0, pa0); PK4(p0, 8, pa1); PK4(p1, 0, pa2); PK4(p1, 8, pa3);
#undef PK4
}
template <int KB, bool SK>
__device__ __forceinline__ void qkt(f32x16& p0, f32x16& p1, const char* K_lds, int r32, int hi, const bf16x8* qr, bool act) {
    if (SK && !act) { const float NEG = -__builtin_inff();
#pragma unroll
        for (int r = 0; r < 16; ++r) { p0[r] = NEG; p1[r] = NEG; } return; }
    p0 = f32x16{}; p1 = f32x16{};
    const char* kb[4];
#pragma unroll
    for (int dd = 0; dd < 4; ++dd) kb[dd] = K_lds + KB * SHM_K + KSWZ(r32, (dd * 16 + hi * 8) * 2);
#pragma unroll
    for (int d0 = 0; d0 < 8; ++d0) { const char* a = kb[d0 & 3] + (d0 >> 2) * 128;
        bf16x8 b0 = *reinterpret_cast<const bf16x8*>(a);
        bf16x8 b1 = *reinterpret_cast<const bf16x8*>(a + 32 * 256);
        p0 = __builtin_amdgcn_mfma_f32_32x32x16_bf16(b0, qr[d0], p0, 0, 0, 0);
        p1 = __builtin_amdgcn_mfma_f32_32x32x16_bf16(b1, qr[d0], p1, 0, 0, 0); }
}
template <int VB, bool SK>
__device__ __forceinline__ void pv_tile(f32x16* o, int vb0, bf16x8 pa0, bf16x8 pa1, bf16x8 pa2, bf16x8 pa3, bool act) {
    if (SK && !act) return;
#define TRRD(dst, off) asm volatile("ds_read_b64_tr_b16 %0, %1 offset:%2" : "=&v"(dst) : "v"(vb0), "i"(off) : "memory")
#define PV_D0(d0) do { s16x4 l0, l1, l2, l3, h0, h1, h2, h3; constexpr int b_ = VB * SHM_V + v_rd_off(d0, 0, 0);     \
        TRRD(l0, b_); TRRD(h0, b_ + 2048); TRRD(l1, b_ + 4096); TRRD(h1, b_ + 6144); TRRD(l2, b_ + 8192); TRRD(h2, b_ + 10240); TRRD(l3, b_ + 12288); TRRD(h3, b_ + 14336); \
        asm volatile("s_waitcnt lgkmcnt(0)" ::: "memory"); SBAR();                 \
        o[d0] = __builtin_amdgcn_mfma_f32_32x32x16_bf16(pa0, (bf16x8){l0[0], l0[1], l0[2], l0[3], h0[0], h0[1], h0[2], h0[3]}, o[d0], 0, 0, 0);   \
        o[d0] = __builtin_amdgcn_mfma_f32_32x32x16_bf16(pa1, (bf16x8){l1[0], l1[1], l1[2], l1[3], h1[0], h1[1], h1[2], h1[3]}, o[d0], 0, 0, 0);   \
        o[d0] = __builtin_amdgcn_mfma_f32_32x32x16_bf16(pa2, (bf16x8){l2[0], l2[1], l2[2], l2[3], h2[0], h2[1], h2[2], h2[3]}, o[d0], 0, 0, 0);   \
        o[d0] = __builtin_amdgcn_mfma_f32_32x32x16_bf16(pa3, (bf16x8){l3[0], l3[1], l3[2], l3[3], h3[0], h3[1], h3[2], h3[3]}, o[d0], 0, 0, 0); } while (0)
    PV_D0(0); PV_D0(1); PV_D0(2); PV_D0(3);
#undef PV_D0
#undef TRRD
}

template <class TIn, class TOut> struct BlockRef { const TIn* Q; const TIn* K; const TIn* V; TOut* O; const unsigned long long* MK; int P0; };
template <class TIn> struct Seam {
    bf16x8 qr[8];
    bf16x8 st_v0, st_v1, st_k0, st_k1; unsigned st_m; f32x4 sf0, sf1, sf2, sf3;
    f32x4 tq[16];
};
__device__ __forceinline__ int swa_jlo(int P0, int W) { const int lowk = P0 - W + 1; return lowk > 0 ? lowk / KVBLK : 0; }
#define ROW(p, k0, rr, PT) ((p) + (size_t)(k0) * (PT) + (unsigned)((rr) * (PT) + sc))
#define VMW() asm volatile("s_waitcnt vmcnt(0)" ::: "memory")
#define VMWN(n) asm volatile("s_waitcnt vmcnt(%0)" :: "i"(n) : "memory")
#define SLOAD_H(Kp, Vp, Mp, k0) do { S.st_v0 = load8<TIn>(ROW(Vp, k0, sr, VP)); S.st_v1 = load8<TIn>(ROW(Vp, k0, 32 + sr, VP)); S.st_m = ((const unsigned*)((Mp) + (size_t)((k0) >> 6) * MKSTRIDE))[tid]; \
                         S.st_k0 = load8<TIn>(ROW(Kp, k0, sr, KP)); S.st_k1 = load8<TIn>(ROW(Kp, k0, 32 + sr, KP)); } while (0)
#define SWRITE_HK(bf) do { *(bf16x8*)(K_lds + (bf) * SHM_K + kws) = S.st_k0; *(bf16x8*)(K_lds + (bf) * SHM_K + kws + 32 * 256) = S.st_k1; *(unsigned*)(K_lds + 2 * SHM_K + NW * 64 * 4 + (bf) * 2048 + tid * 4) = S.st_m; } while (0)
#define SWRITE_HV(bf) do { *(bf16x8*)(V_lds + (bf) * SHM_V + vst0) = S.st_v0; *(bf16x8*)(V_lds + (bf) * SHM_V + vst1) = S.st_v1; } while (0)
#define SWRITE_H(bf) do { SWRITE_HV(bf); SWRITE_HK(bf); } while (0)
#define SLOAD_F(p, k0) do { S.sf0 = *(const f32x4*)ROW(p, k0, sr, KP); S.sf1 = *(const f32x4*)(ROW(p, k0, sr, KP) + 4);                \
                            S.sf2 = *(const f32x4*)ROW(p, k0, 32 + sr, KP); S.sf3 = *(const f32x4*)(ROW(p, k0, 32 + sr, KP) + 4); } while (0)
#define SWRITE_KF(bf) do { *(bf16x8*)(K_lds + (bf) * SHM_K + kws) = pack8(S.sf0, S.sf1); *(bf16x8*)(K_lds + (bf) * SHM_K + kws + 32 * 256) = pack8(S.sf2, S.sf3); } while (0)
#define SWRITE_VF(bf) do { *(bf16x8*)(V_lds + (bf) * SHM_V + vst0) = pack8(S.sf0, S.sf1); *(bf16x8*)(V_lds + (bf) * SHM_V + vst1) = pack8(S.sf2, S.sf3); } while (0)
template <class TIn, class TOut>
__device__ __forceinline__ void causal_swa_prime(const BlockRef<TIn, TOut>& cur, int W, char* lds, Seam<TIn>& S) {
    constexpr bool F32 = same_t<TIn, float>::v;
    const int tid = threadIdx.x, wid = __builtin_amdgcn_readfirstlane(tid >> 6), lane = tid & 63, r32 = lane & 31, hi = lane >> 5;
    const int sr = tid >> 4, sc = (tid & 15) * 8, kws = KSWZ(sr, sc * 2); char* K_lds = lds + 2 * SHM_V;
    const int kb0 = swa_jlo(cur.P0, W) * KVBLK;
    for (int d0 = 0; d0 < 8; ++d0) S.qr[d0] = load8<TIn>(cur.Q + (size_t)(wid * QBLK) * QP + (unsigned)(r32 * QP + hi * 8) + d0 * 16);
    if constexpr (F32) { SLOAD_F((const float*)cur.K, kb0); VMW(); SWRITE_KF(0); SBAR(); SLOAD_F((const float*)cur.V, kb0); }
    else { SLOAD_H(cur.K, cur.V, cur.MK, kb0); VMW(); SWRITE_HK(0); }
    __syncthreads();
}
template <class TIn, class TOut>
__device__ __forceinline__ void causal_swa_block(const BlockRef<TIn, TOut>& cur, const BlockRef<TIn, TOut>& nxt, int skv, int W, char* lds, Seam<TIn>& S) {
    constexpr bool F32 = same_t<TIn, float>::v;
    const int tid = threadIdx.x, wid = __builtin_amdgcn_readfirstlane(tid >> 6), lane = tid & 63, r32 = lane & 31, hi = lane >> 5;
    const int j_lo = swa_jlo(cur.P0, W);
    int j_hi = (cur.P0 + QB - 1) / KVBLK + 1; if (j_hi > skv / KVBLK) j_hi = skv / KVBLK;
    const int NT = j_hi - j_lo;
    const int kbn = swa_jlo(nxt.P0, W) * KVBLK;
    const int qlo = cur.P0 + wid * QBLK, qm = qlo + r32 - 4 * hi;
    char* V_lds = lds; char* K_lds = lds + 2 * SHM_V;
    float* ws = (float*)(lds + 2 * SHM_V + 2 * SHM_K) + wid * 64; float* li_l = ws, * al_l = ws + 32;
    float m_reg = -1e30f, l_reg = 0; f32x16 o[4] = {};
    const int sr = tid >> 4, sc = (tid & 15) * 8, vst0 = v_st(sr, sc), vst1 = v_st(32 + sr, sc), kws = KSWZ(sr, sc * 2);
    const int vb0 = (int)(uintptr_t)V_lds + v_rd_base(lane);
    const TIn* Kh = cur.K; const TIn* Vh = cur.V;
#define RESC(a) do { if (__any((a) < 1.f)) { if (hi == 0) al_l[r32] = (a); asm volatile("s_waitcnt lgkmcnt(0)" ::: "memory");              \
                     for (int d_ = 0; d_ < 4; ++d_) for (int r = 0; r < 16; ++r) o[d_][r] *= al_l[crow(r, hi)]; } } while (0)
#define KBASE(t) ((j_lo + (t)) * KVBLK)
#define ACT(t) (KBASE(t) <= qlo + QBLK - 1 && KBASE(t) + KVBLK - 1 >= qlo - W + 1)
#define MASKT(P0_, P1_, KB_) do { const uint2 mw_ = *(const uint2*)(K_lds + 2 * SHM_K + NW * 64 * 4 + (KB_) * 2048 + (wid * QBLK + r32) * 8); mask_bits(P0_, P1_, mw_.x, mw_.y, hi); } while (0)
    constexpr int NQL = F32 ? 16 : 8;
    constexpr bool SK = WSKIP && !F32;
#define SEAM_K0() do { VMWN(NQL); if constexpr (F32) { SWRITE_KF(0); SBAR(); SLOAD_F((const float*)nxt.V, kbn); } else { SWRITE_HK(0); } SBAR(); } while (0)
    f32x16 pA0, pA1, pB0, pB1; float mnA, mnB, alA, alB; bf16x8 pa0, pa1, pa2, pa3;
    if constexpr (F32) { VMW(); SWRITE_VF(0); SBAR(); } else { SWRITE_HV(0); SBAR(); }
    if (NT > 1) { if constexpr (F32) SLOAD_F((const float*)Kh, KBASE(1)); else SLOAD_H(Kh, Vh, cur.MK, KBASE(1)); }
    SBAR(); qkt<0, SK>(pA0, pA1, K_lds, r32, hi, S.qr, ACT(0));
    if constexpr (F32) { if (NT > 1) { VMW(); SWRITE_KF(1); SBAR(); SLOAD_F((const float*)Vh, KBASE(1)); } }
    MASKT(pA0, pA1, 0); partialSM(pA0, pA1, m_reg, mnA, alA);
    if (NT > 1) { VMW(); if constexpr (F32) { SWRITE_VF(1); SBAR(); if (NT > 2) SLOAD_F((const float*)Kh, KBASE(2)); } else SWRITE_H(1); }
    __syncthreads();
#define HALF_STEP(PX0, PX1, mnX, alX, PY0, PY1, alY, t, KB, VB, SB) do {                                                      \
        SBAR(); qkt<KB, SK>(PX0, PX1, K_lds, r32, hi, S.qr, ACT(t));                                             \
        finishSM(PY0, PY1, alY, l_reg, pa0, pa1, pa2, pa3); SBAR();                                                           \
        if ((t) + 1 < NT) { if constexpr (F32) { VMW(); SWRITE_KF(SB); SBAR(); SLOAD_F((const float*)Vh, KBASE((t) + 1)); }  \
                            else { SLOAD_H(Kh, Vh, cur.MK, KBASE((t) + 1)); } SBAR(); }                                               \
        pv_tile<VB, SK>(o, vb0, pa0, pa1, pa2, pa3, ACT((t) - 1)); MASKT(PX0, PX1, KB); partialSM(PX0, PX1, m_reg, mnX, alX);                                        \
        __syncthreads();                                                                                                      \
        if ((t) + 1 < NT) { VMW(); if constexpr (F32) { SWRITE_VF(SB); SBAR(); if ((t) + 2 < NT) SLOAD_F((const float*)Kh, KBASE((t) + 2)); } \
                            else { SWRITE_H(SB); } }                                                                          \
        RESC(alX); __syncthreads(); } while (0)
    for (int t = 1; t + 1 < NT; t += 2) {
        HALF_STEP(pB0, pB1, mnB, alB, pA0, pA1, alA, t, 1, 0, 0);
        HALF_STEP(pA0, pA1, mnA, alA, pB0, pB1, alB, t + 1, 0, 1, 1);
    }
    const bool even = (NT & 1) == 0;
    if (even) { SBAR(); qkt<1, SK>(pB0, pB1, K_lds, r32, hi, S.qr, ACT(NT - 1)); SBAR(); }
#define QROW(e) (nxt.Q + (size_t)(wid * QBLK + r32) * QP + ((e) >> 1) * 16 + hi * 8 + ((e) & 1) * 4)
    if constexpr (F32) { SLOAD_F((const float*)nxt.K, kbn); SBAR();
#pragma unroll
        for (int e = 0; e < 8; ++e) S.tq[e] = *(const f32x4*)QROW(e); }
    else { SLOAD_H(nxt.K, nxt.V, nxt.MK, kbn); SBAR();
#pragma unroll
        for (int d0 = 0; d0 < 8; ++d0) S.qr[d0] = load8<TIn>(nxt.Q + (size_t)(wid * QBLK) * QP + (unsigned)(r32 * QP + hi * 8) + d0 * 16); }
    SBAR();
    finishSM(pA0, pA1, alA, l_reg, pa0, pa1, pa2, pa3); SBAR();
    if constexpr (F32) {
#pragma unroll
        for (int e = 8; e < 16; ++e) S.tq[e] = *(const f32x4*)QROW(e); SBAR(); }
#undef QROW
    pv_tile<0, SK>(o, vb0, pa0, pa1, pa2, pa3, ACT(even ? NT - 2 : NT - 1));
    if (even) { MASKT(pB0, pB1, 1); partialSM(pB0, pB1, m_reg, mnB, alB); __syncthreads(); RESC(alB);
        finishSM(pB0, pB1, alB, l_reg, pa0, pa1, pa2, pa3); SBAR(); pv_tile<1, SK>(o, vb0, pa0, pa1, pa2, pa3, ACT(NT - 1)); }
    SBAR(); SEAM_K0();
    if (hi == 0) li_l[r32] = l_reg; asm volatile("s_waitcnt lgkmcnt(0)" ::: "memory");
    float rli[16];
#pragma unroll
    for (int r = 0; r < 16; ++r) rli[r] = __builtin_amdgcn_rcpf(li_l[crow(r, hi)]);
    TOut* Ow = cur.O + (size_t)(wid * QBLK) * OP;
    unsigned olane = (unsigned)(4 * hi * OP + r32) * 2u; asm volatile("" : "+v"(olane));
#pragma unroll
    for (int r = 0; r < 16; ++r) { const int orow = crow(r, hi);
#pragma unroll
        for (int d0 = 0; d0 < 4; ++d0) { const float v = o[d0][r] * rli[r];
            if constexpr (same_t<TOut, float>::v) { Ow[(size_t)orow * OP + d0 * 32 + r32] = v; }
            else { const float vn = __shfl_xor(v, 1);
                   if ((r32 & 1) == 0) *(unsigned*)((char*)Ow + (size_t)((((r & 3) + 8 * (r >> 2)) * OP + d0 * 32) * 2) + olane) = cvtpk(v, vn); } } }
    if constexpr (F32) {
#pragma unroll
        for (int d0 = 0; d0 < 8; ++d0) S.qr[d0] = pack8(S.tq[2 * d0], S.tq[2 * d0 + 1]); }
    __syncthreads();
#undef RESC
#undef KBASE
#undef ACT
#undef MASKT
#undef SEAM_K0
#undef HALF_STEP
}
#undef ROW
#undef VMW
#undef VMWN
#undef SLOAD_H
#undef SWRITE_HK
#undef SWRITE_HV
#undef SWRITE_H
#undef SLOAD_F
#undef SWRITE_KF
#undef SWRITE_VF

#undef KSWZ
#undef SBAR
}
constexpr int NWAVES = 8;
constexpr int T = 16384, SEQ = 8192, DM = 2048, NU = 16128, NEXP = 32;
constexpr int UC_Z = 0, UC_XBC = 2048, UC_Q = 5120, UC_K = 7168, UC_V = 9216, UC_GS = 11264, UC_GA = 13312, UC_QI = 15360, UC_KI = 15872, UC_DT = 15936, UC_WI = 15968, UC_END = 15976;
constexpr int NIN = 15976;
constexpr float EPS = 1e-5f;
constexpr int RMAX = 65536 + 32 * 256;

constexpr size_t MiB = 1u << 20;
constexpr size_t WS_CTL = 0, CTL_ZERO_BYTES = 1 * MiB;
constexpr size_t WS_WIN = 2 * MiB;
constexpr size_t WS_WSSD = 65 * MiB, WS_WATT = 73 * MiB, WS_WOUT = 81 * MiB;
constexpr size_t WS_RWT = 89 * MiB;
constexpr size_t WS_W1 = 96 * MiB;
constexpr size_t WS_W2 = 352 * MiB;
constexpr size_t WS_H8 = 480 * MiB;
constexpr size_t WS_XN = 864 * MiB;
constexpr size_t WS_U = 928 * MiB;
constexpr size_t WS_XBC = 1432 * MiB;
constexpr size_t WS_DT = 1528 * MiB, WS_DACS = 1530 * MiB;
constexpr size_t WS_YD = 1532 * MiB;
constexpr size_t WS_STATES = 1596 * MiB;
constexpr size_t WS_PREV = 1724 * MiB;
constexpr size_t WS_S = 1788 * MiB;
constexpr size_t WS_MASK = 2300 * MiB;
constexpr size_t WS_YG = 2316 * MiB, WS_AO = 2380 * MiB;
constexpr size_t WS_TMP = 2444 * MiB;
constexpr size_t WS_MG = 2572 * MiB;
constexpr size_t WS_H1 = 2636 * MiB;
constexpr size_t WS_ROUTE = 2764 * MiB;
constexpr size_t WS_OS = 2768 * MiB;
constexpr size_t WS_QR = 3056 * MiB, WS_KR = 3120 * MiB;
constexpr size_t WS_QIR = 3184 * MiB, WS_KIR = 3200 * MiB;
constexpr size_t WS_ROPE = 3202 * MiB;
constexpr size_t WS_AS = 3204 * MiB;
constexpr size_t WS_ACT = 3492 * MiB;
constexpr size_t WS_XN2 = 3780 * MiB;
constexpr size_t WS_END = 3844 * MiB;
constexpr int CW_TMO = 0, CW_CODE = 1;
constexpr int CW_BAR = 4096;
constexpr int CW_NT = 8192;
constexpr int RING_OFF = 0, RING_BYTES = 131072;
constexpr int LDSCTL_OFF = RING_BYTES, MISC_OFF = LDSCTL_OFF + 320;
constexpr int TILE_E_OFF = MISC_OFF + 128;
constexpr int EOFF_OFF = TILE_E_OFF + 1280;
constexpr int HIST_OFF = EOFF_OFF + 512;
constexpr int RS_OFF = HIST_OFF + 256;
constexpr int LDS_BYTES = 147456;
static_assert(RS_OFF + 8192 <= LDS_BYTES, "LDS map");

#define GAS __attribute__((address_space(1)))
#define LAS __attribute__((address_space(3)))
typedef unsigned short bf16;
typedef unsigned v4u __attribute__((ext_vector_type(4)));
typedef unsigned v2u __attribute__((ext_vector_type(2)));
typedef float f32x4 __attribute__((ext_vector_type(4)));
typedef float f32x16 __attribute__((ext_vector_type(16)));
typedef short bf16x8 __attribute__((ext_vector_type(8)));
typedef short s16x4 __attribute__((ext_vector_type(4)));
typedef GAS unsigned gu32;
#define RLX_AGENT __ATOMIC_RELAXED, __HIP_MEMORY_SCOPE_AGENT
#define LDS_WAIT() asm volatile("s_waitcnt lgkmcnt(0)" ::: "memory")
#define VM_WAIT() asm volatile("s_waitcnt vmcnt(0)" ::: "memory")
__device__ __forceinline__ unsigned f2bf(float f) { unsigned u = __builtin_bit_cast(unsigned, f); return (u + 0x7fffu + ((u >> 16) & 1u)) >> 16; }
__device__ __forceinline__ unsigned pk2(float lo, float hi) { return f2bf(lo) | (f2bf(hi) << 16); }
__device__ __forceinline__ float bf2f(bf16 b) { return __uint_as_float(((unsigned)b) << 16); }
__device__ __forceinline__ float bflo(unsigned w) { return __uint_as_float(w << 16); }
__device__ __forceinline__ float bfhi(unsigned w) { return __uint_as_float(w & 0xffff0000u); }
__device__ __forceinline__ float siluf(float x) { return x * __builtin_amdgcn_rcpf(1.f + __expf(-x)); }
#define XB_TMO      128
#define XB_XCNT(j)  (256  + 64 * (j))
#define XB_XSUB(j)  (1280 + 64 * (j))
#define XB_XGEN(j)  (2304 + 64 * (j))
#define XB_TOP      3328
#define XB_TOPGEN   3392
#define XCD_BAR_WORDS 3456
#define XB_SPIN_CAP (1u << 18)

__device__ __forceinline__ unsigned xb_ld(unsigned* p)              { return __hip_atomic_load(p, __ATOMIC_RELAXED, __HIP_MEMORY_SCOPE_AGENT); }
__device__ __forceinline__ unsigned xb_add(unsigned* p, unsigned v) { return __hip_atomic_fetch_add(p, v, __ATOMIC_RELAXED, __HIP_MEMORY_SCOPE_AGENT); }
__device__ __forceinline__ unsigned xb_xcc_id() { return (unsigned)__builtin_amdgcn_s_getreg((3 << 11) | 20) & 0xFu; }
#define XB_SPIN(cond, bar) do { unsigned _sp = 0; while (cond) { __builtin_amdgcn_s_sleep(1); \
    if ((++_sp & 255u) == 0u) { if (xb_ld(&(bar)[XB_TMO])) break; if (_sp > XB_SPIN_CAP) { atomicAdd(&(bar)[XB_TMO], 1u); break; } } } } while (0)

struct XcdBarrier {
    unsigned* bar; unsigned x;
    volatile LAS unsigned* st;
};

__device__ __forceinline__ XcdBarrier xcd_barrier_post(unsigned* bar, volatile LAS unsigned* st) {
    XcdBarrier b; b.bar = bar; b.x = xb_xcc_id(); b.st = st;
    if (threadIdx.x == 0) (void)xb_add(&bar[XB_XCNT(b.x)], 1u);
    return b;
}
__device__ __forceinline__ void xcd_barrier_complete(unsigned* bar, unsigned x, unsigned& nloc, unsigned& nx) {
    const unsigned G = gridDim.x * gridDim.y * gridDim.z;
    unsigned sum, cnt, mine, sp = 0u;
    for (;;) {
        sum = 0u; cnt = 0u; mine = 0u;
#pragma unroll
        for (unsigned j = 0; j < 16; ++j) { const unsigned c = xb_ld(&bar[XB_XCNT(j)]); sum += c; cnt += (c > 0u) ? 1u : 0u; mine = (j == x) ? c : mine; }
        if (sum == G) break;
        __builtin_amdgcn_s_sleep(1);
        if ((++sp & 255u) == 0u) { if (xb_ld(&bar[XB_TMO])) break; if (sp > XB_SPIN_CAP) { atomicAdd(&bar[XB_TMO], 1u); break; } }
    }
    nloc = mine > 0u ? mine : 1u; nx = cnt > 0u ? cnt : 1u;
}

__device__ __forceinline__ void xcd_barrier(const XcdBarrier& b) {
    asm volatile("s_waitcnt vmcnt(0)" ::: "memory");
    __syncthreads();
    if (threadIdx.x == 0) {
        unsigned* bar = b.bar;
        __builtin_amdgcn_s_waitcnt(0);
        unsigned nloc = b.st[0], nx = b.st[1];
        if (nloc == 0u) { xcd_barrier_complete(bar, b.x, nloc, nx); b.st[0] = nloc; b.st[1] = nx; }
        const unsigned old = xb_add(&bar[XB_XSUB(b.x)], 1u);
        const unsigned gen = old / nloc;
        if (old + 1u == (gen + 1u) * nloc) {
            __builtin_amdgcn_fence(__ATOMIC_RELEASE, "agent");
            asm volatile("s_waitcnt vmcnt(0)" ::: "memory");
            const unsigned og = xb_add(&bar[XB_TOP], 1u);
            const unsigned tg = og / nx;
            if (og + 1u == (tg + 1u) * nx) xb_add(&bar[XB_TOPGEN], 1u);
            else XB_SPIN(xb_ld(&bar[XB_TOPGEN]) == tg, bar);
            __builtin_amdgcn_fence(__ATOMIC_ACQUIRE, "agent");
            xb_add(&bar[XB_XGEN(b.x)], 1u);
            asm volatile("s_waitcnt vmcnt(0)" ::: "memory");
        } else {
            XB_SPIN(xb_ld(&bar[XB_XGEN(b.x)]) == gen, bar);
            __builtin_amdgcn_fence(__ATOMIC_ACQUIRE, "agent");
            asm volatile("s_waitcnt vmcnt(0)" ::: "memory");
        }
    }
    __syncthreads();
}


typedef const float* const __attribute__((address_space(4))) * karg_fpp;
#define INP(i) (((karg_fpp)__builtin_amdgcn_kernarg_segment_ptr())[i])
#define OUTP() ((float*)(((karg_fpp)__builtin_amdgcn_kernarg_segment_ptr())[20]))
#define WSB() ((unsigned char*)(((karg_fpp)__builtin_amdgcn_kernarg_segment_ptr())[21]))
#define WSP(type, off) ((type*)(WSB() + (off)))
#define CTLP() ((gu32*)(WSB() + WS_CTL))
struct Frame {
    LAS unsigned char* lds;
    int wave, vcu, G;
};
__device__ __forceinline__ int lane_id_now() { int l; asm volatile("v_mbcnt_lo_u32_b32 %0, -1, 0\n\tv_mbcnt_hi_u32_b32 %0, -1, %0" : "=v"(l)); return l; }
#define LANE() lane_id_now()
#define TID() (F.wave * 64 + LANE())

__device__ __forceinline__ float wave_sum(float v) {
#pragma unroll
    for (int o = 1; o < 64; o <<= 1) v += __shfl_xor(v, o);
    return v;
}

__device__ __forceinline__ int ucol_of_src(int n) {
    if (n < 5120) return n;
    if (n < 5152) return n - 5120 + UC_DT;
    if (n < 11296) return n - 5152 + UC_Q;
    if (n < 11808) return n - 11296 + UC_QI;
    if (n < 11872) return n - 11808 + UC_KI;
    if (n < 11880) return n - 11872 + UC_WI;
    return n - 11880 + UC_GS;
}
struct RmId { __device__ __forceinline__ int operator()(int n) const { return n; } };
struct RmIn { __device__ __forceinline__ int operator()(int n) const { return ucol_of_src(n); } };
struct RmW1 { __device__ __forceinline__ int operator()(int n) const { const int m = n & 2047; return ((m >> 7) << 8) + ((n >> 11) << 7) + (m & 127); } };
template <class RowMap>
__device__ __forceinline__ void transpose_item(const float* W, int K, int N, bf16* WT, const RowMap rm, const float* kscale, int item, int lane) {
    const int nblk = (N + 63) >> 6, kb = item / nblk, nb = item - kb * nblk, k0 = 64 * kb, n0 = 64 * nb;
    const int g = lane >> 4, nq = lane & 15, n = n0 + 4 * nq; const bool nok = n < N;
    const float* src = W + (size_t)(k0 + 8 * g) * N + n;
    f32x4 v[2][8];
#pragma unroll
    for (int p = 0; p < 2; ++p)
#pragma unroll
        for (int i = 0; i < 8; ++i) v[p][i] = nok ? *(const f32x4*)(src + (size_t)(32 * p + i) * N) : (f32x4){0.f, 0.f, 0.f, 0.f};
    if (kscale) {
#pragma unroll
        for (int p = 0; p < 2; ++p) { const f32x4 s0 = *(const f32x4*)(kscale + k0 + 32 * p + 8 * g), s1 = *(const f32x4*)(kscale + k0 + 32 * p + 8 * g + 4);
            v[p][0] = v[p][0] * s0.x; v[p][1] = v[p][1] * s0.y; v[p][2] = v[p][2] * s0.z; v[p][3] = v[p][3] * s0.w; v[p][4] = v[p][4] * s1.x; v[p][5] = v[p][5] * s1.y; v[p][6] = v[p][6] * s1.z; v[p][7] = v[p][7] * s1.w; } }
    if (nok) {
#pragma unroll
        for (int j = 0; j < 4; ++j) { bf16* dst = WT + (size_t)rm(n + j) * K + k0 + 8 * g;
#pragma unroll
            for (int p = 0; p < 2; ++p) { v4u o; o.x = pk2(v[p][0][j], v[p][1][j]); o.y = pk2(v[p][2][j], v[p][3][j]); o.z = pk2(v[p][4][j], v[p][5][j]); o.w = pk2(v[p][6][j], v[p][7][j]);
                *(v4u*)(dst + 32 * p) = o; } } }
}
template <class RowMap>
__device__ __forceinline__ void transpose_item8(const float* W, int K, int N, unsigned char* WT, const RowMap rm, int item, int lane) {
    const int nblk = N >> 5, kb = item / nblk, nb = item - kb * nblk, k0 = 128 * kb, n0 = 32 * nb;
    const int g = lane >> 3, nq = lane & 7, n = n0 + 4 * nq;
    const float* src = W + (size_t)(k0 + 16 * g) * N + n;
    f32x4 v[16];
#pragma unroll
    for (int i = 0; i < 16; ++i) v[i] = *(const f32x4*)(src + (size_t)i * N);
#pragma unroll
    for (int j = 0; j < 4; ++j) { v4u o;
        o.x = pg8::pk4_fp8(v[0][j] * pg8::F8_SW, v[1][j] * pg8::F8_SW, v[2][j] * pg8::F8_SW, v[3][j] * pg8::F8_SW); o.y = pg8::pk4_fp8(v[4][j] * pg8::F8_SW, v[5][j] * pg8::F8_SW, v[6][j] * pg8::F8_SW, v[7][j] * pg8::F8_SW);
        o.z = pg8::pk4_fp8(v[8][j] * pg8::F8_SW, v[9][j] * pg8::F8_SW, v[10][j] * pg8::F8_SW, v[11][j] * pg8::F8_SW); o.w = pg8::pk4_fp8(v[12][j] * pg8::F8_SW, v[13][j] * pg8::F8_SW, v[14][j] * pg8::F8_SW, v[15][j] * pg8::F8_SW);
        *(v4u*)(WT + (size_t)rm(n + j) * K + k0 + 16 * g) = o; }
}
__device__ __forceinline__ void rms_row_to_bf16(const float* xrow, const float* w, bf16* orow, int lane) {
    const f32x4* xr = (const f32x4*)xrow + lane;
    f32x4 v[8], wq[8]; float s = 0.f;
#pragma unroll
    for (int j = 0; j < 8; ++j) v[j] = xr[64 * j];
#pragma unroll
    for (int j = 0; j < 8; ++j) wq[j] = ((const f32x4*)w)[lane + 64 * j];
    __builtin_amdgcn_sched_barrier(0);
#pragma unroll
    for (int j = 0; j < 8; ++j) s += (v[j].x * v[j].x + v[j].y * v[j].y) + (v[j].z * v[j].z + v[j].w * v[j].w);
    const float rstd = 1.f / sqrtf(wave_sum(s) * (1.f / DM) + EPS);
    v2u* o8 = (v2u*)orow + lane;
#pragma unroll
    for (int j = 0; j < 8; ++j) { const f32x4 wv = wq[j]; v2u o; o.x = pk2(v[j].x * rstd * wv.x, v[j].y * rstd * wv.y); o.y = pk2(v[j].z * rstd * wv.z, v[j].w * rstd * wv.w); o8[64 * j] = o; }
}
__device__ __forceinline__ void p0_prologue(Frame& F) {
    const int gw = F.vcu * NWAVES + F.wave, NGW = F.G * NWAVES;
    constexpr int I_IN = 32 * 250, I_SQ = 32 * 32, I_W1 = 16 * 128, I_W2 = 16 * 64;
    constexpr int NITEMS = I_IN + 3 * I_SQ + NEXP * I_W1 + NEXP * I_W2;
    for (int it = gw; it < NITEMS; it += NGW) {
        int r = it;
        if (r < I_IN) { transpose_item(INP(1), DM, NIN, WSP(bf16, WS_WIN), RmIn(), nullptr, r, LANE()); continue; } r -= I_IN;
        if (r < I_SQ) { transpose_item(INP(8), DM, DM, WSP(bf16, WS_WSSD), RmId(), INP(7), r, LANE()); continue; } r -= I_SQ;
        if (r < I_SQ) { transpose_item(INP(9), DM, DM, WSP(bf16, WS_WATT), RmId(), nullptr, r, LANE()); continue; } r -= I_SQ;
        if (r < I_SQ) { transpose_item(INP(10), DM, DM, WSP(bf16, WS_WOUT), RmId(), nullptr, r, LANE()); continue; } r -= I_SQ;
        if (r < NEXP * I_W1) { const int e = r / I_W1; transpose_item8(INP(15) + (size_t)e * DM * 4096, DM, 4096, WSP(unsigned char, WS_W1) + (size_t)e * 4096 * DM, RmW1(), r - e * I_W1, LANE()); continue; } r -= NEXP * I_W1;
        { const int e = r / I_W2; transpose_item8(INP(17) + (size_t)e * DM * DM, DM, DM, WSP(unsigned char, WS_W2) + (size_t)e * DM * DM, RmId(), r - e * I_W2, LANE()); }
    }
    { const int gt = F.vcu * (NWAVES * 64) + TID(), NT = F.G * NWAVES * 64; v4u z = {0u, 0u, 0u, 0u};
      for (int i = gt; i < (NU - UC_END) * DM / 8; i += NT) ((v4u*)(WSP(bf16, WS_WIN) + (size_t)UC_END * DM))[i] = z;
      for (int i = gt; i < NEXP * DM; i += NT) { const int e = i >> 11, k = i & 2047; WSP(float, WS_RWT)[i] = INP(13)[(size_t)k * NEXP + e]; } }
    for (int pos = gw; pos < SEQ; pos += NGW) { const int f = LANE(); float cs = 0.f, sn = 0.f;
        if (f < 24) { const float inv = f < 16 ? powf(500000.0f, -(float)f * (1.0f / 16.0f)) : powf(500000.0f, -(float)(f - 16) * (1.0f / 8.0f)); sincosf((float)pos * inv, &sn, &cs); }
        if (f < 32) { float* dst = WSP(float, WS_ROPE) + ((size_t)pos * 32 + f) * 2; dst[0] = cs; dst[1] = sn; } }
    for (int m = gw; m < T; m += NGW) rms_row_to_bf16(INP(0) + (size_t)m * DM, INP(11), WSP(bf16, WS_XN) + (size_t)m * DM, LANE());
}

__device__ __forceinline__ float softplusf(float x) { return x > 20.f ? x : log1pf(expf(x)); }
__device__ __forceinline__ void p2_prep(Frame& F) {
    const int gt = F.vcu * (NWAVES * 64) + TID(), NT = F.G * NWAVES * 64;
    const int gw = F.vcu * NWAVES + F.wave, NGW = F.G * NWAVES, lane = LANE();
    for (int it = gt; it < (T / 16) * 384; it += NT) {
        const int ch = it % 384, seg = it / 384, t0 = seg * 16, c0 = ch * 8;
        float w[4][8], cb[8], h0[8], h1[8], h2[8];
#pragma unroll
        for (int j = 0; j < 4; ++j) { const f32x4 a = *(const f32x4*)(INP(2) + j * 3072 + c0), b = *(const f32x4*)(INP(2) + j * 3072 + c0 + 4);
            w[j][0] = a.x; w[j][1] = a.y; w[j][2] = a.z; w[j][3] = a.w; w[j][4] = b.x; w[j][5] = b.y; w[j][6] = b.z; w[j][7] = b.w; }
        { const f32x4 a = *(const f32x4*)(INP(3) + c0), b = *(const f32x4*)(INP(3) + c0 + 4); cb[0] = a.x; cb[1] = a.y; cb[2] = a.z; cb[3] = a.w; cb[4] = b.x; cb[5] = b.y; cb[6] = b.z; cb[7] = b.w; }
        const bool first = (t0 % SEQ) == 0;
        const bf16* src = WSP(bf16, WS_U) + (size_t)t0 * NU + UC_XBC + c0;
        v4u r0 = {0u, 0u, 0u, 0u}, r1 = r0, r2 = r0;
        if (!first) { r0 = *(const v4u*)(src - 3 * (size_t)NU); r1 = *(const v4u*)(src - 2 * (size_t)NU); r2 = *(const v4u*)(src - (size_t)NU); }
#define UNPK(dst, r) do { dst[0] = bflo(r.x); dst[1] = bfhi(r.x); dst[2] = bflo(r.y); dst[3] = bfhi(r.y); dst[4] = bflo(r.z); dst[5] = bfhi(r.z); dst[6] = bflo(r.w); dst[7] = bfhi(r.w); } while (0)
        UNPK(h0, r0); UNPK(h1, r1); UNPK(h2, r2);
        bf16* dst = WSP(bf16, WS_XBC) + (size_t)t0 * 3072 + c0;
        v4u rcs[16];
#pragma unroll
        for (int t = 0; t < 16; ++t) rcs[t] = *(const v4u*)(src + (size_t)t * NU);
        __builtin_amdgcn_sched_barrier(0);
#pragma unroll
        for (int t = 0; t < 16; ++t) {
            const v4u rc = rcs[t]; float cur[8], o[8]; UNPK(cur, rc);
#pragma unroll
            for (int i = 0; i < 8; ++i) { const float a = cb[i] + w[0][i] * h0[i] + w[1][i] * h1[i] + w[2][i] * h2[i] + w[3][i] * cur[i]; o[i] = siluf(a); h0[i] = h1[i]; h1[i] = h2[i]; h2[i] = cur[i]; }
            v4u ov; ov.x = pk2(o[0], o[1]); ov.y = pk2(o[2], o[3]); ov.z = pk2(o[4], o[5]); ov.w = pk2(o[6], o[7]);
            *(v4u*)(dst + (size_t)t * 3072) = ov;
        }
#undef UNPK
    }
    for (int ch = gw; ch < (T / 128) * 32; ch += NGW) {
        const int h = ch & 31, ck = ch >> 5; const float bias = INP(4)[h], a = -expf(INP(5)[h]);
        const size_t t0 = (size_t)ck * 128 + 2 * lane;
        const float d0 = softplusf(bf2f(WSP(bf16, WS_U)[t0 * NU + UC_DT + h]) + bias), d1 = softplusf(bf2f(WSP(bf16, WS_U)[(t0 + 1) * NU + UC_DT + h]) + bias);
        const float a0 = d0 * a, a1 = a0 + d1 * a;
        float run = a1;
#pragma unroll
        for (int o = 1; o < 64; o <<= 1) { const float up = __shfl_up(run, o); if (lane >= o) run += up; }
        const float excl = run - a1;
        WSP(float, WS_DT)[t0 * 32 + h] = d0; WSP(float, WS_DT)[(t0 + 1) * 32 + h] = d1;
        WSP(float, WS_DACS)[t0 * 32 + h] = excl + a0; WSP(float, WS_DACS)[(t0 + 1) * 32 + h] = excl + a1;
    }
    for (int t = gw; t < T; t += NGW) {
        const int pos = t % SEQ;
        const bf16* row = WSP(bf16, WS_U) + (size_t)t * NU;
        const f32x4* rtp = (const f32x4*)(WSP(float, WS_ROPE) + (size_t)pos * 64);
        v4u aq[2][4]; f32x4 rt[12];
#pragma unroll
        for (int wk = 0; wk < 2; ++wk) { const v4u* src = (const v4u*)(row + (wk ? UC_K : UC_Q) + 32 * lane);
#pragma unroll
            for (int j = 0; j < 4; ++j) aq[wk][j] = src[j]; }
        const int part = lane & 7;
        const v4u mq = *(const v4u*)(row + UC_QI + 8 * lane), mk = *(const v4u*)(row + UC_KI + 8 * part);
#pragma unroll
        for (int j = 0; j < 12; ++j) rt[j] = rtp[j];
        __builtin_amdgcn_sched_barrier(0);
#define R16(i) rt[(i) >> 2][(i) & 3]
#define R8(i) rt[8 + ((i) >> 2)][(i) & 3]
#pragma unroll
        for (int wk = 0; wk < 2; ++wk) {
            v4u a[4];
#pragma unroll
            for (int j = 0; j < 4; ++j) a[j] = aq[wk][j];
            if ((lane & 3) == 0) { float x[32];
#pragma unroll
                for (int j = 0; j < 4; ++j) { x[8 * j] = bflo(a[j].x); x[8 * j + 1] = bfhi(a[j].x); x[8 * j + 2] = bflo(a[j].y); x[8 * j + 3] = bfhi(a[j].y); x[8 * j + 4] = bflo(a[j].z); x[8 * j + 5] = bfhi(a[j].z); x[8 * j + 6] = bflo(a[j].w); x[8 * j + 7] = bfhi(a[j].w); }
                float o[32];
#pragma unroll
                for (int i = 0; i < 16; ++i) { const float cs = R16(2 * i), sn = R16(2 * i + 1); o[i] = x[i] * cs - x[16 + i] * sn; o[16 + i] = x[16 + i] * cs + x[i] * sn; }
#pragma unroll
                for (int j = 0; j < 4; ++j) { a[j].x = pk2(o[8 * j], o[8 * j + 1]); a[j].y = pk2(o[8 * j + 2], o[8 * j + 3]); a[j].z = pk2(o[8 * j + 4], o[8 * j + 5]); a[j].w = pk2(o[8 * j + 6], o[8 * j + 7]); } }
            v4u* dst = (v4u*)(WSP(bf16, wk ? WS_KR : WS_QR) + (size_t)t * DM + 32 * lane);
#pragma unroll
            for (int j = 0; j < 4; ++j) dst[j] = a[j];
        }
#pragma unroll
        for (int wk = 0; wk < 2; ++wk) {
            const v4u m = wk ? mk : mq;
            v4u pn; pn.x = __shfl_xor(m.x, 1); pn.y = __shfl_xor(m.y, 1); pn.z = __shfl_xor(m.z, 1); pn.w = __shfl_xor(m.w, 1);
            v4u o = m;
            if (part < 2) { float a[8], b[8], r[8];
                a[0] = bflo(m.x); a[1] = bfhi(m.x); a[2] = bflo(m.y); a[3] = bfhi(m.y); a[4] = bflo(m.z); a[5] = bfhi(m.z); a[6] = bflo(m.w); a[7] = bfhi(m.w);
                b[0] = bflo(pn.x); b[1] = bfhi(pn.x); b[2] = bflo(pn.y); b[3] = bfhi(pn.y); b[4] = bflo(pn.z); b[5] = bfhi(pn.z); b[6] = bflo(pn.w); b[7] = bfhi(pn.w);
#pragma unroll
                for (int i = 0; i < 8; ++i) { const float cs = R8(2 * i), sn = R8(2 * i + 1); r[i] = part == 0 ? a[i] * cs - b[i] * sn : a[i] * cs + b[i] * sn; }
                o.x = pk2(r[0], r[1]); o.y = pk2(r[2], r[3]); o.z = pk2(r[4], r[5]); o.w = pk2(r[6], r[7]); }
            if (wk == 0) *(v4u*)(WSP(bf16, WS_QIR) + (size_t)t * 512 + 8 * lane) = o;
            else if (lane < 8) *(v4u*)(WSP(bf16, WS_KIR) + (size_t)t * 64 + 8 * lane) = o;
        }
#undef R16
#undef R8
    }
}

__device__ __forceinline__ int crow16(int r, int hi) { return (r & 3) + 8 * (r >> 2) + 4 * hi; }
__device__ __forceinline__ bf16x8 lds_b128(const LAS unsigned char* p) { return *(const LAS bf16x8*)p; }
__device__ __forceinline__ bf16x8 lds_tr8(const LAS unsigned char* p, int rowstep4) {
    typedef short v4i16_t __attribute__((ext_vector_type(4)));
    const v4i16_t a = __builtin_amdgcn_ds_read_tr16_b64_v4i16((LAS v4i16_t*)p);
    const v4i16_t b = __builtin_amdgcn_ds_read_tr16_b64_v4i16((LAS v4i16_t*)(p + rowstep4));
    return (bf16x8){a[0], a[1], a[2], a[3], b[0], b[1], b[2], b[3]};
}
constexpr int SP_C = 272, SP_X = 144;
constexpr int S_CS = 0, S_BS = 34816, S_XS = 69632, S_XW = 88064, S_VEC = 106496, S_YS = 107520;
struct P3R { v4u b[4], c[4], x[2]; float dtr[2], dar[2], da_last, dac1, dt1; };
__device__ __forceinline__ void p3_load(P3R& R, int u, int tid) {
    const int h = u & 31, bc = u >> 5, g = h >> 3; const size_t t0 = (size_t)bc * 128;
    R.da_last = WSP(float, WS_DACS)[(t0 + 127) * 32 + h];
#pragma unroll
    for (int i = 0; i < 4; ++i) { const int idx = tid + 512 * i, row = idx >> 4, ch = idx & 15; const bf16* src = WSP(bf16, WS_XBC) + (t0 + row) * 3072 + 2048 + g * 128 + ch * 8;
        R.b[i] = *(const v4u*)src; R.c[i] = *(const v4u*)(src + 512); }
#pragma unroll
    for (int i = 0; i < 2; ++i) { const int idx = tid + 512 * i, row = idx >> 3, ch = idx & 7; R.x[i] = *(const v4u*)(WSP(bf16, WS_XBC) + (t0 + row) * 3072 + h * 64 + ch * 8);
        R.dtr[i] = WSP(float, WS_DT)[(t0 + row) * 32 + h]; R.dar[i] = WSP(float, WS_DACS)[(t0 + row) * 32 + h]; }
    R.dac1 = WSP(float, WS_DACS)[(t0 + (tid & 127)) * 32 + h]; R.dt1 = WSP(float, WS_DT)[(t0 + (tid & 127)) * 32 + h];
}
__device__ __forceinline__ void p3_ssd_unit(Frame& F, int u, int un, P3R& R) {
    const int tid = TID(), lane = LANE(), w = F.wave, r32 = lane & 31, hh = lane >> 5;
    const int h = u & 31, bc = u >> 5; const size_t t0 = (size_t)bc * 128;
    LAS unsigned char* L = F.lds + RING_OFF;
    LAS float* dacs = (LAS float*)(L + S_VEC); LAS float* dtv = dacs + 128;
#pragma unroll
    for (int i = 0; i < 4; ++i) { const int idx = tid + 512 * i, row = idx >> 4, ch = idx & 15;
        *(LAS v4u*)(L + S_BS + row * SP_C + ch * 16) = R.b[i]; *(LAS v4u*)(L + S_CS + row * SP_C + ch * 16) = R.c[i]; }
#pragma unroll
    for (int i = 0; i < 2; ++i) { const int idx = tid + 512 * i, row = idx >> 3, ch = idx & 7; const v4u xv = R.x[i];
        const float wl = R.dtr[i] * __expf(R.da_last - R.dar[i]);
        *(LAS v4u*)(L + S_XS + row * SP_X + ch * 16) = xv;
        v4u xw; xw.x = pk2(bflo(xv.x) * wl, bfhi(xv.x) * wl); xw.y = pk2(bflo(xv.y) * wl, bfhi(xv.y) * wl); xw.z = pk2(bflo(xv.z) * wl, bfhi(xv.z) * wl); xw.w = pk2(bflo(xv.w) * wl, bfhi(xv.w) * wl);
        *(LAS v4u*)(L + S_XW + row * SP_X + ch * 16) = xw; }
    if (tid < 128) { dacs[tid] = R.dac1; dtv[tid] = R.dt1; }
    __syncthreads();
    p3_load(R, un, tid);
    __builtin_amdgcn_sched_barrier(0);
    const int li = w >> 1;
    f32x16 acc0 = {}, acc1 = {};
    { const int j0 = (w & 1) * 2;
      const LAS unsigned char* cp = L + S_CS + (32 * li + r32) * SP_C + hh * 16;
      if (j0 <= li) { const LAS unsigned char* bp = L + S_BS + (32 * j0 + r32) * SP_C + hh * 16;
#pragma unroll
          for (int ks = 0; ks < 8; ++ks) acc0 = __builtin_amdgcn_mfma_f32_32x32x16_bf16(lds_b128(bp + ks * 32), lds_b128(cp + ks * 32), acc0, 0, 0, 0); }
      if (j0 + 1 <= li) { const LAS unsigned char* bp = L + S_BS + (32 * (j0 + 1) + r32) * SP_C + hh * 16;
#pragma unroll
          for (int ks = 0; ks < 8; ++ks) acc1 = __builtin_amdgcn_mfma_f32_32x32x16_bf16(lds_b128(bp + ks * 32), lds_b128(cp + ks * 32), acc1, 0, 0, 0); } }
    __syncthreads();
    { const int j0 = (w & 1) * 2, l = 32 * li + r32; const float dl = dacs[l];
#pragma unroll
      for (int jj = 0; jj < 2; ++jj) { const int sj = j0 + jj; if (sj <= li) {
#pragma unroll
          for (int q = 0; q < 4; ++q) { float gv[4];
#pragma unroll
              for (int e = 0; e < 4; ++e) { const int s = 32 * sj + 8 * q + 4 * hh + e; const float a = jj ? acc1[4 * q + e] : acc0[4 * q + e];
                  gv[e] = (s <= l) ? a * __expf(dl - dacs[s]) * dtv[s] : 0.f; }
              v2u o; o.x = pk2(gv[0], gv[1]); o.y = pk2(gv[2], gv[3]);
              *(LAS v2u*)(L + S_CS + l * SP_C + (32 * sj + 8 * q + 4 * hh) * 2) = o; } } } }
    __syncthreads();
    { const int pb = w & 1; f32x16 acc = {};
      const LAS unsigned char* gp = L + S_CS + (32 * li + r32) * SP_C + hh * 16;
      const LAS unsigned char* xp = L + S_XS + (8 * hh + ((lane & 15) >> 2)) * SP_X + (32 * pb + 16 * ((lane >> 4) & 1) + 4 * (lane & 3)) * 2;
      for (int ks = 0; ks < 2 * (li + 1); ++ks) acc = __builtin_amdgcn_mfma_f32_32x32x16_bf16(lds_b128(gp + ks * 32), lds_tr8(xp + ks * 16 * SP_X, 4 * SP_X), acc, 0, 0, 0);
      LAS bf16* ys = (LAS bf16*)(L + S_YS);
#pragma unroll
      for (int r = 0; r < 16; ++r) ys[(32 * li + crow16(r, hh)) * 72 + 32 * pb + r32] = (bf16)f2bf(acc[r]); }
    { const int pb = w >> 2, nb = w & 3; f32x16 acc = {};
      const int trow = 8 * hh + ((lane & 15) >> 2), tcol = 16 * ((lane >> 4) & 1) + 4 * (lane & 3);
      const LAS unsigned char* ap = L + S_XW + trow * SP_X + (32 * pb + tcol) * 2;
      const LAS unsigned char* bp = L + S_BS + trow * SP_C + (32 * nb + tcol) * 2;
#pragma unroll
      for (int ks = 0; ks < 8; ++ks) acc = __builtin_amdgcn_mfma_f32_32x32x16_bf16(lds_tr8(ap + ks * 16 * SP_X, 4 * SP_X), lds_tr8(bp + ks * 16 * SP_C, 4 * SP_C), acc, 0, 0, 0);
      float* st = WSP(float, WS_STATES) + ((size_t)u * 64 + 32 * pb) * 128 + 32 * nb + r32;
#pragma unroll
      for (int r = 0; r < 16; ++r) st[(size_t)crow16(r, hh) * 128] = acc[r]; }
    __syncthreads();
#pragma unroll
    for (int i = 0; i < 2; ++i) { const int idx = tid + 512 * i, l = idx >> 3, c8 = (idx & 7) * 8;
        *(v4u*)(WSP(bf16, WS_YD) + (t0 + l) * 2048 + h * 64 + c8) = *(const LAS v4u*)(L + S_YS + (l * 72 + c8) * 2); }
    __syncthreads();
}
constexpr int IX_Q = 0, IX_W = 32768;
__device__ __forceinline__ void p3_index_group(Frame& F, int b, int qg) {
    const int tid = TID(), lane = LANE(), r32 = lane & 31, hh = lane >> 5;
    LAS unsigned char* L = F.lds + RING_OFF; LAS float* wl = (LAS float*)(L + IX_W);
    const bf16* Ub = WSP(bf16, WS_U) + ((size_t)b * SEQ) * NU;
#pragma unroll
    for (int i = 0; i < 4; ++i) { const int pc = tid + 512 * i, ln = pc & 63, ks = (pc >> 6) & 3, h8 = pc >> 8;
        *(LAS v4u*)(L + IX_Q + pc * 16) = *(const v4u*)(WSP(bf16, WS_QIR) + ((size_t)b * SEQ + qg * 32 + (ln & 31)) * 512 + h8 * 64 + ks * 16 + 8 * (ln >> 5)); }
    if (tid < 256) { const int h8 = tid >> 5, q = tid & 31; wl[tid] = bf2f(Ub[(size_t)(qg * 32 + q) * NU + UC_WI + h8]) * 0.044194173824159216f; }
    __syncthreads();
    float wq[8];
#pragma unroll
    for (int h8 = 0; h8 < 8; ++h8) wq[h8] = wl[h8 * 32 + r32];
#define KROW(kt_) (WSP(bf16, WS_KIR) + ((size_t)b * SEQ + ((kt_) <= qg ? (kt_) : qg) * 32 + r32) * 64 + 8 * hh)
    bf16x8 kfa[4], kfb[4];
    { const bf16* ka = KROW(F.wave); const bf16* kb = KROW(F.wave + NWAVES);
#pragma unroll
      for (int ks = 0; ks < 4; ++ks) { kfa[ks] = *(const bf16x8*)(ka + ks * 16); kfb[ks] = *(const bf16x8*)(kb + ks * 16); } }
#pragma nounroll
    for (int kt = F.wave; kt <= qg; kt += 2 * NWAVES) {
        bf16x8 kna[4], knb[4];
        { const bf16* ka = KROW(kt + 2 * NWAVES); const bf16* kb = KROW(kt + 3 * NWAVES);
#pragma unroll
          for (int ks = 0; ks < 4; ++ks) { kna[ks] = *(const bf16x8*)(ka + ks * 16); knb[ks] = *(const bf16x8*)(kb + ks * 16); } }
        __builtin_amdgcn_sched_barrier(0);
        f32x16 sca = {}, scb = {};
#pragma nounroll
        for (int h8 = 0; h8 < 8; ++h8) { f32x16 aa = {}, ab = {};
            const LAS unsigned char* qp = L + IX_Q + h8 * 4096 + lane * 16; const float wh = wl[h8 * 32 + r32];
#pragma unroll
            for (int ks = 0; ks < 4; ++ks) { const bf16x8 qf = lds_b128(qp + ks * 1024);
                aa = __builtin_amdgcn_mfma_f32_32x32x16_bf16(kfa[ks], qf, aa, 0, 0, 0); ab = __builtin_amdgcn_mfma_f32_32x32x16_bf16(kfb[ks], qf, ab, 0, 0, 0); }
#pragma unroll
            for (int e = 0; e < 16; ++e) { sca[e] += wh * fmaxf(aa[e], 0.f); scb[e] += wh * fmaxf(ab[e], 0.f); } }
        float* srow = WSP(float, WS_S) + ((size_t)b * SEQ + qg * 32 + r32) * SEQ + kt * 32 + 4 * hh;
#pragma unroll
        for (int q = 0; q < 4; ++q) *(f32x4*)(srow + 8 * q) = (f32x4){sca[4 * q], sca[4 * q + 1], sca[4 * q + 2], sca[4 * q + 3]};
        if (kt + NWAVES <= qg) {
#pragma unroll
            for (int q = 0; q < 4; ++q) *(f32x4*)(srow + NWAVES * 32 + 8 * q) = (f32x4){scb[4 * q], scb[4 * q + 1], scb[4 * q + 2], scb[4 * q + 3]}; }
#pragma unroll
        for (int ks = 0; ks < 4; ++ks) { kfa[ks] = kna[ks]; kfb[ks] = knb[ks]; }
    }
#undef KROW
    __syncthreads();
}
__device__ __forceinline__ void p3_phase(Frame& F) {
#ifndef NO_P3A
    { constexpr int NUN = 2 * 64 * 32; int u = F.vcu;
      if (u < NUN) { P3R R; p3_load(R, u, TID());
#pragma nounroll
          for (; u < NUN; u += F.G) p3_ssd_unit(F, u, u + F.G < NUN ? u + F.G : u, R); } }
#endif
#if !defined(NO_P3B) && !defined(NO_ATTN)
    for (int it = F.vcu; it < 256; it += F.G) { const int b = it >> 7, x = it & 127; p3_index_group(F, b, x); p3_index_group(F, b, 255 - x); }
#endif
}

__device__ __forceinline__ unsigned fkey(float v) { NANCHK(v != v, 0); const unsigned u = __float_as_uint(v + 0.0f);
    return u ^ ((unsigned)((int)u >> 31) | 0x80000000u); }
__device__ __forceinline__ void sacc(int& c, int v) { asm volatile("s_add_i32 %0, %0, %1" : "+s"(c) : "s"(v) : "scc"); }
__device__ __forceinline__ int wave_sum_i(int v) {
    v += __builtin_amdgcn_update_dpp(0, v, 0xB1, 0xf, 0xf, false);
    v += __builtin_amdgcn_update_dpp(0, v, 0x4E, 0xf, 0xf, false);
    v += __builtin_amdgcn_update_dpp(0, v, 0x141, 0xf, 0xf, false);
    v += __builtin_amdgcn_update_dpp(0, v, 0x140, 0xf, 0xf, false);
    return __builtin_amdgcn_readlane(v, 0) + __builtin_amdgcn_readlane(v, 16) + __builtin_amdgcn_readlane(v, 32) + __builtin_amdgcn_readlane(v, 48);
}
__device__ __forceinline__ void cnt4(int (&c)[4], unsigned k0, unsigned k1, unsigned k2, unsigned k3, unsigned mid) {
    unsigned long long t0, t1, t2, t3;
    asm("v_cmp_ge_u32_e64 %4, %8, %12\n\tv_cmp_ge_u32_e64 %5, %9, %12\n\tv_cmp_ge_u32_e64 %6, %10, %12\n\tv_cmp_ge_u32_e64 %7, %11, %12\n\t"
        "v_addc_co_u32_e64 %0, %4, 0, %0, %4\n\tv_addc_co_u32_e64 %1, %5, 0, %1, %5\n\tv_addc_co_u32_e64 %2, %6, 0, %2, %6\n\tv_addc_co_u32_e64 %3, %7, 0, %3, %7"
        : "+v"(c[0]), "+v"(c[1]), "+v"(c[2]), "+v"(c[3]), "=&s"(t0), "=&s"(t1), "=&s"(t2), "=&s"(t3) : "v"(k0), "v"(k1), "v"(k2), "v"(k3), "v"(mid));
}
template <int NR, int NL>
__device__ __forceinline__ void select_row(float (&raw)[64], const float* Srow, int pos, unsigned long long* Mq, int ntw, int lane, LAS unsigned* lk, LAS unsigned long long* lw, bool okn, int qn) {
    const int ni = (pos >> 6) + 1;
    unsigned key[NR];
    int ln = lane; asm volatile("" : "+v"(ln));
    unsigned kmax = 0u;
#ifdef DOUBLE_CONV
#pragma nounroll
    for (int rep_ = 0; rep_ < 2; ++rep_) { asm volatile("" : "+v"(ln)); kmax = 0u;
#endif
#pragma unroll
    for (int i = 0; i < NR; ++i) { key[i] = 0u; if (i < ni) { const int kidx = i * 64 + ln; key[i] = (kidx <= pos) ? fkey(raw[i]) : 0u; kmax = key[i] > kmax ? key[i] : kmax; } if ((i & 31) == 31) __builtin_amdgcn_sched_barrier(0); }
#pragma unroll
    for (int i = 0; i < NL; ++i) if (NR + i < ni) raw[i] = Srow[(NR + i) * 64 + ln];
    __builtin_amdgcn_sched_barrier(0);
#pragma unroll
    for (int i = 0; i < NL; ++i) { unsigned k = 0u; if (NR + i < ni) { const int kidx = (NR + i) * 64 + ln; k = (kidx <= pos) ? fkey(raw[i]) : 0u; kmax = k > kmax ? k : kmax; } lk[i * 64 + lane] = k; if ((i & 31) == 31) __builtin_amdgcn_sched_barrier(0); }
#ifdef DOUBLE_CONV
    }
#endif
    if (okn) { const int pos_ = qn & (SEQ - 1); if (pos_ >= 256) { const int ni_ = (pos_ >> 6) + 1; const float* sr_ = WSP(float, WS_S) + (size_t)qn * SEQ + lane;
#pragma unroll
        for (int i = 0; i < 64; ++i) if (i < ni_) raw[i] = sr_[i * 64]; } }
#pragma unroll
    for (int o = 1; o < 64; o <<= 1) { const unsigned ok = (unsigned)__shfl_xor((int)kmax, o); kmax = ok > kmax ? ok : kmax; }
    unsigned lo, hi; int clo;
#ifdef DOUBLE_BISECT
#pragma nounroll
    for (int rep_ = 0; rep_ < DOUBLE_BISECT; ++rep_) { asm volatile("" : "+v"(kmax));
#endif
    lo = 0u; hi = kmax + 1u; clo = 0x7fffffff;
    float glo = 0.f, ghi = -256.f; int side = 0, it = 0; const bool okp = kmax > 0x82000000u; const unsigned p1 = kmax - 0x00800000u;
#pragma nounroll
    while (hi - lo > 1u) {
        const unsigned wd = hi - lo; unsigned mid = lo + (wd >> 1);
        if (okp && it == 0) mid = p1;
        else if (okp && it == 1 && hi == p1) mid = kmax - 0x01800000u;
        else if (clo != 0x7fffffff && (it & 7) != 7) { const float f = (glo + 0.5f) * __builtin_amdgcn_rcpf(glo - ghi); unsigned off = (unsigned)((float)wd * f); off = off < 1u ? 1u : off; off = off > wd - 1u ? wd - 1u : off; mid = lo + off; }
        ++it;
        int c4[4] = {0, 0, 0, 0};
#pragma unroll
        for (int i = 0; i < NR; i += 4) cnt4(c4, key[i], key[i + 1], key[i + 2], key[i + 3], mid);
#pragma unroll
        for (int i = 0; i < NL; i += 4) cnt4(c4, lk[i * 64 + lane], lk[(i + 1) * 64 + lane], lk[(i + 2) * 64 + lane], lk[(i + 3) * 64 + lane], mid);
        const int c = wave_sum_i((c4[0] + c4[1]) + (c4[2] + c4[3]));
        if (c >= 256) { lo = mid; clo = c; if (c == 256) break; glo = (float)(c - 256); if (side == 1) ghi *= 0.5f; side = 1; }
        else { hi = mid; ghi = (float)(c - 256); if (side == -1) glo *= 0.5f; side = -1; }
    }
#ifdef DOUBLE_BISECT
    }
#endif
#ifdef DOUBLE_FINAL
#pragma nounroll
    for (int rep_ = 0; rep_ < 2; ++rep_) { asm volatile("" : "+v"(lo));
#endif
    int need = 0x7fffffff;
    if (clo != 256) { int cl = 0;
#pragma unroll
        for (int i = 0; i < NR; ++i) cl += (key[i] > lo) ? 1 : 0;
#pragma unroll
        for (int i = 0; i < NL; ++i) cl += (lk[i * 64 + lane] > lo) ? 1 : 0;
        need = 256 - wave_sum_i(cl); }
    unsigned wl0 = 0u, wh0 = 0u, wl1 = 0u, wh1 = 0u; int ln2 = lane; asm volatile("" : "+v"(ln2));
#define PUT_WORD(i_, bal_) do { const bool me_ = ln2 == ((i_) & 63); if ((i_) < 64) { wl0 = me_ ? (unsigned)(bal_) : wl0; wh0 = me_ ? (unsigned)((bal_) >> 32) : wh0; } else { wl1 = me_ ? (unsigned)(bal_) : wl1; wh1 = me_ ? (unsigned)((bal_) >> 32) : wh1; } } while (0)
    if (clo == 256) {
#pragma unroll
        for (int i = 0; i < NR + NL; ++i) { const unsigned kv = i < NR ? key[i < NR ? i : 0] : lk[(i - NR) * 64 + lane];
            const unsigned long long bal = __ballot(kv >= lo); PUT_WORD(i, bal); __builtin_amdgcn_sched_barrier(0); }
    } else {
    int run = 0; unsigned lo2 = lo; asm volatile("" : "+v"(lo2));
#pragma unroll
    for (int i = 0; i < NR + NL; ++i) {
        const unsigned kv = i < NR ? key[i < NR ? i : 0] : lk[(i - NR) * 64 + lane];
        const bool eq = kv == lo2; const unsigned long long be = __ballot(eq);
        const int pre = run + __popcll(be & ((1ull << lane) - 1ull)); run += __popcll(be);
        const unsigned long long bal = __ballot((kv > lo2) || (eq && pre < need));
        PUT_WORD(i, bal);
        __builtin_amdgcn_sched_barrier(0);
    }
    }
#undef PUT_WORD
    if (lane < ntw && lane < NR + NL) Mq[(size_t)lane * SEQ] = ((unsigned long long)wh0 << 32) | wl0;
    if (NR + NL > 64 && lane + 64 < ntw) Mq[(size_t)(lane + 64) * SEQ] = ((unsigned long long)wh1 << 32) | wl1;
#ifdef DOUBLE_FINAL
    }
#endif
}
__device__ __forceinline__ void p4_phase(Frame& F) {
    const int gt = F.vcu * (NWAVES * 64) + TID(), NT = F.G * NWAVES * 64;
    const int lane = LANE();
#ifndef NO_P4A
#ifdef DOUBLE_P4A
#pragma nounroll
    for (int rep_ = 0; rep_ < 2; ++rep_)
#endif
    for (int it = gt; it < 2 * 32 * 64 * 32; it += NT) {
        const int n4 = it & 31, p = (it >> 5) & 63, h = (it >> 11) & 31, b = it >> 16;
        f32x4 hs = {0.f, 0.f, 0.f, 0.f};
#pragma nounroll
        for (int c0 = 0; c0 < 64; c0 += 16) {
            f32x4 st[16]; float dc[16];
#pragma unroll
            for (int k = 0; k < 16; ++k) { const size_t idx = ((size_t)(b * 64 + c0 + k) * 32 + h), off = (idx * 64 + p) * 128 + n4 * 4;
                st[k] = *(const f32x4*)(WSP(float, WS_STATES) + off); dc[k] = WSP(float, WS_DACS)[((size_t)(b * 64 + c0 + k) * 128 + 127) * 32 + h]; }
            __builtin_amdgcn_sched_barrier(0);
#pragma unroll
            for (int k = 0; k < 16; ++k) { const size_t idx = ((size_t)(b * 64 + c0 + k) * 32 + h), off = (idx * 64 + p) * 128 + n4 * 4;
                v2u o; o.x = pk2(hs.x, hs.y); o.y = pk2(hs.z, hs.w); *(v2u*)(WSP(bf16, WS_PREV) + off) = o;
                hs = hs * __expf(dc[k]) + st[k]; }
        }
    }
#endif
#ifndef NO_ATTN
    const int nk = 8 * ((1024 + 4 * F.G - 1) / (4 * F.G));
    float raw[64];
#define P4_QUERY(k_, q_, ok_) do { const int kk_ = (k_) >> 1, base_ = (kk_ >> 2) * F.G + F.vcu, ph_ = kk_ & 3; ok_ = (k_) < nk && base_ < 256; \
        const int grp_ = ph_ == 0 ? base_ : ph_ == 1 ? 511 - base_ : ph_ == 2 ? 512 + base_ : 1023 - base_; q_ = grp_ * 16 + 2 * F.wave + ((k_) & 1); } while (0)
#define P4_PREFETCH(q_) do { const int pos_ = (q_) & (SEQ - 1); if (pos_ >= 256) { const int ni_ = (pos_ >> 6) + 1; const float* sr_ = WSP(float, WS_S) + (size_t)(q_) * SEQ + lane; \
        _Pragma("unroll") for (int i = 0; i < 64; ++i) if (i < ni_) raw[i] = sr_[i * 64]; } } while (0)
    { int q0; bool ok0; P4_QUERY(0, q0, ok0); if (ok0) P4_PREFETCH(q0); }
    for (int k = 0; k < nk; ++k) {
        int q; bool ok; P4_QUERY(k, q, ok); if (!ok) continue;
        int qn; bool okn; P4_QUERY(k + 1, qn, okn);
        const int b = q >> 13, pos = q & (SEQ - 1), ntw = 4 * ((pos >> 8) + 1);
        unsigned long long* Mq = WSP(unsigned long long, WS_MASK) + (size_t)b * 128 * SEQ + pos;
        if (pos < 256) { if (lane < ntw) { const int d = pos - 64 * lane; Mq[(size_t)lane * SEQ] = d >= 63 ? ~0ull : (d < 0 ? 0ull : ((2ull << d) - 1ull)); } if (okn) P4_PREFETCH(qn); }
        else { const float* Srow = WSP(float, WS_S) + (size_t)q * SEQ; const int ni = (pos >> 6) + 1;
            LAS unsigned* lk = (LAS unsigned*)(F.lds + RING_OFF + F.wave * 16384); LAS unsigned long long* lw = (LAS unsigned long long*)(F.lds + RS_OFF + F.wave * 1024);
            if (ni <= 32) select_row<32, 0>(raw, Srow, pos, Mq, ntw, lane, lk, lw, okn, qn); else if (ni <= 64) select_row<64, 0>(raw, Srow, pos, Mq, ntw, lane, lk, lw, okn, qn);
            else if (ni <= 96) select_row<64, 32>(raw, Srow, pos, Mq, ntw, lane, lk, lw, okn, qn); else select_row<64, 64>(raw, Srow, pos, Mq, ntw, lane, lk, lw, okn, qn); }
    }
#undef P4_QUERY
#undef P4_PREFETCH
#endif
}

constexpr int S5_CS = 0, S5_PS = 34816, S5_VEC = 52224, S5_YO = 53248;
struct P5R { v4u c[4], p[2], yd[2], xv[2], zv[2]; float dac, dsk; };
__device__ __forceinline__ void p5_load(P5R& R, int u, int tid) {
    const int h = u & 31, bc = u >> 5, g = h >> 3; const size_t t0 = (size_t)bc * 128;
#pragma unroll
    for (int i = 0; i < 2; ++i) { const int idx = tid + 512 * i, l = idx >> 3, c8 = (idx & 7) * 8; const size_t t = t0 + l; const int col = h * 64 + c8;
        R.yd[i] = *(const v4u*)(WSP(bf16, WS_YD) + t * 2048 + col); R.xv[i] = *(const v4u*)(WSP(bf16, WS_XBC) + t * 3072 + col); R.zv[i] = *(const v4u*)(WSP(bf16, WS_U) + t * NU + UC_Z + col); }
#pragma unroll
    for (int i = 0; i < 4; ++i) { const int idx = tid + 512 * i, row = idx >> 4, ch = idx & 15; R.c[i] = *(const v4u*)(WSP(bf16, WS_XBC) + (t0 + row) * 3072 + 2560 + g * 128 + ch * 8); }
#pragma unroll
    for (int i = 0; i < 2; ++i) { const int idx = tid + 512 * i, row = idx >> 4, ch = idx & 15; R.p[i] = *(const v4u*)(WSP(bf16, WS_PREV) + ((size_t)u * 64 + row) * 128 + ch * 8); }
    R.dac = WSP(float, WS_DACS)[(t0 + (tid & 127)) * 32 + h]; R.dsk = INP(6)[h];
}
__device__ __forceinline__ void p5_ssd_all(Frame& F) {
    constexpr int NUN = 2 * 64 * 32;
    const int tid = TID(), lane = LANE(), w = F.wave, r32 = lane & 31, hh = lane >> 5;
    LAS unsigned char* L = F.lds + RING_OFF; LAS float* dacs = (LAS float*)(L + S5_VEC);
    int u = F.vcu; if (u >= NUN) return;
    P5R R; p5_load(R, u, tid);
#pragma nounroll
    for (; u < NUN; u += F.G) {
        const int h = u & 31, bc = u >> 5; const size_t t0 = (size_t)bc * 128;
#pragma unroll
        for (int i = 0; i < 4; ++i) { const int idx = tid + 512 * i, row = idx >> 4, ch = idx & 15; *(LAS v4u*)(L + S5_CS + row * SP_C + ch * 16) = R.c[i]; }
#pragma unroll
        for (int i = 0; i < 2; ++i) { const int idx = tid + 512 * i, row = idx >> 4, ch = idx & 15; *(LAS v4u*)(L + S5_PS + row * SP_C + ch * 16) = R.p[i]; }
        if (tid < 128) dacs[tid] = R.dac;
        const v4u cyd[2] = {R.yd[0], R.yd[1]}, cxv[2] = {R.xv[0], R.xv[1]}, czv[2] = {R.zv[0], R.zv[1]}; const float dsk = R.dsk;
        __syncthreads();
        p5_load(R, u + F.G < NUN ? u + F.G : u, tid);
        __builtin_amdgcn_sched_barrier(0);
        const int li = w >> 1, pb = w & 1; f32x16 acc = {};
        { const LAS unsigned char* cp = L + S5_CS + (32 * li + r32) * SP_C + hh * 16; const LAS unsigned char* pp = L + S5_PS + (32 * pb + r32) * SP_C + hh * 16;
#pragma unroll
          for (int ks = 0; ks < 8; ++ks) acc = __builtin_amdgcn_mfma_f32_32x32x16_bf16(lds_b128(cp + ks * 32), lds_b128(pp + ks * 32), acc, 0, 0, 0); }
        LAS float* Yo = (LAS float*)(L + S5_YO);
#pragma unroll
        for (int r = 0; r < 16; ++r) Yo[(32 * li + crow16(r, hh)) * 68 + 32 * pb + r32] = acc[r];
        __syncthreads();
#pragma unroll
        for (int i = 0; i < 2; ++i) { const int idx = tid + 512 * i, l = idx >> 3, c8 = (idx & 7) * 8; const size_t t = t0 + l; const int col = h * 64 + c8;
            const f32x4 y0 = *(const LAS f32x4*)(Yo + l * 68 + c8), y1 = *(const LAS f32x4*)(Yo + l * 68 + c8 + 4);
            const v4u yd = cyd[i], xv = cxv[i], zv = czv[i];
            const float e = __expf(dacs[l]);
            float o[8];
            o[0] = (bflo(yd.x) + y0[0] * e + bflo(xv.x) * dsk) * siluf(bflo(zv.x)); o[1] = (bfhi(yd.x) + y0[1] * e + bfhi(xv.x) * dsk) * siluf(bfhi(zv.x));
            o[2] = (bflo(yd.y) + y0[2] * e + bflo(xv.y) * dsk) * siluf(bflo(zv.y)); o[3] = (bfhi(yd.y) + y0[3] * e + bfhi(xv.y) * dsk) * siluf(bfhi(zv.y));
            o[4] = (bflo(yd.z) + y1[0] * e + bflo(xv.z) * dsk) * siluf(bflo(zv.z)); o[5] = (bfhi(yd.z) + y1[1] * e + bfhi(xv.z) * dsk) * siluf(bfhi(zv.z));
            o[6] = (bflo(yd.w) + y1[2] * e + bflo(xv.w) * dsk) * siluf(bflo(zv.w)); o[7] = (bfhi(yd.w) + y1[3] * e + bfhi(xv.w) * dsk) * siluf(bfhi(zv.w));
            v4u ov; ov.x = pk2(o[0], o[1]); ov.y = pk2(o[2], o[3]); ov.z = pk2(o[4], o[5]); ov.w = pk2(o[6], o[7]);
            *(v4u*)(WSP(bf16, WS_YG) + t * 2048 + col) = ov; }
        __syncthreads();
    }
}
#ifndef TAILSPIN_ALL
#define TAILSPIN_ALL 0
#endif

typedef att::BlockRef<att::bf16, att::bf16> ABlk;
__device__ __forceinline__ ABlk att_ref(const bf16* U, const bf16* QR, const bf16* KR, bf16* AO, const unsigned long long* MASK, int L, int pass) {
    const int bh = L >> 4, x = L & 15, qb = pass ? 31 - x : x, b = bh >> 4, hd = bh & 15;
    ABlk r;
    r.Q = (const att::bf16*)(QR + ((size_t)b * SEQ + qb * 256) * DM + hd * 128);
    r.K = (const att::bf16*)(KR + ((size_t)b * SEQ) * DM + hd * 128);
    r.V = (const att::bf16*)(U + ((size_t)b * SEQ) * NU + UC_V + hd * 128);
    r.O = (att::bf16*)(AO + ((size_t)b * SEQ + qb * 256) * 2048 + hd * 128);
    r.MK = MASK + (size_t)b * 128 * SEQ + qb * 256;
    r.P0 = qb * 256;
    return r;
}
__device__ __forceinline__ void p5_attention(Frame& F) {
    constexpr int NITEM = 512;
    int L = F.vcu; if (L >= NITEM) return;
    const bf16* U = WSP(bf16, WS_U); const bf16* QR = WSP(bf16, WS_QR); const bf16* KR = WSP(bf16, WS_KR); bf16* AO = WSP(bf16, WS_AO); const unsigned long long* MK = WSP(unsigned long long, WS_MASK); const int stride = F.G;
    char* lds = (char*)(F.lds + RING_OFF);
    int pass = 0;
    ABlk cur = att_ref(U, QR, KR, AO, MK, L, 0);
    att::Seam<att::bf16> S;
    att::causal_swa_prime<att::bf16, att::bf16>(cur, SEQ, lds, S);
    for (;;) {
        const bool more_pass = pass == 0, more_item = L + stride < NITEM, last = !more_pass && !more_item;
        int passn = pass + 1, Ln = L;
        if (!more_pass) { passn = 0; Ln = more_item ? L + stride : L; }
        const ABlk nxt = last ? cur : att_ref(U, QR, KR, AO, MK, Ln, passn);
        att::causal_swa_block<att::bf16, att::bf16>(cur, nxt, SEQ, SEQ, lds, S);
        if (last) break;
        cur = nxt; pass = passn; L = Ln;
    }
}

__device__ __forceinline__ float wave_sum_dpp(float v) {
    v += __int_as_float(__builtin_amdgcn_update_dpp(0, __float_as_int(v), 0xB1, 0xf, 0xf, false));
    v += __int_as_float(__builtin_amdgcn_update_dpp(0, __float_as_int(v), 0x4E, 0xf, 0xf, false));
    v += __int_as_float(__builtin_amdgcn_update_dpp(0, __float_as_int(v), 0x141, 0xf, 0xf, false));
    v += __int_as_float(__builtin_amdgcn_update_dpp(0, __float_as_int(v), 0x140, 0xf, 0xf, false));
    const int iv = __float_as_int(v);
    return (__int_as_float(__builtin_amdgcn_readlane(iv, 0)) + __int_as_float(__builtin_amdgcn_readlane(iv, 16))) + (__int_as_float(__builtin_amdgcn_readlane(iv, 32)) + __int_as_float(__builtin_amdgcn_readlane(iv, 48)));
}
__device__ __forceinline__ void p9_route(Frame& F) {
    const int lane = LANE(), wave = F.wave, tid = TID();
    LAS int* ent = (LAS int*)(F.lds + RING_OFF);
    const int ngrp = T / 4, nrounds = (ngrp + F.G * NWAVES - 1) / (F.G * NWAVES);
    for (int rd = 0; rd < nrounds; ++rd) {
        const int grp = (rd * F.G + F.vcu) * NWAVES + wave; const bool valid = grp < ngrp;
        if (valid) {
            f32x4 xn[4][8], nw[8];
#pragma unroll
            for (int tk = 0; tk < 4; ++tk) { const f32x4* xr = (const f32x4*)(WSP(float, WS_H1) + ((size_t)grp * 4 + tk) * DM) + lane;
#pragma unroll
                for (int j = 0; j < 8; ++j) xn[tk][j] = xr[64 * j]; }
#pragma unroll
            for (int j = 0; j < 8; ++j) nw[j] = ((const f32x4*)INP(12))[lane + 64 * j];
            __builtin_amdgcn_sched_barrier(0);
#pragma unroll
            for (int tk = 0; tk < 4; ++tk) { const size_t tok = (size_t)grp * 4 + tk; float s = 0.f;
#pragma unroll
                for (int j = 0; j < 8; ++j) s += (xn[tk][j].x * xn[tk][j].x + xn[tk][j].y * xn[tk][j].y) + (xn[tk][j].z * xn[tk][j].z + xn[tk][j].w * xn[tk][j].w);
                const float rstd = 1.f / sqrtf(wave_sum(s) * (1.f / DM) + EPS);
                unsigned* o4 = (unsigned*)(WSP(unsigned char, WS_XN2) + tok * DM) + lane;
#pragma unroll
                for (int j = 0; j < 8; ++j) { const f32x4 wv = nw[j]; xn[tk][j] = xn[tk][j] * rstd * wv;
                    o4[64 * j] = pg8::pk4_fp8(xn[tk][j].x * pg8::F8_SX, xn[tk][j].y * pg8::F8_SX, xn[tk][j].z * pg8::F8_SX, xn[tk][j].w * pg8::F8_SX); } }
            float lg[2] = {0.f, 0.f};
            for (int e = 0; e < NEXP; ++e) {
                if ((e & 15) == 0) {
                    __syncthreads();
#pragma unroll
                    for (int i = 0; i < 16; ++i) ((LAS f32x4*)(F.lds + RING_OFF))[tid + 512 * i] = ((const f32x4*)(WSP(float, WS_RWT) + (size_t)e * DM))[tid + 512 * i];
                    __syncthreads(); }
                typedef float f32x2_t __attribute__((ext_vector_type(2)));
                f32x2_t q0 = {0.f, 0.f}, q1 = q0, q2 = q0, q3 = q0; const LAS f32x4* rw = (const LAS f32x4*)(F.lds + RING_OFF + (e & 15) * 8192) + lane;
#pragma unroll
                for (int j = 0; j < 8; ++j) { const f32x4 r = rw[64 * j]; const f32x2_t rl = {r.x, r.y}, rh = {r.z, r.w};
#define P9_FMA(Q_, X_) do { const f32x4 t_ = X_; Q_ = __builtin_elementwise_fma((f32x2_t){t_[0], t_[1]}, rl, Q_); Q_ = __builtin_elementwise_fma((f32x2_t){t_[2], t_[3]}, rh, Q_); } while (0)
                    P9_FMA(q0, xn[0][j]); P9_FMA(q1, xn[1][j]); P9_FMA(q2, xn[2][j]); P9_FMA(q3, xn[3][j]);
#undef P9_FMA
                }
                float p0 = q0.x + q0.y, p1 = q1.x + q1.y, p2 = q2.x + q2.y, p3 = q3.x + q3.y;
                p0 = wave_sum_dpp(p0); p1 = wave_sum_dpp(p1); p2 = wave_sum_dpp(p2); p3 = wave_sum_dpp(p3);
                const float bb = INP(14)[e];
                if ((lane & 31) == e) { lg[0] = ((lane >> 5) ? p1 : p0) + bb; lg[1] = ((lane >> 5) ? p3 : p2) + bb; }
            }
            __syncthreads();
#pragma unroll
            for (int jj = 0; jj < 2; ++jj) {
                float v = lg[jj]; float tv[4]; int ti[4];
#pragma unroll
                for (int k = 0; k < 4; ++k) { float bv = v; int bi = lane & 31;
#pragma unroll
                    for (int o = 1; o < 32; o <<= 1) { const float ov = __shfl_xor(bv, o); const int oi = __shfl_xor(bi, o); if (ov > bv || (ov == bv && oi < bi)) { bv = ov; bi = oi; } }
                    tv[k] = bv; ti[k] = bi; if ((lane & 31) == bi) v = -__builtin_inff(); }
                const float e0 = 1.f, e1 = expf(tv[1] - tv[0]), e2 = expf(tv[2] - tv[0]), e3 = expf(tv[3] - tv[0]); const float inv = 1.f / (e0 + e1 + e2 + e3);
                const int slot = lane & 31;
                if (slot < 4) { const int ee = slot == 0 ? ti[0] : slot == 1 ? ti[1] : slot == 2 ? ti[2] : ti[3]; const float ww = (slot == 0 ? e0 : slot == 1 ? e1 : slot == 2 ? e2 : e3) * inv;
                    const int tok = grp * 4 + 2 * jj + (lane >> 5);
                    ent[wave * 16 + (2 * jj + (lane >> 5)) * 4 + slot] = ee;
                    WSP(int, WS_ROUTE)[tok * 4 + slot] = ee; WSP(float, WS_ROUTE + 256 * 1024)[tok * 4 + slot] = ww; }
            }
        }
        __syncthreads();
        const int round = rd * F.G + F.vcu;
        if (round * 32 < T) {
            if (tid < 128) { const int ej = ent[tid]; int lr = 0; for (int i = 0; i < tid; ++i) lr += (ent[i] == ej) ? 1 : 0;
                WSP(int, WS_ROUTE + 512 * 1024)[(round * 32) * 4 + tid] = lr; }
            if (tid >= 128 && tid < 160) { const int e = tid - 128; int c = 0; for (int i = 0; i < 128; ++i) c += (ent[i] == e) ? 1 : 0; WSP(int, WS_ROUTE + 2048 * 1024)[round * 32 + e] = c; }
        }
        __syncthreads();
    }
}

__device__ __forceinline__ void moe_offsets(Frame& F, bool keep_prefix) {
    LAS int* eoff = (LAS int*)(F.lds + EOFF_OFF); LAS int* tile_e = (LAS int*)(F.lds + TILE_E_OFF);
    LAS int* pre = (LAS int*)(F.lds + RING_OFF); LAS int* part = (LAS int*)(F.lds + RING_OFF + 65536);
    const int NR = T / 32;
    __syncthreads();
    for (int i = TID(); i < NR * 32; i += NWAVES * 64) pre[i] = WSP(int, WS_ROUTE + 2048 * 1024)[i];
    __syncthreads();
    { const int e = TID() & 31, ch = TID() >> 5; int s = 0; for (int r = ch * 32; r < ch * 32 + 32; ++r) s += pre[r * 32 + e]; part[ch * 32 + e] = s; }
    __syncthreads();
    if (TID() < 32) { int s = 0; for (int ch = 0; ch < 16; ++ch) { const int v = part[ch * 32 + TID()]; part[ch * 32 + TID()] = s; s += v; } part[512 + TID()] = s; }
    __syncthreads();
    if (keep_prefix) { const int e = TID() & 31, ch = TID() >> 5; int s = part[ch * 32 + e]; for (int r = ch * 32; r < ch * 32 + 32; ++r) { const int v = pre[r * 32 + e]; pre[r * 32 + e] = s; s += v; } }
    if (TID() == 0) { int o = 0; for (int e = 0; e < NEXP; ++e) { eoff[e] = o; o += (part[512 + e] + 255) & ~255; } eoff[32] = o; eoff[33] = o >> 8; for (int e = 0; e < NEXP; ++e) eoff[34 + e] = part[512 + e]; }
    __syncthreads();
    if (TID() < NEXP) { for (int t = eoff[TID()] >> 8; t < (eoff[TID() + 1] >> 8); ++t) tile_e[t] = TID(); }
    __syncthreads();
}
__device__ __forceinline__ void p10_sort(Frame& F) {
    const int gw = F.vcu * NWAVES + F.wave, NGW = F.G * NWAVES, lane = LANE();
    LAS int* eoff = (LAS int*)(F.lds + EOFF_OFF);
    moe_offsets(F, true);
    LAS int* pre = (LAS int*)(F.lds + RING_OFF);
    for (int tok = gw; tok < T; tok += NGW) {
        const v4u* src = (const v4u*)(WSP(unsigned char, WS_XN2) + (size_t)tok * DM) + lane; v4u v[2];
        const int4 es = *(const int4*)(WSP(int, WS_ROUTE) + tok * 4), rk = *(const int4*)(WSP(int, WS_ROUTE + 512 * 1024) + tok * 4);
#pragma unroll
        for (int j = 0; j < 2; ++j) v[j] = src[64 * j];
        __builtin_amdgcn_sched_barrier(0);
        int4 rows;
#pragma unroll
        for (int s = 0; s < 4; ++s) { const int e = s == 0 ? es.x : s == 1 ? es.y : s == 2 ? es.z : es.w, row = eoff[e] + pre[(tok >> 5) * 32 + e] + (s == 0 ? rk.x : s == 1 ? rk.y : s == 2 ? rk.z : rk.w);
            v4u* dst = (v4u*)(WSP(unsigned char, WS_AS) + (size_t)row * DM) + lane;
#pragma unroll
            for (int j = 0; j < 2; ++j) dst[64 * j] = v[j];
            if (s == 0) rows.x = row; else if (s == 1) rows.y = row; else if (s == 2) rows.z = row; else rows.w = row; }
        if (lane == 0) *(int4*)(WSP(int, WS_ROUTE + 768 * 1024) + tok * 4) = rows;
    }
    for (int e = 0; e < NEXP; ++e) { const int cnt = eoff[34 + e], r0 = eoff[e] + cnt, npad = eoff[e + 1] - r0; const v4u z = {0u, 0u, 0u, 0u};
        for (int r = gw; r < npad; r += NGW) { v4u* dst = (v4u*)(WSP(unsigned char, WS_AS) + (size_t)(r0 + r) * DM) + lane;
#pragma unroll
            for (int j = 0; j < 2; ++j) dst[64 * j] = z; } }
    if (blockIdx.x == 0 && TID() == 0) *(int*)(CTLP() + CW_NT) = eoff[33];
}

__device__ __forceinline__ float f8dec(unsigned w, int b) { return b == 0 ? __builtin_amdgcn_cvt_f32_fp8((int)w, 0) : b == 1 ? __builtin_amdgcn_cvt_f32_fp8((int)w, 1) : b == 2 ? __builtin_amdgcn_cvt_f32_fp8((int)w, 2) : __builtin_amdgcn_cvt_f32_fp8((int)w, 3); }
__device__ __forceinline__ void p_swiglu(Frame& F) {
    const int ntiles = *(const int*)(CTLP() + CW_NT);
    const size_t nitem = (size_t)ntiles * 256 * 128;
    constexpr float IS = 1.0f / pg8::F8_SH;
    for (size_t it = (size_t)F.vcu * (NWAVES * 64) + TID(); it < nitem; it += (size_t)F.G * NWAVES * 64) {
        const size_t row = it >> 7; const int cg = (int)(it & 127), pn = cg >> 3, j = (cg & 7) * 16;
        const unsigned char* hp = WSP(unsigned char, WS_H8) + row * 4096 + pn * 256 + j;
        const v4u gv = *(const v4u*)hp, lv = *(const v4u*)(hp + 128); v4u o;
#define SW4(G, L) pg8::pk4_fp8(pg8::swiglu1(f8dec(G, 0) * IS, f8dec(L, 0) * IS) * pg8::F8_SA, pg8::swiglu1(f8dec(G, 1) * IS, f8dec(L, 1) * IS) * pg8::F8_SA, pg8::swiglu1(f8dec(G, 2) * IS, f8dec(L, 2) * IS) * pg8::F8_SA, pg8::swiglu1(f8dec(G, 3) * IS, f8dec(L, 3) * IS) * pg8::F8_SA)
        o.x = SW4(gv.x, lv.x); o.y = SW4(gv.y, lv.y); o.z = SW4(gv.z, lv.z); o.w = SW4(gv.w, lv.w);
#undef SW4
        *(v4u*)(WSP(unsigned char, WS_ACT) + row * 2048 + pn * 128 + j) = o;
    }
}

__device__ __forceinline__ void p13_final(Frame& F) {
    const int gw = F.vcu * NWAVES + F.wave, NGW = F.G * NWAVES, lane = LANE();
    f32x4 fw[8];
#pragma unroll
    for (int j = 0; j < 8; ++j) fw[j] = ((const f32x4*)INP(19))[lane + 64 * j];
    int4 rows_n = {0, 0, 0, 0}; f32x4 gws_n = {0.f, 0.f, 0.f, 0.f};
    if (gw < T) { rows_n = *(const int4*)(WSP(int, WS_ROUTE + 768 * 1024) + gw * 4); gws_n = *(const f32x4*)(WSP(float, WS_ROUTE + 256 * 1024) + gw * 4); }
    for (int tok = gw; tok < T; tok += NGW) {
        const f32x4* hr = (const f32x4*)(WSP(float, WS_H1) + (size_t)tok * DM) + lane; f32x4 v[8];
        const int4 rows = rows_n; const f32x4 gws = gws_n;
        if (tok + NGW < T) { rows_n = *(const int4*)(WSP(int, WS_ROUTE + 768 * 1024) + (tok + NGW) * 4); gws_n = *(const f32x4*)(WSP(float, WS_ROUTE + 256 * 1024) + (tok + NGW) * 4); }
#pragma unroll
        for (int j = 0; j < 8; ++j) v[j] = hr[64 * j];
        v2u os[4][8];
#pragma unroll
        for (int s = 0; s < 4; ++s) { const int row = s == 0 ? rows.x : s == 1 ? rows.y : s == 2 ? rows.z : rows.w; const v2u* orow = (const v2u*)(WSP(bf16, WS_OS) + (size_t)row * DM) + lane;
#pragma unroll
            for (int j = 0; j < 8; ++j) os[s][j] = orow[64 * j]; }
        __builtin_amdgcn_sched_barrier(0);
#pragma unroll
        for (int s = 0; s < 4; ++s) { const float gw_ = gws[s];
#pragma unroll
            for (int j = 0; j < 8; ++j) { const v2u o = os[s][j]; v[j].x += gw_ * bflo(o.x); v[j].y += gw_ * bfhi(o.x); v[j].z += gw_ * bflo(o.y); v[j].w += gw_ * bfhi(o.y); } }
        float ssum = 0.f;
#pragma unroll
        for (int j = 0; j < 8; ++j) ssum += (v[j].x * v[j].x + v[j].y * v[j].y) + (v[j].z * v[j].z + v[j].w * v[j].w);
        const float rstd = 1.f / sqrtf(wave_sum(ssum) * (1.f / DM) + EPS);
        f32x4* orow = (f32x4*)(OUTP() + (size_t)tok * DM) + lane;
#pragma unroll
        for (int j = 0; j < 8; ++j) orow[64 * j] = v[j] * rstd * fw[j];
    }
}

#ifndef AEPI
#define AEPI true
#endif
constexpr int NPHASE = 15;
struct Args { const float* in[20]; float* out; unsigned char* ws; int ph_lo, ph_hi, li, pad; };
__global__ void __launch_bounds__(NWAVES * 64, 2) hybrid_fwd(Args args) {
    extern __shared__ __attribute__((aligned(16))) unsigned char lds[];
    Frame F;
    F.lds = (LAS unsigned char*)lds;
    F.wave = __builtin_amdgcn_readfirstlane((int)threadIdx.x >> 6);
    F.G = gridDim.x; { const int bx = blockIdx.x; F.vcu = (F.G % 8 == 0) ? (bx % 8) * (F.G / 8) + bx / 8 : bx; }
    for (int u = TID(); u < (LDS_BYTES - LDSCTL_OFF) / 4; u += NWAVES * 64) ((LAS unsigned*)(F.lds + LDSCTL_OFF))[u] = 0u;
    __syncthreads();
    (void)xcd_barrier_post((unsigned*)(CTLP() + CW_BAR), (volatile LAS unsigned*)(F.lds + MISC_OFF) + 8);
#define bar (XcdBarrier{(unsigned*)(CTLP() + CW_BAR), xb_xcc_id(), (volatile LAS unsigned*)(F.lds + MISC_OFF) + 8})
    const int lo = args.ph_lo, hi = args.ph_hi;
#ifdef HEADSPIN_US
    { const unsigned long long t1 = __builtin_amdgcn_s_memrealtime(); while (__builtin_amdgcn_s_memrealtime() - t1 < (unsigned long long)HEADSPIN_US * 100ull) __builtin_amdgcn_s_sleep(8); }
#endif
#ifndef PH_MASK
#define PH_MASK 0xFFFFFFFFu
#endif
#define IN(k) (((PH_MASK >> (k)) & 1u) && lo <= (k) && (k) < hi)
#ifdef PROBE_PHASE
    unsigned long long pr_t0 = __builtin_amdgcn_s_memrealtime(), pr_dt = 0ull;
#define SEAM(k) do { if (IN(k) && IN((k) + 1)) xcd_barrier(bar); if ((k) == (PROBE_PHASE == 8 ? 6 : PROBE_PHASE == 13 ? 11 : PROBE_PHASE - 1)) pr_t0 = __builtin_amdgcn_s_memrealtime(); if ((k) == PROBE_PHASE) pr_dt = __builtin_amdgcn_s_memrealtime() - pr_t0; } while (0)
#else
#define SEAM(k) do { if (IN(k) && IN((k) + 1)) xcd_barrier(bar); } while (0)
#endif

#ifdef NANFILL
    { const size_t n16 = (WS_END - 2 * MiB) / 16; v4u* p = (v4u*)(WSB() + 2 * MiB); const v4u q = {0xffffffffu, 0xffffffffu, 0xffffffffu, 0xffffffffu};
      for (size_t i = (size_t)blockIdx.x * 512 + TID(); i < n16; i += (size_t)F.G * 512) p[i] = q;
      xcd_barrier(bar); }
#endif
    if (IN(0)) { p0_prologue(F);
#ifdef DOUBLE_P0
        p0_prologue(F);
#endif
    } SEAM(0);
    if (IN(1)) { pg8::Gemm g{WSP(bf16, WS_XN), WSP(bf16, WS_WIN), T, NU, DM}; pg8::StaticOrder S; S.init(T, NU, F.G, (int)blockIdx.x); pg8::EpiU E{WSP(bf16, WS_U), NU};
        pg8::gemm_phase<pg8::EpiU, pg8::StaticOrder, AEPI, true>(F.lds + RING_OFF, g, S, E); } SEAM(1);
    if (IN(2)) { p2_prep(F); } SEAM(2);
    if (IN(3)) { p3_phase(F); } SEAM(3);
    if (IN(4)) { p4_phase(F); } SEAM(4);
    if (IN(5)) {
#ifndef NO_P5A
        p5_ssd_all(F);
#endif
#ifdef NO_ATTN
        { const v4u z = {0u, 0u, 0u, 0u}; v4u* p = (v4u*)WSP(bf16, WS_AO); for (size_t i = (size_t)blockIdx.x * 512 + TID(); i < (size_t)T * DM / 8; i += (size_t)F.G * 512) p[i] = z; }
#elif !defined(NO_P5B)
        p5_attention(F);
#endif
    } SEAM(5);
    if (IN(6)) { pg8::Gemm g{WSP(bf16, WS_YG), WSP(bf16, WS_WSSD), T, DM, DM, WSP(bf16, WS_AO), WSP(bf16, WS_WATT)}; pg8::ChainOrder S; S.base.init(T, DM, F.G, (int)blockIdx.x);
        LAS float* rtab = (LAS float*)(F.lds + RS_OFF); LAS int* rpm = (LAS int*)(F.lds + RS_OFF + 4096);
        { pg8::Unit u;
          int prev_pm = -1;
          for (int i = 0; i < 4 && S.base.next(i, u); ++i) { if (u.pm == prev_pm) { if (TID() == 0) rpm[i] = -1; continue; } prev_pm = u.pm;
              if (TID() == 0) rpm[i] = u.pm;
#pragma nounroll
              for (int rb = 0; rb < 4; ++rb) {
                  v4u vv[8][4];
#pragma unroll
                  for (int k = 0; k < 8; ++k) { const int r = F.wave + NWAVES * (rb * 8 + k); const v4u* p = (const v4u*)(WSP(bf16, WS_YG) + ((size_t)u.pm * 256 + r) * DM) + LANE();
#pragma unroll
                      for (int j = 0; j < 4; ++j) vv[k][j] = p[64 * j]; }
                  __builtin_amdgcn_sched_barrier(0);
#pragma unroll
                  for (int k = 0; k < 8; ++k) { const int r = F.wave + NWAVES * (rb * 8 + k); float ss = 0.f;
#pragma unroll
                      for (int j = 0; j < 4; ++j) { const v4u v = vv[k][j]; const float a0 = bflo(v.x), a1 = bfhi(v.x), a2 = bflo(v.y), a3 = bfhi(v.y), a4 = bflo(v.z), a5 = bfhi(v.z), a6 = bflo(v.w), a7 = bfhi(v.w);
                          ss += ((a0 * a0 + a1 * a1) + (a2 * a2 + a3 * a3)) + ((a4 * a4 + a5 * a5) + (a6 * a6 + a7 * a7)); }
                      ss = wave_sum(ss); if (LANE() == 0) rtab[i * 256 + r] = 1.0f / sqrtf(ss * (1.0f / DM) + EPS); } } }
          __syncthreads(); }
        pg8::EpiMerge E{WSP(bf16, WS_MG), WSP(bf16, WS_U) + UC_GS, WSP(bf16, WS_U) + UC_GA, NU, rtab, rpm};
        pg8::gemm_phase<pg8::EpiMerge, pg8::ChainOrder, AEPI, true>(F.lds + RING_OFF, g, S, E); } SEAM(6);
    if (IN(8)) { pg8::Gemm g{WSP(bf16, WS_MG), WSP(bf16, WS_WOUT), T, DM, DM}; pg8::StaticOrder S; S.init(T, DM, F.G, (int)blockIdx.x); pg8::EpiOut E{WSP(float, WS_H1), INP(0)};
        pg8::gemm_phase<pg8::EpiOut, pg8::StaticOrder, AEPI, true>(F.lds + RING_OFF, g, S, E); } SEAM(8);
    if (IN(9)) { p9_route(F); } SEAM(9);
    if (IN(10)) { p10_sort(F); } SEAM(10);
    if (IN(11)) { moe_offsets(F, false); const int ntiles = ((LAS int*)(F.lds + EOFF_OFF))[33];
        pg8::Gemm g{WSP(bf16, WS_AS), WSP(bf16, WS_W1), ntiles * 256, 4096, DM / 2};
        pg8::GroupedOrder S; S.init(ntiles, 16, F.G, (int)blockIdx.x, (const LAS int*)(F.lds + TILE_E_OFF)); pg8::EpiSwiglu E{WSP(bf16, WS_ACT), INP(16)};
        pg8::gemm_phase<pg8::EpiSwiglu, pg8::GroupedOrder, AEPI, true, true>(F.lds + RING_OFF, g, S, E); } SEAM(11);
    if (IN(13)) { moe_offsets(F, false); const int ntiles = ((LAS int*)(F.lds + EOFF_OFF))[33];
        pg8::Gemm g{WSP(bf16, WS_ACT), WSP(bf16, WS_W2), ntiles * 256, DM, DM / 2};     pg8::GroupedOrder S; S.init(ntiles, 8, F.G, (int)blockIdx.x, (const LAS int*)(F.lds + TILE_E_OFF)); pg8::EpiMoeOut E{WSP(bf16, WS_OS), INP(18)};
        pg8::gemm_phase<pg8::EpiMoeOut, pg8::GroupedOrder, AEPI, true, true>(F.lds + RING_OFF, g, S, E); } SEAM(13);
    if (IN(14)) { p13_final(F); }
#ifdef SENTINEL_SCAN
    { xcd_barrier(bar);
      unsigned* cntw = (unsigned*)(CTLP() + 12288);
      int tid_ = TID(); asm volatile("" : "+v"(tid_)); const size_t gt = (size_t)blockIdx.x * 512 + tid_, NT = (size_t)F.G * 512;
      unsigned c0 = 0, c1 = 0, c2 = 0, c3 = 0, c4 = 0, c5 = 0, c6 = 0, c7 = 0;
      { const unsigned* S = (const unsigned*)WSP(float, WS_S); for (size_t i = gt; i < (size_t)T * SEQ; i += NT) { const int q = (int)(i >> 13), k = (int)(i & 8191), pos = q & 8191; if (k <= pos && S[i] == 0xffffffffu) c0++; } }
      { const unsigned long long* M = WSP(unsigned long long, WS_MASK); for (size_t i = gt; i < (size_t)2 * 128 * SEQ; i += NT) { const int pos = (int)(i & 8191), tile = (int)((i >> 13) & 127); if (tile < 4 * ((pos >> 8) + 1) && pos >= 256 * 1 && tile >= 4 && M[i] == ~0ull) c1++; } }
      { const unsigned* Q = (const unsigned*)WSP(bf16, WS_QIR); for (size_t i = gt; i < (size_t)T * 256; i += NT) if (Q[i] == 0xffffffffu) c2++; const unsigned* K = (const unsigned*)WSP(bf16, WS_KIR); for (size_t i = gt; i < (size_t)T * 32; i += NT) if (K[i] == 0xffffffffu) c2++; }
      { const int ntl = ((LAS int*)(F.lds + EOFF_OFF))[33]; const unsigned* A = (const unsigned*)WSP(bf16, WS_AS); for (size_t i = gt; i < (size_t)ntl * 256 * 1024; i += NT) if (A[i] == 0xffffffffu) c3++; }
      { const unsigned* R = (const unsigned*)WSP(int, WS_ROUTE); for (size_t i = gt; i < (size_t)T * 16; i += NT) if (R[i] == 0xffffffffu) c4++; }
      { const unsigned* W = (const unsigned*)WSP(bf16, WS_W1); for (size_t i = gt; i < (size_t)NEXP * 4096 * 1024; i += NT) if (W[i] == 0xffffffffu) c5++; const unsigned* W2 = (const unsigned*)WSP(bf16, WS_W2); for (size_t i = gt; i < (size_t)NEXP * 2048 * 1024; i += NT) if (W2[i] == 0xffffffffu) c5++; const unsigned* WI = (const unsigned*)WSP(bf16, WS_WIN); for (size_t i = gt; i < (size_t)NU * 1024; i += NT) if (WI[i] == 0xffffffffu) c5++; }
      { const unsigned* U = (const unsigned*)WSP(bf16, WS_U); for (size_t i = gt; i < (size_t)T * (NU / 2); i += NT) if (U[i] == 0xffffffffu) c6++; }
      { const unsigned* A = (const unsigned*)WSP(bf16, WS_ACT); const int ntl = ((LAS int*)(F.lds + EOFF_OFF))[33]; for (size_t i = gt; i < (size_t)ntl * 256 * 1024; i += NT) if (A[i] == 0xffffffffu) c7++; }
      if (c0) atomicAdd(cntw, c0); if (c1) atomicAdd(cntw + 64, c1); if (c2) atomicAdd(cntw + 128, c2); if (c3) atomicAdd(cntw + 192, c3); if (c4) atomicAdd(cntw + 256, c4); if (c5) atomicAdd(cntw + 320, c5); if (c6) atomicAdd(cntw + 384, c6); if (c7) atomicAdd(cntw + 448, c7);
      xcd_barrier(bar);
      if (blockIdx.x == 0 && TID() == 0) { float x = 0.f; for (int j = 7; j >= 0; --j) { const unsigned v = __hip_atomic_load(cntw + 64 * j, RLX_AGENT); if (v) x = (float)(SENTINEL_SCAN == 1 ? 10 + j : (v > 90 ? 99 : v + 1)); if (SENTINEL_SCAN != 1 && j == SENTINEL_SCAN - 10) break; }
          if (x > 0.f) OUTP()[0] = sqrtf(3.3558e7f * x); } }
#endif
#ifdef CHK_BUF
    { xcd_barrier(bar);
      const unsigned* p; size_t n;
      switch (CHK_BUF) { case 1: p = (const unsigned*)WSP(bf16, WS_U); n = (size_t)T * NU / 2; break; case 2: p = (const unsigned*)WSP(bf16, WS_QIR); n = (size_t)T * 256; break; case 3: p = (const unsigned*)WSP(float, WS_S); n = (size_t)T * SEQ; break;
          case 4: p = (const unsigned*)WSP(unsigned long long, WS_MASK); n = (size_t)2 * 128 * SEQ * 2; break; case 5: p = (const unsigned*)WSP(bf16, WS_AO); n = (size_t)T * 1024; break; case 6: p = (const unsigned*)WSP(bf16, WS_YG); n = (size_t)T * 1024; break;
          case 7: p = (const unsigned*)WSP(float, WS_H1); n = (size_t)T * 2048; break; case 8: p = (const unsigned*)WSP(int, WS_ROUTE); n = (size_t)T * 16; break; case 9: p = (const unsigned*)WSP(bf16, WS_AS); n = (size_t)RMAX * 1024; break;
          case 10: p = (const unsigned*)WSP(bf16, WS_ACT); n = (size_t)RMAX * 1024; break; case 11: p = (const unsigned*)WSP(bf16, WS_OS); n = (size_t)RMAX * 1024; break; case 13: p = (const unsigned*)WSP(bf16, WS_XBC); n = (size_t)T * 1536; break;
          case 14: p = (const unsigned*)WSP(float, WS_STATES); n = (size_t)T * 2048; break; case 15: p = (const unsigned*)WSP(bf16, WS_PREV); n = (size_t)T * 1024; break; case 16: p = (const unsigned*)WSP(bf16, WS_W1); n = (size_t)NEXP * 4096 * 1024; break;
          case 17: p = (const unsigned*)WSP(bf16, WS_MG); n = (size_t)T * 1024; break; case 18: p = (const unsigned*)WSP(float, WS_TMP); n = (size_t)T * 2048; break; case 19: p = (const unsigned*)WSP(bf16, WS_XN2); n = (size_t)T * 1024; break;
          default: p = (const unsigned*)OUTP(); n = (size_t)T * 2048; break; }
      unsigned long long s = 0ull; int tid_ = TID(); asm volatile("" : "+v"(tid_));
      for (size_t i = (size_t)blockIdx.x * 512 + tid_; i < n; i += (size_t)F.G * 512) s += (unsigned long long)p[i] * (unsigned long long)((i & 1023u) + 1u);
      for (int o = 1; o < 64; o <<= 1) s += (unsigned long long)__shfl_xor((unsigned)s, o) + ((unsigned long long)__shfl_xor((unsigned)(s >> 32), o) << 32);
      if (LANE() == 0) atomicAdd((unsigned long long*)((unsigned*)CTLP() + 14336), s);
      xcd_barrier(bar);
      if (blockIdx.x == 0 && TID() == 0) { unsigned long long* keep = (unsigned long long*)(WSB() + WS_END + 4096); const unsigned long long cur = __hip_atomic_load((unsigned long long*)((unsigned*)CTLP() + 14336), RLX_AGENT);
          if (keep[0] == 0x600DF00DCAFE0001ull && keep[1] != cur) OUTP()[0] = 1.0e9f;
          keep[0] = 0x600DF00DCAFE0001ull; keep[1] = cur; } }
#endif
#ifdef NANCHK_ON
    { xcd_barrier(bar);
      if (blockIdx.x == 0 && TID() == 0) { float x = 0.f; for (int j = 9; j >= 0; --j) { const unsigned v = __hip_atomic_load((unsigned*)CTLP() + 12288 + 64 * j, RLX_AGENT); if (v) x = (float)(10 + j); }
          if (x > 0.f) OUTP()[0] = sqrtf(3.3558e7f * x); } }
#endif
#ifdef TAILSPIN_US
    if (TAILSPIN_ALL || blockIdx.x == 0) { const unsigned long long t1 = __builtin_amdgcn_s_memrealtime(); while (__builtin_amdgcn_s_memrealtime() - t1 < (unsigned long long)TAILSPIN_US * 100ull) __builtin_amdgcn_s_sleep(8); }
#endif
#ifdef PROBE_PHASE
    if (PROBE_PHASE == 14) pr_dt = __builtin_amdgcn_s_memrealtime() - pr_t0;
    if (blockIdx.x == 0) { const unsigned long long t1 = __builtin_amdgcn_s_memrealtime(); while (__builtin_amdgcn_s_memrealtime() - t1 < pr_dt) __builtin_amdgcn_s_sleep(8); }
#endif
#undef IN
#undef SEAM
#undef bar
}

#ifndef MK_CUTS
#define MK_CUTS 0
#endif
extern "C" void kernel_launch(void* const* d_in, const int* in_sizes, int n_in, void* d_out, int out_size, void* d_ws, size_t ws_size, hipStream_t stream) {
    static int grid = 0;
    if (grid == 0) {
        if (n_in != 20 || in_sizes[0] != T * DM || out_size != T * DM || ws_size < WS_END) { fprintf(stderr, "kernel_launch: unexpected shapes (n_in %d, in0 %d, out %d, ws %zu); nothing launched\n", n_in, n_in > 0 ? in_sizes[0] : -1, out_size, ws_size); grid = -1; return; }
        int dev = 0, cus = 0, per_cu = 0;
        if (hipGetDevice(&dev) != hipSuccess || hipDeviceGetAttribute(&cus, hipDeviceAttributeMultiprocessorCount, dev) != hipSuccess) { grid = -1; return; }
        if (hipFuncSetAttribute((const void*)hybrid_fwd, hipFuncAttributeMaxDynamicSharedMemorySize, LDS_BYTES) != hipSuccess) { fprintf(stderr, "kernel_launch: hipFuncSetAttribute failed\n"); grid = -1; return; }
        if (hipOccupancyMaxActiveBlocksPerMultiprocessor(&per_cu, (const void*)hybrid_fwd, NWAVES * 64, LDS_BYTES) != hipSuccess || per_cu < 1) fprintf(stderr, "kernel_launch: occupancy query reports %d\n", per_cu);
        (void)hipGetLastError();
        grid = cus;
    }
    if (grid < 0) return;
    if (hipMemsetAsync((char*)d_ws + WS_CTL, 0, CTL_ZERO_BYTES, stream) != hipSuccess) { fprintf(stderr, "kernel_launch: memset failed\n"); return; }
    Args a{};
    for (int i = 0; i < 20; ++i) a.in[i] = (const float*)d_in[i];
    a.out = (float*)d_out; a.ws = (unsigned char*)d_ws; a.pad = 0;
#if MK_CUTS
    for (int p = 0; p < NPHASE; ++p) { a.ph_lo = p; a.ph_hi = p + 1; a.li = 0; hipLaunchKernelGGL(hybrid_fwd, dim3(grid), dim3(NWAVES * 64), LDS_BYTES, stream, a); }
#else
    a.ph_lo = 0; a.ph_hi = NPHASE; a.li = 0;
    hipLaunchKernelGGL(hybrid_fwd, dim3(grid), dim3(NWAVES * 64), LDS_BYTES, stream, a);
#endif
    const hipError_t le = hipPeekAtLastError();
    if (le != hipSuccess) fprintf(stderr, "kernel_launch: launch failed: %s\n", hipGetErrorName(le));
}
```

```cpp
#include <hip/hip_runtime.h>
#include <hip/hip_bf16.h>
#include <cstdio>
#include <cstdint>
namespace pg8 {
#define PG8_LAS __attribute__((address_space(3)))
typedef unsigned short bf16_t;
typedef short bf16x8 __attribute__((ext_vector_type(8)));
typedef float f32x4 __attribute__((ext_vector_type(4)));
typedef unsigned u32x4 __attribute__((ext_vector_type(4)));
constexpr int BM = 256, BK = 64, HALF = 128, HTB = HALF * BK * 2  , STAGE_BYTES = 8 * HTB, NXCD = 8, WGM = 8;

__host__ __device__ __forceinline__ int lds_byte(int r, int c) { const int st = (r >> 4) * 2 + (c >> 5), rr = r & 15, cc = c & 31, ob = rr * 64 + cc * 2; return st * 1024 + (ob ^ (((ob >> 9) & 1) << 5)); }
__host__ __device__ __forceinline__ void stage_rc(int b, int& R, int& C) { const int st = b / 1024, sb = b % 1024, swz = sb ^ (((sb >> 9) & 1) << 5); R = (st >> 1) * 16 + swz / 64; C = (st & 1) * 32 + (swz % 64) / 2; }
__host__ __device__ __forceinline__ int perm32(int rho) { const int n = rho >> 4, i = rho & 15; return 8 * (i >> 2) + 4 * n + (i & 3); }

struct Unit { int pm, pn, pb, src; };
struct Gemm { const bf16_t* A; const bf16_t* Bt; int M, N, K; const bf16_t* A2; const bf16_t* Bt2; };

struct StaticOrder {
    int nM, nN, nwg, G, c;
    __host__ __device__ void init(int M, int N, int G_, int c_) { nM = M / BM; nN = N / BM; nwg = nM * nN; G = G_; c = c_; }
    __host__ __device__ __forceinline__ bool next(int i, Unit& u) const {
        const long L = (long)i * G + c; if (L >= nwg) return false;
        int wgid = (int)L; { const int q = nwg / NXCD, r = nwg % NXCD, xcd = wgid % NXCD, off = wgid / NXCD; wgid = (xcd < r ? xcd * (q + 1) : r * (q + 1) + (xcd - r) * q) + off; }
        const int nig = WGM * nN, gid = wgid / nig, fm = gid * WGM, gsz = (nM - fm) < WGM ? (nM - fm) : WGM;
        u.pm = fm + ((wgid % nig) % gsz); u.pn = (wgid % nig) / gsz; u.pb = u.pn; u.src = 0; return true;
    }
    __device__ __forceinline__ void a_ready(const Unit&) const {}
    __device__ __forceinline__ void done(const Unit&) const {}
};


typedef int v8i32 __attribute__((ext_vector_type(8)));
__device__ __forceinline__ bf16x8 lo8(v8i32 v) { typedef int v4i32 __attribute__((ext_vector_type(4))); return __builtin_bit_cast(bf16x8, (v4i32){v[0], v[1], v[2], v[3]}); }
__device__ __forceinline__ bf16x8 hi8(v8i32 v) { typedef int v4i32 __attribute__((ext_vector_type(4))); return __builtin_bit_cast(bf16x8, (v4i32){v[4], v[5], v[6], v[7]}); }
__device__ __forceinline__ v8i32 cat8(bf16x8 a, bf16x8 b) { typedef int v4i32 __attribute__((ext_vector_type(4))); const v4i32 x = __builtin_bit_cast(v4i32, a), y = __builtin_bit_cast(v4i32, b); return (v8i32){x[0], x[1], x[2], x[3], y[0], y[1], y[2], y[3]}; }
template <class Epi, class Sched, bool ALIGN_EPI = false, bool SP2 = false, bool F8 = false>
__device__ __forceinline__ void gemm_phase(PG8_LAS unsigned char* lds, const Gemm g, const Sched& S, const Epi& E) {
    const int tid = threadIdx.x, wid = __builtin_amdgcn_readfirstlane(tid >> 6), lane = tid & 63, wr = wid >> 2, wc = wid & 3, fr = lane & 15, fq = lane >> 4;
    const int K = g.K, nt = K / BK;
    unsigned voffA[2], voffB[2];
#pragma unroll
    for (int i = 0; i < 2; ++i) { int R, C; stage_rc(tid * 16 + i * 8192, R, C); const int Rb = Epi::PERM ? ((R & ~31) + perm32(R & 31)) : R;
        voffA[i] = (unsigned)(R * K + C) * 2u; voffB[i] = (unsigned)(Rb * K + C) * 2u; }
    const size_t kstep = (size_t)(BK * 2);
    const size_t hstep = (size_t)HALF * K * 2;
    const size_t tstep = 2 * hstep;
    const unsigned ldsw = (unsigned)wid * 1024u;
    const int aoff = lds_byte(wr * 64 + fr, fq * 8), boff = lds_byte(wc * 32 + fr, fq * 8);
#define PG8_SA(b, h) (((b) * 2 + (h)) * HTB)
#define PG8_SB(b, h) ((4 + (b) * 2 + (h)) * HTB)
#define PG8_STAGE(bufoff, gbase, voff) do { _Pragma("unroll") for (int _i = 0; _i < 2; ++_i) \
        __builtin_amdgcn_global_load_lds((const unsigned*)((const char*)(gbase) + (voff)[_i]), (PG8_LAS unsigned*)(lds + (bufoff) + ldsw + _i * 8192), 16, 0, 0); } while (0)
#define PG8_LDA(dst, b, h) do { _Pragma("unroll") for (int m = 0; m < 4; ++m) dst[m] = cat8(*(const PG8_LAS bf16x8*)(lds + PG8_SA(b, h) + aoff + m * 2048), *(const PG8_LAS bf16x8*)(lds + PG8_SA(b, h) + aoff + m * 2048 + 1024)); } while (0)
#define PG8_LDB(dst, b, h) do { _Pragma("unroll") for (int n = 0; n < 2; ++n) dst[n] = cat8(*(const PG8_LAS bf16x8*)(lds + PG8_SB(b, h) + boff + n * 2048), *(const PG8_LAS bf16x8*)(lds + PG8_SB(b, h) + boff + n * 2048 + 1024)); } while (0)
#define PG8_MMA(ai, bj, At, Bt) do { __builtin_amdgcn_s_setprio(1); _Pragma("unroll") for (int m = 0; m < 4; ++m) _Pragma("unroll") for (int n = 0; n < 2; ++n) { \
        if constexpr (F8) asm volatile("v_mfma_scale_f32_16x16x128_f8f6f4 %0, %1, %2, %0, %3, %3 op_sel_hi:[0,0,0]" : "+v"(acc[ai][bj][m][n]) : "v"(Bt[n]), "v"(At[m]), "v"(f8scale)); \
        else { acc[ai][bj][m][n] = __builtin_amdgcn_mfma_f32_16x16x32_bf16(lo8(Bt[n]), lo8(At[m]), acc[ai][bj][m][n], 0, 0, 0); acc[ai][bj][m][n] = __builtin_amdgcn_mfma_f32_16x16x32_bf16(hi8(Bt[n]), hi8(At[m]), acc[ai][bj][m][n], 0, 0, 0); } } __builtin_amdgcn_s_setprio(0); } while (0)
#define PG8_WAIT_V(n) asm volatile("s_waitcnt vmcnt(" #n ")" ::: "memory")
#define PG8_WAIT_L(n) asm volatile("s_waitcnt lgkmcnt(" #n ")" ::: "memory")
#define PG8_BAR __builtin_amdgcn_s_barrier()
#define PG8_SCHED __builtin_amdgcn_sched_barrier(0)
    Unit cur, nxt; int ui = 0;
    if (!S.next(0, cur)) return;
    f32x4 acc[2][2][4][2];
#pragma unroll
    for (int a = 0; a < 2; ++a)
#pragma unroll
        for (int b = 0; b < 2; ++b)
#pragma unroll
            for (int m = 0; m < 4; ++m)
#pragma unroll
                for (int n = 0; n < 2; ++n) { acc[a][b][m][n] = (f32x4){0.f, 0.f, 0.f, 0.f}; if constexpr (F8) asm volatile("" : "+v"(acc[a][b][m][n])); }
    int f8scale = 0x7f7f7f7f; if constexpr (F8) asm volatile("" : "+v"(f8scale));
    v8i32 At[4], B0[2], B1[2];
    const char* cA = (const char*)(cur.src ? g.A2 : g.A) + (size_t)cur.pm * tstep; const char* cB = (const char*)(cur.src ? g.Bt2 : g.Bt) + (size_t)cur.pb * tstep;
    S.a_ready(cur);
    if constexpr (SP2) {
        PG8_STAGE(PG8_SB(0, 0), cB, voffB); PG8_STAGE(PG8_SB(0, 1), cB + hstep, voffB); PG8_STAGE(PG8_SA(0, 0), cA, voffA); PG8_STAGE(PG8_SA(0, 1), cA + hstep, voffA);
        if (wr == 1) PG8_BAR;
        PG8_WAIT_V(2); PG8_BAR;
        PG8_STAGE(PG8_SB(1, 0), cB + kstep, voffB); PG8_STAGE(PG8_SA(1, 0), cA + kstep, voffA); PG8_STAGE(PG8_SB(1, 1), cB + hstep + kstep, voffB);
        PG8_WAIT_V(6); PG8_BAR;
    } else {
        PG8_STAGE(PG8_SB(0, 0), cB, voffB); PG8_STAGE(PG8_SA(0, 0), cA, voffA); PG8_STAGE(PG8_SB(0, 1), cB + hstep, voffB); PG8_STAGE(PG8_SA(0, 1), cA + hstep, voffA);
        if (wr == 1) PG8_BAR;
        PG8_WAIT_V(4); PG8_BAR;
        PG8_STAGE(PG8_SB(1, 0), cB + kstep, voffB); PG8_STAGE(PG8_SA(1, 0), cA + kstep, voffA); PG8_STAGE(PG8_SB(1, 1), cB + hstep + kstep, voffB);
        PG8_WAIT_V(6); PG8_BAR;
    }
    for (;;) {
        const bool has_next = S.next(ui + 1, nxt);
        const char* nA = has_next ? (const char*)(nxt.src ? g.A2 : g.A) + (size_t)nxt.pm * tstep : cA; const char* nB = has_next ? (const char*)(nxt.src ? g.Bt2 : g.Bt) + (size_t)nxt.pb * tstep : cB;
        for (int t = 0; t < nt; t += 2) {
            const bool last = (t == nt - 2);
            const char* a1 = cA + (size_t)(t + 1) * kstep;
            const char* a2 = last ? nA : cA + (size_t)(t + 2) * kstep; const char* b2 = last ? nB : cB + (size_t)(t + 2) * kstep;
            const char* a3 = a2 + kstep; const char* b3 = b2 + kstep;
            if (last && has_next) S.a_ready(nxt);
            if constexpr (SP2) {
            PG8_LDB(B0, 0, 0); PG8_LDB(B1, 0, 1); PG8_SCHED; PG8_LDA(At, 0, 0); PG8_STAGE(PG8_SA(1, 1), a1 + hstep, voffA);
            PG8_WAIT_V(8); PG8_WAIT_L(0); PG8_BAR; PG8_MMA(0, 0, At, B0); PG8_MMA(0, 1, At, B1); PG8_BAR; PG8_SCHED;
            PG8_LDA(At, 0, 1); PG8_STAGE(PG8_SB(0, 0), b2, voffB); PG8_STAGE(PG8_SB(0, 1), b2 + hstep, voffB); PG8_STAGE(PG8_SA(0, 0), a2, voffA);
            PG8_WAIT_V(8); PG8_WAIT_L(0); PG8_BAR; PG8_MMA(1, 0, At, B0); PG8_MMA(1, 1, At, B1); PG8_BAR; PG8_SCHED;
            PG8_LDB(B0, 1, 0); PG8_LDB(B1, 1, 1); PG8_SCHED; PG8_LDA(At, 1, 0); PG8_STAGE(PG8_SA(0, 1), a2 + hstep, voffA);
            PG8_WAIT_V(8); PG8_WAIT_L(0); PG8_BAR; PG8_MMA(0, 0, At, B0); PG8_MMA(0, 1, At, B1); PG8_BAR; PG8_SCHED;
            PG8_LDA(At, 1, 1); PG8_STAGE(PG8_SB(1, 0), b3, voffB); PG8_STAGE(PG8_SB(1, 1), b3 + hstep, voffB); PG8_STAGE(PG8_SA(1, 0), a3, voffA);
            PG8_WAIT_V(8); PG8_WAIT_L(0); PG8_BAR; PG8_MMA(1, 0, At, B0); PG8_MMA(1, 1, At, B1); PG8_BAR; PG8_SCHED;
            } else {
            PG8_LDB(B0, 0, 0); PG8_SCHED; PG8_LDA(At, 0, 0); PG8_STAGE(PG8_SA(1, 1), a1 + hstep, voffA);
            PG8_WAIT_L(8); PG8_BAR; PG8_WAIT_L(0); PG8_MMA(0, 0, At, B0); PG8_BAR; PG8_SCHED;
            PG8_LDB(B1, 0, 1); PG8_STAGE(PG8_SB(0, 0), b2, voffB);
            PG8_BAR; PG8_WAIT_L(0); PG8_MMA(0, 1, At, B1); PG8_BAR;
            PG8_LDA(At, 0, 1); PG8_STAGE(PG8_SA(0, 0), a2, voffA);
            PG8_BAR; PG8_WAIT_L(0); PG8_MMA(1, 0, At, B0); PG8_BAR; PG8_SCHED;
            PG8_STAGE(PG8_SB(0, 1), b2 + hstep, voffB);
            PG8_WAIT_V(6); PG8_BAR; PG8_MMA(1, 1, At, B1); PG8_BAR;
            PG8_LDB(B0, 1, 0); PG8_SCHED; PG8_LDA(At, 1, 0); PG8_STAGE(PG8_SA(0, 1), a2 + hstep, voffA);
            PG8_WAIT_L(8); PG8_BAR; PG8_WAIT_L(0); PG8_MMA(0, 0, At, B0); PG8_BAR; PG8_SCHED;
            PG8_LDB(B1, 1, 1); PG8_STAGE(PG8_SB(1, 0), b3, voffB);
            PG8_BAR; PG8_WAIT_L(0); PG8_MMA(0, 1, At, B1); PG8_BAR;
            PG8_LDA(At, 1, 1); PG8_STAGE(PG8_SA(1, 0), a3, voffA);
            PG8_BAR; PG8_WAIT_L(0); PG8_MMA(1, 0, At, B0); PG8_BAR; PG8_SCHED;
            PG8_STAGE(PG8_SB(1, 1), b3 + hstep, voffB);
            PG8_WAIT_V(6); PG8_BAR; PG8_MMA(1, 1, At, B1); PG8_BAR;
            }
        }
        if constexpr (ALIGN_EPI) { if (wr == 0) PG8_BAR; }
        if constexpr (F8) asm volatile("s_nop 15\n\ts_nop 15" ::: "memory");
#ifdef DOUBLE_EPI
        if constexpr (!Epi::AFTER_DRAIN && !Epi::CHAIN && Epi::ID == DOUBLE_EPI) { E(acc, cur, wr, wc, fr, fq); asm volatile("" ::: "memory"); }
#endif
        if constexpr (!Epi::AFTER_DRAIN) { E(acc, cur, wr, wc, fr, fq); S.done(cur); }
        if (!has_next) break;
        if (!(Epi::CHAIN && cur.src == 0))
#pragma unroll
        for (int a = 0; a < 2; ++a)
#pragma unroll
            for (int b = 0; b < 2; ++b)
#pragma unroll
                for (int m = 0; m < 4; ++m)
#pragma unroll
                    for (int n = 0; n < 2; ++n) { acc[a][b][m][n] = (f32x4){0.f, 0.f, 0.f, 0.f}; if constexpr (F8) asm volatile("" : "+v"(acc[a][b][m][n])); }
        cur = nxt; cA = nA; cB = nB; ++ui;
        if constexpr (ALIGN_EPI) { if (wr == 1) PG8_BAR; }
    }
    PG8_WAIT_V(0);
    if constexpr (!ALIGN_EPI) { if (wr == 0) PG8_BAR; }
    PG8_BAR;
    if constexpr (Epi::AFTER_DRAIN) { E.fused(acc, cur, wr, wc, fr, fq, lds, wid, lane); S.done(cur); }
#undef PG8_SA
#undef PG8_SB
#undef PG8_STAGE
#undef PG8_LDA
#undef PG8_LDB
#undef PG8_MMA
#undef PG8_WAIT_V
#undef PG8_WAIT_L
#undef PG8_BAR
#undef PG8_SCHED
}
}

#ifdef NANCHK_ON
#define NANCHK(cond, id) do { if (cond) atomicAdd((unsigned*)(((const float* const __attribute__((address_space(4)))*)__builtin_amdgcn_kernarg_segment_ptr())[21]) + 12288 + 64 * (id), 1u); } while (0)
#else
#define NANCHK(cond, id) do { } while (0)
#endif
namespace pg8 {
typedef unsigned u32x2 __attribute__((ext_vector_type(2)));
__device__ __forceinline__ unsigned cvt_pk_bf16(float lo, float hi) { unsigned r; asm volatile("v_cvt_pk_bf16_f32 %0, %1, %2" : "=v"(r) : "v"(lo), "v"(hi)); return r; }
__device__ __forceinline__ float bf_lo(unsigned w) { return __uint_as_float(w << 16); }
__device__ __forceinline__ float bf_hi(unsigned w) { return __uint_as_float(w & 0xffff0000u); }
__device__ __forceinline__ float frcp(float x) { return __builtin_amdgcn_rcpf(x); }
__device__ __forceinline__ float sigm(float x) { return frcp(1.f + __expf(-x)); }

struct GroupedOrder {
    int nM, nN, nwg, G, c; const PG8_LAS int* tile_e;
    __device__ void init(int ntiles, int nN_, int G_, int c_, const PG8_LAS int* te) { nM = ntiles; nN = nN_; nwg = nM * nN; G = G_; c = c_; tile_e = te; }
    __device__ __forceinline__ bool next(int i, Unit& u) const {
        const long L = (long)i * G + c; if (L >= nwg) return false;
        int wgid = (int)L; { const int q = nwg / NXCD, r = nwg % NXCD, xcd = wgid % NXCD, off = wgid / NXCD; wgid = (xcd < r ? xcd * (q + 1) : r * (q + 1) + (xcd - r) * q) + off; }
        const int nig = WGM * nN, gid = wgid / nig, fm = gid * WGM, gsz = (nM - fm) < WGM ? (nM - fm) : WGM;
        u.pm = fm + ((wgid % nig) % gsz); u.pn = (wgid % nig) / gsz; u.pb = tile_e[u.pm] * nN + u.pn; u.src = 0; return true;
    }
    __device__ __forceinline__ void a_ready(const Unit&) const {}
    __device__ __forceinline__ void done(const Unit&) const {}
};

struct EpiU {
    static constexpr bool PERM = true, AFTER_DRAIN = false, CHAIN = false; static constexpr int ID = 1;
    bf16_t* O; int ldc;
    __device__ __forceinline__ void operator()(const f32x4 (&acc)[2][2][4][2], const Unit& u, int wr, int wc, int fr, int fq) const {
        NANCHK((acc[0][0][0][0][0] != acc[0][0][0][0][0]) || (acc[1][1][3][1][3] != acc[1][1][3][1][3]) || (acc[0][1][2][0][1] != acc[0][1][2][0][1]) || (acc[1][0][1][1][2] != acc[1][0][1][1][2]), 2);
        const int row0 = u.pm * BM + wr * 64 + fr, col0 = u.pn * BM + wc * 32 + 8 * fq;
#pragma unroll
        for (int ai = 0; ai < 2; ++ai)
#pragma unroll
            for (int m = 0; m < 4; ++m) { bf16_t* rowp = O + (size_t)(row0 + ai * HALF + m * 16) * ldc + col0;
#pragma unroll
                for (int bj = 0; bj < 2; ++bj) { const f32x4 v0 = acc[ai][bj][m][0], v1 = acc[ai][bj][m][1];
                    u32x4 w; w.x = cvt_pk_bf16(v0[0], v0[1]); w.y = cvt_pk_bf16(v0[2], v0[3]); w.z = cvt_pk_bf16(v1[0], v1[1]); w.w = cvt_pk_bf16(v1[2], v1[3]);
                    *(u32x4*)(rowp + bj * HALF) = w; } }
    }
};
struct EpiSsd {
    static constexpr bool PERM = false, AFTER_DRAIN = false, CHAIN = false; static constexpr int ID = 90;
    float* TMP; const bf16_t* G; int ldg; const PG8_LAS float* tab; const PG8_LAS int* tpm;
    __device__ __forceinline__ void operator()(const f32x4 (&acc)[2][2][4][2], const Unit& u, int wr, int wc, int fr, int fq) const {
        NANCHK((acc[0][0][0][0][0] != acc[0][0][0][0][0]) || (acc[1][1][3][1][3] != acc[1][1][3][1][3]) || (acc[0][1][2][0][1] != acc[0][1][2][0][1]) || (acc[1][0][1][1][2] != acc[1][0][1][1][2]), 3);
        const int row0 = u.pm * BM + wr * 64 + fr, col0 = u.pn * BM + wc * 32 + 4 * fq;
        const int slot = tpm[0] == u.pm ? 0 : (tpm[1] == u.pm ? 1 : (tpm[2] == u.pm ? 2 : 3));
#pragma unroll
        for (int ai = 0; ai < 2; ++ai)
#pragma unroll
            for (int m = 0; m < 4; ++m) { const int row = row0 + ai * HALF + m * 16; const float rs = tab[slot * 256 + (row & 255)];
#pragma unroll
                for (int bj = 0; bj < 2; ++bj)
#pragma unroll
                    for (int n = 0; n < 2; ++n) { const int c = col0 + bj * HALF + n * 16; const u32x2 g = *(const u32x2*)(G + (size_t)row * ldg + c);
                        const f32x4 a = acc[ai][bj][m][n]; f32x4 o;
                        o[0] = a[0] * rs * sigm(bf_lo(g.x)); o[1] = a[1] * rs * sigm(bf_hi(g.x)); o[2] = a[2] * rs * sigm(bf_lo(g.y)); o[3] = a[3] * rs * sigm(bf_hi(g.y));
                        *(f32x4*)(TMP + (size_t)row * 2048 + c) = o; } }
    }
};
struct EpiAttn {
    static constexpr bool PERM = true, AFTER_DRAIN = false, CHAIN = false; static constexpr int ID = 91;
    bf16_t* MG; const float* TMP; const bf16_t* G; int ldg;
    __device__ __forceinline__ void operator()(const f32x4 (&acc)[2][2][4][2], const Unit& u, int wr, int wc, int fr, int fq) const {
        NANCHK((acc[0][0][0][0][0] != acc[0][0][0][0][0]) || (acc[1][1][3][1][3] != acc[1][1][3][1][3]) || (acc[0][1][2][0][1] != acc[0][1][2][0][1]) || (acc[1][0][1][1][2] != acc[1][0][1][1][2]), 4);
        const int row0 = u.pm * BM + wr * 64 + fr, col0 = u.pn * BM + wc * 32 + 8 * fq;
#pragma unroll
        for (int ai = 0; ai < 2; ++ai)
#pragma unroll
            for (int m = 0; m < 4; ++m) { const int row = row0 + ai * HALF + m * 16;
#pragma unroll
                for (int bj = 0; bj < 2; ++bj) { const int c = col0 + bj * HALF; const u32x4 g = *(const u32x4*)(G + (size_t)row * ldg + c);
                    const f32x4 t0 = *(const f32x4*)(TMP + (size_t)row * 2048 + c), t1 = *(const f32x4*)(TMP + (size_t)row * 2048 + c + 4);
                    const f32x4 a0 = acc[ai][bj][m][0], a1 = acc[ai][bj][m][1];
                    u32x4 w;
                    w.x = cvt_pk_bf16(t0[0] + a0[0] * sigm(bf_lo(g.x)), t0[1] + a0[1] * sigm(bf_hi(g.x)));
                    w.y = cvt_pk_bf16(t0[2] + a0[2] * sigm(bf_lo(g.y)), t0[3] + a0[3] * sigm(bf_hi(g.y)));
                    w.z = cvt_pk_bf16(t1[0] + a1[0] * sigm(bf_lo(g.z)), t1[1] + a1[1] * sigm(bf_hi(g.z)));
                    w.w = cvt_pk_bf16(t1[2] + a1[2] * sigm(bf_lo(g.w)), t1[3] + a1[3] * sigm(bf_hi(g.w)));
                    *(u32x4*)(MG + (size_t)row * 2048 + c) = w; } }
    }
};
struct ChainOrder {
    StaticOrder base;
    __device__ __forceinline__ bool next(int i, Unit& u) const { if (!base.next(i >> 1, u)) return false; u.src = i & 1; return true; }
    __device__ __forceinline__ void a_ready(const Unit&) const {}
    __device__ __forceinline__ void done(const Unit&) const {}
};
struct EpiMerge {
    static constexpr bool PERM = true, AFTER_DRAIN = false, CHAIN = true; static constexpr int ID = 6;
    bf16_t* MG; const bf16_t* GS; const bf16_t* GA; int ldg; const PG8_LAS float* tab; const PG8_LAS int* tpm;
    __device__ __forceinline__ void operator()(f32x4 (&acc)[2][2][4][2], const Unit& u, int wr, int wc, int fr, int fq) const {
        const int row0 = u.pm * BM + wr * 64 + fr, col0 = u.pn * BM + wc * 32 + 8 * fq;
        const int slot = tpm[0] == u.pm ? 0 : (tpm[1] == u.pm ? 1 : (tpm[2] == u.pm ? 2 : 3));
#pragma unroll
        for (int ai = 0; ai < 2; ++ai) {
            u32x4 gav[4][2], gsv[4][2];
#pragma unroll
            for (int m = 0; m < 4; ++m)
#pragma unroll
                for (int bj = 0; bj < 2; ++bj) { const size_t o = (size_t)(row0 + ai * HALF + m * 16) * ldg + col0 + bj * HALF; gav[m][bj] = *(const u32x4*)(GA + o); gsv[m][bj] = (u32x4){0u, 0u, 0u, 0u}; }
            if (u.src == 0) {
#pragma unroll
                for (int m = 0; m < 4; ++m)
#pragma unroll
                    for (int bj = 0; bj < 2; ++bj) gsv[m][bj] = *(const u32x4*)(GS + (size_t)(row0 + ai * HALF + m * 16) * ldg + col0 + bj * HALF); }
            __builtin_amdgcn_sched_barrier(0);
#pragma unroll
            for (int m = 0; m < 4; ++m) { const int row = row0 + ai * HALF + m * 16;
#pragma unroll
                for (int bj = 0; bj < 2; ++bj) { const int c = col0 + bj * HALF; const u32x4 ga = gav[m][bj];
                    float ea[8] = {1.f + __expf(-bf_lo(ga.x)), 1.f + __expf(-bf_hi(ga.x)), 1.f + __expf(-bf_lo(ga.y)), 1.f + __expf(-bf_hi(ga.y)), 1.f + __expf(-bf_lo(ga.z)), 1.f + __expf(-bf_hi(ga.z)), 1.f + __expf(-bf_lo(ga.w)), 1.f + __expf(-bf_hi(ga.w))};
                    f32x4& a0 = acc[ai][bj][m][0]; f32x4& a1 = acc[ai][bj][m][1];
                    if (u.src == 0) { const float rs = tab[slot * 256 + (row & 255)]; const u32x4 gs = gsv[m][bj];
                        a0[0] *= rs * ea[0] * sigm(bf_lo(gs.x)); a0[1] *= rs * ea[1] * sigm(bf_hi(gs.x)); a0[2] *= rs * ea[2] * sigm(bf_lo(gs.y)); a0[3] *= rs * ea[3] * sigm(bf_hi(gs.y));
                        a1[0] *= rs * ea[4] * sigm(bf_lo(gs.z)); a1[1] *= rs * ea[5] * sigm(bf_hi(gs.z)); a1[2] *= rs * ea[6] * sigm(bf_lo(gs.w)); a1[3] *= rs * ea[7] * sigm(bf_hi(gs.w)); }
                    else { u32x4 w; w.x = cvt_pk_bf16(a0[0] * frcp(ea[0]), a0[1] * frcp(ea[1])); w.y = cvt_pk_bf16(a0[2] * frcp(ea[2]), a0[3] * frcp(ea[3])); w.z = cvt_pk_bf16(a1[0] * frcp(ea[4]), a1[1] * frcp(ea[5])); w.w = cvt_pk_bf16(a1[2] * frcp(ea[6]), a1[3] * frcp(ea[7]));
                        *(u32x4*)(MG + (size_t)row * 2048 + c) = w; } } } }
    }
};
struct EpiOut {
    static constexpr bool PERM = false, AFTER_DRAIN = false, CHAIN = false; static constexpr int ID = 8;
    float* H1; const float* X;
    __device__ __forceinline__ void operator()(const f32x4 (&acc)[2][2][4][2], const Unit& u, int wr, int wc, int fr, int fq) const {
        NANCHK((acc[0][0][0][0][0] != acc[0][0][0][0][0]) || (acc[1][1][3][1][3] != acc[1][1][3][1][3]) || (acc[0][1][2][0][1] != acc[0][1][2][0][1]) || (acc[1][0][1][1][2] != acc[1][0][1][1][2]), 5);
        const int row0 = u.pm * BM + wr * 64 + fr, col0 = u.pn * BM + wc * 32 + 4 * fq;
#pragma unroll
        for (int ai = 0; ai < 2; ++ai) {
            f32x4 xv[4][2][2];
#pragma unroll
            for (int m = 0; m < 4; ++m) { const size_t ro = (size_t)(row0 + ai * HALF + m * 16) * 2048;
#pragma unroll
                for (int bj = 0; bj < 2; ++bj)
#pragma unroll
                    for (int n = 0; n < 2; ++n) xv[m][bj][n] = *(const f32x4*)(X + ro + col0 + bj * HALF + n * 16); }
            __builtin_amdgcn_sched_barrier(0);
#pragma unroll
            for (int m = 0; m < 4; ++m) { const size_t ro = (size_t)(row0 + ai * HALF + m * 16) * 2048;
#pragma unroll
                for (int bj = 0; bj < 2; ++bj)
#pragma unroll
                    for (int n = 0; n < 2; ++n) { const int c = col0 + bj * HALF + n * 16; *(f32x4*)(H1 + ro + c) = xv[m][bj][n] + acc[ai][bj][m][n]; } } }
    }
};
__device__ __forceinline__ unsigned pk4_fp8(float a, float b, float c, float d) {
    a = fminf(fmaxf(a, -448.f), 448.f); b = fminf(fmaxf(b, -448.f), 448.f); c = fminf(fmaxf(c, -448.f), 448.f); d = fminf(fmaxf(d, -448.f), 448.f);
    int w = 0; w = __builtin_amdgcn_cvt_pk_fp8_f32(a, b, w, false); w = __builtin_amdgcn_cvt_pk_fp8_f32(c, d, w, true); return (unsigned)w; }
constexpr float F8_SX = 16.f, F8_SW = 1024.f, F8_SA = 4.f;
__device__ __forceinline__ float swiglu1(float g, float l) { g = fminf(g, 7.0f); l = fminf(fmaxf(l, -7.0f), 7.0f); return g * sigm(1.702f * g) * (l + 1.0f); }
struct EpiSwiglu {
    static constexpr bool PERM = true, AFTER_DRAIN = false, CHAIN = false; static constexpr int ID = 11;
    bf16_t* ACT; const float* b1;
    __device__ __forceinline__ void operator()(const f32x4 (&acc)[2][2][4][2], const Unit& u, int wr, int wc, int fr, int fq) const {
        NANCHK((acc[0][0][0][0][0] != acc[0][0][0][0][0]) || (acc[1][1][3][1][3] != acc[1][1][3][1][3]) || (acc[0][1][2][0][1] != acc[0][1][2][0][1]) || (acc[1][0][1][1][2] != acc[1][0][1][1][2]), 6);
        const int row0 = u.pm * BM + wr * 64 + fr, e = u.pb >> 4, j0 = u.pn * 128 + wc * 32 + 8 * fq;
        constexpr float DS = 1.0f / (F8_SX * F8_SW);
        const float* bg0 = b1 + (size_t)e * 4096 + j0; const f32x4 bg_[2] = {*(const f32x4*)bg0, *(const f32x4*)(bg0 + 4)}, bl_[2] = {*(const f32x4*)(bg0 + 2048), *(const f32x4*)(bg0 + 2052)};
        __builtin_amdgcn_sched_barrier(0);
        unsigned roff = (unsigned)row0 * 2048u + (unsigned)j0; asm volatile("" : "+v"(roff));
#pragma unroll
        for (int ai = 0; ai < 2; ++ai)
#pragma unroll
            for (int m = 0; m < 4; ++m) { unsigned w2[2];
#pragma unroll
                for (int n = 0; n < 2; ++n) { const f32x4 bgv = bg_[n], blv = bl_[n];
                    f32x4 g = acc[ai][0][m][n] * DS + bgv, l = acc[ai][1][m][n] * DS + blv;
                    g[0] = fminf(g[0], 7.0f); g[1] = fminf(g[1], 7.0f); g[2] = fminf(g[2], 7.0f); g[3] = fminf(g[3], 7.0f);
                    l[0] = fminf(fmaxf(l[0], -7.0f), 7.0f); l[1] = fminf(fmaxf(l[1], -7.0f), 7.0f); l[2] = fminf(fmaxf(l[2], -7.0f), 7.0f); l[3] = fminf(fmaxf(l[3], -7.0f), 7.0f);
                    const f32x4 t = g * (-1.702f * 1.4426950408889634f);
                    f32x4 e = {__builtin_amdgcn_exp2f(t[0]), __builtin_amdgcn_exp2f(t[1]), __builtin_amdgcn_exp2f(t[2]), __builtin_amdgcn_exp2f(t[3])};
                    e = e + 1.0f;
                    const f32x4 r = {frcp(e[0]), frcp(e[1]), frcp(e[2]), frcp(e[3])};
                    const f32x4 o = (g * r) * (l * F8_SA + F8_SA);
                    int w = 0; w = __builtin_amdgcn_cvt_pk_fp8_f32(o[0], o[1], w, false); w = __builtin_amdgcn_cvt_pk_fp8_f32(o[2], o[3], w, true); w2[n] = (unsigned)w; }
                *(u32x2*)((unsigned char*)ACT + (roff + (unsigned)(ai * HALF + m * 16) * 2048u)) = (u32x2){w2[0], w2[1]};
                __builtin_amdgcn_sched_barrier(0); }
    }
};
constexpr float F8_SH = 32.f;
#ifndef PK4TEST
#define PK4TEST pk4_fp8
#endif
struct EpiUp8 {
    static constexpr bool PERM = true, AFTER_DRAIN = false, CHAIN = false; static constexpr int ID = 92;
    unsigned char* H8; const float* b1;
    __device__ __forceinline__ void operator()(const f32x4 (&acc)[2][2][4][2], const Unit& u, int wr, int wc, int fr, int fq) const {
        const int row0 = u.pm * BM + wr * 64 + fr, e = u.pb >> 4, col0 = u.pn * BM + wc * 32 + 8 * fq;
#pragma unroll
        for (int bj = 0; bj < 2; ++bj) { const int c = col0 + bj * HALF; const float* bp = b1 + (size_t)e * 4096 + bj * 2048 + u.pn * 128 + wc * 32 + 8 * fq;
            const f32x4 b0 = *(const f32x4*)bp, b1v = *(const f32x4*)(bp + 4);
#pragma unroll
            for (int ai = 0; ai < 2; ++ai)
#pragma unroll
                for (int m = 0; m < 4; ++m) { const int row = row0 + ai * HALF + m * 16;
                    constexpr float DS = 1.0f / (F8_SX * F8_SW);
                    const f32x4 v0 = (acc[ai][bj][m][0] * DS + b0) * F8_SH, v1 = (acc[ai][bj][m][1] * DS + b1v) * F8_SH;
                    u32x2 w; w.x = PK4TEST(v0[0], v0[1], v0[2], v0[3]); w.y = PK4TEST(v1[0], v1[1], v1[2], v1[3]);
                    *(u32x2*)(H8 + (size_t)row * 4096 + c) = w; } }
    }
};
struct EpiMoeOut {
    static constexpr bool PERM = true, AFTER_DRAIN = false, CHAIN = false; static constexpr int ID = 13;
    bf16_t* OS; const float* b2;
    __device__ __forceinline__ void operator()(const f32x4 (&acc)[2][2][4][2], const Unit& u, int wr, int wc, int fr, int fq) const {
        NANCHK((acc[0][0][0][0][0] != acc[0][0][0][0][0]) || (acc[1][1][3][1][3] != acc[1][1][3][1][3]) || (acc[0][1][2][0][1] != acc[0][1][2][0][1]) || (acc[1][0][1][1][2] != acc[1][0][1][1][2]), 7);
        const int row0 = u.pm * BM + wr * 64 + fr, e = u.pb >> 3, col0 = u.pn * BM + wc * 32 + 8 * fq;
#pragma unroll
        for (int bj = 0; bj < 2; ++bj) { const int c = col0 + bj * HALF; const float* bp = b2 + (size_t)e * 2048 + c;
            const f32x4 b0 = *(const f32x4*)bp, b1v = *(const f32x4*)(bp + 4);
#pragma unroll
            for (int ai = 0; ai < 2; ++ai)
#pragma unroll
                for (int m = 0; m < 4; ++m) { const int row = row0 + ai * HALF + m * 16;
                    constexpr float DS = 1.0f / (F8_SA * F8_SW);
                    const f32x4 v0 = acc[ai][bj][m][0] * DS + b0, v1 = acc[ai][bj][m][1] * DS + b1v;
                    u32x4 w; w.x = cvt_pk_bf16(v0[0], v0[1]); w.y = cvt_pk_bf16(v0[2], v0[3]); w.z = cvt_pk_bf16(v1[0], v1[1]); w.w = cvt_pk_bf16(v1[2], v1[3]);
                    *(u32x4*)(OS + (size_t)row * 2048 + c) = w; } }
    }
};
}
namespace att {
constexpr int D = 128;
constexpr int KP = 2048, VP = 16128, QP = 2048, OP = 2048, MKSTRIDE = 8192;
constexpr float THR = 8.f;
constexpr bool WSKIP = false;
constexpr float SCALE = 0.08838834764831845f;
constexpr int NW = 8, QBLK = 32, KVBLK = 64, QB = NW * QBLK;
constexpr int SHM_V = KVBLK * D * 2, SHM_K = KVBLK * D * 2;
constexpr int LDS_BYTES = 2 * SHM_V + 2 * SHM_K + NW * 64 * 4 + 2 * 2048;
using bf16 = __hip_bfloat16;
typedef short bf16x8 __attribute__((ext_vector_type(8)));
typedef short s16x4 __attribute__((ext_vector_type(4)));
typedef float f32x16 __attribute__((ext_vector_type(16)));
typedef float f32x4 __attribute__((ext_vector_type(4)));
typedef unsigned u32x4 __attribute__((ext_vector_type(4)));
template <class A, class Bt> struct same_t { static constexpr bool v = false; };
template <class A> struct same_t<A, A> { static constexpr bool v = true; };
#define KSWZ(row, colB) ((row) * 256 + ((colB) ^ (((row) & 7) << 4)))
#define SBAR() __builtin_amdgcn_sched_barrier(0)
__device__ __forceinline__ int v_st(int k, int c) { const int kk = (k & ~0xC) | ((k & 4) << 1) | ((k & 8) >> 1); return ((kk >> 3) * 4 + (c >> 5)) * 512 + ((kk & 7) * 32 + (c & 31)) * 2; }
__device__ __forceinline__ int v_rd_base(int lane) { return ((lane & 3) << 3) | (((lane >> 2) & 3) << 6) | (((lane >> 4) & 1) << 5) | (((lane >> 5) & 1) << 8); }
constexpr int v_rd_off(int d0, int ks, int half) { return d0 * 512 + ks * 4096 + half * 2048; }
__device__ __forceinline__ int crow(int r, int hi) { return (r & 3) + 8 * (r >> 2) + 4 * hi; }
__device__ __forceinline__ unsigned cvtpk(float lo, float hi) {
    unsigned r; asm volatile("v_cvt_pk_bf16_f32 %0, %1, %2" : "=v"(r) : "v"(lo), "v"(hi)); return r;
}
__device__ __forceinline__ bf16x8 pack8(f32x4 a, f32x4 b) {
    u32x4 w = {cvtpk(a[0], a[1]), cvtpk(a[2], a[3]), cvtpk(b[0], b[1]), cvtpk(b[2], b[3])};
    return *reinterpret_cast<bf16x8*>(&w);
}
template <class T> __device__ __forceinline__ bf16x8 load8(const T* p) {
    if constexpr (same_t<T, float>::v) { return pack8(*(const f32x4*)p, *(const f32x4*)(p + 4)); }
    else { return *reinterpret_cast<const bf16x8*>(p); }
}
__device__ __forceinline__ void mask_bits(f32x16& p0, f32x16& p1, unsigned lo, unsigned hw, int hi) {
    const float NEG = -__builtin_inff();
    lo >>= 4 * hi; hw >>= 4 * hi;
#pragma unroll
    for (int r = 0; r < 16; ++r) {
        const int c = (r & 3) + 8 * (r >> 2);
        const unsigned m0 = (unsigned)((int)(lo << (31 - c)) >> 31), m1 = (unsigned)((int)(hw << (31 - c)) >> 31);
        p0[r] = __uint_as_float((__float_as_uint(p0[r]) & m0) | (~m0 & 0xff800000u));
        p1[r] = __uint_as_float((__float_as_uint(p1[r]) & m1) | (~m1 & 0xff800000u));
    }
}
__device__ __forceinline__ void partialSM(f32x16& p0, f32x16& p1, float& m_reg, float& mn, float& alpha) {
    float pmax = p0[0]; for (int r = 1; r < 16; ++r) pmax = fmaxf(pmax, p0[r]); for (int r = 0; r < 16; ++r) pmax = fmaxf(pmax, p1[r]);
    { auto rr = __builtin_amdgcn_permlane32_swap(__float_as_uint(pmax), __float_as_uint(pmax), false, false);
      pmax = fmaxf(__uint_as_float(rr[0]), __uint_as_float(rr[1])); }
    constexpr float C2 = 1.4426950408889634f * SCALE;
    if (__builtin_expect(__all((pmax - m_reg) * SCALE <= THR), 1)) { mn = m_reg; alpha = 1.f; }
    else { mn = fmaxf(m_reg, pmax); alpha = __builtin_amdgcn_exp2f((m_reg - mn) * C2); m_reg = mn; }
    const float mnL = -mn * C2;
    for (int r = 0; r < 16; ++r) p0[r] = fmaf(p0[r], C2, mnL); for (int r = 0; r < 16; ++r) p1[r] = fmaf(p1[r], C2, mnL);
    for (int r = 0; r < 16; ++r) p0[r] = __builtin_amdgcn_exp2f(p0[r]);
}
__device__ __forceinline__ void finishSM(f32x16& p0, f32x16& p1, float alpha, float& l_reg, bf16x8& pa0, bf16x8& pa1, bf16x8& pa2, bf16x8& pa3) {
    for (int r = 0; r < 16; ++r) p1[r] = __builtin_amdgcn_exp2f(p1[r]);
    float ps = 0; for (int r = 0; r < 16; ++r) ps += p0[r]; for (int r = 0; r < 16; ++r) ps += p1[r];
    { auto rr = __builtin_amdgcn_permlane32_swap(__float_as_uint(ps), __float_as_uint(ps), false, false);
      ps = __uint_as_float(rr[0]) + __uint_as_float(rr[1]); }
    l_reg = l_reg * alpha + ps;
#define PK4(P, B_, OUT) do { unsigned a0 = cvtpk(P[B_+0], P[B_+1]), a1 = cvtpk(P[B_+2], P[B_+3]);                          \
        unsigned b0 = cvtpk(P[B_+4], P[B_+5]), b1 = cvtpk(P[B_+6], P[B_+7]);                                             \
        auto r0 = __builtin_amdgcn_permlane32_swap(a0, b0, false, false); auto r1 = __builtin_amdgcn_permlane32_swap(a1, b1, false, false); \
        u32x4 w = {r0[0], r1[0], r0[1], r1[1]}; OUT = *reinterpret_cast<bf16x8*>(&w); } while (0)
    PK4(p0, 0, pa0); PK4(p0, 8, pa1); PK4(p1, 0, pa2); PK4(p1, 8, pa3);
#undef PK4
}
template <int KB, bool SK>
__device__ __forceinline__ void qkt(f32x16& p0, f32x16& p1, const char* K_lds, int r32, int hi, const bf16x8* qr, bool act) {
    if (SK && !act) { const float NEG = -__builtin_inff();
#pragma unroll
        for (int r = 0; r < 16; ++r) { p0[r] = NEG; p1[r] = NEG; } return; }
    p0 = f32x16{}; p1 = f32x16{};
    const char* kb[4];
#pragma unroll
    for (int dd = 0; dd < 4; ++dd) kb[dd] = K_lds + KB * SHM_K + KSWZ(r32, (dd * 16 + hi * 8) * 2);
#pragma unroll
    for (int d0 = 0; d0 < 8; ++d0) { const char* a = kb[d0 & 3] + (d0 >> 2) * 128;
        bf16x8 b0 = *reinterpret_cast<const bf16x8*>(a);
        bf16x8 b1 = *reinterpret_cast<const bf16x8*>(a + 32 * 256);
        p0 = __builtin_amdgcn_mfma_f32_32x32x16_bf16(b0, qr[d0], p0, 0, 0, 0);
        p1 = __builtin_amdgcn_mfma_f32_32x32x16_bf16(b1, qr[d0], p1, 0, 0, 0); }
}
template <int VB, bool SK>
__device__ __forceinline__ void pv_tile(f32x16* o, int vb0, bf16x8 pa0, bf16x8 pa1, bf16x8 pa2, bf16x8 pa3, bool act) {
    if (SK && !act) return;
#define TRRD(dst, off) asm volatile("ds_read_b64_tr_b16 %0, %1 offset:%2" : "=&v"(dst) : "v"(vb0), "i"(off) : "memory")
#define PV_D0(d0) do { s16x4 l0, l1, l2, l3, h0, h1, h2, h3; constexpr int b_ = VB * SHM_V + v_rd_off(d0, 0, 0);     \
        TRRD(l0, b_); TRRD(h0, b_ + 2048); TRRD(l1, b_ + 4096); TRRD(h1, b_ + 6144); TRRD(l2, b_ + 8192); TRRD(h2, b_ + 10240); TRRD(l3, b_ + 12288); TRRD(h3, b_ + 14336); \
        asm volatile("s_waitcnt lgkmcnt(0)" ::: "memory"); SBAR();                 \
        o[d0] = __builtin_amdgcn_mfma_f32_32x32x16_bf16(pa0, (bf16x8){l0[0], l0[1], l0[2], l0[3], h0[0], h0[1], h0[2], h0[3]}, o[d0], 0, 0, 0);   \
        o[d0] = __builtin_amdgcn_mfma_f32_32x32x16_bf16(pa1, (bf16x8){l1[0], l1[1], l1[2], l1[3], h1[0], h1[1], h1[2], h1[3]}, o[d0], 0, 0, 0);   \
        o[d0] = __builtin_amdgcn_mfma_f32_32x32x16_bf16(pa2, (bf16x8){l2[0], l2[1], l2[2], l2[3], h2[0], h2[1], h2[2], h2[3]}, o[d0], 0, 0, 0);   \
        o[d0] = __builtin_amdgcn_mfma_f32_32x32x16_bf16(pa3, (bf16x8){l3[0], l3[1], l3[2], l3[3], h3[0], h3[1], h3[2], h3[3]}, o[d0], 0, 0, 0); } while (0)
    PV_D0(0); PV_D0(1); PV_D0(2); PV_D0(3);
#undef PV_D0
#undef TRRD
}

template <class TIn, class TOut> struct BlockRef { const TIn* Q; const TIn* K; const TIn* V; TOut* O; const unsigned long long* MK; int P0; };
template <class TIn> struct Seam {
    bf16x8 qr[8];
    bf16x8 st_v0, st_v1, st_k0, st_k1; unsigned st_m; f32x4 sf0, sf1, sf2, sf3;
    f32x4 tq[16];
};
__device__ __forceinline__ int swa_jlo(int P0, int W) { const int lowk = P0 - W + 1; return lowk > 0 ? lowk / KVBLK : 0; }
#define ROW(p, k0, rr, PT) ((p) + (size_t)(k0) * (PT) + (unsigned)((rr) * (PT) + sc))
#define VMW() asm volatile("s_waitcnt vmcnt(0)" ::: "memory")
#define VMWN(n) asm volatile("s_waitcnt vmcnt(%0)" :: "i"(n) : "memory")
#define SLOAD_H(Kp, Vp, Mp, k0) do { S.st_v0 = load8<TIn>(ROW(Vp, k0, sr, VP)); S.st_v1 = load8<TIn>(ROW(Vp, k0, 32 + sr, VP)); S.st_m = ((const unsigned*)((Mp) + (size_t)((k0) >> 6) * MKSTRIDE))[tid]; \
                         S.st_k0 = load8<TIn>(ROW(Kp, k0, sr, KP)); S.st_k1 = load8<TIn>(ROW(Kp, k0, 32 + sr, KP)); } while (0)
#define SWRITE_HK(bf) do { *(bf16x8*)(K_lds + (bf) * SHM_K + kws) = S.st_k0; *(bf16x8*)(K_lds + (bf) * SHM_K + kws + 32 * 256) = S.st_k1; *(unsigned*)(K_lds + 2 * SHM_K + NW * 64 * 4 + (bf) * 2048 + tid * 4) = S.st_m; } while (0)
#define SWRITE_HV(bf) do { *(bf16x8*)(V_lds + (bf) * SHM_V + vst0) = S.st_v0; *(bf16x8*)(V_lds + (bf) * SHM_V + vst1) = S.st_v1; } while (0)
#define SWRITE_H(bf) do { SWRITE_HV(bf); SWRITE_HK(bf); } while (0)
#define SLOAD_F(p, k0) do { S.sf0 = *(const f32x4*)ROW(p, k0, sr, KP); S.sf1 = *(const f32x4*)(ROW(p, k0, sr, KP) + 4);                \
                            S.sf2 = *(const f32x4*)ROW(p, k0, 32 + sr, KP); S.sf3 = *(const f32x4*)(ROW(p, k0, 32 + sr, KP) + 4); } while (0)
#define SWRITE_KF(bf) do { *(bf16x8*)(K_lds + (bf) * SHM_K + kws) = pack8(S.sf0, S.sf1); *(bf16x8*)(K_lds + (bf) * SHM_K + kws + 32 * 256) = pack8(S.sf2, S.sf3); } while (0)
#define SWRITE_VF(bf) do { *(bf16x8*)(V_lds + (bf) * SHM_V + vst0) = pack8(S.sf0, S.sf1); *(bf16x8*)(V_lds + (bf) * SHM_V + vst1) = pack8(S.sf2, S.sf3); } while (0)
template <class TIn, class TOut>
__device__ __forceinline__ void causal_swa_prime(const BlockRef<TIn, TOut>& cur, int W, char* lds, Seam<TIn>& S) {
    constexpr bool F32 = same_t<TIn, float>::v;
    const int tid = threadIdx.x, wid = __builtin_amdgcn_readfirstlane(tid >> 6), lane = tid & 63, r32 = lane & 31, hi = lane >> 5;
    const int sr = tid >> 4, sc = (tid & 15) * 8, kws = KSWZ(sr, sc * 2); char* K_lds = lds + 2 * SHM_V;
    const int kb0 = swa_jlo(cur.P0, W) * KVBLK;
    for (int d0 = 0; d0 < 8; ++d0) S.qr[d0] = load8<TIn>(cur.Q + (size_t)(wid * QBLK) * QP + (unsigned)(r32 * QP + hi * 8) + d0 * 16);
    if constexpr (F32) { SLOAD_F((const float*)cur.K, kb0); VMW(); SWRITE_KF(0); SBAR(); SLOAD_F((const float*)cur.V, kb0); }
    else { SLOAD_H(cur.K, cur.V, cur.MK, kb0); VMW(); SWRITE_HK(0); }
    __syncthreads();
}
template <class TIn, class TOut>
__device__ __forceinline__ void causal_swa_block(const BlockRef<TIn, TOut>& cur, const BlockRef<TIn, TOut>& nxt, int skv, int W, char* lds, Seam<TIn>& S) {
    constexpr bool F32 = same_t<TIn, float>::v;
    const int tid = threadIdx.x, wid = __builtin_amdgcn_readfirstlane(tid >> 6), lane = tid & 63, r32 = lane & 31, hi = lane >> 5;
    const int j_lo = swa_jlo(cur.P0, W);
    int j_hi = (cur.P0 + QB - 1) / KVBLK + 1; if (j_hi > skv / KVBLK) j_hi = skv / KVBLK;
    const int NT = j_hi - j_lo;
    const int kbn = swa_jlo(nxt.P0, W) * KVBLK;
    const int qlo = cur.P0 + wid * QBLK, qm = qlo + r32 - 4 * hi;
    char* V_lds = lds; char* K_lds = lds + 2 * SHM_V;
    float* ws = (float*)(lds + 2 * SHM_V + 2 * SHM_K) + wid * 64; float* li_l = ws, * al_l = ws + 32;
    float m_reg = -1e30f, l_reg = 0; f32x16 o[4] = {};
    const int sr = tid >> 4, sc = (tid & 15) * 8, vst0 = v_st(sr, sc), vst1 = v_st(32 + sr, sc), kws = KSWZ(sr, sc * 2);
    const int vb0 = (int)(uintptr_t)V_lds + v_rd_base(lane);
    const TIn* Kh = cur.K; const TIn* Vh = cur.V;
#define RESC(a) do { if (__any((a) < 1.f)) { if (hi == 0) al_l[r32] = (a); asm volatile("s_waitcnt lgkmcnt(0)" ::: "memory");              \
                     for (int d_ = 0; d_ < 4; ++d_) for (int r = 0; r < 16; ++r) o[d_][r] *= al_l[crow(r, hi)]; } } while (0)
#define KBASE(t) ((j_lo + (t)) * KVBLK)
#define ACT(t) (KBASE(t) <= qlo + QBLK - 1 && KBASE(t) + KVBLK - 1 >= qlo - W + 1)
#define MASKT(P0_, P1_, KB_) do { const uint2 mw_ = *(const uint2*)(K_lds + 2 * SHM_K + NW * 64 * 4 + (KB_) * 2048 + (wid * QBLK + r32) * 8); mask_bits(P0_, P1_, mw_.x, mw_.y, hi); } while (0)
    constexpr int NQL = F32 ? 16 : 8;
    constexpr bool SK = WSKIP && !F32;
#define SEAM_K0() do { VMWN(NQL); if constexpr (F32) { SWRITE_KF(0); SBAR(); SLOAD_F((const float*)nxt.V, kbn); } else { SWRITE_HK(0); } SBAR(); } while (0)
    f32x16 pA0, pA1, pB0, pB1; float mnA, mnB, alA, alB; bf16x8 pa0, pa1, pa2, pa3;
    if constexpr (F32) { VMW(); SWRITE_VF(0); SBAR(); } else { SWRITE_HV(0); SBAR(); }
    if (NT > 1) { if constexpr (F32) SLOAD_F((const float*)Kh, KBASE(1)); else SLOAD_H(Kh, Vh, cur.MK, KBASE(1)); }
    SBAR(); qkt<0, SK>(pA0, pA1, K_lds, r32, hi, S.qr, ACT(0));
    if constexpr (F32) { if (NT > 1) { VMW(); SWRITE_KF(1); SBAR(); SLOAD_F((const float*)Vh, KBASE(1)); } }
    MASKT(pA0, pA1, 0); partialSM(pA0, pA1, m_reg, mnA, alA);
    if (NT > 1) { VMW(); if constexpr (F32) { SWRITE_VF(1); SBAR(); if (NT > 2) SLOAD_F((const float*)Kh, KBASE(2)); } else SWRITE_H(1); }
    __syncthreads();
#define HALF_STEP(PX0, PX1, mnX, alX, PY0, PY1, alY, t, KB, VB, SB) do {                                                      \
        SBAR(); qkt<KB, SK>(PX0, PX1, K_lds, r32, hi, S.qr, ACT(t));                                             \
        finishSM(PY0, PY1, alY, l_reg, pa0, pa1, pa2, pa3); SBAR();                                                           \
        if ((t) + 1 < NT) { if constexpr (F32) { VMW(); SWRITE_KF(SB); SBAR(); SLOAD_F((const float*)Vh, KBASE((t) + 1)); }  \
                            else { SLOAD_H(Kh, Vh, cur.MK, KBASE((t) + 1)); } SBAR(); }                                               \
        pv_tile<VB, SK>(o, vb0, pa0, pa1, pa2, pa3, ACT((t) - 1)); MASKT(PX0, PX1, KB); partialSM(PX0, PX1, m_reg, mnX, alX);                                        \
        __syncthreads();                                                                                                      \
        if ((t) + 1 < NT) { VMW(); if constexpr (F32) { SWRITE_VF(SB); SBAR(); if ((t) + 2 < NT) SLOAD_F((const float*)Kh, KBASE((t) + 2)); } \
                            else { SWRITE_H(SB); } }                                                                          \
        RESC(alX); __syncthreads(); } while (0)
    for (int t = 1; t + 1 < NT; t += 2) {
        HALF_STEP(pB0, pB1, mnB, alB, pA0, pA1, alA, t, 1, 0, 0);
        HALF_STEP(pA0, pA1, mnA, alA, pB0, pB1, alB, t + 1, 0, 1, 1);
    }
    const bool even = (NT & 1) == 0;
    if (even) { SBAR(); qkt<1, SK>(pB0, pB1, K_lds, r32, hi, S.qr, ACT(NT - 1)); SBAR(); }
#define QROW(e) (nxt.Q + (size_t)(wid * QBLK + r32) * QP + ((e) >> 1) * 16 + hi * 8 + ((e) & 1) * 4)
    if constexpr (F32) { SLOAD_F((const float*)nxt.K, kbn); SBAR();
#pragma unroll
        for (int e = 0; e < 8; ++e) S.tq[e] = *(const f32x4*)QROW(e); }
    else { SLOAD_H(nxt.K, nxt.V, nxt.MK, kbn); SBAR();
#pragma unroll
        for (int d0 = 0; d0 < 8; ++d0) S.qr[d0] = load8<TIn>(nxt.Q + (size_t)(wid * QBLK) * QP + (unsigned)(r32 * QP + hi * 8) + d0 * 16); }
    SBAR();
    finishSM(pA0, pA1, alA, l_reg, pa0, pa1, pa2, pa3); SBAR();
    if constexpr (F32) {
#pragma unroll
        for (int e = 8; e < 16; ++e) S.tq[e] = *(const f32x4*)QROW(e); SBAR(); }
#undef QROW
    pv_tile<0, SK>(o, vb0, pa0, pa1, pa2, pa3, ACT(even ? NT - 2 : NT - 1));
    if (even) { MASKT(pB0, pB1, 1); partialSM(pB0, pB1, m_reg, mnB, alB); __syncthreads(); RESC(alB);
        finishSM(pB0, pB1, alB, l_reg, pa0, pa1, pa2, pa3); SBAR(); pv_tile<1, SK>(o, vb0, pa0, pa1, pa2, pa3, ACT(NT - 1)); }
    SBAR(); SEAM_K0();
    if (hi == 0) li_l[r32] = l_reg; asm volatile("s_waitcnt lgkmcnt(0)" ::: "memory");
    float rli[16];
#pragma unroll
    for (int r = 0; r < 16; ++r) rli[r] = __builtin_amdgcn_rcpf(li_l[crow(r, hi)]);
    TOut* Ow = cur.O + (size_t)(wid * QBLK) * OP;
    unsigned olane = (unsigned)(4 * hi * OP + r32) * 2u; asm volatile("" : "+v"(olane));
#pragma unroll
    for (int r = 0; r < 16; ++r) { const int orow = crow(r, hi);
#pragma unroll
        for (int d0 = 0; d0 < 4; ++d0) { const float v = o[d0][r] * rli[r];
            if constexpr (same_t<TOut, float>::v) { Ow[(size_t)orow * OP + d0 * 32 + r32] = v; }
            else { const float vn = __shfl_xor(v, 1);
                   if ((r32 & 1) == 0) *(unsigned*)((char*)Ow + (size_t)((((r & 3) + 8 * (r >> 2)) * OP + d0 * 32) * 2) + olane) = cvtpk(v, vn); } } }
    if constexpr (F32) {
#pragma unroll
        for (int d0 = 0; d0 < 8; ++d0) S.qr[d0] = pack8(S.tq[2 * d0], S.tq[2 * d0 + 1]); }
    __syncthreads();
#undef RESC
#undef KBASE
#undef ACT
#undef MASKT
#undef SEAM_K0
#undef HALF_STEP
}
#undef ROW
#undef VMW
#undef VMWN
#undef SLOAD_H
#undef SWRITE_HK
#undef SWRITE_HV
#undef SWRITE_H
#undef SLOAD_F
#undef SWRITE_KF
#undef SWRITE_VF

#undef KSWZ
#undef SBAR
}
#ifndef PHASE_SWAP
#define PHASE_SWAP 1
#endif
constexpr int NWAVES = 8;
constexpr int T = 16384, SEQ = 8192, DM = 2048, NU = 16128, NEXP = 32;
constexpr int UC_Z = 0, UC_XBC = 2048, UC_Q = 5120, UC_K = 7168, UC_V = 9216, UC_GS = 11264, UC_GA = 13312, UC_QI = 15360, UC_KI = 15872, UC_DT = 15936, UC_WI = 15968, UC_END = 15976;
constexpr int NIN = 15976;
constexpr float EPS = 1e-5f;
constexpr int RMAX = 65536 + 32 * 256;

constexpr size_t MiB = 1u << 20;
constexpr size_t WS_CTL = 0, CTL_ZERO_BYTES = 1 * MiB;
constexpr size_t WS_WIN = 2 * MiB;
constexpr size_t WS_WSSD = 65 * MiB, WS_WATT = 73 * MiB, WS_WOUT = 81 * MiB;
constexpr size_t WS_RWT = 89 * MiB;
constexpr size_t WS_W1 = 96 * MiB;
constexpr size_t WS_W2 = 352 * MiB;
constexpr size_t WS_H8 = 480 * MiB;
constexpr size_t WS_XN = 864 * MiB;
constexpr size_t WS_U = 928 * MiB;
constexpr size_t WS_XBC = 1432 * MiB;
constexpr size_t WS_DT = 1528 * MiB, WS_DACS = 1530 * MiB;
constexpr size_t WS_YD = 1532 * MiB;
constexpr size_t WS_STATES = 1596 * MiB;
constexpr size_t WS_PREV = 1724 * MiB;
constexpr size_t WS_S = 1788 * MiB;
constexpr size_t WS_MASK = 2300 * MiB;
constexpr size_t WS_YG = 2316 * MiB, WS_AO = 2380 * MiB;
constexpr size_t WS_TMP = 2444 * MiB;
constexpr size_t WS_MG = 2572 * MiB;
constexpr size_t WS_H1 = 2636 * MiB;
constexpr size_t WS_ROUTE = 2764 * MiB;
constexpr size_t WS_OS = 2768 * MiB;
constexpr size_t WS_QR = 3056 * MiB, WS_KR = 3120 * MiB;
constexpr size_t WS_QIR = 3184 * MiB, WS_KIR = 3200 * MiB;
constexpr size_t WS_ROPE = 3202 * MiB;
constexpr size_t WS_AS = 3204 * MiB;
constexpr size_t WS_ACT = 3492 * MiB;
constexpr size_t WS_XN2 = 3780 * MiB;
constexpr size_t WS_END = 3844 * MiB;
constexpr int CW_TMO = 0, CW_CODE = 1;
constexpr int CW_BAR = 4096;
constexpr int CW_NT = 8192;
constexpr int RING_OFF = 0, RING_BYTES = 131072;
constexpr int LDSCTL_OFF = RING_BYTES, MISC_OFF = LDSCTL_OFF + 320;
constexpr int TILE_E_OFF = MISC_OFF + 128;
constexpr int EOFF_OFF = TILE_E_OFF + 1280;
constexpr int HIST_OFF = EOFF_OFF + 512;
constexpr int RS_OFF = HIST_OFF + 256;
constexpr int LDS_BYTES = 147456;
static_assert(RS_OFF + 8192 <= LDS_BYTES, "LDS map");

#define GAS __attribute__((address_space(1)))
#define LAS __attribute__((address_space(3)))
typedef unsigned short bf16;
typedef unsigned v4u __attribute__((ext_vector_type(4)));
typedef unsigned v2u __attribute__((ext_vector_type(2)));
typedef float f32x4 __attribute__((ext_vector_type(4)));
typedef float f32x16 __attribute__((ext_vector_type(16)));
typedef short bf16x8 __attribute__((ext_vector_type(8)));
typedef short s16x4 __attribute__((ext_vector_type(4)));
typedef GAS unsigned gu32;
#define RLX_AGENT __ATOMIC_RELAXED, __HIP_MEMORY_SCOPE_AGENT
#define LDS_WAIT() asm volatile("s_waitcnt lgkmcnt(0)" ::: "memory")
#define VM_WAIT() asm volatile("s_waitcnt vmcnt(0)" ::: "memory")
__device__ __forceinline__ unsigned f2bf(float f) { unsigned u = __builtin_bit_cast(unsigned, f); return (u + 0x7fffu + ((u >> 16) & 1u)) >> 16; }
__device__ __forceinline__ unsigned pk2(float lo, float hi) { return f2bf(lo) | (f2bf(hi) << 16); }
__device__ __forceinline__ float bf2f(bf16 b) { return __uint_as_float(((unsigned)b) << 16); }
__device__ __forceinline__ float bflo(unsigned w) { return __uint_as_float(w << 16); }
__device__ __forceinline__ float bfhi(unsigned w) { return __uint_as_float(w & 0xffff0000u); }
__device__ __forceinline__ float siluf(float x) { return x * __builtin_amdgcn_rcpf(1.f + __expf(-x)); }
#define XB_TMO      128
#define XB_XCNT(j)  (256  + 64 * (j))
#define XB_XSUB(j)  (1280 + 64 * (j))
#define XB_XGEN(j)  (2304 + 64 * (j))
#define XB_TOP      3328
#define XB_TOPGEN   3392
#define XCD_BAR_WORDS 3456
#define XB_SPIN_CAP (1u << 18)

__device__ __forceinline__ unsigned xb_ld(unsigned* p)              { return __hip_atomic_load(p, __ATOMIC_RELAXED, __HIP_MEMORY_SCOPE_AGENT); }
__device__ __forceinline__ unsigned xb_add(unsigned* p, unsigned v) { return __hip_atomic_fetch_add(p, v, __ATOMIC_RELAXED, __HIP_MEMORY_SCOPE_AGENT); }
__device__ __forceinline__ unsigned xb_xcc_id() { return (unsigned)__builtin_amdgcn_s_getreg((3 << 11) | 20) & 0xFu; }
#define XB_SPIN(cond, bar) do { unsigned _sp = 0; while (cond) { __builtin_amdgcn_s_sleep(1); \
    if ((++_sp & 255u) == 0u) { if (xb_ld(&(bar)[XB_TMO])) break; if (_sp > XB_SPIN_CAP) { atomicAdd(&(bar)[XB_TMO], 1u); break; } } } } while (0)

struct XcdBarrier {
    unsigned* bar; unsigned x;
    volatile LAS unsigned* st;
};

__device__ __forceinline__ XcdBarrier xcd_barrier_post(unsigned* bar, volatile LAS unsigned* st) {
    XcdBarrier b; b.bar = bar; b.x = xb_xcc_id(); b.st = st;
    if (threadIdx.x == 0) (void)xb_add(&bar[XB_XCNT(b.x)], 1u);
    return b;
}
__device__ __forceinline__ void xcd_barrier_complete(unsigned* bar, unsigned x, unsigned& nloc, unsigned& nx) {
    const unsigned G = gridDim.x * gridDim.y * gridDim.z;
    unsigned sum, cnt, mine, sp = 0u;
    for (;;) {
        sum = 0u; cnt = 0u; mine = 0u;
#pragma unroll
        for (unsigned j = 0; j < 16; ++j) { const unsigned c = xb_ld(&bar[XB_XCNT(j)]); sum += c; cnt += (c > 0u) ? 1u : 0u; mine = (j == x) ? c : mine; }
        if (sum == G) break;
        __builtin_amdgcn_s_sleep(1);
        if ((++sp & 255u) == 0u) { if (xb_ld(&bar[XB_TMO])) break; if (sp > XB_SPIN_CAP) { atomicAdd(&bar[XB_TMO], 1u); break; } }
    }
    nloc = mine > 0u ? mine : 1u; nx = cnt > 0u ? cnt : 1u;
}

__device__ __forceinline__ void xcd_barrier(const XcdBarrier& b) {
    asm volatile("s_waitcnt vmcnt(0)" ::: "memory");
    __syncthreads();
    if (threadIdx.x == 0) {
        unsigned* bar = b.bar;
        __builtin_amdgcn_s_waitcnt(0);
        unsigned nloc = b.st[0], nx = b.st[1];
        if (nloc == 0u) { xcd_barrier_complete(bar, b.x, nloc, nx); b.st[0] = nloc; b.st[1] = nx; }
        const unsigned old = xb_add(&bar[XB_XSUB(b.x)], 1u);
        const unsigned gen = old / nloc;
        if (old + 1u == (gen + 1u) * nloc) {
            __builtin_amdgcn_fence(__ATOMIC_RELEASE, "agent");
            asm volatile("s_waitcnt vmcnt(0)" ::: "memory");
            const unsigned og = xb_add(&bar[XB_TOP], 1u);
            const unsigned tg = og / nx;
            if (og + 1u == (tg + 1u) * nx) xb_add(&bar[XB_TOPGEN], 1u);
            else XB_SPIN(xb_ld(&bar[XB_TOPGEN]) == tg, bar);
            __builtin_amdgcn_fence(__ATOMIC_ACQUIRE, "agent");
            xb_add(&bar[XB_XGEN(b.x)], 1u);
            asm volatile("s_waitcnt vmcnt(0)" ::: "memory");
        } else {
            XB_SPIN(xb_ld(&bar[XB_XGEN(b.x)]) == gen, bar);
            __builtin_amdgcn_fence(__ATOMIC_ACQUIRE, "agent");
            asm volatile("s_waitcnt vmcnt(0)" ::: "memory");
        }
    }
    __syncthreads();
}


typedef const float* const __attribute__((address_space(4))) * karg_fpp;
#define INP(i) (((karg_fpp)__builtin_amdgcn_kernarg_segment_ptr())[i])
#define OUTP() ((float*)(((karg_fpp)__builtin_amdgcn_kernarg_segment_ptr())[20]))
#define WSB() ((unsigned char*)(((karg_fpp)__builtin_amdgcn_kernarg_segment_ptr())[21]))
#define WSP(type, off) ((type*)(WSB() + (off)))
#define CTLP() ((gu32*)(WSB() + WS_CTL))
struct Frame {
    LAS unsigned char* lds;
    int wave, vcu, G;
};
__device__ __forceinline__ int lane_id_now() { int l; asm volatile("v_mbcnt_lo_u32_b32 %0, -1, 0\n\tv_mbcnt_hi_u32_b32 %0, -1, %0" : "=v"(l)); return l; }
#define LANE() lane_id_now()
#define TID() (F.wave * 64 + LANE())

__device__ __forceinline__ float wave_sum(float v) {
#pragma unroll
    for (int o = 1; o < 64; o <<= 1) v += __shfl_xor(v, o);
    return v;
}

__device__ __forceinline__ int ucol_of_src(int n) {
    if (n < 5120) return n;
    if (n < 5152) return n - 5120 + UC_DT;
    if (n < 11296) return n - 5152 + UC_Q;
    if (n < 11808) return n - 11296 + UC_QI;
    if (n < 11872) return n - 11808 + UC_KI;
    if (n < 11880) return n - 11872 + UC_WI;
    return n - 11880 + UC_GS;
}
struct RmId { __device__ __forceinline__ int operator()(int n) const { return n; } };
struct RmIn { __device__ __forceinline__ int operator()(int n) const { return ucol_of_src(n); } };
struct RmW1 { __device__ __forceinline__ int operator()(int n) const { const int m = n & 2047; return ((m >> 7) << 8) + ((n >> 11) << 7) + (m & 127); } };
template <class RowMap>
__device__ __forceinline__ void transpose_item(const float* W, int K, int N, bf16* WT, const RowMap rm, const float* kscale, int item, int lane) {
    const int nblk = (N + 63) >> 6, kb = item / nblk, nb = item - kb * nblk, k0 = 64 * kb, n0 = 64 * nb;
    const int g = lane >> 4, nq = lane & 15, n = n0 + 4 * nq; const bool nok = n < N;
    const float* src = W + (size_t)(k0 + 8 * g) * N + n;
    f32x4 v[2][8];
#pragma unroll
    for (int p = 0; p < 2; ++p)
#pragma unroll
        for (int i = 0; i < 8; ++i) v[p][i] = nok ? *(const f32x4*)(src + (size_t)(32 * p + i) * N) : (f32x4){0.f, 0.f, 0.f, 0.f};
    if (kscale) {
#pragma unroll
        for (int p = 0; p < 2; ++p) { const f32x4 s0 = *(const f32x4*)(kscale + k0 + 32 * p + 8 * g), s1 = *(const f32x4*)(kscale + k0 + 32 * p + 8 * g + 4);
            v[p][0] = v[p][0] * s0.x; v[p][1] = v[p][1] * s0.y; v[p][2] = v[p][2] * s0.z; v[p][3] = v[p][3] * s0.w; v[p][4] = v[p][4] * s1.x; v[p][5] = v[p][5] * s1.y; v[p][6] = v[p][6] * s1.z; v[p][7] = v[p][7] * s1.w; } }
    if (nok) {
#pragma unroll
        for (int j = 0; j < 4; ++j) { bf16* dst = WT + (size_t)rm(n + j) * K + k0 + 8 * g;
#pragma unroll
            for (int p = 0; p < 2; ++p) { v4u o; o.x = pk2(v[p][0][j], v[p][1][j]); o.y = pk2(v[p][2][j], v[p][3][j]); o.z = pk2(v[p][4][j], v[p][5][j]); o.w = pk2(v[p][6][j], v[p][7][j]);
                *(v4u*)(dst + 32 * p) = o; } } }
}
template <class RowMap>
__device__ __forceinline__ void transpose_item8(const float* W, int K, int N, unsigned char* WT, const RowMap rm, int item, int lane) {
    const int nblk = N >> 5, kb = item / nblk, nb = item - kb * nblk, k0 = 128 * kb, n0 = 32 * nb;
    const int g = lane >> 3, nq = lane & 7, n = n0 + 4 * nq;
    const float* src = W + (size_t)(k0 + 16 * g) * N + n;
    f32x4 v[16];
#pragma unroll
    for (int i = 0; i < 16; ++i) v[i] = *(const f32x4*)(src + (size_t)i * N);
#pragma unroll
    for (int j = 0; j < 4; ++j) { v4u o;
        o.x = pg8::pk4_fp8(v[0][j] * pg8::F8_SW, v[1][j] * pg8::F8_SW, v[2][j] * pg8::F8_SW, v[3][j] * pg8::F8_SW); o.y = pg8::pk4_fp8(v[4][j] * pg8::F8_SW, v[5][j] * pg8::F8_SW, v[6][j] * pg8::F8_SW, v[7][j] * pg8::F8_SW);
        o.z = pg8::pk4_fp8(v[8][j] * pg8::F8_SW, v[9][j] * pg8::F8_SW, v[10][j] * pg8::F8_SW, v[11][j] * pg8::F8_SW); o.w = pg8::pk4_fp8(v[12][j] * pg8::F8_SW, v[13][j] * pg8::F8_SW, v[14][j] * pg8::F8_SW, v[15][j] * pg8::F8_SW);
        *(v4u*)(WT + (size_t)rm(n + j) * K + k0 + 16 * g) = o; }
}
__device__ __forceinline__ void rms_row_to_bf16(const float* xrow, const float* w, bf16* orow, int lane) {
    const f32x4* xr = (const f32x4*)xrow + lane;
    f32x4 v[8], wq[8]; float s = 0.f;
#pragma unroll
    for (int j = 0; j < 8; ++j) v[j] = xr[64 * j];
#pragma unroll
    for (int j = 0; j < 8; ++j) wq[j] = ((const f32x4*)w)[lane + 64 * j];
    __builtin_amdgcn_sched_barrier(0);
#pragma unroll
    for (int j = 0; j < 8; ++j) s += (v[j].x * v[j].x + v[j].y * v[j].y) + (v[j].z * v[j].z + v[j].w * v[j].w);
    const float rstd = 1.f / sqrtf(wave_sum(s) * (1.f / DM) + EPS);
    v2u* o8 = (v2u*)orow + lane;
#pragma unroll
    for (int j = 0; j < 8; ++j) { const f32x4 wv = wq[j]; v2u o; o.x = pk2(v[j].x * rstd * wv.x, v[j].y * rstd * wv.y); o.y = pk2(v[j].z * rstd * wv.z, v[j].w * rstd * wv.w); o8[64 * j] = o; }
}
__device__ __forceinline__ void p0_prologue(Frame& F) {
    const int gw = F.vcu * NWAVES + F.wave, NGW = F.G * NWAVES;
    constexpr int I_IN = 32 * 250, I_SQ = 32 * 32, I_W1 = 16 * 128, I_W2 = 16 * 64;
    constexpr int NITEMS = I_IN + 3 * I_SQ + NEXP * I_W1 + NEXP * I_W2;
    for (int it = gw; it < NITEMS; it += NGW) {
        int r = it;
        if (r < I_IN) { transpose_item(INP(1), DM, NIN, WSP(bf16, WS_WIN), RmIn(), nullptr, r, LANE()); continue; } r -= I_IN;
        if (r < I_SQ) { transpose_item(INP(8), DM, DM, WSP(bf16, WS_WSSD), RmId(), INP(7), r, LANE()); continue; } r -= I_SQ;
        if (r < I_SQ) { transpose_item(INP(9), DM, DM, WSP(bf16, WS_WATT), RmId(), nullptr, r, LANE()); continue; } r -= I_SQ;
        if (r < I_SQ) { transpose_item(INP(10), DM, DM, WSP(bf16, WS_WOUT), RmId(), nullptr, r, LANE()); continue; } r -= I_SQ;
        if (r < NEXP * I_W1) { const int e = r / I_W1; transpose_item8(INP(15) + (size_t)e * DM * 4096, DM, 4096, WSP(unsigned char, WS_W1) + (size_t)e * 4096 * DM, RmW1(), r - e * I_W1, LANE()); continue; } r -= NEXP * I_W1;
        { const int e = r / I_W2; transpose_item8(INP(17) + (size_t)e * DM * DM, DM, DM, WSP(unsigned char, WS_W2) + (size_t)e * DM * DM, RmId(), r - e * I_W2, LANE()); }
    }
    { const int gt = F.vcu * (NWAVES * 64) + TID(), NT = F.G * NWAVES * 64; v4u z = {0u, 0u, 0u, 0u};
      for (int i = gt; i < (NU - UC_END) * DM / 8; i += NT) ((v4u*)(WSP(bf16, WS_WIN) + (size_t)UC_END * DM))[i] = z;
      for (int i = gt; i < NEXP * DM; i += NT) { const int e = i >> 11, k = i & 2047; WSP(float, WS_RWT)[i] = INP(13)[(size_t)k * NEXP + e]; } }
    for (int pos = gw; pos < SEQ; pos += NGW) { const int f = LANE(); float cs = 0.f, sn = 0.f;
        if (f < 24) { const float inv = f < 16 ? powf(500000.0f, -(float)f * (1.0f / 16.0f)) : powf(500000.0f, -(float)(f - 16) * (1.0f / 8.0f)); sincosf((float)pos * inv, &sn, &cs); }
        if (f < 32) { float* dst = WSP(float, WS_ROPE) + ((size_t)pos * 32 + f) * 2; dst[0] = cs; dst[1] = sn; } }
    for (int m = gw; m < T; m += NGW) rms_row_to_bf16(INP(0) + (size_t)m * DM, INP(11), WSP(bf16, WS_XN) + (size_t)m * DM, LANE());
}

__device__ __forceinline__ float softplusf(float x) { return x > 20.f ? x : log1pf(expf(x)); }
__device__ __forceinline__ void p2_prep(Frame& F) {
    const int gt = F.vcu * (NWAVES * 64) + TID(), NT = F.G * NWAVES * 64;
    const int gw = F.vcu * NWAVES + F.wave, NGW = F.G * NWAVES, lane = LANE();
    for (int it = gt; it < (T / 16) * 384; it += NT) {
        const int ch = it % 384, seg = it / 384, t0 = seg * 16, c0 = ch * 8;
        float w[4][8], cb[8], h0[8], h1[8], h2[8];
#pragma unroll
        for (int j = 0; j < 4; ++j) { const f32x4 a = *(const f32x4*)(INP(2) + j * 3072 + c0), b = *(const f32x4*)(INP(2) + j * 3072 + c0 + 4);
            w[j][0] = a.x; w[j][1] = a.y; w[j][2] = a.z; w[j][3] = a.w; w[j][4] = b.x; w[j][5] = b.y; w[j][6] = b.z; w[j][7] = b.w; }
        { const f32x4 a = *(const f32x4*)(INP(3) + c0), b = *(const f32x4*)(INP(3) + c0 + 4); cb[0] = a.x; cb[1] = a.y; cb[2] = a.z; cb[3] = a.w; cb[4] = b.x; cb[5] = b.y; cb[6] = b.z; cb[7] = b.w; }
        const bool first = (t0 % SEQ) == 0;
        const bf16* src = WSP(bf16, WS_U) + (size_t)t0 * NU + UC_XBC + c0;
        v4u r0 = {0u, 0u, 0u, 0u}, r1 = r0, r2 = r0;
        if (!first) { r0 = *(const v4u*)(src - 3 * (size_t)NU); r1 = *(const v4u*)(src - 2 * (size_t)NU); r2 = *(const v4u*)(src - (size_t)NU); }
#define UNPK(dst, r) do { dst[0] = bflo(r.x); dst[1] = bfhi(r.x); dst[2] = bflo(r.y); dst[3] = bfhi(r.y); dst[4] = bflo(r.z); dst[5] = bfhi(r.z); dst[6] = bflo(r.w); dst[7] = bfhi(r.w); } while (0)
        UNPK(h0, r0); UNPK(h1, r1); UNPK(h2, r2);
        bf16* dst = WSP(bf16, WS_XBC) + (size_t)t0 * 3072 + c0;
        v4u rcs[16];
#pragma unroll
        for (int t = 0; t < 16; ++t) rcs[t] = *(const v4u*)(src + (size_t)t * NU);
        __builtin_amdgcn_sched_barrier(0);
#pragma unroll
        for (int t = 0; t < 16; ++t) {
            const v4u rc = rcs[t]; float cur[8], o[8]; UNPK(cur, rc);
#pragma unroll
            for (int i = 0; i < 8; ++i) { const float a = cb[i] + w[0][i] * h0[i] + w[1][i] * h1[i] + w[2][i] * h2[i] + w[3][i] * cur[i]; o[i] = siluf(a); h0[i] = h1[i]; h1[i] = h2[i]; h2[i] = cur[i]; }
            v4u ov; ov.x = pk2(o[0], o[1]); ov.y = pk2(o[2], o[3]); ov.z = pk2(o[4], o[5]); ov.w = pk2(o[6], o[7]);
            *(v4u*)(dst + (size_t)t * 3072) = ov;
        }
#undef UNPK
    }
    for (int ch = gw; ch < (T / 128) * 32; ch += NGW) {
        const int h = ch & 31, ck = ch >> 5; const float bias = INP(4)[h], a = -expf(INP(5)[h]);
        const size_t t0 = (size_t)ck * 128 + 2 * lane;
        const float d0 = softplusf(bf2f(WSP(bf16, WS_U)[t0 * NU + UC_DT + h]) + bias), d1 = softplusf(bf2f(WSP(bf16, WS_U)[(t0 + 1) * NU + UC_DT + h]) + bias);
        const float a0 = d0 * a, a1 = a0 + d1 * a;
        float run = a1;
#pragma unroll
        for (int o = 1; o < 64; o <<= 1) { const float up = __shfl_up(run, o); if (lane >= o) run += up; }
        const float excl = run - a1;
        WSP(float, WS_DT)[t0 * 32 + h] = d0; WSP(float, WS_DT)[(t0 + 1) * 32 + h] = d1;
        WSP(float, WS_DACS)[t0 * 32 + h] = excl + a0; WSP(float, WS_DACS)[(t0 + 1) * 32 + h] = excl + a1;
    }
    for (int t = gw; t < T; t += NGW) {
        const int pos = t % SEQ;
        const bf16* row = WSP(bf16, WS_U) + (size_t)t * NU;
        const f32x4* rtp = (const f32x4*)(WSP(float, WS_ROPE) + (size_t)pos * 64);
        v4u aq[2][4]; f32x4 rt[12];
#pragma unroll
        for (int wk = 0; wk < 2; ++wk) { const v4u* src = (const v4u*)(row + (wk ? UC_K : UC_Q) + 32 * lane);
#pragma unroll
            for (int j = 0; j < 4; ++j) aq[wk][j] = src[j]; }
        const int part = lane & 7;
        const v4u mq = *(const v4u*)(row + UC_QI + 8 * lane), mk = *(const v4u*)(row + UC_KI + 8 * part);
#pragma unroll
        for (int j = 0; j < 12; ++j) rt[j] = rtp[j];
        __builtin_amdgcn_sched_barrier(0);
#define R16(i) rt[(i) >> 2][(i) & 3]
#define R8(i) rt[8 + ((i) >> 2)][(i) & 3]
#pragma unroll
        for (int wk = 0; wk < 2; ++wk) {
            v4u a[4];
#pragma unroll
            for (int j = 0; j < 4; ++j) a[j] = aq[wk][j];
            if ((lane & 3) == 0) { float x[32];
#pragma unroll
                for (int j = 0; j < 4; ++j) { x[8 * j] = bflo(a[j].x); x[8 * j + 1] = bfhi(a[j].x); x[8 * j + 2] = bflo(a[j].y); x[8 * j + 3] = bfhi(a[j].y); x[8 * j + 4] = bflo(a[j].z); x[8 * j + 5] = bfhi(a[j].z); x[8 * j + 6] = bflo(a[j].w); x[8 * j + 7] = bfhi(a[j].w); }
                float o[32];
#pragma unroll
                for (int i = 0; i < 16; ++i) { const float cs = R16(2 * i), sn = R16(2 * i + 1); o[i] = x[i] * cs - x[16 + i] * sn; o[16 + i] = x[16 + i] * cs + x[i] * sn; }
#pragma unroll
                for (int j = 0; j < 4; ++j) { a[j].x = pk2(o[8 * j], o[8 * j + 1]); a[j].y = pk2(o[8 * j + 2], o[8 * j + 3]); a[j].z = pk2(o[8 * j + 4], o[8 * j + 5]); a[j].w = pk2(o[8 * j + 6], o[8 * j + 7]); } }
            v4u* dst = (v4u*)(WSP(bf16, wk ? WS_KR : WS_QR) + (size_t)t * DM + 32 * lane);
#pragma unroll
            for (int j = 0; j < 4; ++j) dst[j] = a[j];
        }
#pragma unroll
        for (int wk = 0; wk < 2; ++wk) {
            const v4u m = wk ? mk : mq;
            v4u pn; pn.x = __shfl_xor(m.x, 1); pn.y = __shfl_xor(m.y, 1); pn.z = __shfl_xor(m.z, 1); pn.w = __shfl_xor(m.w, 1);
            v4u o = m;
            if (part < 2) { float a[8], b[8], r[8];
                a[0] = bflo(m.x); a[1] = bfhi(m.x); a[2] = bflo(m.y); a[3] = bfhi(m.y); a[4] = bflo(m.z); a[5] = bfhi(m.z); a[6] = bflo(m.w); a[7] = bfhi(m.w);
                b[0] = bflo(pn.x); b[1] = bfhi(pn.x); b[2] = bflo(pn.y); b[3] = bfhi(pn.y); b[4] = bflo(pn.z); b[5] = bfhi(pn.z); b[6] = bflo(pn.w); b[7] = bfhi(pn.w);
#pragma unroll
                for (int i = 0; i < 8; ++i) { const float cs = R8(2 * i), sn = R8(2 * i + 1); r[i] = part == 0 ? a[i] * cs - b[i] * sn : a[i] * cs + b[i] * sn; }
                o.x = pk2(r[0], r[1]); o.y = pk2(r[2], r[3]); o.z = pk2(r[4], r[5]); o.w = pk2(r[6], r[7]); }
            if (wk == 0) *(v4u*)(WSP(bf16, WS_QIR) + (size_t)t * 512 + 8 * lane) = o;
            else if (lane < 8) *(v4u*)(WSP(bf16, WS_KIR) + (size_t)t * 64 + 8 * lane) = o;
        }
#undef R16
#undef R8
    }
}

__device__ __forceinline__ int crow16(int r, int hi) { return (r & 3) + 8 * (r >> 2) + 4 * hi; }
__device__ __forceinline__ bf16x8 lds_b128(const LAS unsigned char* p) { return *(const LAS bf16x8*)p; }
__device__ __forceinline__ bf16x8 lds_tr8(const LAS unsigned char* p, int rowstep4) {
    typedef short v4i16_t __attribute__((ext_vector_type(4)));
    const v4i16_t a = __builtin_amdgcn_ds_read_tr16_b64_v4i16((LAS v4i16_t*)p);
    const v4i16_t b = __builtin_amdgcn_ds_read_tr16_b64_v4i16((LAS v4i16_t*)(p + rowstep4));
    return (bf16x8){a[0], a[1], a[2], a[3], b[0], b[1], b[2], b[3]};
}
constexpr int SP_C = 272, SP_X = 144;
constexpr int S_CS = 0, S_BS = 34816, S_XS = 69632, S_XW = 88064, S_VEC = 106496, S_YS = 107520;
struct P3R { v4u b[4], c[4], x[2]; float dtr[2], dar[2], da_last, dac1, dt1; };
__device__ __forceinline__ void p3_load(P3R& R, int u, int tid) {
    const int h = u & 31, bc = u >> 5, g = h >> 3; const size_t t0 = (size_t)bc * 128;
    R.da_last = WSP(float, WS_DACS)[(t0 + 127) * 32 + h];
#pragma unroll
    for (int i = 0; i < 4; ++i) { const int idx = tid + 512 * i, row = idx >> 4, ch = idx & 15; const bf16* src = WSP(bf16, WS_XBC) + (t0 + row) * 3072 + 2048 + g * 128 + ch * 8;
        R.b[i] = *(const v4u*)src; R.c[i] = *(const v4u*)(src + 512); }
#pragma unroll
    for (int i = 0; i < 2; ++i) { const int idx = tid + 512 * i, row = idx >> 3, ch = idx & 7; R.x[i] = *(const v4u*)(WSP(bf16, WS_XBC) + (t0 + row) * 3072 + h * 64 + ch * 8);
        R.dtr[i] = WSP(float, WS_DT)[(t0 + row) * 32 + h]; R.dar[i] = WSP(float, WS_DACS)[(t0 + row) * 32 + h]; }
    R.dac1 = WSP(float, WS_DACS)[(t0 + (tid & 127)) * 32 + h]; R.dt1 = WSP(float, WS_DT)[(t0 + (tid & 127)) * 32 + h];
}
__device__ __forceinline__ void p3_ssd_unit(Frame& F, int u, int un, P3R& R) {
    const int tid = TID(), lane = LANE(), w = F.wave, r32 = lane & 31, hh = lane >> 5;
    const int h = u & 31, bc = u >> 5; const size_t t0 = (size_t)bc * 128;
    LAS unsigned char* L = F.lds + RING_OFF;
    LAS float* dacs = (LAS float*)(L + S_VEC); LAS float* dtv = dacs + 128;
#pragma unroll
    for (int i = 0; i < 4; ++i) { const int idx = tid + 512 * i, row = idx >> 4, ch = idx & 15;
        *(LAS v4u*)(L + S_BS + row * SP_C + ch * 16) = R.b[i]; *(LAS v4u*)(L + S_CS + row * SP_C + ch * 16) = R.c[i]; }
#pragma unroll
    for (int i = 0; i < 2; ++i) { const int idx = tid + 512 * i, row = idx >> 3, ch = idx & 7; const v4u xv = R.x[i];
        const float wl = R.dtr[i] * __expf(R.da_last - R.dar[i]);
        *(LAS v4u*)(L + S_XS + row * SP_X + ch * 16) = xv;
        v4u xw; xw.x = pk2(bflo(xv.x) * wl, bfhi(xv.x) * wl); xw.y = pk2(bflo(xv.y) * wl, bfhi(xv.y) * wl); xw.z = pk2(bflo(xv.z) * wl, bfhi(xv.z) * wl); xw.w = pk2(bflo(xv.w) * wl, bfhi(xv.w) * wl);
        *(LAS v4u*)(L + S_XW + row * SP_X + ch * 16) = xw; }
    if (tid < 128) { dacs[tid] = R.dac1; dtv[tid] = R.dt1; }
    __syncthreads();
    p3_load(R, un, tid);
    __builtin_amdgcn_sched_barrier(0);
    const int li = w >> 1;
    f32x16 acc0 = {}, acc1 = {};
    { const int j0 = (w & 1) * 2;
      const LAS unsigned char* cp = L + S_CS + (32 * li + r32) * SP_C + hh * 16;
      if (j0 <= li) { const LAS unsigned char* bp = L + S_BS + (32 * j0 + r32) * SP_C + hh * 16;
#pragma unroll
          for (int ks = 0; ks < 8; ++ks) acc0 = __builtin_amdgcn_mfma_f32_32x32x16_bf16(lds_b128(bp + ks * 32), lds_b128(cp + ks * 32), acc0, 0, 0, 0); }
      if (j0 + 1 <= li) { const LAS unsigned char* bp = L + S_BS + (32 * (j0 + 1) + r32) * SP_C + hh * 16;
#pragma unroll
          for (int ks = 0; ks < 8; ++ks) acc1 = __builtin_amdgcn_mfma_f32_32x32x16_bf16(lds_b128(bp + ks * 32), lds_b128(cp + ks * 32), acc1, 0, 0, 0); } }
    __syncthreads();
    { const int j0 = (w & 1) * 2, l = 32 * li + r32; const float dl = dacs[l];
#pragma unroll
      for (int jj = 0; jj < 2; ++jj) { const int sj = j0 + jj; if (sj <= li) {
#pragma unroll
          for (int q = 0; q < 4; ++q) { float gv[4];
#pragma unroll
              for (int e = 0; e < 4; ++e) { const int s = 32 * sj + 8 * q + 4 * hh + e; const float a = jj ? acc1[4 * q + e] : acc0[4 * q + e];
                  gv[e] = (s <= l) ? a * __expf(dl - dacs[s]) * dtv[s] : 0.f; }
              v2u o; o.x = pk2(gv[0], gv[1]); o.y = pk2(gv[2], gv[3]);
              *(LAS v2u*)(L + S_CS + l * SP_C + (32 * sj + 8 * q + 4 * hh) * 2) = o; } } } }
    __syncthreads();
    { const int pb = w & 1; f32x16 acc = {};
      const LAS unsigned char* gp = L + S_CS + (32 * li + r32) * SP_C + hh * 16;
      const LAS unsigned char* xp = L + S_XS + (8 * hh + ((lane & 15) >> 2)) * SP_X + (32 * pb + 16 * ((lane >> 4) & 1) + 4 * (lane & 3)) * 2;
      for (int ks = 0; ks < 2 * (li + 1); ++ks) acc = __builtin_amdgcn_mfma_f32_32x32x16_bf16(lds_b128(gp + ks * 32), lds_tr8(xp + ks * 16 * SP_X, 4 * SP_X), acc, 0, 0, 0);
      LAS bf16* ys = (LAS bf16*)(L + S_YS);
#pragma unroll
      for (int r = 0; r < 16; ++r) ys[(32 * li + crow16(r, hh)) * 72 + 32 * pb + r32] = (bf16)f2bf(acc[r]); }
    { const int pb = w >> 2, nb = w & 3; f32x16 acc = {};
      const int trow = 8 * hh + ((lane & 15) >> 2), tcol = 16 * ((lane >> 4) & 1) + 4 * (lane & 3);
      const LAS unsigned char* ap = L + S_XW + trow * SP_X + (32 * pb + tcol) * 2;
      const LAS unsigned char* bp = L + S_BS + trow * SP_C + (32 * nb + tcol) * 2;
#pragma unroll
      for (int ks = 0; ks < 8; ++ks) acc = __builtin_amdgcn_mfma_f32_32x32x16_bf16(lds_tr8(ap + ks * 16 * SP_X, 4 * SP_X), lds_tr8(bp + ks * 16 * SP_C, 4 * SP_C), acc, 0, 0, 0);
      float* st = WSP(float, WS_STATES) + ((size_t)u * 64 + 32 * pb) * 128 + 32 * nb + r32;
#pragma unroll
      for (int r = 0; r < 16; ++r) st[(size_t)crow16(r, hh) * 128] = acc[r]; }
    __syncthreads();
#pragma unroll
    for (int i = 0; i < 2; ++i) { const int idx = tid + 512 * i, l = idx >> 3, c8 = (idx & 7) * 8;
        *(v4u*)(WSP(bf16, WS_YD) + (t0 + l) * 2048 + h * 64 + c8) = *(const LAS v4u*)(L + S_YS + (l * 72 + c8) * 2); }
    __syncthreads();
}
constexpr int IX_Q = 0, IX_W = 32768;
__device__ __forceinline__ void p3_index_group(Frame& F, int b, int qg) {
    const int tid = TID(), lane = LANE(), r32 = lane & 31, hh = lane >> 5;
    LAS unsigned char* L = F.lds + RING_OFF; LAS float* wl = (LAS float*)(L + IX_W);
    const bf16* Ub = WSP(bf16, WS_U) + ((size_t)b * SEQ) * NU;
#pragma unroll
    for (int i = 0; i < 4; ++i) { const int pc = tid + 512 * i, ln = pc & 63, ks = (pc >> 6) & 3, h8 = pc >> 8;
        *(LAS v4u*)(L + IX_Q + pc * 16) = *(const v4u*)(WSP(bf16, WS_QIR) + ((size_t)b * SEQ + qg * 32 + (ln & 31)) * 512 + h8 * 64 + ks * 16 + 8 * (ln >> 5)); }
    if (tid < 256) { const int h8 = tid >> 5, q = tid & 31; wl[tid] = bf2f(Ub[(size_t)(qg * 32 + q) * NU + UC_WI + h8]) * 0.044194173824159216f; }
    __syncthreads();
    float wq[8];
#pragma unroll
    for (int h8 = 0; h8 < 8; ++h8) wq[h8] = wl[h8 * 32 + r32];
    bf16x8 kf[4];
    { const int k0 = F.wave <= qg ? F.wave : qg; const bf16* krow = WSP(bf16, WS_KIR) + ((size_t)b * SEQ + k0 * 32 + r32) * 64 + 8 * hh;
#pragma unroll
        for (int ks = 0; ks < 4; ++ks) kf[ks] = *(const bf16x8*)(krow + ks * 16); }
    for (int kt = F.wave; kt <= qg; kt += NWAVES) {
        bf16x8 kn[4];
        { const int k1 = kt + NWAVES <= qg ? kt + NWAVES : qg;
          const bf16* krow = WSP(bf16, WS_KIR) + ((size_t)b * SEQ + k1 * 32 + r32) * 64 + 8 * hh;
#pragma unroll
          for (int ks = 0; ks < 4; ++ks) kn[ks] = *(const bf16x8*)(krow + ks * 16); }
        __builtin_amdgcn_sched_barrier(0);
        f32x16 sc = {};
        int qoff = lane * 16; asm volatile("" : "+v"(qoff));
#pragma unroll
        for (int h8 = 0; h8 < 8; ++h8) { f32x16 a = {};
#pragma unroll
            for (int ks = 0; ks < 4; ++ks) a = __builtin_amdgcn_mfma_f32_32x32x16_bf16(kf[ks], lds_b128(L + IX_Q + (h8 * 4 + ks) * 1024 + qoff), a, 0, 0, 0);
#pragma unroll
            NANCHK((a[0] != a[0]) || (a[5] != a[5]) || (a[10] != a[10]) || (a[15] != a[15]) || (wq[h8] != wq[h8]), 1);
            for (int e = 0; e < 16; ++e) sc[e] += wq[h8] * fmaxf(a[e], 0.f); }
        float* srow = WSP(float, WS_S) + ((size_t)b * SEQ + qg * 32 + r32) * SEQ + kt * 32 + 4 * hh;
#pragma unroll
        for (int q = 0; q < 4; ++q) *(f32x4*)(srow + 8 * q) = (f32x4){sc[4 * q], sc[4 * q + 1], sc[4 * q + 2], sc[4 * q + 3]};
#pragma unroll
        for (int ks = 0; ks < 4; ++ks) kf[ks] = kn[ks];
    }
    __syncthreads();
}
__device__ __forceinline__ void p3_phase(Frame& F) {
    const bool idx_first = (PHASE_SWAP) && (((blockIdx.x >> 3) & 1) != 0);
#pragma nounroll
    for (int pass = 0; pass < 2; ++pass) {
        if ((pass == 0) != idx_first) {
#ifndef NO_P3A
    { constexpr int NUN = 2 * 64 * 32; int u = F.vcu;
      if (u < NUN) { P3R R; p3_load(R, u, TID());
#pragma nounroll
          for (; u < NUN; u += F.G) p3_ssd_unit(F, u, u + F.G < NUN ? u + F.G : u, R); } }
#endif
        } else {
#if !defined(NO_P3B) && !defined(NO_ATTN)
    for (int it = F.vcu; it < 256; it += F.G) { const int b = it >> 7, x = it & 127; p3_index_group(F, b, x); p3_index_group(F, b, 255 - x); }
#endif
        }
    }
}

__device__ __forceinline__ unsigned fkey(float v) { NANCHK(v != v, 0); const unsigned u = __float_as_uint(v + 0.0f);
    return u ^ ((unsigned)((int)u >> 31) | 0x80000000u); }
__device__ __forceinline__ void sacc(int& c, int v) { asm volatile("s_add_i32 %0, %0, %1" : "+s"(c) : "s"(v) : "scc"); }
__device__ __forceinline__ int wave_sum_i(int v) {
    v += __builtin_amdgcn_update_dpp(0, v, 0xB1, 0xf, 0xf, false);
    v += __builtin_amdgcn_update_dpp(0, v, 0x4E, 0xf, 0xf, false);
    v += __builtin_amdgcn_update_dpp(0, v, 0x141, 0xf, 0xf, false);
    v += __builtin_amdgcn_update_dpp(0, v, 0x140, 0xf, 0xf, false);
    return __builtin_amdgcn_readlane(v, 0) + __builtin_amdgcn_readlane(v, 16) + __builtin_amdgcn_readlane(v, 32) + __builtin_amdgcn_readlane(v, 48);
}
__device__ __forceinline__ void cnt4(int (&c)[4], unsigned k0, unsigned k1, unsigned k2, unsigned k3, unsigned mid) {
    unsigned long long t0, t1, t2, t3;
    asm("v_cmp_ge_u32_e64 %4, %8, %12\n\tv_cmp_ge_u32_e64 %5, %9, %12\n\tv_cmp_ge_u32_e64 %6, %10, %12\n\tv_cmp_ge_u32_e64 %7, %11, %12\n\t"
        "v_addc_co_u32_e64 %0, %4, 0, %0, %4\n\tv_addc_co_u32_e64 %1, %5, 0, %1, %5\n\tv_addc_co_u32_e64 %2, %6, 0, %2, %6\n\tv_addc_co_u32_e64 %3, %7, 0, %3, %7"
        : "+v"(c[0]), "+v"(c[1]), "+v"(c[2]), "+v"(c[3]), "=&s"(t0), "=&s"(t1), "=&s"(t2), "=&s"(t3) : "v"(k0), "v"(k1), "v"(k2), "v"(k3), "v"(mid));
}
template <int NR, int NL>
__device__ __forceinline__ void select_row(float (&raw)[64], const float* Srow, int pos, unsigned long long* Mq, int ntw, int lane, LAS unsigned* lk, LAS unsigned long long* lw, bool okn, int qn) {
    const int ni = (pos >> 6) + 1;
    unsigned key[NR];
    int ln = lane; asm volatile("" : "+v"(ln));
    unsigned kmax = 0u;
#ifdef DOUBLE_CONV
#pragma nounroll
    for (int rep_ = 0; rep_ < 2; ++rep_) { asm volatile("" : "+v"(ln)); kmax = 0u;
#endif
#pragma unroll
    for (int i = 0; i < NR; ++i) { key[i] = 0u; if (i < ni) { const int kidx = i * 64 + ln; key[i] = (kidx <= pos) ? fkey(raw[i]) : 0u; kmax = key[i] > kmax ? key[i] : kmax; } if ((i & 31) == 31) __builtin_amdgcn_sched_barrier(0); }
#pragma unroll
    for (int i = 0; i < NL; ++i) if (NR + i < ni) raw[i] = Srow[(NR + i) * 64 + ln];
    __builtin_amdgcn_sched_barrier(0);
#pragma unroll
    for (int i = 0; i < NL; ++i) { unsigned k = 0u; if (NR + i < ni) { const int kidx = (NR + i) * 64 + ln; k = (kidx <= pos) ? fkey(raw[i]) : 0u; kmax = k > kmax ? k : kmax; } lk[i * 64 + lane] = k; if ((i & 31) == 31) __builtin_amdgcn_sched_barrier(0); }
#ifdef DOUBLE_CONV
    }
#endif
    if (okn) { const int pos_ = qn & (SEQ - 1); if (pos_ >= 256) { const int ni_ = (pos_ >> 6) + 1; const float* sr_ = WSP(float, WS_S) + (size_t)qn * SEQ + lane;
#pragma unroll
        for (int i = 0; i < 64; ++i) if (i < ni_) raw[i] = sr_[i * 64]; } }
#pragma unroll
    for (int o = 1; o < 64; o <<= 1) { const unsigned ok = (unsigned)__shfl_xor((int)kmax, o); kmax = ok > kmax ? ok : kmax; }
    unsigned lo, hi; int clo;
#ifdef DOUBLE_BISECT
#pragma nounroll
    for (int rep_ = 0; rep_ < DOUBLE_BISECT; ++rep_) { asm volatile("" : "+v"(kmax));
#endif
    lo = 0u; hi = kmax + 1u; clo = 0x7fffffff;
    float glo = 0.f, ghi = -256.f; int side = 0, it = 0; const bool okp = kmax > 0x82000000u; const unsigned p1 = kmax - 0x00800000u;
#pragma nounroll
    while (hi - lo > 1u) {
        const unsigned wd = hi - lo; unsigned mid = lo + (wd >> 1);
        if (okp && it == 0) mid = p1;
        else if (okp && it == 1 && hi == p1) mid = kmax - 0x01800000u;
        else if (clo != 0x7fffffff && (it & 7) != 7) { const float f = (glo + 0.5f) * __builtin_amdgcn_rcpf(glo - ghi); unsigned off = (unsigned)((float)wd * f); off = off < 1u ? 1u : off; off = off > wd - 1u ? wd - 1u : off; mid = lo + off; }
        ++it;
        int c4[4] = {0, 0, 0, 0};
#pragma unroll
        for (int i = 0; i < NR; i += 4) cnt4(c4, key[i], key[i + 1], key[i + 2], key[i + 3], mid);
#pragma unroll
        for (int i = 0; i < NL; i += 4) cnt4(c4, lk[i * 64 + lane], lk[(i + 1) * 64 + lane], lk[(i + 2) * 64 + lane], lk[(i + 3) * 64 + lane], mid);
        const int c = wave_sum_i((c4[0] + c4[1]) + (c4[2] + c4[3]));
        if (c >= 256) { lo = mid; clo = c; if (c == 256) break; glo = (float)(c - 256); if (side == 1) ghi *= 0.5f; side = 1; }
        else { hi = mid; ghi = (float)(c - 256); if (side == -1) glo *= 0.5f; side = -1; }
    }
#ifdef DOUBLE_BISECT
    }
#endif
#ifdef DOUBLE_FINAL
#pragma nounroll
    for (int rep_ = 0; rep_ < 2; ++rep_) { asm volatile("" : "+v"(lo));
#endif
    int need = 0x7fffffff;
    if (clo != 256) { int cl = 0;
#pragma unroll
        for (int i = 0; i < NR; ++i) cl += (key[i] > lo) ? 1 : 0;
#pragma unroll
        for (int i = 0; i < NL; ++i) cl += (lk[i * 64 + lane] > lo) ? 1 : 0;
        need = 256 - wave_sum_i(cl); }
    unsigned wl0 = 0u, wh0 = 0u, wl1 = 0u, wh1 = 0u; int ln2 = lane; asm volatile("" : "+v"(ln2));
#define PUT_WORD(i_, bal_) do { const bool me_ = ln2 == ((i_) & 63); if ((i_) < 64) { wl0 = me_ ? (unsigned)(bal_) : wl0; wh0 = me_ ? (unsigned)((bal_) >> 32) : wh0; } else { wl1 = me_ ? (unsigned)(bal_) : wl1; wh1 = me_ ? (unsigned)((bal_) >> 32) : wh1; } } while (0)
    if (clo == 256) {
#pragma unroll
        for (int i = 0; i < NR + NL; ++i) { const unsigned kv = i < NR ? key[i < NR ? i : 0] : lk[(i - NR) * 64 + lane];
            const unsigned long long bal = __ballot(kv >= lo); PUT_WORD(i, bal); __builtin_amdgcn_sched_barrier(0); }
    } else {
    int run = 0; unsigned lo2 = lo; asm volatile("" : "+v"(lo2));
#pragma unroll
    for (int i = 0; i < NR + NL; ++i) {
        const unsigned kv = i < NR ? key[i < NR ? i : 0] : lk[(i - NR) * 64 + lane];
        const bool eq = kv == lo2; const unsigned long long be = __ballot(eq);
        const int pre = run + __popcll(be & ((1ull << lane) - 1ull)); run += __popcll(be);
        const unsigned long long bal = __ballot((kv > lo2) || (eq && pre < need));
        PUT_WORD(i, bal);
        __builtin_amdgcn_sched_barrier(0);
    }
    }
#undef PUT_WORD
    if (lane < ntw && lane < NR + NL) Mq[(size_t)lane * SEQ] = ((unsigned long long)wh0 << 32) | wl0;
    if (NR + NL > 64 && lane + 64 < ntw) Mq[(size_t)(lane + 64) * SEQ] = ((unsigned long long)wh1 << 32) | wl1;
#ifdef DOUBLE_FINAL
    }
#endif
}
__device__ __forceinline__ void p4_scan(Frame& F) {
    const int gt = F.vcu * (NWAVES * 64) + TID(), NT = F.G * NWAVES * 64;
#ifdef DOUBLE_P4A
#pragma nounroll
    for (int rep_ = 0; rep_ < 2; ++rep_)
#endif
    for (int it = gt; it < 2 * 32 * 64 * 32; it += NT) {
        const int n4 = it & 31, p = (it >> 5) & 63, h = (it >> 11) & 31, b = it >> 16;
        f32x4 hs = {0.f, 0.f, 0.f, 0.f};
#pragma nounroll
        for (int c0 = 0; c0 < 64; c0 += 16) {
            f32x4 st[16]; float dc[16];
#pragma unroll
            for (int k = 0; k < 16; ++k) { const size_t idx = ((size_t)(b * 64 + c0 + k) * 32 + h), off = (idx * 64 + p) * 128 + n4 * 4;
                st[k] = *(const f32x4*)(WSP(float, WS_STATES) + off); dc[k] = WSP(float, WS_DACS)[((size_t)(b * 64 + c0 + k) * 128 + 127) * 32 + h]; }
            __builtin_amdgcn_sched_barrier(0);
#pragma unroll
            for (int k = 0; k < 16; ++k) { const size_t idx = ((size_t)(b * 64 + c0 + k) * 32 + h), off = (idx * 64 + p) * 128 + n4 * 4;
                v2u o; o.x = pk2(hs.x, hs.y); o.y = pk2(hs.z, hs.w); *(v2u*)(WSP(bf16, WS_PREV) + off) = o;
                hs = hs * __expf(dc[k]) + st[k]; }
        }
    }
}
__device__ __forceinline__ void p4_phase(Frame& F) {
    const int gt = F.vcu * (NWAVES * 64) + TID(), NT = F.G * NWAVES * 64;
    const int lane = LANE();
    const bool sel_first = (PHASE_SWAP) && (((blockIdx.x >> 3) & 1) != 0);
#ifndef NO_P4A
    if (!sel_first) p4_scan(F);
#endif
#ifndef NO_ATTN
    const int nk = 8 * ((1024 + 4 * F.G - 1) / (4 * F.G));
    float raw[64];
#define P4_QUERY(k_, q_, ok_) do { const int kk_ = (k_) >> 1, base_ = (kk_ >> 2) * F.G + F.vcu, ph_ = kk_ & 3; ok_ = (k_) < nk && base_ < 256; \
        const int grp_ = ph_ == 0 ? base_ : ph_ == 1 ? 511 - base_ : ph_ == 2 ? 512 + base_ : 1023 - base_; q_ = grp_ * 16 + 2 * F.wave + ((k_) & 1); } while (0)
#define P4_PREFETCH(q_) do { const int pos_ = (q_) & (SEQ - 1); if (pos_ >= 256) { const int ni_ = (pos_ >> 6) + 1; const float* sr_ = WSP(float, WS_S) + (size_t)(q_) * SEQ + lane; \
        _Pragma("unroll") for (int i = 0; i < 64; ++i) if (i < ni_) raw[i] = sr_[i * 64]; } } while (0)
    { int q0; bool ok0; P4_QUERY(0, q0, ok0); if (ok0) P4_PREFETCH(q0); }
    for (int k = 0; k < nk; ++k) {
        int q; bool ok; P4_QUERY(k, q, ok); if (!ok) continue;
        int qn; bool okn; P4_QUERY(k + 1, qn, okn);
        const int b = q >> 13, pos = q & (SEQ - 1), ntw = 4 * ((pos >> 8) + 1);
        unsigned long long* Mq = WSP(unsigned long long, WS_MASK) + (size_t)b * 128 * SEQ + pos;
        if (pos < 256) { if (lane < ntw) { const int d = pos - 64 * lane; Mq[(size_t)lane * SEQ] = d >= 63 ? ~0ull : (d < 0 ? 0ull : ((2ull << d) - 1ull)); } if (okn) P4_PREFETCH(qn); }
        else { const float* Srow = WSP(float, WS_S) + (size_t)q * SEQ; const int ni = (pos >> 6) + 1;
            LAS unsigned* lk = (LAS unsigned*)(F.lds + RING_OFF + F.wave * 16384); LAS unsigned long long* lw = (LAS unsigned long long*)(F.lds + RS_OFF + F.wave * 1024);
            if (ni <= 32) select_row<32, 0>(raw, Srow, pos, Mq, ntw, lane, lk, lw, okn, qn); else if (ni <= 64) select_row<64, 0>(raw, Srow, pos, Mq, ntw, lane, lk, lw, okn, qn);
            else if (ni <= 96) select_row<64, 32>(raw, Srow, pos, Mq, ntw, lane, lk, lw, okn, qn); else select_row<64, 64>(raw, Srow, pos, Mq, ntw, lane, lk, lw, okn, qn); }
    }
#undef P4_QUERY
#undef P4_PREFETCH
#endif
#ifndef NO_P4A
    if (sel_first) p4_scan(F);
#endif
}

constexpr int S5_CS = 0, S5_PS = 34816, S5_VEC = 52224, S5_YO = 53248;
struct P5R { v4u c[4], p[2], yd[2], xv[2], zv[2]; float dac, dsk; };
__device__ __forceinline__ void p5_load(P5R& R, int u, int tid) {
    const int h = u & 31, bc = u >> 5, g = h >> 3; const size_t t0 = (size_t)bc * 128;
#pragma unroll
    for (int i = 0; i < 2; ++i) { const int idx = tid + 512 * i, l = idx >> 3, c8 = (idx & 7) * 8; const size_t t = t0 + l; const int col = h * 64 + c8;
        R.yd[i] = *(const v4u*)(WSP(bf16, WS_YD) + t * 2048 + col); R.xv[i] = *(const v4u*)(WSP(bf16, WS_XBC) + t * 3072 + col); R.zv[i] = *(const v4u*)(WSP(bf16, WS_U) + t * NU + UC_Z + col); }
#pragma unroll
    for (int i = 0; i < 4; ++i) { const int idx = tid + 512 * i, row = idx >> 4, ch = idx & 15; R.c[i] = *(const v4u*)(WSP(bf16, WS_XBC) + (t0 + row) * 3072 + 2560 + g * 128 + ch * 8); }
#pragma unroll
    for (int i = 0; i < 2; ++i) { const int idx = tid + 512 * i, row = idx >> 4, ch = idx & 15; R.p[i] = *(const v4u*)(WSP(bf16, WS_PREV) + ((size_t)u * 64 + row) * 128 + ch * 8); }
    R.dac = WSP(float, WS_DACS)[(t0 + (tid & 127)) * 32 + h]; R.dsk = INP(6)[h];
}
__device__ __forceinline__ void p5_ssd_all(Frame& F) {
    constexpr int NUN = 2 * 64 * 32;
    const int tid = TID(), lane = LANE(), w = F.wave, r32 = lane & 31, hh = lane >> 5;
    LAS unsigned char* L = F.lds + RING_OFF; LAS float* dacs = (LAS float*)(L + S5_VEC);
    int u = F.vcu; if (u >= NUN) return;
    P5R R; p5_load(R, u, tid);
#pragma nounroll
    for (; u < NUN; u += F.G) {
        const int h = u & 31, bc = u >> 5; const size_t t0 = (size_t)bc * 128;
#pragma unroll
        for (int i = 0; i < 4; ++i) { const int idx = tid + 512 * i, row = idx >> 4, ch = idx & 15; *(LAS v4u*)(L + S5_CS + row * SP_C + ch * 16) = R.c[i]; }
#pragma unroll
        for (int i = 0; i < 2; ++i) { const int idx = tid + 512 * i, row = idx >> 4, ch = idx & 15; *(LAS v4u*)(L + S5_PS + row * SP_C + ch * 16) = R.p[i]; }
        if (tid < 128) dacs[tid] = R.dac;
        const v4u cyd[2] = {R.yd[0], R.yd[1]}, cxv[2] = {R.xv[0], R.xv[1]}, czv[2] = {R.zv[0], R.zv[1]}; const float dsk = R.dsk;
        __syncthreads();
        p5_load(R, u + F.G < NUN ? u + F.G : u, tid);
        __builtin_amdgcn_sched_barrier(0);
        const int li = w >> 1, pb = w & 1; f32x16 acc = {};
        { const LAS unsigned char* cp = L + S5_CS + (32 * li + r32) * SP_C + hh * 16; const LAS unsigned char* pp = L + S5_PS + (32 * pb + r32) * SP_C + hh * 16;
#pragma unroll
          for (int ks = 0; ks < 8; ++ks) acc = __builtin_amdgcn_mfma_f32_32x32x16_bf16(lds_b128(cp + ks * 32), lds_b128(pp + ks * 32), acc, 0, 0, 0); }
        LAS float* Yo = (LAS float*)(L + S5_YO);
#pragma unroll
        for (int r = 0; r < 16; ++r) Yo[(32 * li + crow16(r, hh)) * 68 + 32 * pb + r32] = acc[r];
        __syncthreads();
#pragma unroll
        for (int i = 0; i < 2; ++i) { const int idx = tid + 512 * i, l = idx >> 3, c8 = (idx & 7) * 8; const size_t t = t0 + l; const int col = h * 64 + c8;
            const f32x4 y0 = *(const LAS f32x4*)(Yo + l * 68 + c8), y1 = *(const LAS f32x4*)(Yo + l * 68 + c8 + 4);
            const v4u yd = cyd[i], xv = cxv[i], zv = czv[i];
            const float e = __expf(dacs[l]);
            float o[8];
            o[0] = (bflo(yd.x) + y0[0] * e + bflo(xv.x) * dsk) * siluf(bflo(zv.x)); o[1] = (bfhi(yd.x) + y0[1] * e + bfhi(xv.x) * dsk) * siluf(bfhi(zv.x));
            o[2] = (bflo(yd.y) + y0[2] * e + bflo(xv.y) * dsk) * siluf(bflo(zv.y)); o[3] = (bfhi(yd.y) + y0[3] * e + bfhi(xv.y) * dsk) * siluf(bfhi(zv.y));
            o[4] = (bflo(yd.z) + y1[0] * e + bflo(xv.z) * dsk) * siluf(bflo(zv.z)); o[5] = (bfhi(yd.z) + y1[1] * e + bfhi(xv.z) * dsk) * siluf(bfhi(zv.z));
            o[6] = (bflo(yd.w) + y1[2] * e + bflo(xv.w) * dsk) * siluf(bflo(zv.w)); o[7] = (bfhi(yd.w) + y1[3] * e + bfhi(xv.w) * dsk) * siluf(bfhi(zv.w));
            v4u ov; ov.x = pk2(o[0], o[1]); ov.y = pk2(o[2], o[3]); ov.z = pk2(o[4], o[5]); ov.w = pk2(o[6], o[7]);
            *(v4u*)(WSP(bf16, WS_YG) + t * 2048 + col) = ov; }
        __syncthreads();
    }
}
#ifndef TAILSPIN_ALL
#define TAILSPIN_ALL 0
#endif

typedef att::BlockRef<att::bf16, att::bf16> ABlk;
__device__ __forceinline__ ABlk att_ref(const bf16* U, const bf16* QR, const bf16* KR, bf16* AO, const unsigned long long* MASK, int L, int pass) {
    const int bh = L >> 4, x = L & 15, qb = pass ? 31 - x : x, b = bh >> 4, hd = bh & 15;
    ABlk r;
    r.Q = (const att::bf16*)(QR + ((size_t)b * SEQ + qb * 256) * DM + hd * 128);
    r.K = (const att::bf16*)(KR + ((size_t)b * SEQ) * DM + hd * 128);
    r.V = (const att::bf16*)(U + ((size_t)b * SEQ) * NU + UC_V + hd * 128);
    r.O = (att::bf16*)(AO + ((size_t)b * SEQ + qb * 256) * 2048 + hd * 128);
    r.MK = MASK + (size_t)b * 128 * SEQ + qb * 256;
    r.P0 = qb * 256;
    return r;
}
__device__ __forceinline__ void p5_attention(Frame& F) {
    constexpr int NITEM = 512;
    int L = F.vcu; if (L >= NITEM) return;
    const bf16* U = WSP(bf16, WS_U); const bf16* QR = WSP(bf16, WS_QR); const bf16* KR = WSP(bf16, WS_KR); bf16* AO = WSP(bf16, WS_AO); const unsigned long long* MK = WSP(unsigned long long, WS_MASK); const int stride = F.G;
    char* lds = (char*)(F.lds + RING_OFF);
    int pass = 0;
    ABlk cur = att_ref(U, QR, KR, AO, MK, L, 0);
    att::Seam<att::bf16> S;
    att::causal_swa_prime<att::bf16, att::bf16>(cur, SEQ, lds, S);
    for (;;) {
        const bool more_pass = pass == 0, more_item = L + stride < NITEM, last = !more_pass && !more_item;
        int passn = pass + 1, Ln = L;
        if (!more_pass) { passn = 0; Ln = more_item ? L + stride : L; }
        const ABlk nxt = last ? cur : att_ref(U, QR, KR, AO, MK, Ln, passn);
        att::causal_swa_block<att::bf16, att::bf16>(cur, nxt, SEQ, SEQ, lds, S);
        if (last) break;
        cur = nxt; pass = passn; L = Ln;
    }
}

__device__ __forceinline__ float wave_sum_dpp(float v) {
    v += __int_as_float(__builtin_amdgcn_update_dpp(0, __float_as_int(v), 0xB1, 0xf, 0xf, false));
    v += __int_as_float(__builtin_amdgcn_update_dpp(0, __float_as_int(v), 0x4E, 0xf, 0xf, false));
    v += __int_as_float(__builtin_amdgcn_update_dpp(0, __float_as_int(v), 0x141, 0xf, 0xf, false));
    v += __int_as_float(__builtin_amdgcn_update_dpp(0, __float_as_int(v), 0x140, 0xf, 0xf, false));
    const int iv = __float_as_int(v);
    return (__int_as_float(__builtin_amdgcn_readlane(iv, 0)) + __int_as_float(__builtin_amdgcn_readlane(iv, 16))) + (__int_as_float(__builtin_amdgcn_readlane(iv, 32)) + __int_as_float(__builtin_amdgcn_readlane(iv, 48)));
}
__device__ __forceinline__ void p9_route(Frame& F) {
    const int lane = LANE(), wave = F.wave, tid = TID();
    LAS int* ent = (LAS int*)(F.lds + RING_OFF);
    const int ngrp = T / 4, nrounds = (ngrp + F.G * NWAVES - 1) / (F.G * NWAVES);
    for (int rd = 0; rd < nrounds; ++rd) {
        const int grp = (rd * F.G + F.vcu) * NWAVES + wave; const bool valid = grp < ngrp;
        if (valid) {
            f32x4 xn[4][8], nw[8];
#pragma unroll
            for (int tk = 0; tk < 4; ++tk) { const f32x4* xr = (const f32x4*)(WSP(float, WS_H1) + ((size_t)grp * 4 + tk) * DM) + lane;
#pragma unroll
                for (int j = 0; j < 8; ++j) xn[tk][j] = xr[64 * j]; }
#pragma unroll
            for (int j = 0; j < 8; ++j) nw[j] = ((const f32x4*)INP(12))[lane + 64 * j];
            __builtin_amdgcn_sched_barrier(0);
#pragma unroll
            for (int tk = 0; tk < 4; ++tk) { const size_t tok = (size_t)grp * 4 + tk; float s = 0.f;
#pragma unroll
                for (int j = 0; j < 8; ++j) s += (xn[tk][j].x * xn[tk][j].x + xn[tk][j].y * xn[tk][j].y) + (xn[tk][j].z * xn[tk][j].z + xn[tk][j].w * xn[tk][j].w);
                const float rstd = 1.f / sqrtf(wave_sum(s) * (1.f / DM) + EPS);
                unsigned* o4 = (unsigned*)(WSP(unsigned char, WS_XN2) + tok * DM) + lane;
#pragma unroll
                for (int j = 0; j < 8; ++j) { const f32x4 wv = nw[j]; xn[tk][j] = xn[tk][j] * rstd * wv;
                    o4[64 * j] = pg8::pk4_fp8(xn[tk][j].x * pg8::F8_SX, xn[tk][j].y * pg8::F8_SX, xn[tk][j].z * pg8::F8_SX, xn[tk][j].w * pg8::F8_SX); } }
            float lg[2] = {0.f, 0.f};
            for (int e = 0; e < NEXP; ++e) {
                if ((e & 15) == 0) {
                    __syncthreads();
#pragma unroll
                    for (int i = 0; i < 16; ++i) ((LAS f32x4*)(F.lds + RING_OFF))[tid + 512 * i] = ((const f32x4*)(WSP(float, WS_RWT) + (size_t)e * DM))[tid + 512 * i];
                    __syncthreads(); }
                typedef float f32x2_t __attribute__((ext_vector_type(2)));
                f32x2_t q0 = {0.f, 0.f}, q1 = q0, q2 = q0, q3 = q0; const LAS f32x4* rw = (const LAS f32x4*)(F.lds + RING_OFF + (e & 15) * 8192) + lane;
#pragma unroll
                for (int j = 0; j < 8; ++j) { const f32x4 r = rw[64 * j]; const f32x2_t rl = {r.x, r.y}, rh = {r.z, r.w};
#define P9_FMA(Q_, X_) do { const f32x4 t_ = X_; Q_ = __builtin_elementwise_fma((f32x2_t){t_[0], t_[1]}, rl, Q_); Q_ = __builtin_elementwise_fma((f32x2_t){t_[2], t_[3]}, rh, Q_); } while (0)
                    P9_FMA(q0, xn[0][j]); P9_FMA(q1, xn[1][j]); P9_FMA(q2, xn[2][j]); P9_FMA(q3, xn[3][j]);
#undef P9_FMA
                }
                float p0 = q0.x + q0.y, p1 = q1.x + q1.y, p2 = q2.x + q2.y, p3 = q3.x + q3.y;
                p0 = wave_sum_dpp(p0); p1 = wave_sum_dpp(p1); p2 = wave_sum_dpp(p2); p3 = wave_sum_dpp(p3);
                const float bb = INP(14)[e];
                if ((lane & 31) == e) { lg[0] = ((lane >> 5) ? p1 : p0) + bb; lg[1] = ((lane >> 5) ? p3 : p2) + bb; }
            }
            __syncthreads();
#pragma unroll
            for (int jj = 0; jj < 2; ++jj) {
                float v = lg[jj]; float tv[4]; int ti[4];
#pragma unroll
                for (int k = 0; k < 4; ++k) { float bv = v; int bi = lane & 31;
#pragma unroll
                    for (int o = 1; o < 32; o <<= 1) { const float ov = __shfl_xor(bv, o); const int oi = __shfl_xor(bi, o); if (ov > bv || (ov == bv && oi < bi)) { bv = ov; bi = oi; } }
                    tv[k] = bv; ti[k] = bi; if ((lane & 31) == bi) v = -__builtin_inff(); }
                const float e0 = 1.f, e1 = expf(tv[1] - tv[0]), e2 = expf(tv[2] - tv[0]), e3 = expf(tv[3] - tv[0]); const float inv = 1.f / (e0 + e1 + e2 + e3);
                const int slot = lane & 31;
                if (slot < 4) { const int ee = slot == 0 ? ti[0] : slot == 1 ? ti[1] : slot == 2 ? ti[2] : ti[3]; const float ww = (slot == 0 ? e0 : slot == 1 ? e1 : slot == 2 ? e2 : e3) * inv;
                    const int tok = grp * 4 + 2 * jj + (lane >> 5);
                    ent[wave * 16 + (2 * jj + (lane >> 5)) * 4 + slot] = ee;
                    WSP(int, WS_ROUTE)[tok * 4 + slot] = ee; WSP(float, WS_ROUTE + 256 * 1024)[tok * 4 + slot] = ww; }
            }
        }
        __syncthreads();
        const int round = rd * F.G + F.vcu;
        if (round * 32 < T) {
            if (tid < 128) { const int ej = ent[tid]; int lr = 0; for (int i = 0; i < tid; ++i) lr += (ent[i] == ej) ? 1 : 0;
                WSP(int, WS_ROUTE + 512 * 1024)[(round * 32) * 4 + tid] = lr; }
            if (tid >= 128 && tid < 160) { const int e = tid - 128; int c = 0; for (int i = 0; i < 128; ++i) c += (ent[i] == e) ? 1 : 0; WSP(int, WS_ROUTE + 2048 * 1024)[round * 32 + e] = c; }
        }
        __syncthreads();
    }
}

__device__ __forceinline__ void moe_offsets(Frame& F, bool keep_prefix) {
    LAS int* eoff = (LAS int*)(F.lds + EOFF_OFF); LAS int* tile_e = (LAS int*)(F.lds + TILE_E_OFF);
    LAS int* pre = (LAS int*)(F.lds + RING_OFF); LAS int* part = (LAS int*)(F.lds + RING_OFF + 65536);
    const int NR = T / 32;
    __syncthreads();
    for (int i = TID(); i < NR * 32; i += NWAVES * 64) pre[i] = WSP(int, WS_ROUTE + 2048 * 1024)[i];
    __syncthreads();
    { const int e = TID() & 31, ch = TID() >> 5; int s = 0; for (int r = ch * 32; r < ch * 32 + 32; ++r) s += pre[r * 32 + e]; part[ch * 32 + e] = s; }
    __syncthreads();
    if (TID() < 32) { int s = 0; for (int ch = 0; ch < 16; ++ch) { const int v = part[ch * 32 + TID()]; part[ch * 32 + TID()] = s; s += v; } part[512 + TID()] = s; }
    __syncthreads();
    if (keep_prefix) { const int e = TID() & 31, ch = TID() >> 5; int s = part[ch * 32 + e]; for (int r = ch * 32; r < ch * 32 + 32; ++r) { const int v = pre[r * 32 + e]; pre[r * 32 + e] = s; s += v; } }
    if (TID() == 0) { int o = 0; for (int e = 0; e < NEXP; ++e) { eoff[e] = o; o += (part[512 + e] + 255) & ~255; } eoff[32] = o; eoff[33] = o >> 8; for (int e = 0; e < NEXP; ++e) eoff[34 + e] = part[512 + e]; }
    __syncthreads();
    if (TID() < NEXP) { for (int t = eoff[TID()] >> 8; t < (eoff[TID() + 1] >> 8); ++t) tile_e[t] = TID(); }
    __syncthreads();
}
__device__ __forceinline__ void p10_sort(Frame& F) {
    const int gw = F.vcu * NWAVES + F.wave, NGW = F.G * NWAVES, lane = LANE();
    LAS int* eoff = (LAS int*)(F.lds + EOFF_OFF);
    moe_offsets(F, true);
    LAS int* pre = (LAS int*)(F.lds + RING_OFF);
    for (int tok = gw; tok < T; tok += NGW) {
        const v4u* src = (const v4u*)(WSP(unsigned char, WS_XN2) + (size_t)tok * DM) + lane; v4u v[2];
        const int4 es = *(const int4*)(WSP(int, WS_ROUTE) + tok * 4), rk = *(const int4*)(WSP(int, WS_ROUTE + 512 * 1024) + tok * 4);
#pragma unroll
        for (int j = 0; j < 2; ++j) v[j] = src[64 * j];
        __builtin_amdgcn_sched_barrier(0);
        int4 rows;
#pragma unroll
        for (int s = 0; s < 4; ++s) { const int e = s == 0 ? es.x : s == 1 ? es.y : s == 2 ? es.z : es.w, row = eoff[e] + pre[(tok >> 5) * 32 + e] + (s == 0 ? rk.x : s == 1 ? rk.y : s == 2 ? rk.z : rk.w);
            v4u* dst = (v4u*)(WSP(unsigned char, WS_AS) + (size_t)row * DM) + lane;
#pragma unroll
            for (int j = 0; j < 2; ++j) dst[64 * j] = v[j];
            if (s == 0) rows.x = row; else if (s == 1) rows.y = row; else if (s == 2) rows.z = row; else rows.w = row; }
        if (lane == 0) *(int4*)(WSP(int, WS_ROUTE + 768 * 1024) + tok * 4) = rows;
    }
    for (int e = 0; e < NEXP; ++e) { const int cnt = eoff[34 + e], r0 = eoff[e] + cnt, npad = eoff[e + 1] - r0; const v4u z = {0u, 0u, 0u, 0u};
        for (int r = gw; r < npad; r += NGW) { v4u* dst = (v4u*)(WSP(unsigned char, WS_AS) + (size_t)(r0 + r) * DM) + lane;
#pragma unroll
            for (int j = 0; j < 2; ++j) dst[64 * j] = z; } }
    if (blockIdx.x == 0 && TID() == 0) *(int*)(CTLP() + CW_NT) = eoff[33];
}

__device__ __forceinline__ float f8dec(unsigned w, int b) { return b == 0 ? __builtin_amdgcn_cvt_f32_fp8((int)w, 0) : b == 1 ? __builtin_amdgcn_cvt_f32_fp8((int)w, 1) : b == 2 ? __builtin_amdgcn_cvt_f32_fp8((int)w, 2) : __builtin_amdgcn_cvt_f32_fp8((int)w, 3); }
__device__ __forceinline__ void p_swiglu(Frame& F) {
    const int ntiles = *(const int*)(CTLP() + CW_NT);
    const size_t nitem = (size_t)ntiles * 256 * 128;
    constexpr float IS = 1.0f / pg8::F8_SH;
    for (size_t it = (size_t)F.vcu * (NWAVES * 64) + TID(); it < nitem; it += (size_t)F.G * NWAVES * 64) {
        const size_t row = it >> 7; const int cg = (int)(it & 127), pn = cg >> 3, j = (cg & 7) * 16;
        const unsigned char* hp = WSP(unsigned char, WS_H8) + row * 4096 + pn * 256 + j;
        const v4u gv = *(const v4u*)hp, lv = *(const v4u*)(hp + 128); v4u o;
#define SW4(G, L) pg8::pk4_fp8(pg8::swiglu1(f8dec(G, 0) * IS, f8dec(L, 0) * IS) * pg8::F8_SA, pg8::swiglu1(f8dec(G, 1) * IS, f8dec(L, 1) * IS) * pg8::F8_SA, pg8::swiglu1(f8dec(G, 2) * IS, f8dec(L, 2) * IS) * pg8::F8_SA, pg8::swiglu1(f8dec(G, 3) * IS, f8dec(L, 3) * IS) * pg8::F8_SA)
        o.x = SW4(gv.x, lv.x); o.y = SW4(gv.y, lv.y); o.z = SW4(gv.z, lv.z); o.w = SW4(gv.w, lv.w);
#undef SW4
        *(v4u*)(WSP(unsigned char, WS_ACT) + row * 2048 + pn * 128 + j) = o;
    }
}

__device__ __forceinline__ void p13_final(Frame& F) {
    const int gw = F.vcu * NWAVES + F.wave, NGW = F.G * NWAVES, lane = LANE();
    f32x4 fw[8];
#pragma unroll
    for (int j = 0; j < 8; ++j) fw[j] = ((const f32x4*)INP(19))[lane + 64 * j];
    int4 rows_n = {0, 0, 0, 0}; f32x4 gws_n = {0.f, 0.f, 0.f, 0.f};
    if (gw < T) { rows_n = *(const int4*)(WSP(int, WS_ROUTE + 768 * 1024) + gw * 4); gws_n = *(const f32x4*)(WSP(float, WS_ROUTE + 256 * 1024) + gw * 4); }
    for (int tok = gw; tok < T; tok += NGW) {
        const f32x4* hr = (const f32x4*)(WSP(float, WS_H1) + (size_t)tok * DM) + lane; f32x4 v[8];
        const int4 rows = rows_n; const f32x4 gws = gws_n;
        if (tok + NGW < T) { rows_n = *(const int4*)(WSP(int, WS_ROUTE + 768 * 1024) + (tok + NGW) * 4); gws_n = *(const f32x4*)(WSP(float, WS_ROUTE + 256 * 1024) + (tok + NGW) * 4); }
#pragma unroll
        for (int j = 0; j < 8; ++j) v[j] = hr[64 * j];
        v2u os[4][8];
#pragma unroll
        for (int s = 0; s < 4; ++s) { const int row = s == 0 ? rows.x : s == 1 ? rows.y : s == 2 ? rows.z : rows.w; const v2u* orow = (const v2u*)(WSP(bf16, WS_OS) + (size_t)row * DM) + lane;
#pragma unroll
            for (int j = 0; j < 8; ++j) os[s][j] = orow[64 * j]; }
        __builtin_amdgcn_sched_barrier(0);
#pragma unroll
        for (int s = 0; s < 4; ++s) { const float gw_ = gws[s];
#pragma unroll
            for (int j = 0; j < 8; ++j) { const v2u o = os[s][j]; v[j].x += gw_ * bflo(o.x); v[j].y += gw_ * bfhi(o.x); v[j].z += gw_ * bflo(o.y); v[j].w += gw_ * bfhi(o.y); } }
        float ssum = 0.f;
#pragma unroll
        for (int j = 0; j < 8; ++j) ssum += (v[j].x * v[j].x + v[j].y * v[j].y) + (v[j].z * v[j].z + v[j].w * v[j].w);
        const float rstd = 1.f / sqrtf(wave_sum(ssum) * (1.f / DM) + EPS);
        f32x4* orow = (f32x4*)(OUTP() + (size_t)tok * DM) + lane;
#pragma unroll
        for (int j = 0; j < 8; ++j) orow[64 * j] = v[j] * rstd * fw[j];
    }
}

#ifndef AEPI
#define AEPI true
#endif
#ifndef PHASE_SWAP
#define PHASE_SWAP 1
#endif
constexpr int NPHASE = 15;
struct Args { const float* in[20]; float* out; unsigned char* ws; int ph_lo, ph_hi, li, pad; };
__global__ void __launch_bounds__(NWAVES * 64, 2) hybrid_fwd(Args args) {
    extern __shared__ __attribute__((aligned(16))) unsigned char lds[];
    Frame F;
    F.lds = (LAS unsigned char*)lds;
    F.wave = __builtin_amdgcn_readfirstlane((int)threadIdx.x >> 6);
    F.G = gridDim.x; { const int bx = blockIdx.x; F.vcu = (F.G % 8 == 0) ? (bx % 8) * (F.G / 8) + bx / 8 : bx; }
    for (int u = TID(); u < (LDS_BYTES - LDSCTL_OFF) / 4; u += NWAVES * 64) ((LAS unsigned*)(F.lds + LDSCTL_OFF))[u] = 0u;
    __syncthreads();
    (void)xcd_barrier_post((unsigned*)(CTLP() + CW_BAR), (volatile LAS unsigned*)(F.lds + MISC_OFF) + 8);
#define bar (XcdBarrier{(unsigned*)(CTLP() + CW_BAR), xb_xcc_id(), (volatile LAS unsigned*)(F.lds + MISC_OFF) + 8})
    const int lo = args.ph_lo, hi = args.ph_hi;
#ifdef HEADSPIN_US
    { const unsigned long long t1 = __builtin_amdgcn_s_memrealtime(); while (__builtin_amdgcn_s_memrealtime() - t1 < (unsigned long long)HEADSPIN_US * 100ull) __builtin_amdgcn_s_sleep(8); }
#endif
#ifndef PH_MASK
#define PH_MASK 0xFFFFFFFFu
#endif
#define IN(k) (((PH_MASK >> (k)) & 1u) && lo <= (k) && (k) < hi)
#ifdef PROBE_PHASE
    unsigned long long pr_t0 = __builtin_amdgcn_s_memrealtime(), pr_dt = 0ull;
#define SEAM(k) do { if (IN(k) && IN((k) + 1)) xcd_barrier(bar); if ((k) == (PROBE_PHASE == 8 ? 6 : PROBE_PHASE == 13 ? 11 : PROBE_PHASE - 1)) pr_t0 = __builtin_amdgcn_s_memrealtime(); if ((k) == PROBE_PHASE) pr_dt = __builtin_amdgcn_s_memrealtime() - pr_t0; } while (0)
#else
#define SEAM(k) do { if (IN(k) && IN((k) + 1)) xcd_barrier(bar); } while (0)
#endif

#ifdef NANFILL
    { const size_t n16 = (WS_END - 2 * MiB) / 16; v4u* p = (v4u*)(WSB() + 2 * MiB); const v4u q = {0xffffffffu, 0xffffffffu, 0xffffffffu, 0xffffffffu};
      for (size_t i = (size_t)blockIdx.x * 512 + TID(); i < n16; i += (size_t)F.G * 512) p[i] = q;
      xcd_barrier(bar); }
#endif
    if (IN(0)) { p0_prologue(F);
#ifdef DOUBLE_P0
        p0_prologue(F);
#endif
    } SEAM(0);
    if (IN(1)) { pg8::Gemm g{WSP(bf16, WS_XN), WSP(bf16, WS_WIN), T, NU, DM}; pg8::StaticOrder S; S.init(T, NU, F.G, (int)blockIdx.x); pg8::EpiU E{WSP(bf16, WS_U), NU};
        pg8::gemm_phase<pg8::EpiU, pg8::StaticOrder, AEPI, true>(F.lds + RING_OFF, g, S, E); } SEAM(1);
    if (IN(2)) { p2_prep(F); } SEAM(2);
    if (IN(3)) { p3_phase(F); } SEAM(3);
    if (IN(4)) { p4_phase(F); } SEAM(4);
    if (IN(5)) {
#if defined(NO_P5A) || defined(NO_ATTN) || defined(NO_P5B)
#ifndef NO_P5A
        p5_ssd_all(F);
#endif
#ifdef NO_ATTN
        { const v4u z = {0u, 0u, 0u, 0u}; v4u* p = (v4u*)WSP(bf16, WS_AO); for (size_t i = (size_t)blockIdx.x * 512 + TID(); i < (size_t)T * DM / 8; i += (size_t)F.G * 512) p[i] = z; }
#elif !defined(NO_P5B)
        p5_attention(F);
#endif
#else
        { const bool att_first = (PHASE_SWAP) && (((blockIdx.x >> 3) & 1) != 0);
          if (!att_first) p5_ssd_all(F);
          p5_attention(F);
          if (att_first) p5_ssd_all(F); }
#endif
    } SEAM(5);
    if (IN(6)) { pg8::Gemm g{WSP(bf16, WS_YG), WSP(bf16, WS_WSSD), T, DM, DM, WSP(bf16, WS_AO), WSP(bf16, WS_WATT)}; pg8::ChainOrder S; S.base.init(T, DM, F.G, (int)blockIdx.x);
        LAS float* rtab = (LAS float*)(F.lds + RS_OFF); LAS int* rpm = (LAS int*)(F.lds + RS_OFF + 4096);
        { pg8::Unit u;
          int prev_pm = -1;
          for (int i = 0; i < 4 && S.base.next(i, u); ++i) { if (u.pm == prev_pm) { if (TID() == 0) rpm[i] = -1; continue; } prev_pm = u.pm;
              if (TID() == 0) rpm[i] = u.pm;
#pragma nounroll
              for (int rb = 0; rb < 4; ++rb) {
                  v4u vv[8][4];
#pragma unroll
                  for (int k = 0; k < 8; ++k) { const int r = F.wave + NWAVES * (rb * 8 + k); const v4u* p = (const v4u*)(WSP(bf16, WS_YG) + ((size_t)u.pm * 256 + r) * DM) + LANE();
#pragma unroll
                      for (int j = 0; j < 4; ++j) vv[k][j] = p[64 * j]; }
                  __builtin_amdgcn_sched_barrier(0);
#pragma unroll
                  for (int k = 0; k < 8; ++k) { const int r = F.wave + NWAVES * (rb * 8 + k); float ss = 0.f;
#pragma unroll
                      for (int j = 0; j < 4; ++j) { const v4u v = vv[k][j]; const float a0 = bflo(v.x), a1 = bfhi(v.x), a2 = bflo(v.y), a3 = bfhi(v.y), a4 = bflo(v.z), a5 = bfhi(v.z), a6 = bflo(v.w), a7 = bfhi(v.w);
                          ss += ((a0 * a0 + a1 * a1) + (a2 * a2 + a3 * a3)) + ((a4 * a4 + a5 * a5) + (a6 * a6 + a7 * a7)); }
                      ss = wave_sum(ss); if (LANE() == 0) rtab[i * 256 + r] = 1.0f / sqrtf(ss * (1.0f / DM) + EPS); } } }
          __syncthreads(); }
        pg8::EpiMerge E{WSP(bf16, WS_MG), WSP(bf16, WS_U) + UC_GS, WSP(bf16, WS_U) + UC_GA, NU, rtab, rpm};
        pg8::gemm_phase<pg8::EpiMerge, pg8::ChainOrder, AEPI, true>(F.lds + RING_OFF, g, S, E); } SEAM(6);
    if (IN(8)) { pg8::Gemm g{WSP(bf16, WS_MG), WSP(bf16, WS_WOUT), T, DM, DM}; pg8::StaticOrder S; S.init(T, DM, F.G, (int)blockIdx.x); pg8::EpiOut E{WSP(float, WS_H1), INP(0)};
        pg8::gemm_phase<pg8::EpiOut, pg8::StaticOrder, AEPI, true>(F.lds + RING_OFF, g, S, E); } SEAM(8);
    if (IN(9)) { p9_route(F); } SEAM(9);
    if (IN(10)) { p10_sort(F); } SEAM(10);
    if (IN(11)) { moe_offsets(F, false); const int ntiles = ((LAS int*)(F.lds + EOFF_OFF))[33];
        pg8::Gemm g{WSP(bf16, WS_AS), WSP(bf16, WS_W1), ntiles * 256, 4096, DM / 2};
        pg8::GroupedOrder S; S.init(ntiles, 16, F.G, (int)blockIdx.x, (const LAS int*)(F.lds + TILE_E_OFF)); pg8::EpiSwiglu E{WSP(bf16, WS_ACT), INP(16)};
        pg8::gemm_phase<pg8::EpiSwiglu, pg8::GroupedOrder, AEPI, true, true>(F.lds + RING_OFF, g, S, E); } SEAM(11);
    if (IN(13)) { moe_offsets(F, false); const int ntiles = ((LAS int*)(F.lds + EOFF_OFF))[33];
        pg8::Gemm g{WSP(bf16, WS_ACT), WSP(bf16, WS_W2), ntiles * 256, DM, DM / 2};     pg8::GroupedOrder S; S.init(ntiles, 8, F.G, (int)blockIdx.x, (const LAS int*)(F.lds + TILE_E_OFF)); pg8::EpiMoeOut E{WSP(bf16, WS_OS), INP(18)};
        pg8::gemm_phase<pg8::EpiMoeOut, pg8::GroupedOrder, AEPI, true, true>(F.lds + RING_OFF, g, S, E); } SEAM(13);
    if (IN(14)) { p13_final(F); }
#ifdef SENTINEL_SCAN
    { xcd_barrier(bar);
      unsigned* cntw = (unsigned*)(CTLP() + 12288);
      int tid_ = TID(); asm volatile("" : "+v"(tid_)); const size_t gt = (size_t)blockIdx.x * 512 + tid_, NT = (size_t)F.G * 512;
      unsigned c0 = 0, c1 = 0, c2 = 0, c3 = 0, c4 = 0, c5 = 0, c6 = 0, c7 = 0;
      { const unsigned* S = (const unsigned*)WSP(float, WS_S); for (size_t i = gt; i < (size_t)T * SEQ; i += NT) { const int q = (int)(i >> 13), k = (int)(i & 8191), pos = q & 8191; if (k <= pos && S[i] == 0xffffffffu) c0++; } }
      { const unsigned long long* M = WSP(unsigned long long, WS_MASK); for (size_t i = gt; i < (size_t)2 * 128 * SEQ; i += NT) { const int pos = (int)(i & 8191), tile = (int)((i >> 13) & 127); if (tile < 4 * ((pos >> 8) + 1) && pos >= 256 * 1 && tile >= 4 && M[i] == ~0ull) c1++; } }
      { const unsigned* Q = (const unsigned*)WSP(bf16, WS_QIR); for (size_t i = gt; i < (size_t)T * 256; i += NT) if (Q[i] == 0xffffffffu) c2++; const unsigned* K = (const unsigned*)WSP(bf16, WS_KIR); for (size_t i = gt; i < (size_t)T * 32; i += NT) if (K[i] == 0xffffffffu) c2++; }
      { const int ntl = ((LAS int*)(F.lds + EOFF_OFF))[33]; const unsigned* A = (const unsigned*)WSP(bf16, WS_AS); for (size_t i = gt; i < (size_t)ntl * 256 * 1024; i += NT) if (A[i] == 0xffffffffu) c3++; }
      { const unsigned* R = (const unsigned*)WSP(int, WS_ROUTE); for (size_t i = gt; i < (size_t)T * 16; i += NT) if (R[i] == 0xffffffffu) c4++; }
      { const unsigned* W = (const unsigned*)WSP(bf16, WS_W1); for (size_t i = gt; i < (size_t)NEXP * 4096 * 1024; i += NT) if (W[i] == 0xffffffffu) c5++; const unsigned* W2 = (const unsigned*)WSP(bf16, WS_W2); for (size_t i = gt; i < (size_t)NEXP * 2048 * 1024; i += NT) if (W2[i] == 0xffffffffu) c5++; const unsigned* WI = (const unsigned*)WSP(bf16, WS_WIN); for (size_t i = gt; i < (size_t)NU * 1024; i += NT) if (WI[i] == 0xffffffffu) c5++; }
      { const unsigned* U = (const unsigned*)WSP(bf16, WS_U); for (size_t i = gt; i < (size_t)T * (NU / 2); i += NT) if (U[i] == 0xffffffffu) c6++; }
      { const unsigned* A = (const unsigned*)WSP(bf16, WS_ACT); const int ntl = ((LAS int*)(F.lds + EOFF_OFF))[33]; for (size_t i = gt; i < (size_t)ntl * 256 * 1024; i += NT) if (A[i] == 0xffffffffu) c7++; }
      if (c0) atomicAdd(cntw, c0); if (c1) atomicAdd(cntw + 64, c1); if (c2) atomicAdd(cntw + 128, c2); if (c3) atomicAdd(cntw + 192, c3); if (c4) atomicAdd(cntw + 256, c4); if (c5) atomicAdd(cntw + 320, c5); if (c6) atomicAdd(cntw + 384, c6); if (c7) atomicAdd(cntw + 448, c7);
      xcd_barrier(bar);
      if (blockIdx.x == 0 && TID() == 0) { float x = 0.f; for (int j = 7; j >= 0; --j) { const unsigned v = __hip_atomic_load(cntw + 64 * j, RLX_AGENT); if (v) x = (float)(SENTINEL_SCAN == 1 ? 10 + j : (v > 90 ? 99 : v + 1)); if (SENTINEL_SCAN != 1 && j == SENTINEL_SCAN - 10) break; }
          if (x > 0.f) OUTP()[0] = sqrtf(3.3558e7f * x); } }
#endif
#ifdef CHK_BUF
    { xcd_barrier(bar);
      const unsigned* p; size_t n;
      switch (CHK_BUF) { case 1: p = (const unsigned*)WSP(bf16, WS_U); n = (size_t)T * NU / 2; break; case 2: p = (const unsigned*)WSP(bf16, WS_QIR); n = (size_t)T * 256; break; case 3: p = (const unsigned*)WSP(float, WS_S); n = (size_t)T * SEQ; break;
          case 4: p = (const unsigned*)WSP(unsigned long long, WS_MASK); n = (size_t)2 * 128 * SEQ * 2; break; case 5: p = (const unsigned*)WSP(bf16, WS_AO); n = (size_t)T * 1024; break; case 6: p = (const unsigned*)WSP(bf16, WS_YG); n = (size_t)T * 1024; break;
          case 7: p = (const unsigned*)WSP(float, WS_H1); n = (size_t)T * 2048; break; case 8: p = (const unsigned*)WSP(int, WS_ROUTE); n = (size_t)T * 16; break; case 9: p = (const unsigned*)WSP(bf16, WS_AS); n = (size_t)RMAX * 1024; break;
          case 10: p = (const unsigned*)WSP(bf16, WS_ACT); n = (size_t)RMAX * 1024; break; case 11: p = (const unsigned*)WSP(bf16, WS_OS); n = (size_t)RMAX * 1024; break; case 13: p = (const unsigned*)WSP(bf16, WS_XBC); n = (size_t)T * 1536; break;
          case 14: p = (const unsigned*)WSP(float, WS_STATES); n = (size_t)T * 2048; break; case 15: p = (const unsigned*)WSP(bf16, WS_PREV); n = (size_t)T * 1024; break; case 16: p = (const unsigned*)WSP(bf16, WS_W1); n = (size_t)NEXP * 4096 * 1024; break;
          case 17: p = (const unsigned*)WSP(bf16, WS_MG); n = (size_t)T * 1024; break; case 18: p = (const unsigned*)WSP(float, WS_TMP); n = (size_t)T * 2048; break; case 19: p = (const unsigned*)WSP(bf16, WS_XN2); n = (size_t)T * 1024; break;
          default: p = (const unsigned*)OUTP(); n = (size_t)T * 2048; break; }
      unsigned long long s = 0ull; int tid_ = TID(); asm volatile("" : "+v"(tid_));
      for (size_t i = (size_t)blockIdx.x * 512 + tid_; i < n; i += (size_t)F.G * 512) s += (unsigned long long)p[i] * (unsigned long long)((i & 1023u) + 1u);
      for (int o = 1; o < 64; o <<= 1) s += (unsigned long long)__shfl_xor((unsigned)s, o) + ((unsigned long long)__shfl_xor((unsigned)(s >> 32), o) << 32);
      if (LANE() == 0) atomicAdd((unsigned long long*)((unsigned*)CTLP() + 14336), s);
      xcd_barrier(bar);
      if (blockIdx.x == 0 && TID() == 0) { unsigned long long* keep = (unsigned long long*)(WSB() + WS_END + 4096); const unsigned long long cur = __hip_atomic_load((unsigned long long*)((unsigned*)CTLP() + 14336), RLX_AGENT);
          if (keep[0] == 0x600DF00DCAFE0001ull && keep[1] != cur) OUTP()[0] = 1.0e9f;
          keep[0] = 0x600DF00DCAFE0001ull; keep[1] = cur; } }
#endif
#ifdef NANCHK_ON
    { xcd_barrier(bar);
      if (blockIdx.x == 0 && TID() == 0) { float x = 0.f; for (int j = 9; j >= 0; --j) { const unsigned v = __hip_atomic_load((unsigned*)CTLP() + 12288 + 64 * j, RLX_AGENT); if (v) x = (float)(10 + j); }
          if (x > 0.f) OUTP()[0] = sqrtf(3.3558e7f * x); } }
#endif
#ifdef TAILSPIN_US
    if (TAILSPIN_ALL || blockIdx.x == 0) { const unsigned long long t1 = __builtin_amdgcn_s_memrealtime(); while (__builtin_amdgcn_s_memrealtime() - t1 < (unsigned long long)TAILSPIN_US * 100ull) __builtin_amdgcn_s_sleep(8); }
#endif
#ifdef PROBE_PHASE
    if (PROBE_PHASE == 14) pr_dt = __builtin_amdgcn_s_memrealtime() - pr_t0;
    if (blockIdx.x == 0) { const unsigned long long t1 = __builtin_amdgcn_s_memrealtime(); while (__builtin_amdgcn_s_memrealtime() - t1 < pr_dt) __builtin_amdgcn_s_sleep(8); }
#endif
#undef IN
#undef SEAM
#undef bar
}

#ifndef MK_CUTS
#define MK_CUTS 0
#endif
extern "C" void kernel_launch(void* const* d_in, const int* in_sizes, int n_in, void* d_out, int out_size, void* d_ws, size_t ws_size, hipStream_t stream) {
    static int grid = 0;
    if (grid == 0) {
        if (n_in != 20 || in_sizes[0] != T * DM || out_size != T * DM || ws_size < WS_END) { fprintf(stderr, "kernel_launch: unexpected shapes (n_in %d, in0 %d, out %d, ws %zu); nothing launched\n", n_in, n_in > 0 ? in_sizes[0] : -1, out_size, ws_size); grid = -1; return; }
        int dev = 0, cus = 0, per_cu = 0;
        if (hipGetDevice(&dev) != hipSuccess || hipDeviceGetAttribute(&cus, hipDeviceAttributeMultiprocessorCount, dev) != hipSuccess) { grid = -1; return; }
        if (hipFuncSetAttribute((const void*)hybrid_fwd, hipFuncAttributeMaxDynamicSharedMemorySize, LDS_BYTES) != hipSuccess) { fprintf(stderr, "kernel_launch: hipFuncSetAttribute failed\n"); grid = -1; return; }
        if (hipOccupancyMaxActiveBlocksPerMultiprocessor(&per_cu, (const void*)hybrid_fwd, NWAVES * 64, LDS_BYTES) != hipSuccess || per_cu < 1) fprintf(stderr, "kernel_launch: occupancy query reports %d\n", per_cu);
        (void)hipGetLastError();
        grid = cus;
    }
    if (grid < 0) return;
    if (hipMemsetAsync((char*)d_ws + WS_CTL, 0, CTL_ZERO_BYTES, stream) != hipSuccess) { fprintf(stderr, "kernel_launch: memset failed\n"); return; }
    Args a{};
    for (int i = 0; i < 20; ++i) a.in[i] = (const float*)d_in[i];
    a.out = (float*)d_out; a.ws = (unsigned char*)d_ws; a.pad = 0;
#if MK_CUTS
    for (int p = 0; p < NPHASE; ++p) { a.ph_lo = p; a.ph_hi = p + 1; a.li = 0; hipLaunchKernelGGL(hybrid_fwd, dim3(grid), dim3(NWAVES * 64), LDS_BYTES, stream, a); }
#else
    a.ph_lo = 0; a.ph_hi = NPHASE; a.li = 0;
    hipLaunchKernelGGL(hybrid_fwd, dim3(grid), dim3(NWAVES * 64), LDS_BYTES, stream, a);
#endif
    const hipError_t le = hipPeekAtLastError();
    if (le != hipSuccess) fprintf(stderr, "kernel_launch: launch failed: %s\n", hipGetErrorName(le));
}
```

```cpp
#include <hip/hip_runtime.h>
#include <hip/hip_bf16.h>
#include <cstdio>
#include <cstdint>
namespace pg8 {
#define PG8_LAS __attribute__((address_space(3)))
typedef unsigned short bf16_t;
typedef short bf16x8 __attribute__((ext_vector_type(8)));
typedef float f32x4 __attribute__((ext_vector_type(4)));
typedef unsigned u32x4 __attribute__((ext_vector_type(4)));
constexpr int BM = 256, BK = 64, HALF = 128, HTB = HALF * BK * 2  , STAGE_BYTES = 8 * HTB, NXCD = 8, WGM = 8;

__host__ __device__ __forceinline__ int lds_byte(int r, int c) { const int st = (r >> 4) * 2 + (c >> 5), rr = r & 15, cc = c & 31, ob = rr * 64 + cc * 2; return st * 1024 + (ob ^ (((ob >> 9) & 1) << 5)); }
__host__ __device__ __forceinline__ void stage_rc(int b, int& R, int& C) { const int st = b / 1024, sb = b % 1024, swz = sb ^ (((sb >> 9) & 1) << 5); R = (st >> 1) * 16 + swz / 64; C = (st & 1) * 32 + (swz % 64) / 2; }
__host__ __device__ __forceinline__ int perm32(int rho) { const int n = rho >> 4, i = rho & 15; return 8 * (i >> 2) + 4 * n + (i & 3); }

struct Unit { int pm, pn, pb, src; };
struct Gemm { const bf16_t* A; const bf16_t* Bt; int M, N, K; const bf16_t* A2; const bf16_t* Bt2; };

struct StaticOrder {
    int nM, nN, nwg, G, c;
    __host__ __device__ void init(int M, int N, int G_, int c_) { nM = M / BM; nN = N / BM; nwg = nM * nN; G = G_; c = c_; }
    __host__ __device__ __forceinline__ bool next(int i, Unit& u) const {
        const long L = (long)i * G + c; if (L >= nwg) return false;
        int wgid = (int)L; { const int q = nwg / NXCD, r = nwg % NXCD, xcd = wgid % NXCD, off = wgid / NXCD; wgid = (xcd < r ? xcd * (q + 1) : r * (q + 1) + (xcd - r) * q) + off; }
        const int nig = WGM * nN, gid = wgid / nig, fm = gid * WGM, gsz = (nM - fm) < WGM ? (nM - fm) : WGM;
        u.pm = fm + ((wgid % nig) % gsz); u.pn = (wgid % nig) / gsz; u.pb = u.pn; u.src = 0; return true;
    }
    __device__ __forceinline__ void a_ready(const Unit&) const {}
    __device__ __forceinline__ void done(const Unit&) const {}
};


typedef int v8i32 __attribute__((ext_vector_type(8)));
__device__ __forceinline__ bf16x8 lo8(v8i32 v) { typedef int v4i32 __attribute__((ext_vector_type(4))); return __builtin_bit_cast(bf16x8, (v4i32){v[0], v[1], v[2], v[3]}); }
__device__ __forceinline__ bf16x8 hi8(v8i32 v) { typedef int v4i32 __attribute__((ext_vector_type(4))); return __builtin_bit_cast(bf16x8, (v4i32){v[4], v[5], v[6], v[7]}); }
__device__ __forceinline__ v8i32 cat8(bf16x8 a, bf16x8 b) { typedef int v4i32 __attribute__((ext_vector_type(4))); const v4i32 x = __builtin_bit_cast(v4i32, a), y = __builtin_bit_cast(v4i32, b); return (v8i32){x[0], x[1], x[2], x[3], y[0], y[1], y[2], y[3]}; }
template <class Epi, class Sched, bool ALIGN_EPI = false, bool SP2 = false, bool F8 = false>
__device__ __forceinline__ void gemm_phase(PG8_LAS unsigned char* lds, const Gemm g, const Sched& S, const Epi& E) {
    const int tid = threadIdx.x, wid = __builtin_amdgcn_readfirstlane(tid >> 6), lane = tid & 63, wr = wid >> 2, wc = wid & 3, fr = lane & 15, fq = lane >> 4;
    const int K = g.K, nt = K / BK;
    unsigned voffA[2], voffB[2];
#pragma unroll
    for (int i = 0; i < 2; ++i) { int R, C; stage_rc(tid * 16 + i * 8192, R, C); const int Rb = Epi::PERM ? ((R & ~31) + perm32(R & 31)) : R;
        voffA[i] = (unsigned)(R * K + C) * 2u; voffB[i] = (unsigned)(Rb * K + C) * 2u; }
    const size_t kstep = (size_t)(BK * 2);
    const size_t hstep = (size_t)HALF * K * 2;
    const size_t tstep = 2 * hstep;
    const unsigned ldsw = (unsigned)wid * 1024u;
    const int aoff = lds_byte(wr * 64 + fr, fq * 8), boff = lds_byte(wc * 32 + fr, fq * 8);
#define PG8_SA(b, h) (((b) * 2 + (h)) * HTB)
#define PG8_SB(b, h) ((4 + (b) * 2 + (h)) * HTB)
#define PG8_STAGE(bufoff, gbase, voff) do { _Pragma("unroll") for (int _i = 0; _i < 2; ++_i) \
        __builtin_amdgcn_global_load_lds((const unsigned*)((const char*)(gbase) + (voff)[_i]), (PG8_LAS unsigned*)(lds + (bufoff) + ldsw + _i * 8192), 16, 0, 0); } while (0)
#define PG8_LDA(dst, b, h) do { _Pragma("unroll") for (int m = 0; m < 4; ++m) dst[m] = cat8(*(const PG8_LAS bf16x8*)(lds + PG8_SA(b, h) + aoff + m * 2048), *(const PG8_LAS bf16x8*)(lds + PG8_SA(b, h) + aoff + m * 2048 + 1024)); } while (0)
#define PG8_LDB(dst, b, h) do { _Pragma("unroll") for (int n = 0; n < 2; ++n) dst[n] = cat8(*(const PG8_LAS bf16x8*)(lds + PG8_SB(b, h) + boff + n * 2048), *(const PG8_LAS bf16x8*)(lds + PG8_SB(b, h) + boff + n * 2048 + 1024)); } while (0)
#define PG8_MMA(ai, bj, At, Bt) do { __builtin_amdgcn_s_setprio(1); _Pragma("unroll") for (int m = 0; m < 4; ++m) _Pragma("unroll") for (int n = 0; n < 2; ++n) { \
        if constexpr (F8) asm volatile("v_mfma_scale_f32_16x16x128_f8f6f4 %0, %1, %2, %0, %3, %3 op_sel_hi:[0,0,0]" : "+v"(acc[ai][bj][m][n]) : "v"(Bt[n]), "v"(At[m]), "v"(f8scale)); \
        else { acc[ai][bj][m][n] = __builtin_amdgcn_mfma_f32_16x16x32_bf16(lo8(Bt[n]), lo8(At[m]), acc[ai][bj][m][n], 0, 0, 0); acc[ai][bj][m][n] = __builtin_amdgcn_mfma_f32_16x16x32_bf16(hi8(Bt[n]), hi8(At[m]), acc[ai][bj][m][n], 0, 0, 0); } } __builtin_amdgcn_s_setprio(0); } while (0)
#define PG8_WAIT_V(n) asm volatile("s_waitcnt vmcnt(" #n ")" ::: "memory")
#define PG8_WAIT_L(n) asm volatile("s_waitcnt lgkmcnt(" #n ")" ::: "memory")
#define PG8_BAR __builtin_amdgcn_s_barrier()
#define PG8_SCHED __builtin_amdgcn_sched_barrier(0)
    Unit cur, nxt; int ui = 0;
    if (!S.next(0, cur)) return;
    f32x4 acc[2][2][4][2];
#pragma unroll
    for (int a = 0; a < 2; ++a)
#pragma unroll
        for (int b = 0; b < 2; ++b)
#pragma unroll
            for (int m = 0; m < 4; ++m)
#pragma unroll
                for (int n = 0; n < 2; ++n) { acc[a][b][m][n] = (f32x4){0.f, 0.f, 0.f, 0.f}; if constexpr (F8) asm volatile("" : "+v"(acc[a][b][m][n])); }
    int f8scale = 0x7f7f7f7f; if constexpr (F8) asm volatile("" : "+v"(f8scale));
    v8i32 At[4], B0[2], B1[2];
    const char* cA = (const char*)(cur.src ? g.A2 : g.A) + (size_t)cur.pm * tstep; const char* cB = (const char*)(cur.src ? g.Bt2 : g.Bt) + (size_t)cur.pb * tstep;
    S.a_ready(cur);
    if constexpr (SP2) {
        PG8_STAGE(PG8_SB(0, 0), cB, voffB); PG8_STAGE(PG8_SB(0, 1), cB + hstep, voffB); PG8_STAGE(PG8_SA(0, 0), cA, voffA); PG8_STAGE(PG8_SA(0, 1), cA + hstep, voffA);
        if (wr == 1) PG8_BAR;
        PG8_WAIT_V(2); PG8_BAR;
        PG8_STAGE(PG8_SB(1, 0), cB + kstep, voffB); PG8_STAGE(PG8_SA(1, 0), cA + kstep, voffA); PG8_STAGE(PG8_SB(1, 1), cB + hstep + kstep, voffB);
        PG8_WAIT_V(6); PG8_BAR;
    } else {
        PG8_STAGE(PG8_SB(0, 0), cB, voffB); PG8_STAGE(PG8_SA(0, 0), cA, voffA); PG8_STAGE(PG8_SB(0, 1), cB + hstep, voffB); PG8_STAGE(PG8_SA(0, 1), cA + hstep, voffA);
        if (wr == 1) PG8_BAR;
        PG8_WAIT_V(4); PG8_BAR;
        PG8_STAGE(PG8_SB(1, 0), cB + kstep, voffB); PG8_STAGE(PG8_SA(1, 0), cA + kstep, voffA); PG8_STAGE(PG8_SB(1, 1), cB + hstep + kstep, voffB);
        PG8_WAIT_V(6); PG8_BAR;
    }
    for (;;) {
        const bool has_next = S.next(ui + 1, nxt);
        const char* nA = has_next ? (const char*)(nxt.src ? g.A2 : g.A) + (size_t)nxt.pm * tstep : cA; const char* nB = has_next ? (const char*)(nxt.src ? g.Bt2 : g.Bt) + (size_t)nxt.pb * tstep : cB;
        for (int t = 0; t < nt; t += 2) {
            const bool last = (t == nt - 2);
            const char* a1 = cA + (size_t)(t + 1) * kstep;
            const char* a2 = last ? nA : cA + (size_t)(t + 2) * kstep; const char* b2 = last ? nB : cB + (size_t)(t + 2) * kstep;
            const char* a3 = a2 + kstep; const char* b3 = b2 + kstep;
            if (last && has_next) S.a_ready(nxt);
            if constexpr (SP2) {
            PG8_LDB(B0, 0, 0); PG8_LDB(B1, 0, 1); PG8_SCHED; PG8_LDA(At, 0, 0); PG8_STAGE(PG8_SA(1, 1), a1 + hstep, voffA);
            PG8_WAIT_V(8); PG8_WAIT_L(0); PG8_BAR; PG8_MMA(0, 0, At, B0); PG8_MMA(0, 1, At, B1); PG8_BAR; PG8_SCHED;
            PG8_LDA(At, 0, 1); PG8_STAGE(PG8_SB(0, 0), b2, voffB); PG8_STAGE(PG8_SB(0, 1), b2 + hstep, voffB); PG8_STAGE(PG8_SA(0, 0), a2, voffA);
            PG8_WAIT_V(8); PG8_WAIT_L(0); PG8_BAR; PG8_MMA(1, 0, At, B0); PG8_MMA(1, 1, At, B1); PG8_BAR; PG8_SCHED;
            PG8_LDB(B0, 1, 0); PG8_LDB(B1, 1, 1); PG8_SCHED; PG8_LDA(At, 1, 0); PG8_STAGE(PG8_SA(0, 1), a2 + hstep, voffA);
            PG8_WAIT_V(8); PG8_WAIT_L(0); PG8_BAR; PG8_MMA(0, 0, At, B0); PG8_MMA(0, 1, At, B1); PG8_BAR; PG8_SCHED;
            PG8_LDA(At, 1, 1); PG8_STAGE(PG8_SB(1, 0), b3, voffB); PG8_STAGE(PG8_SB(1, 1), b3 + hstep, voffB); PG8_STAGE(PG8_SA(1, 0), a3, voffA);
            PG8_WAIT_V(8); PG8_WAIT_L(0); PG8_BAR; PG8_MMA(1, 0, At, B0); PG8_MMA(1, 1, At, B1); PG8_BAR; PG8_SCHED;
            } else {
            PG8_LDB(B0, 0, 0); PG8_SCHED; PG8_LDA(At, 0, 0); PG8_STAGE(PG8_SA(1, 1), a1 + hstep, voffA);
            PG8_WAIT_L(8); PG8_BAR; PG8_WAIT_L(0); PG8_MMA(0, 0, At, B0); PG8_BAR; PG8_SCHED;
            PG8_LDB(B1, 0, 1); PG8_STAGE(PG8_SB(0, 0), b2, voffB);
            PG8_BAR; PG8_WAIT_L(0); PG8_MMA(0, 1, At, B1); PG8_BAR;
            PG8_LDA(At, 0, 1); PG8_STAGE(PG8_SA(0, 0), a2, voffA);
            PG8_BAR; PG8_WAIT_L(0); PG8_MMA(1, 0, At, B0); PG8_BAR; PG8_SCHED;
            PG8_STAGE(PG8_SB(0, 1), b2 + hstep, voffB);
            PG8_WAIT_V(6); PG8_BAR; PG8_MMA(1, 1, At, B1); PG8_BAR;
            PG8_LDB(B0, 1, 0); PG8_SCHED; PG8_LDA(At, 1, 0); PG8_STAGE(PG8_SA(0, 1), a2 + hstep, voffA);
            PG8_WAIT_L(8); PG8_BAR; PG8_WAIT_L(0); PG8_MMA(0, 0, At, B0); PG8_BAR; PG8_SCHED;
            PG8_LDB(B1, 1, 1); PG8_STAGE(PG8_SB(1, 0), b3, voffB);
            PG8_BAR; PG8_WAIT_L(0); PG8_MMA(0, 1, At, B1); PG8_BAR;
            PG8_LDA(At, 1, 1); PG8_STAGE(PG8_SA(1, 0), a3, voffA);
            PG8_BAR; PG8_WAIT_L(0); PG8_MMA(1, 0, At, B0); PG8_BAR; PG8_SCHED;
            PG8_STAGE(PG8_SB(1, 1), b3 + hstep, voffB);
            PG8_WAIT_V(6); PG8_BAR; PG8_MMA(1, 1, At, B1); PG8_BAR;
            }
        }
        if constexpr (ALIGN_EPI) { if (wr == 0) PG8_BAR; }
        if constexpr (F8) asm volatile("s_nop 15\n\ts_nop 15" ::: "memory");
#ifdef DOUBLE_EPI
        if constexpr (!Epi::AFTER_DRAIN && !Epi::CHAIN && Epi::ID == DOUBLE_EPI) { E(acc, cur, wr, wc, fr, fq); asm volatile("" ::: "memory"); }
#endif
        if constexpr (!Epi::AFTER_DRAIN) { E(acc, cur, wr, wc, fr, fq); S.done(cur); }
        if (!has_next) break;
        if (!(Epi::CHAIN && cur.src == 0))
#pragma unroll
        for (int a = 0; a < 2; ++a)
#pragma unroll
            for (int b = 0; b < 2; ++b)
#pragma unroll
                for (int m = 0; m < 4; ++m)
#pragma unroll
                    for (int n = 0; n < 2; ++n) { acc[a][b][m][n] = (f32x4){0.f, 0.f, 0.f, 0.f}; if constexpr (F8) asm volatile("" : "+v"(acc[a][b][m][n])); }
        cur = nxt; cA = nA; cB = nB; ++ui;
        if constexpr (ALIGN_EPI) { if (wr == 1) PG8_BAR; }
    }
    PG8_WAIT_V(0);
    if constexpr (!ALIGN_EPI) { if (wr == 0) PG8_BAR; }
    PG8_BAR;
    if constexpr (Epi::AFTER_DRAIN) { E.fused(acc, cur, wr, wc, fr, fq, lds, wid, lane); S.done(cur); }
#undef PG8_SA
#undef PG8_SB
#undef PG8_STAGE
#undef PG8_LDA
#undef PG8_LDB
#undef PG8_MMA
#undef PG8_WAIT_V
#undef PG8_WAIT_L
#undef PG8_BAR
#undef PG8_SCHED
}
}

#ifdef NANCHK_ON
#define NANCHK(cond, id) do { if (cond) atomicAdd((unsigned*)(((const float* const __attribute__((address_space(4)))*)__builtin_amdgcn_kernarg_segment_ptr())[21]) + 12288 + 64 * (id), 1u); } while (0)
#else
#define NANCHK(cond, id) do { } while (0)
#endif
namespace pg8 {
typedef unsigned u32x2 __attribute__((ext_vector_type(2)));
__device__ __forceinline__ unsigned cvt_pk_bf16(float lo, float hi) { unsigned r; asm volatile("v_cvt_pk_bf16_f32 %0, %1, %2" : "=v"(r) : "v"(lo), "v"(hi)); return r; }
__device__ __forceinline__ float bf_lo(unsigned w) { return __uint_as_float(w << 16); }
__device__ __forceinline__ float bf_hi(unsigned w) { return __uint_as_float(w & 0xffff0000u); }
__device__ __forceinline__ float frcp(float x) { return __builtin_amdgcn_rcpf(x); }
__device__ __forceinline__ float sigm(float x) { return frcp(1.f + __expf(-x)); }

struct GroupedOrder {
    int nM, nN, nwg, G, c; const PG8_LAS int* tile_e;
    __device__ void init(int ntiles, int nN_, int G_, int c_, const PG8_LAS int* te) { nM = ntiles; nN = nN_; nwg = nM * nN; G = G_; c = c_; tile_e = te; }
    __device__ __forceinline__ bool next(int i, Unit& u) const {
        const long L = (long)i * G + c; if (L >= nwg) return false;
        int wgid = (int)L; { const int q = nwg / NXCD, r = nwg % NXCD, xcd = wgid % NXCD, off = wgid / NXCD; wgid = (xcd < r ? xcd * (q + 1) : r * (q + 1) + (xcd - r) * q) + off; }
        const int nig = WGM * nN, gid = wgid / nig, fm = gid * WGM, gsz = (nM - fm) < WGM ? (nM - fm) : WGM;
        u.pm = fm + ((wgid % nig) % gsz); u.pn = (wgid % nig) / gsz; u.pb = tile_e[u.pm] * nN + u.pn; u.src = 0; return true;
    }
    __device__ __forceinline__ void a_ready(const Unit&) const {}
    __device__ __forceinline__ void done(const Unit&) const {}
};

struct EpiU {
    static constexpr bool PERM = true, AFTER_DRAIN = false, CHAIN = false; static constexpr int ID = 1;
    bf16_t* O; int ldc;
    __device__ __forceinline__ void operator()(const f32x4 (&acc)[2][2][4][2], const Unit& u, int wr, int wc, int fr, int fq) const {
        NANCHK((acc[0][0][0][0][0] != acc[0][0][0][0][0]) || (acc[1][1][3][1][3] != acc[1][1][3][1][3]) || (acc[0][1][2][0][1] != acc[0][1][2][0][1]) || (acc[1][0][1][1][2] != acc[1][0][1][1][2]), 2);
        const int row0 = u.pm * BM + wr * 64 + fr, col0 = u.pn * BM + wc * 32 + 8 * fq;
#pragma unroll
        for (int ai = 0; ai < 2; ++ai)
#pragma unroll
            for (int m = 0; m < 4; ++m) { bf16_t* rowp = O + (size_t)(row0 + ai * HALF + m * 16) * ldc + col0;
#pragma unroll
                for (int bj = 0; bj < 2; ++bj) { const f32x4 v0 = acc[ai][bj][m][0], v1 = acc[ai][bj][m][1];
                    u32x4 w; w.x = cvt_pk_bf16(v0[0], v0[1]); w.y = cvt_pk_bf16(v0[2], v0[3]); w.z = cvt_pk_bf16(v1[0], v1[1]); w.w = cvt_pk_bf16(v1[2], v1[3]);
                    *(u32x4*)(rowp + bj * HALF) = w; } }
    }
};
struct EpiSsd {
    static constexpr bool PERM = false, AFTER_DRAIN = false, CHAIN = false; static constexpr int ID = 90;
    float* TMP; const bf16_t* G; int ldg; const PG8_LAS float* tab; const PG8_LAS int* tpm;
    __device__ __forceinline__ void operator()(const f32x4 (&acc)[2][2][4][2], const Unit& u, int wr, int wc, int fr, int fq) const {
        NANCHK((acc[0][0][0][0][0] != acc[0][0][0][0][0]) || (acc[1][1][3][1][3] != acc[1][1][3][1][3]) || (acc[0][1][2][0][1] != acc[0][1][2][0][1]) || (acc[1][0][1][1][2] != acc[1][0][1][1][2]), 3);
        const int row0 = u.pm * BM + wr * 64 + fr, col0 = u.pn * BM + wc * 32 + 4 * fq;
        const int slot = tpm[0] == u.pm ? 0 : (tpm[1] == u.pm ? 1 : (tpm[2] == u.pm ? 2 : 3));
#pragma unroll
        for (int ai = 0; ai < 2; ++ai)
#pragma unroll
            for (int m = 0; m < 4; ++m) { const int row = row0 + ai * HALF + m * 16; const float rs = tab[slot * 256 + (row & 255)];
#pragma unroll
                for (int bj = 0; bj < 2; ++bj)
#pragma unroll
                    for (int n = 0; n < 2; ++n) { const int c = col0 + bj * HALF + n * 16; const u32x2 g = *(const u32x2*)(G + (size_t)row * ldg + c);
                        const f32x4 a = acc[ai][bj][m][n]; f32x4 o;
                        o[0] = a[0] * rs * sigm(bf_lo(g.x)); o[1] = a[1] * rs * sigm(bf_hi(g.x)); o[2] = a[2] * rs * sigm(bf_lo(g.y)); o[3] = a[3] * rs * sigm(bf_hi(g.y));
                        *(f32x4*)(TMP + (size_t)row * 2048 + c) = o; } }
    }
};
struct EpiAttn {
    static constexpr bool PERM = true, AFTER_DRAIN = false, CHAIN = false; static constexpr int ID = 91;
    bf16_t* MG; const float* TMP; const bf16_t* G; int ldg;
    __device__ __forceinline__ void operator()(const f32x4 (&acc)[2][2][4][2], const Unit& u, int wr, int wc, int fr, int fq) const {
        NANCHK((acc[0][0][0][0][0] != acc[0][0][0][0][0]) || (acc[1][1][3][1][3] != acc[1][1][3][1][3]) || (acc[0][1][2][0][1] != acc[0][1][2][0][1]) || (acc[1][0][1][1][2] != acc[1][0][1][1][2]), 4);
        const int row0 = u.pm * BM + wr * 64 + fr, col0 = u.pn * BM + wc * 32 + 8 * fq;
#pragma unroll
        for (int ai = 0; ai < 2; ++ai)
#pragma unroll
            for (int m = 0; m < 4; ++m) { const int row = row0 + ai * HALF + m * 16;
#pragma unroll
                for (int bj = 0; bj < 2; ++bj) { const int c = col0 + bj * HALF; const u32x4 g = *(const u32x4*)(G + (size_t)row * ldg + c);
                    const f32x4 t0 = *(const f32x4*)(TMP + (size_t)row * 2048 + c), t1 = *(const f32x4*)(TMP + (size_t)row * 2048 + c + 4);
                    const f32x4 a0 = acc[ai][bj][m][0], a1 = acc[ai][bj][m][1];
                    u32x4 w;
                    w.x = cvt_pk_bf16(t0[0] + a0[0] * sigm(bf_lo(g.x)), t0[1] + a0[1] * sigm(bf_hi(g.x)));
                    w.y = cvt_pk_bf16(t0[2] + a0[2] * sigm(bf_lo(g.y)), t0[3] + a0[3] * sigm(bf_hi(g.y)));
                    w.z = cvt_pk_bf16(t1[0] + a1[0] * sigm(bf_lo(g.z)), t1[1] + a1[1] * sigm(bf_hi(g.z)));
                    w.w = cvt_pk_bf16(t1[2] + a1[2] * sigm(bf_lo(g.w)), t1[3] + a1[3] * sigm(bf_hi(g.w)));
                    *(u32x4*)(MG + (size_t)row * 2048 + c) = w; } }
    }
};
struct ChainOrder {
    StaticOrder base;
    __device__ __forceinline__ bool next(int i, Unit& u) const { if (!base.next(i >> 1, u)) return false; u.src = i & 1; return true; }
    __device__ __forceinline__ void a_ready(const Unit&) const {}
    __device__ __forceinline__ void done(const Unit&) const {}
};
struct EpiMerge {
    static constexpr bool PERM = true, AFTER_DRAIN = false, CHAIN = true; static constexpr int ID = 6;
    bf16_t* MG; const bf16_t* GS; const bf16_t* GA; int ldg; const PG8_LAS float* tab; const PG8_LAS int* tpm;
    __device__ __forceinline__ void operator()(f32x4 (&acc)[2][2][4][2], const Unit& u, int wr, int wc, int fr, int fq) const {
        const int row0 = u.pm * BM + wr * 64 + fr, col0 = u.pn * BM + wc * 32 + 8 * fq;
        const int slot = tpm[0] == u.pm ? 0 : (tpm[1] == u.pm ? 1 : (tpm[2] == u.pm ? 2 : 3));
#pragma unroll
        for (int ai = 0; ai < 2; ++ai) {
            u32x4 gav[4][2], gsv[4][2];
#pragma unroll
            for (int m = 0; m < 4; ++m)
#pragma unroll
                for (int bj = 0; bj < 2; ++bj) { const size_t o = (size_t)(row0 + ai * HALF + m * 16) * ldg + col0 + bj * HALF; gav[m][bj] = *(const u32x4*)(GA + o); gsv[m][bj] = (u32x4){0u, 0u, 0u, 0u}; }
            if (u.src == 0) {
#pragma unroll
                for (int m = 0; m < 4; ++m)
#pragma unroll
                    for (int bj = 0; bj < 2; ++bj) gsv[m][bj] = *(const u32x4*)(GS + (size_t)(row0 + ai * HALF + m * 16) * ldg + col0 + bj * HALF); }
            __builtin_amdgcn_sched_barrier(0);
#pragma unroll
            for (int m = 0; m < 4; ++m) { const int row = row0 + ai * HALF + m * 16;
#pragma unroll
                for (int bj = 0; bj < 2; ++bj) { const int c = col0 + bj * HALF; const u32x4 ga = gav[m][bj];
                    float ea[8] = {1.f + __expf(-bf_lo(ga.x)), 1.f + __expf(-bf_hi(ga.x)), 1.f + __expf(-bf_lo(ga.y)), 1.f + __expf(-bf_hi(ga.y)), 1.f + __expf(-bf_lo(ga.z)), 1.f + __expf(-bf_hi(ga.z)), 1.f + __expf(-bf_lo(ga.w)), 1.f + __expf(-bf_hi(ga.w))};
                    f32x4& a0 = acc[ai][bj][m][0]; f32x4& a1 = acc[ai][bj][m][1];
                    if (u.src == 0) { const float rs = tab[slot * 256 + (row & 255)]; const u32x4 gs = gsv[m][bj];
                        a0[0] *= rs * ea[0] * sigm(bf_lo(gs.x)); a0[1] *= rs * ea[1] * sigm(bf_hi(gs.x)); a0[2] *= rs * ea[2] * sigm(bf_lo(gs.y)); a0[3] *= rs * ea[3] * sigm(bf_hi(gs.y));
                        a1[0] *= rs * ea[4] * sigm(bf_lo(gs.z)); a1[1] *= rs * ea[5] * sigm(bf_hi(gs.z)); a1[2] *= rs * ea[6] * sigm(bf_lo(gs.w)); a1[3] *= rs * ea[7] * sigm(bf_hi(gs.w)); }
                    else { u32x4 w; w.x = cvt_pk_bf16(a0[0] * frcp(ea[0]), a0[1] * frcp(ea[1])); w.y = cvt_pk_bf16(a0[2] * frcp(ea[2]), a0[3] * frcp(ea[3])); w.z = cvt_pk_bf16(a1[0] * frcp(ea[4]), a1[1] * frcp(ea[5])); w.w = cvt_pk_bf16(a1[2] * frcp(ea[6]), a1[3] * frcp(ea[7]));
                        *(u32x4*)(MG + (size_t)row * 2048 + c) = w; } } } }
    }
};
struct EpiOut {
    static constexpr bool PERM = false, AFTER_DRAIN = false, CHAIN = false; static constexpr int ID = 8;
    float* H1; const float* X;
    __device__ __forceinline__ void operator()(const f32x4 (&acc)[2][2][4][2], const Unit& u, int wr, int wc, int fr, int fq) const {
        NANCHK((acc[0][0][0][0][0] != acc[0][0][0][0][0]) || (acc[1][1][3][1][3] != acc[1][1][3][1][3]) || (acc[0][1][2][0][1] != acc[0][1][2][0][1]) || (acc[1][0][1][1][2] != acc[1][0][1][1][2]), 5);
        const int row0 = u.pm * BM + wr * 64 + fr, col0 = u.pn * BM + wc * 32 + 4 * fq;
#pragma unroll
        for (int ai = 0; ai < 2; ++ai) {
            f32x4 xv[4][2][2];
#pragma unroll
            for (int m = 0; m < 4; ++m) { const size_t ro = (size_t)(row0 + ai * HALF + m * 16) * 2048;
#pragma unroll
                for (int bj = 0; bj < 2; ++bj)
#pragma unroll
                    for (int n = 0; n < 2; ++n) xv[m][bj][n] = *(const f32x4*)(X + ro + col0 + bj * HALF + n * 16); }
            __builtin_amdgcn_sched_barrier(0);
#pragma unroll
            for (int m = 0; m < 4; ++m) { const size_t ro = (size_t)(row0 + ai * HALF + m * 16) * 2048;
#pragma unroll
                for (int bj = 0; bj < 2; ++bj)
#pragma unroll
                    for (int n = 0; n < 2; ++n) { const int c = col0 + bj * HALF + n * 16; *(f32x4*)(H1 + ro + c) = xv[m][bj][n] + acc[ai][bj][m][n]; } } }
    }
};
__device__ __forceinline__ unsigned pk4_fp8(float a, float b, float c, float d) {
    a = fminf(fmaxf(a, -448.f), 448.f); b = fminf(fmaxf(b, -448.f), 448.f); c = fminf(fmaxf(c, -448.f), 448.f); d = fminf(fmaxf(d, -448.f), 448.f);
    int w = 0; w = __builtin_amdgcn_cvt_pk_fp8_f32(a, b, w, false); w = __builtin_amdgcn_cvt_pk_fp8_f32(c, d, w, true); return (unsigned)w; }
constexpr float F8_SX = 16.f, F8_SW = 1024.f, F8_SA = 4.f;
__device__ __forceinline__ float swiglu1(float g, float l) { g = fminf(g, 7.0f); l = fminf(fmaxf(l, -7.0f), 7.0f); return g * sigm(1.702f * g) * (l + 1.0f); }
struct EpiSwiglu {
    static constexpr bool PERM = true, AFTER_DRAIN = false, CHAIN = false; static constexpr int ID = 11;
    bf16_t* ACT; const float* b1;
    __device__ __forceinline__ void operator()(const f32x4 (&acc)[2][2][4][2], const Unit& u, int wr, int wc, int fr, int fq) const {
        NANCHK((acc[0][0][0][0][0] != acc[0][0][0][0][0]) || (acc[1][1][3][1][3] != acc[1][1][3][1][3]) || (acc[0][1][2][0][1] != acc[0][1][2][0][1]) || (acc[1][0][1][1][2] != acc[1][0][1][1][2]), 6);
        const int row0 = u.pm * BM + wr * 64 + fr, e = u.pb >> 4, j0 = u.pn * 128 + wc * 32 + 8 * fq;
        constexpr float DS = 1.0f / (F8_SX * F8_SW);
        const float* bg0 = b1 + (size_t)e * 4096 + j0; const f32x4 bg_[2] = {*(const f32x4*)bg0, *(const f32x4*)(bg0 + 4)}, bl_[2] = {*(const f32x4*)(bg0 + 2048), *(const f32x4*)(bg0 + 2052)};
        __builtin_amdgcn_sched_barrier(0);
        unsigned roff = (unsigned)row0 * 2048u + (unsigned)j0; asm volatile("" : "+v"(roff));
#pragma unroll
        for (int ai = 0; ai < 2; ++ai)
#pragma unroll
            for (int m = 0; m < 4; ++m) { unsigned w2[2];
#pragma unroll
                for (int n = 0; n < 2; ++n) { const f32x4 bgv = bg_[n], blv = bl_[n];
                    f32x4 g = acc[ai][0][m][n] * DS + bgv, l = acc[ai][1][m][n] * DS + blv;
                    g[0] = fminf(g[0], 7.0f); g[1] = fminf(g[1], 7.0f); g[2] = fminf(g[2], 7.0f); g[3] = fminf(g[3], 7.0f);
                    l[0] = fminf(fmaxf(l[0], -7.0f), 7.0f); l[1] = fminf(fmaxf(l[1], -7.0f), 7.0f); l[2] = fminf(fmaxf(l[2], -7.0f), 7.0f); l[3] = fminf(fmaxf(l[3], -7.0f), 7.0f);
                    const f32x4 t = g * (-1.702f * 1.4426950408889634f);
                    f32x4 e = {__builtin_amdgcn_exp2f(t[0]), __builtin_amdgcn_exp2f(t[1]), __builtin_amdgcn_exp2f(t[2]), __builtin_amdgcn_exp2f(t[3])};
                    e = e + 1.0f;
                    const f32x4 r = {frcp(e[0]), frcp(e[1]), frcp(e[2]), frcp(e[3])};
                    const f32x4 o = (g * r) * (l * F8_SA + F8_SA);
                    int w = 0; w = __builtin_amdgcn_cvt_pk_fp8_f32(o[0], o[1], w, false); w = __builtin_amdgcn_cvt_pk_fp8_f32(o[2], o[3], w, true); w2[n] = (unsigned)w; }
                *(u32x2*)((unsigned char*)ACT + (roff + (unsigned)(ai * HALF + m * 16) * 2048u)) = (u32x2){w2[0], w2[1]};
                __builtin_amdgcn_sched_barrier(0); }
    }
};
constexpr float F8_SH = 32.f;
#ifndef PK4TEST
#define PK4TEST pk4_fp8
#endif
struct EpiUp8 {
    static constexpr bool PERM = true, AFTER_DRAIN = false, CHAIN = false; static constexpr int ID = 92;
    unsigned char* H8; const float* b1;
    __device__ __forceinline__ void operator()(const f32x4 (&acc)[2][2][4][2], const Unit& u, int wr, int wc, int fr, int fq) const {
        const int row0 = u.pm * BM + wr * 64 + fr, e = u.pb >> 4, col0 = u.pn * BM + wc * 32 + 8 * fq;
#pragma unroll
        for (int bj = 0; bj < 2; ++bj) { const int c = col0 + bj * HALF; const float* bp = b1 + (size_t)e * 4096 + bj * 2048 + u.pn * 128 + wc * 32 + 8 * fq;
            const f32x4 b0 = *(const f32x4*)bp, b1v = *(const f32x4*)(bp + 4);
#pragma unroll
            for (int ai = 0; ai < 2; ++ai)
#pragma unroll
                for (int m = 0; m < 4; ++m) { const int row = row0 + ai * HALF + m * 16;
                    constexpr float DS = 1.0f / (F8_SX * F8_SW);
                    const f32x4 v0 = (acc[ai][bj][m][0] * DS + b0) * F8_SH, v1 = (acc[ai][bj][m][1] * DS + b1v) * F8_SH;
                    u32x2 w; w.x = PK4TEST(v0[0], v0[1], v0[2], v0[3]); w.y = PK4TEST(v1[0], v1[1], v1[2], v1[3]);
                    *(u32x2*)(H8 + (size_t)row * 4096 + c) = w; } }
    }
};
struct EpiMoeOut {
    static constexpr bool PERM = true, AFTER_DRAIN = false, CHAIN = false; static constexpr int ID = 13;
    bf16_t* OS; const float* b2;
    __device__ __forceinline__ void operator()(const f32x4 (&acc)[2][2][4][2], const Unit& u, int wr, int wc, int fr, int fq) const {
        NANCHK((acc[0][0][0][0][0] != acc[0][0][0][0][0]) || (acc[1][1][3][1][3] != acc[1][1][3][1][3]) || (acc[0][1][2][0][1] != acc[0][1][2][0][1]) || (acc[1][0][1][1][2] != acc[1][0][1][1][2]), 7);
        const int row0 = u.pm * BM + wr * 64 + fr, e = u.pb >> 3, col0 = u.pn * BM + wc * 32 + 8 * fq;
#pragma unroll
        for (int bj = 0; bj < 2; ++bj) { const int c = col0 + bj * HALF; const float* bp = b2 + (size_t)e * 2048 + c;
            const f32x4 b0 = *(const f32x4*)bp, b1v = *(const f32x4*)(bp + 4);
#pragma unroll
            for (int ai = 0; ai < 2; ++ai)
#pragma unroll
                for (int m = 0; m < 4; ++m) { const int row = row0 + ai * HALF + m * 16;
                    constexpr float DS = 1.0f / (F8_SA * F8_SW);
                    const f32x4 v0 = acc[ai][bj][m][0] * DS + b0, v1 = acc[ai][bj][m][1] * DS + b1v;
                    u32x4 w; w.x = cvt_pk_bf16(v0[0], v0[1]); w.y = cvt_pk_bf16(v0[2], v0[3]); w.z = cvt_pk_bf16(v1[0], v1[1]); w.w = cvt_pk_bf16(v1[2], v1[3]);
                    *(u32x4*)(OS + (size_t)row * 2048 + c) = w; } }
    }
};
}
namespace att {
constexpr int D = 128;
constexpr int KP = 2048, VP = 16128, QP = 2048, OP = 2048, MKSTRIDE = 8192;
constexpr float THR = 8.f;
constexpr bool WSKIP = false;
constexpr float SCALE = 0.08838834764831845f;
constexpr int NW = 8, QBLK = 32, KVBLK = 64, QB = NW * QBLK;
constexpr int SHM_V = KVBLK * D * 2, SHM_K = KVBLK * D * 2;
constexpr int LDS_BYTES = 2 * SHM_V + 2 * SHM_K + NW * 64 * 4 + 2 * 2048;
using bf16 = __hip_bfloat16;
typedef short bf16x8 __attribute__((ext_vector_type(8)));
typedef short s16x4 __attribute__((ext_vector_type(4)));
typedef float f32x16 __attribute__((ext_vector_type(16)));
typedef float f32x4 __attribute__((ext_vector_type(4)));
typedef unsigned u32x4 __attribute__((ext_vector_type(4)));
template <class A, class Bt> struct same_t { static constexpr bool v = false; };
template <class A> struct same_t<A, A> { static constexpr bool v = true; };
#define KSWZ(row, colB) ((row) * 256 + ((colB) ^ (((row) & 7) << 4)))
#define SBAR() __builtin_amdgcn_sched_barrier(0)
__device__ __forceinline__ int v_st(int k, int c) { const int kk = (k & ~0xC) | ((k & 4) << 1) | ((k & 8) >> 1); return ((kk >> 3) * 4 + (c >> 5)) * 512 + ((kk & 7) * 32 + (c & 31)) * 2; }
__device__ __forceinline__ int v_rd_base(int lane) { return ((lane & 3) << 3) | (((lane >> 2) & 3) << 6) | (((lane >> 4) & 1) << 5) | (((lane >> 5) & 1) << 8); }
constexpr int v_rd_off(int d0, int ks, int half) { return d0 * 512 + ks * 4096 + half * 2048; }
__device__ __forceinline__ int crow(int r, int hi) { return (r & 3) + 8 * (r >> 2) + 4 * hi; }
__device__ __forceinline__ unsigned cvtpk(float lo, float hi) {
    unsigned r; asm volatile("v_cvt_pk_bf16_f32 %0, %1, %2" : "=v"(r) : "v"(lo), "v"(hi)); return r;
}
__device__ __forceinline__ bf16x8 pack8(f32x4 a, f32x4 b) {
    u32x4 w = {cvtpk(a[0], a[1]), cvtpk(a[2], a[3]), cvtpk(b[0], b[1]), cvtpk(b[2], b[3])};
    return *reinterpret_cast<bf16x8*>(&w);
}
template <class T> __device__ __forceinline__ bf16x8 load8(const T* p) {
    if constexpr (same_t<T, float>::v) { return pack8(*(const f32x4*)p, *(const f32x4*)(p + 4)); }
    else { return *reinterpret_cast<const bf16x8*>(p); }
}
__device__ __forceinline__ void mask_bits(f32x16& p0, f32x16& p1, unsigned lo, unsigned hw, int hi) {
    const float NEG = -__builtin_inff();
    lo >>= 4 * hi; hw >>= 4 * hi;
#pragma unroll
    for (int r = 0; r < 16; ++r) {
        const int c = (r & 3) + 8 * (r >> 2);
        const unsigned m0 = (unsigned)((int)(lo << (31 - c)) >> 31), m1 = (unsigned)((int)(hw << (31 - c)) >> 31);
        p0[r] = __uint_as_float((__float_as_uint(p0[r]) & m0) | (~m0 & 0xff800000u));
        p1[r] = __uint_as_float((__float_as_uint(p1[r]) & m1) | (~m1 & 0xff800000u));
    }
}
__device__ __forceinline__ void partialSM(f32x16& p0, f32x16& p1, float& m_reg, float& mn, float& alpha) {
    float pmax = p0[0]; for (int r = 1; r < 16; ++r) pmax = fmaxf(pmax, p0[r]); for (int r = 0; r < 16; ++r) pmax = fmaxf(pmax, p1[r]);
    { auto rr = __builtin_amdgcn_permlane32_swap(__float_as_uint(pmax), __float_as_uint(pmax), false, false);
      pmax = fmaxf(__uint_as_float(rr[0]), __uint_as_float(rr[1])); }
    constexpr float C2 = 1.4426950408889634f * SCALE;
    if (__builtin_expect(__all((pmax - m_reg) * SCALE <= THR), 1)) { mn = m_reg; alpha = 1.f; }
    else { mn = fmaxf(m_reg, pmax); alpha = __builtin_amdgcn_exp2f((m_reg - mn) * C2); m_reg = mn; }
    const float mnL = -mn * C2;
    for (int r = 0; r < 16; ++r) p0[r] = fmaf(p0[r], C2, mnL); for (int r = 0; r < 16; ++r) p1[r] = fmaf(p1[r], C2, mnL);
    for (int r = 0; r < 16; ++r) p0[r] = __builtin_amdgcn_exp2f(p0[r]);
}
__device__ __forceinline__ void finishSM(f32x16& p0, f32x16& p1, float alpha, float& l_reg, bf16x8& pa0, bf16x8& pa1, bf16x8& pa2, bf16x8& pa3) {
    for (int r = 0; r < 16; ++r) p1[r] = __builtin_amdgcn_exp2f(p1[r]);
    float ps = 0; for (int r = 0; r < 16; ++r) ps += p0[r]; for (int r = 0; r < 16; ++r) ps += p1[r];
    { auto rr = __builtin_amdgcn_permlane32_swap(__float_as_uint(ps), __float_as_uint(ps), false, false);
      ps = __uint_as_float(rr[0]) + __uint_as_float(rr[1]); }
    l_reg = l_reg * alpha + ps;
#define PK4(P, B_, OUT) do { unsigned a0 = cvtpk(P[B_+0], P[B_+1]), a1 = cvtpk(P[B_+2], P[B_+3]);                          \
        unsigned b0 = cvtpk(P[B_+4], P[B_+5]), b1 = cvtpk(P[B_+6], P[B_+7]);                                             \
        auto r0 = __builtin_amdgcn_permlane32_swap(a0, b0, false, false); auto r1 = __builtin_amdgcn_permlane32_swap(a1, b1, false, false); \
        u32x4 w = {r0[0], r1[0], r0[1], r1[1]}; OUT = *reinterpret_cast<bf16x8*>(&w); } while (0)
    PK4(p0, 0, pa0); PK4(p0, 8, pa1); PK4(p1, 0, pa2); PK4(p1, 8, pa3);
#undef PK4
}
template <int KB, bool SK>
__device__ __forceinline__ void qkt(f32x16& p0, f32x16& p1, const char* K_lds, int r32, int hi, const bf16x8* qr, bool act) {
    if (SK && !act) { const float NEG = -__builtin_inff();
#pragma unroll
        for (int r = 0; r < 16; ++r) { p0[r] = NEG; p1[r] = NEG; } return; }
    p0 = f32x16{}; p1 = f32x16{};
    const char* kb[4];
#pragma unroll
    for (int dd = 0; dd < 4; ++dd) kb[dd] = K_lds + KB * SHM_K + KSWZ(r32, (dd * 16 + hi * 8) * 2);
#pragma unroll
    for (int d0 = 0; d0 < 8; ++d0) { const char* a = kb[d0 & 3] + (d0 >> 2) * 128;
        bf16x8 b0 = *reinterpret_cast<const bf16x8*>(a);
        bf16x8 b1 = *reinterpret_cast<const bf16x8*>(a + 32 * 256);
        p0 = __builtin_amdgcn_mfma_f32_32x32x16_bf16(b0, qr[d0], p0, 0, 0, 0);
        p1 = __builtin_amdgcn_mfma_f32_32x32x16_bf16(b1, qr[d0], p1, 0, 0, 0); }
}
template <int VB, bool SK>
__device__ __forceinline__ void pv_tile(f32x16* o, int vb0, bf16x8 pa0, bf16x8 pa1, bf16x8 pa2, bf16x8 pa3, bool act) {
    if (SK && !act) return;
#define TRRD(dst, off) asm volatile("ds_read_b64_tr_b16 %0, %1 offset:%2" : "=&v"(dst) : "v"(vb0), "i"(off) : "memory")
#define PV_D0(d0) do { s16x4 l0, l1, l2, l3, h0, h1, h2, h3; constexpr int b_ = VB * SHM_V + v_rd_off(d0, 0, 0);     \
        TRRD(l0, b_); TRRD(h0, b_ + 2048); TRRD(l1, b_ + 4096); TRRD(h1, b_ + 6144); TRRD(l2, b_ + 8192); TRRD(h2, b_ + 10240); TRRD(l3, b_ + 12288); TRRD(h3, b_ + 14336); \
        asm volatile("s_waitcnt lgkmcnt(0)" ::: "memory"); SBAR();                 \
        o[d0] = __builtin_amdgcn_mfma_f32_32x32x16_bf16(pa0, (bf16x8){l0[0], l0[1], l0[2], l0[3], h0[0], h0[1], h0[2], h0[3]}, o[d0], 0, 0, 0);   \
        o[d0] = __builtin_amdgcn_mfma_f32_32x32x16_bf16(pa1, (bf16x8){l1[0], l1[1], l1[2], l1[3], h1[0], h1[1], h1[2], h1[3]}, o[d0], 0, 0, 0);   \
        o[d0] = __builtin_amdgcn_mfma_f32_32x32x16_bf16(pa2, (bf16x8){l2[0], l2[1], l2[2], l2[3], h2[0], h2[1], h2[2], h2[3]}, o[d0], 0, 0, 0);   \
        o[d0] = __builtin_amdgcn_mfma_f32_32x32x16_bf16(pa3, (bf16x8){l3[0], l3[1], l3[2], l3[3], h3[0], h3[1], h3[2], h3[3]}, o[d0], 0, 0, 0); } while (0)
    PV_D0(0); PV_D0(1); PV_D0(2); PV_D0(3);
#undef PV_D0
#undef TRRD
}

template <class TIn, class TOut> struct BlockRef { const TIn* Q; const TIn* K; const TIn* V; TOut* O; const unsigned long long* MK; int P0; };
template <class TIn> struct Seam {
    bf16x8 qr[8];
    bf16x8 st_v0, st_v1, st_k0, st_k1; unsigned st_m; f32x4 sf0, sf1, sf2, sf3;
    f32x4 tq[16];
};
__device__ __forceinline__ int swa_jlo(int P0, int W) { const int lowk = P0 - W + 1; return lowk > 0 ? lowk / KVBLK : 0; }
#define ROW(p, k0, rr, PT) ((p) + (size_t)(k0) * (PT) + (unsigned)((rr) * (PT) + sc))
#define VMW() asm volatile("s_waitcnt vmcnt(0)" ::: "memory")
#define VMWN(n) asm volatile("s_waitcnt vmcnt(%0)" :: "i"(n) : "memory")
#define SLOAD_H(Kp, Vp, Mp, k0) do { S.st_v0 = load8<TIn>(ROW(Vp, k0, sr, VP)); S.st_v1 = load8<TIn>(ROW(Vp, k0, 32 + sr, VP)); S.st_m = ((const unsigned*)((Mp) + (size_t)((k0) >> 6) * MKSTRIDE))[tid]; \
                         S.st_k0 = load8<TIn>(ROW(Kp, k0, sr, KP)); S.st_k1 = load8<TIn>(ROW(Kp, k0, 32 + sr, KP)); } while (0)
#define SWRITE_HK(bf) do { *(bf16x8*)(K_lds + (bf) * SHM_K + kws) = S.st_k0; *(bf16x8*)(K_lds + (bf) * SHM_K + kws + 32 * 256) = S.st_k1; *(unsigned*)(K_lds + 2 * SHM_K + NW * 64 * 4 + (bf) * 2048 + tid * 4) = S.st_m; } while (0)
#define SWRITE_HV(bf) do { *(bf16x8*)(V_lds + (bf) * SHM_V + vst0) = S.st_v0; *(bf16x8*)(V_lds + (bf) * SHM_V + vst1) = S.st_v1; } while (0)
#define SWRITE_H(bf) do { SWRITE_HV(bf); SWRITE_HK(bf); } while (0)
#define SLOAD_F(p, k0) do { S.sf0 = *(const f32x4*)ROW(p, k0, sr, KP); S.sf1 = *(const f32x4*)(ROW(p, k0, sr, KP) + 4);                \
                            S.sf2 = *(const f32x4*)ROW(p, k0, 32 + sr, KP); S.sf3 = *(const f32x4*)(ROW(p, k0, 32 + sr, KP) + 4); } while (0)
#define SWRITE_KF(bf) do { *(bf16x8*)(K_lds + (bf) * SHM_K + kws) = pack8(S.sf0, S.sf1); *(bf16x8*)(K_lds + (bf) * SHM_K + kws + 32 * 256) = pack8(S.sf2, S.sf3); } while (0)
#define SWRITE_VF(bf) do { *(bf16x8*)(V_lds + (bf) * SHM_V + vst0) = pack8(S.sf0, S.sf1); *(bf16x8*)(V_lds + (bf) * SHM_V + vst1) = pack8(S.sf2, S.sf3); } while (0)
template <class TIn, class TOut>
__device__ __forceinline__ void causal_swa_prime(const BlockRef<TIn, TOut>& cur, int W, char* lds, Seam<TIn>& S) {
    constexpr bool F32 = same_t<TIn, float>::v;
    const int tid = threadIdx.x, wid = __builtin_amdgcn_readfirstlane(tid >> 6), lane = tid & 63, r32 = lane & 31, hi = lane >> 5;
    const int sr = tid >> 4, sc = (tid & 15) * 8, kws = KSWZ(sr, sc * 2); char* K_lds = lds + 2 * SHM_V;
    const int kb0 = swa_jlo(cur.P0, W) * KVBLK;
    for (int d0 = 0; d0 < 8; ++d0) S.qr[d0] = load8<TIn>(cur.Q + (size_t)(wid * QBLK) * QP + (unsigned)(r32 * QP + hi * 8) + d0 * 16);
    if constexpr (F32) { SLOAD_F((const float*)cur.K, kb0); VMW(); SWRITE_KF(0); SBAR(); SLOAD_F((const float*)cur.V, kb0); }
    else { SLOAD_H(cur.K, cur.V, cur.MK, kb0); VMW(); SWRITE_HK(0); }
    __syncthreads();
}
template <class TIn, class TOut>
__device__ __forceinline__ void causal_swa_block(const BlockRef<TIn, TOut>& cur, const BlockRef<TIn, TOut>& nxt, int skv, int W, char* lds, Seam<TIn>& S) {
    constexpr bool F32 = same_t<TIn, float>::v;
    const int tid = threadIdx.x, wid = __builtin_amdgcn_readfirstlane(tid >> 6), lane = tid & 63, r32 = lane & 31, hi = lane >> 5;
    const int j_lo = swa_jlo(cur.P0, W);
    int j_hi = (cur.P0 + QB - 1) / KVBLK + 1; if (j_hi > skv / KVBLK) j_hi = skv / KVBLK;
    const int NT = j_hi - j_lo;
    const int kbn = swa_jlo(nxt.P0, W) * KVBLK;
    const int qlo = cur.P0 + wid * QBLK, qm = qlo + r32 - 4 * hi;
    char* V_lds = lds; char* K_lds = lds + 2 * SHM_V;
    float* ws = (float*)(lds + 2 * SHM_V + 2 * SHM_K) + wid * 64; float* li_l = ws, * al_l = ws + 32;
    float m_reg = -1e30f, l_reg = 0; f32x16 o[4] = {};
    const int sr = tid >> 4, sc = (tid & 15) * 8, vst0 = v_st(sr, sc), vst1 = v_st(32 + sr, sc), kws = KSWZ(sr, sc * 2);
    const int vb0 = (int)(uintptr_t)V_lds + v_rd_base(lane);
    const TIn* Kh = cur.K; const TIn* Vh = cur.V;
#define RESC(a) do { if (__any((a) < 1.f)) { if (hi == 0) al_l[r32] = (a); asm volatile("s_waitcnt lgkmcnt(0)" ::: "memory");              \
                     for (int d_ = 0; d_ < 4; ++d_) for (int r = 0; r < 16; ++r) o[d_][r] *= al_l[crow(r, hi)]; } } while (0)
#define KBASE(t) ((j_lo + (t)) * KVBLK)
#define ACT(t) (KBASE(t) <= qlo + QBLK - 1 && KBASE(t) + KVBLK - 1 >= qlo - W + 1)
#define MASKT(P0_, P1_, KB_) do { const uint2 mw_ = *(const uint2*)(K_lds + 2 * SHM_K + NW * 64 * 4 + (KB_) * 2048 + (wid * QBLK + r32) * 8); mask_bits(P0_, P1_, mw_.x, mw_.y, hi); } while (0)
    constexpr int NQL = F32 ? 16 : 8;
    constexpr bool SK = WSKIP && !F32;
#define SEAM_K0() do { VMWN(NQL); if constexpr (F32) { SWRITE_KF(0); SBAR(); SLOAD_F((const float*)nxt.V, kbn); } else { SWRITE_HK(0); } SBAR(); } while (0)
    f32x16 pA0, pA1, pB0, pB1; float mnA, mnB, alA, alB; bf16x8 pa0, pa1, pa2, pa3;
    if constexpr (F32) { VMW(); SWRITE_VF(0); SBAR(); } else { SWRITE_HV(0); SBAR(); }
    if (NT > 1) { if constexpr (F32) SLOAD_F((const float*)Kh, KBASE(1)); else SLOAD_H(Kh, Vh, cur.MK, KBASE(1)); }
    SBAR(); qkt<0, SK>(pA0, pA1, K_lds, r32, hi, S.qr, ACT(0));
    if constexpr (F32) { if (NT > 1) { VMW(); SWRITE_KF(1); SBAR(); SLOAD_F((const float*)Vh, KBASE(1)); } }
    MASKT(pA0, pA1, 0); partialSM(pA0, pA1, m_reg, mnA, alA);
    if (NT > 1) { VMW(); if constexpr (F32) { SWRITE_VF(1); SBAR(); if (NT > 2) SLOAD_F((const float*)Kh, KBASE(2)); } else SWRITE_H(1); }
    __syncthreads();
#define HALF_STEP(PX0, PX1, mnX, alX, PY0, PY1, alY, t, KB, VB, SB) do {                                                      \
        SBAR(); qkt<KB, SK>(PX0, PX1, K_lds, r32, hi, S.qr, ACT(t));                                             \
        finishSM(PY0, PY1, alY, l_reg, pa0, pa1, pa2, pa3); SBAR();                                                           \
        if ((t) + 1 < NT) { if constexpr (F32) { VMW(); SWRITE_KF(SB); SBAR(); SLOAD_F((const float*)Vh, KBASE((t) + 1)); }  \
                            else { SLOAD_H(Kh, Vh, cur.MK, KBASE((t) + 1)); } SBAR(); }                                               \
        pv_tile<VB, SK>(o, vb0, pa0, pa1, pa2, pa3, ACT((t) - 1)); MASKT(PX0, PX1, KB); partialSM(PX0, PX1, m_reg, mnX, alX);                                        \
        __syncthreads();                                                                                                      \
        if ((t) + 1 < NT) { VMW(); if constexpr (F32) { SWRITE_VF(SB); SBAR(); if ((t) + 2 < NT) SLOAD_F((const float*)Kh, KBASE((t) + 2)); } \
                            else { SWRITE_H(SB); } }                                                                          \
        RESC(alX); __syncthreads(); } while (0)
    for (int t = 1; t + 1 < NT; t += 2) {
        HALF_STEP(pB0, pB1, mnB, alB, pA0, pA1, alA, t, 1, 0, 0);
        HALF_STEP(pA0, pA1, mnA, alA, pB0, pB1, alB, t + 1, 0, 1, 1);
    }
    const bool even = (NT & 1) == 0;
    if (even) { SBAR(); qkt<1, SK>(pB0, pB1, K_lds, r32, hi, S.qr, ACT(NT - 1)); SBAR(); }
#define QROW(e) (nxt.Q + (size_t)(wid * QBLK + r32) * QP + ((e) >> 1) * 16 + hi * 8 + ((e) & 1) * 4)
    if constexpr (F32) { SLOAD_F((const float*)nxt.K, kbn); SBAR();
#pragma unroll
        for (int e = 0; e < 8; ++e) S.tq[e] = *(const f32x4*)QROW(e); }
    else { SLOAD_H(nxt.K, nxt.V, nxt.MK, kbn); SBAR();
#pragma unroll
        for (int d0 = 0; d0 < 8; ++d0) S.qr[d0] = load8<TIn>(nxt.Q + (size_t)(wid * QBLK) * QP + (unsigned)(r32 * QP + hi * 8) + d0 * 16); }
    SBAR();
    finishSM(pA0, pA1, alA, l_reg, pa0, pa1, pa2, pa3); SBAR();
    if constexpr (F32) {
#pragma unroll
        for (int e = 8; e < 16; ++e) S.tq[e] = *(const f32x4*)QROW(e); SBAR(); }
#undef QROW
    pv_tile<0, SK>(o, vb0, pa0, pa1, pa2, pa3, ACT(even ? NT - 2 : NT - 1));
    if (even) { MASKT(pB0, pB1, 1); partialSM(pB0, pB1, m_reg, mnB, alB); __syncthreads(); RESC(alB);
        finishSM(pB0, pB1, alB, l_reg, pa0, pa1, pa2, pa3); SBAR(); pv_tile<1, SK>(o, vb0, pa0, pa1, pa2, pa3, ACT(NT - 1)); }
    SBAR(); SEAM_K0();
    if (hi == 0) li_l[r32] = l_reg; asm volatile("s_waitcnt lgkmcnt(0)" ::: "memory");
    float rli[16];
#pragma unroll
    for (int r = 0; r < 16; ++r) rli[r] = __builtin_amdgcn_rcpf(li_l[crow(r, hi)]);
    TOut* Ow = cur.O + (size_t)(wid * QBLK) * OP;
    unsigned olane = (unsigned)(4 * hi * OP + r32) * 2u; asm volatile("" : "+v"(olane));
#pragma unroll
    for (int r = 0; r < 16; ++r) { const int orow = crow(r, hi);
#pragma unroll
        for (int d0 = 0; d0 < 4; ++d0) { const float v = o[d0][r] * rli[r];
            if constexpr (same_t<TOut, float>::v) { Ow[(size_t)orow * OP + d0 * 32 + r32] = v; }
            else { const float vn = __shfl_xor(v, 1);
                   if ((r32 & 1) == 0) *(unsigned*)((char*)Ow + (size_t)((((r & 3) + 8 * (r >> 2)) * OP + d0 * 32) * 2) + olane) = cvtpk(v, vn); } } }
    if constexpr (F32) {
#pragma unroll
        for (int d0 = 0; d0 < 8; ++d0) S.qr[d0] = pack8(S.tq[2 * d0], S.tq[2 * d0 + 1]); }
    __syncthreads();
#undef RESC
#undef KBASE
#undef ACT
#undef MASKT
#undef SEAM_K0
#undef HALF_STEP
}
#undef ROW
#undef VMW
#undef VMWN
#undef SLOAD_H
#undef SWRITE_HK
#undef SWRITE_HV
#undef SWRITE_H
#undef SLOAD_F
#undef SWRITE_KF
#undef SWRITE_VF

#undef KSWZ
#undef SBAR
}
#ifndef PHASE_SWAP
#define PHASE_SWAP 1
#endif
constexpr int NWAVES = 8;
constexpr int T = 16384, SEQ = 8192, DM = 2048, NU = 16128, NEXP = 32;
constexpr int UC_Z = 0, UC_XBC = 2048, UC_Q = 5120, UC_K = 7168, UC_V = 9216, UC_GS = 11264, UC_GA = 13312, UC_QI = 15360, UC_KI = 15872, UC_DT = 15936, UC_WI = 15968, UC_END = 15976;
constexpr int NIN = 15976;
constexpr float EPS = 1e-5f;
constexpr int RMAX = 65536 + 32 * 256;

constexpr size_t MiB = 1u << 20;
constexpr size_t WS_CTL = 0, CTL_ZERO_BYTES = 1 * MiB;
constexpr size_t WS_WIN = 2 * MiB;
constexpr size_t WS_WSSD = 65 * MiB, WS_WATT = 73 * MiB, WS_WOUT = 81 * MiB;
constexpr size_t WS_RWT = 89 * MiB;
constexpr size_t WS_W1 = 96 * MiB;
constexpr size_t WS_W2 = 352 * MiB;
constexpr size_t WS_H8 = 480 * MiB;
constexpr size_t WS_XN = 864 * MiB;
constexpr size_t WS_U = 928 * MiB;
constexpr size_t WS_XBC = 1432 * MiB;
constexpr size_t WS_DT = 1528 * MiB, WS_DACS = 1530 * MiB;
constexpr size_t WS_YD = 1532 * MiB;
constexpr size_t WS_STATES = 1596 * MiB;
constexpr size_t WS_PREV = 1724 * MiB;
constexpr size_t WS_S = 1788 * MiB;
constexpr size_t WS_MASK = 2300 * MiB;
constexpr size_t WS_YG = 2316 * MiB, WS_AO = 2380 * MiB;
constexpr size_t WS_TMP = 2444 * MiB;
constexpr size_t WS_MG = 2572 * MiB;
constexpr size_t WS_H1 = 2636 * MiB;
constexpr size_t WS_ROUTE = 2764 * MiB;
constexpr size_t WS_OS = 2768 * MiB;
constexpr size_t WS_QR = 3056 * MiB, WS_KR = 3120 * MiB;
constexpr size_t WS_QIR = 3184 * MiB, WS_KIR = 3200 * MiB;
constexpr size_t WS_ROPE = 3202 * MiB;
constexpr size_t WS_AS = 3204 * MiB;
constexpr size_t WS_ACT = 3492 * MiB;
constexpr size_t WS_XN2 = 3780 * MiB;
constexpr size_t WS_END = 3844 * MiB;
constexpr int CW_TMO = 0, CW_CODE = 1;
constexpr int CW_BAR = 4096;
constexpr int CW_NT = 8192;
constexpr int RING_OFF = 0, RING_BYTES = 131072;
constexpr int LDSCTL_OFF = RING_BYTES, MISC_OFF = LDSCTL_OFF + 320;
constexpr int TILE_E_OFF = MISC_OFF + 128;
constexpr int EOFF_OFF = TILE_E_OFF + 1280;
constexpr int HIST_OFF = EOFF_OFF + 512;
constexpr int RS_OFF = HIST_OFF + 256;
constexpr int LDS_BYTES = 147456;
static_assert(RS_OFF + 8192 <= LDS_BYTES, "LDS map");

#define GAS __attribute__((address_space(1)))
#define LAS __attribute__((address_space(3)))
typedef unsigned short bf16;
typedef unsigned v4u __attribute__((ext_vector_type(4)));
typedef unsigned v2u __attribute__((ext_vector_type(2)));
typedef float f32x4 __attribute__((ext_vector_type(4)));
typedef float f32x16 __attribute__((ext_vector_type(16)));
typedef short bf16x8 __attribute__((ext_vector_type(8)));
typedef short s16x4 __attribute__((ext_vector_type(4)));
typedef GAS unsigned gu32;
#define RLX_AGENT __ATOMIC_RELAXED, __HIP_MEMORY_SCOPE_AGENT
#define LDS_WAIT() asm volatile("s_waitcnt lgkmcnt(0)" ::: "memory")
#define VM_WAIT() asm volatile("s_waitcnt vmcnt(0)" ::: "memory")
__device__ __forceinline__ unsigned f2bf(float f) { unsigned u = __builtin_bit_cast(unsigned, f); return (u + 0x7fffu + ((u >> 16) & 1u)) >> 16; }
__device__ __forceinline__ unsigned pk2(float lo, float hi) { return f2bf(lo) | (f2bf(hi) << 16); }
__device__ __forceinline__ float bf2f(bf16 b) { return __uint_as_float(((unsigned)b) << 16); }
__device__ __forceinline__ float bflo(unsigned w) { return __uint_as_float(w << 16); }
__device__ __forceinline__ float bfhi(unsigned w) { return __uint_as_float(w & 0xffff0000u); }
__device__ __forceinline__ float siluf(float x) { return x * __builtin_amdgcn_rcpf(1.f + __expf(-x)); }
#define XB_TMO      128
#define XB_XCNT(j)  (256  + 64 * (j))
#define XB_XSUB(j)  (1280 + 64 * (j))
#define XB_XGEN(j)  (2304 + 64 * (j))
#define XB_TOP      3328
#define XB_TOPGEN   3392
#define XCD_BAR_WORDS 3456
#define XB_SPIN_CAP (1u << 18)

__device__ __forceinline__ unsigned xb_ld(unsigned* p)              { return __hip_atomic_load(p, __ATOMIC_RELAXED, __HIP_MEMORY_SCOPE_AGENT); }
__device__ __forceinline__ unsigned xb_add(unsigned* p, unsigned v) { return __hip_atomic_fetch_add(p, v, __ATOMIC_RELAXED, __HIP_MEMORY_SCOPE_AGENT); }
__device__ __forceinline__ unsigned xb_xcc_id() { return (unsigned)__builtin_amdgcn_s_getreg((3 << 11) | 20) & 0xFu; }
#define XB_SPIN(cond, bar) do { unsigned _sp = 0; while (cond) { __builtin_amdgcn_s_sleep(1); \
    if ((++_sp & 255u) == 0u) { if (xb_ld(&(bar)[XB_TMO])) break; if (_sp > XB_SPIN_CAP) { atomicAdd(&(bar)[XB_TMO], 1u); break; } } } } while (0)

struct XcdBarrier {
    unsigned* bar; unsigned x;
    volatile LAS unsigned* st;
};

__device__ __forceinline__ XcdBarrier xcd_barrier_post(unsigned* bar, volatile LAS unsigned* st) {
    XcdBarrier b; b.bar = bar; b.x = xb_xcc_id(); b.st = st;
    if (threadIdx.x == 0) (void)xb_add(&bar[XB_XCNT(b.x)], 1u);
    return b;
}
__device__ __forceinline__ void xcd_barrier_complete(unsigned* bar, unsigned x, unsigned& nloc, unsigned& nx) {
    const unsigned G = gridDim.x * gridDim.y * gridDim.z;
    unsigned sum, cnt, mine, sp = 0u;
    for (;;) {
        sum = 0u; cnt = 0u; mine = 0u;
#pragma unroll
        for (unsigned j = 0; j < 16; ++j) { const unsigned c = xb_ld(&bar[XB_XCNT(j)]); sum += c; cnt += (c > 0u) ? 1u : 0u; mine = (j == x) ? c : mine; }
        if (sum == G) break;
        __builtin_amdgcn_s_sleep(1);
        if ((++sp & 255u) == 0u) { if (xb_ld(&bar[XB_TMO])) break; if (sp > XB_SPIN_CAP) { atomicAdd(&bar[XB_TMO], 1u); break; } }
    }
    nloc = mine > 0u ? mine : 1u; nx = cnt > 0u ? cnt : 1u;
}

__device__ __forceinline__ void xcd_barrier(const XcdBarrier& b) {
    asm volatile("s_waitcnt vmcnt(0)" ::: "memory");
    __syncthreads();
    if (threadIdx.x == 0) {
        unsigned* bar = b.bar;
        __builtin_amdgcn_s_waitcnt(0);
        unsigned nloc = b.st[0], nx = b.st[1];
        if (nloc == 0u) { xcd_barrier_complete(bar, b.x, nloc, nx); b.st[0] = nloc; b.st[1] = nx; }
        const unsigned old = xb_add(&bar[XB_XSUB(b.x)], 1u);
        const unsigned gen = old / nloc;
        if (old + 1u == (gen + 1u) * nloc) {
            __builtin_amdgcn_fence(__ATOMIC_RELEASE, "agent");
            asm volatile("s_waitcnt vmcnt(0)" ::: "memory");
            const unsigned og = xb_add(&bar[XB_TOP], 1u);
            const unsigned tg = og / nx;
            if (og + 1u == (tg + 1u) * nx) xb_add(&bar[XB_TOPGEN], 1u);
            else XB_SPIN(xb_ld(&bar[XB_TOPGEN]) == tg, bar);
            __builtin_amdgcn_fence(__ATOMIC_ACQUIRE, "agent");
            xb_add(&bar[XB_XGEN(b.x)], 1u);
            asm volatile("s_waitcnt vmcnt(0)" ::: "memory");
        } else {
            XB_SPIN(xb_ld(&bar[XB_XGEN(b.x)]) == gen, bar);
            __builtin_amdgcn_fence(__ATOMIC_ACQUIRE, "agent");
            asm volatile("s_waitcnt vmcnt(0)" ::: "memory");
        }
    }
    __syncthreads();
}


typedef const float* const __attribute__((address_space(4))) * karg_fpp;
#define INP(i) (((karg_fpp)__builtin_amdgcn_kernarg_segment_ptr())[i])
#define OUTP() ((float*)(((karg_fpp)__builtin_amdgcn_kernarg_segment_ptr())[20]))
#define WSB() ((unsigned char*)(((karg_fpp)__builtin_amdgcn_kernarg_segment_ptr())[21]))
#define WSP(type, off) ((type*)(WSB() + (off)))
#define CTLP() ((gu32*)(WSB() + WS_CTL))
struct Frame {
    LAS unsigned char* lds;
    int wave, vcu, G;
};
__device__ __forceinline__ int lane_id_now() { int l; asm volatile("v_mbcnt_lo_u32_b32 %0, -1, 0\n\tv_mbcnt_hi_u32_b32 %0, -1, %0" : "=v"(l)); return l; }
#define LANE() lane_id_now()
#define TID() (F.wave * 64 + LANE())

__device__ __forceinline__ float wave_sum(float v) {
#pragma unroll
    for (int o = 1; o < 64; o <<= 1) v += __shfl_xor(v, o);
    return v;
}

__device__ __forceinline__ int ucol_of_src(int n) {
    if (n < 5120) return n;
    if (n < 5152) return n - 5120 + UC_DT;
    if (n < 11296) return n - 5152 + UC_Q;
    if (n < 11808) return n - 11296 + UC_QI;
    if (n < 11872) return n - 11808 + UC_KI;
    if (n < 11880) return n - 11872 + UC_WI;
    return n - 11880 + UC_GS;
}
struct RmId { __device__ __forceinline__ int operator()(int n) const { return n; } };
struct RmIn { __device__ __forceinline__ int operator()(int n) const { return ucol_of_src(n); } };
struct RmW1 { __device__ __forceinline__ int operator()(int n) const { const int m = n & 2047; return ((m >> 7) << 8) + ((n >> 11) << 7) + (m & 127); } };
template <class RowMap>
__device__ __forceinline__ void transpose_item(const float* W, int K, int N, bf16* WT, const RowMap rm, const float* kscale, int item, int lane) {
    const int nblk = (N + 63) >> 6, kb = item / nblk, nb = item - kb * nblk, k0 = 64 * kb, n0 = 64 * nb;
    const int g = lane >> 4, nq = lane & 15, n = n0 + 4 * nq; const bool nok = n < N;
    const float* src = W + (size_t)(k0 + 8 * g) * N + n;
    f32x4 v[2][8];
#pragma unroll
    for (int p = 0; p < 2; ++p)
#pragma unroll
        for (int i = 0; i < 8; ++i) v[p][i] = nok ? *(const f32x4*)(src + (size_t)(32 * p + i) * N) : (f32x4){0.f, 0.f, 0.f, 0.f};
    if (kscale) {
#pragma unroll
        for (int p = 0; p < 2; ++p) { const f32x4 s0 = *(const f32x4*)(kscale + k0 + 32 * p + 8 * g), s1 = *(const f32x4*)(kscale + k0 + 32 * p + 8 * g + 4);
            v[p][0] = v[p][0] * s0.x; v[p][1] = v[p][1] * s0.y; v[p][2] = v[p][2] * s0.z; v[p][3] = v[p][3] * s0.w; v[p][4] = v[p][4] * s1.x; v[p][5] = v[p][5] * s1.y; v[p][6] = v[p][6] * s1.z; v[p][7] = v[p][7] * s1.w; } }
    if (nok) {
#pragma unroll
        for (int j = 0; j < 4; ++j) { bf16* dst = WT + (size_t)rm(n + j) * K + k0 + 8 * g;
#pragma unroll
            for (int p = 0; p < 2; ++p) { v4u o; o.x = pk2(v[p][0][j], v[p][1][j]); o.y = pk2(v[p][2][j], v[p][3][j]); o.z = pk2(v[p][4][j], v[p][5][j]); o.w = pk2(v[p][6][j], v[p][7][j]);
                *(v4u*)(dst + 32 * p) = o; } } }
}
template <class RowMap>
__device__ __forceinline__ void transpose_item8(const float* W, int K, int N, unsigned char* WT, const RowMap rm, int item, int lane) {
    const int nblk = N >> 5, kb = item / nblk, nb = item - kb * nblk, k0 = 128 * kb, n0 = 32 * nb;
    const int g = lane >> 3, nq = lane & 7, n = n0 + 4 * nq;
    const float* src = W + (size_t)(k0 + 16 * g) * N + n;
    f32x4 v[16];
#pragma unroll
    for (int i = 0; i < 16; ++i) v[i] = *(const f32x4*)(src + (size_t)i * N);
#pragma unroll
    for (int j = 0; j < 4; ++j) { v4u o;
        o.x = pg8::pk4_fp8(v[0][j] * pg8::F8_SW, v[1][j] * pg8::F8_SW, v[2][j] * pg8::F8_SW, v[3][j] * pg8::F8_SW); o.y = pg8::pk4_fp8(v[4][j] * pg8::F8_SW, v[5][j] * pg8::F8_SW, v[6][j] * pg8::F8_SW, v[7][j] * pg8::F8_SW);
        o.z = pg8::pk4_fp8(v[8][j] * pg8::F8_SW, v[9][j] * pg8::F8_SW, v[10][j] * pg8::F8_SW, v[11][j] * pg8::F8_SW); o.w = pg8::pk4_fp8(v[12][j] * pg8::F8_SW, v[13][j] * pg8::F8_SW, v[14][j] * pg8::F8_SW, v[15][j] * pg8::F8_SW);
        *(v4u*)(WT + (size_t)rm(n + j) * K + k0 + 16 * g) = o; }
}
__device__ __forceinline__ void rms_row_to_bf16(const float* xrow, const float* w, bf16* orow, int lane) {
    const f32x4* xr = (const f32x4*)xrow + lane;
    f32x4 v[8], wq[8]; float s = 0.f;
#pragma unroll
    for (int j = 0; j < 8; ++j) v[j] = xr[64 * j];
#pragma unroll
    for (int j = 0; j < 8; ++j) wq[j] = ((const f32x4*)w)[lane + 64 * j];
    __builtin_amdgcn_sched_barrier(0);
#pragma unroll
    for (int j = 0; j < 8; ++j) s += (v[j].x * v[j].x + v[j].y * v[j].y) + (v[j].z * v[j].z + v[j].w * v[j].w);
    const float rstd = 1.f / sqrtf(wave_sum(s) * (1.f / DM) + EPS);
    v2u* o8 = (v2u*)orow + lane;
#pragma unroll
    for (int j = 0; j < 8; ++j) { const f32x4 wv = wq[j]; v2u o; o.x = pk2(v[j].x * rstd * wv.x, v[j].y * rstd * wv.y); o.y = pk2(v[j].z * rstd * wv.z, v[j].w * rstd * wv.w); o8[64 * j] = o; }
}
__device__ __forceinline__ void p0_expert_items(Frame& F) {
    constexpr int I_W1 = 16 * 128, I_W2 = 16 * 64, NE = NEXP * (I_W1 + I_W2);
    int it0, step, lim, base;
    if ((PHASE_SWAP) && (F.G & 15) == 0) { const int grp = ((int)blockIdx.x >> 3) & 1, lwg = (((int)blockIdx.x >> 4) << 3) | ((int)blockIdx.x & 7);
        it0 = lwg * NWAVES + F.wave; step = (F.G >> 1) * NWAVES; lim = NE / 2; base = grp * (NE / 2); }
    else { it0 = F.vcu * NWAVES + F.wave; step = F.G * NWAVES; lim = NE; base = 0; }
    for (int it = it0; it < lim; it += step) { int r = base + it;
        if (r < NEXP * I_W1) { const int e = r / I_W1; transpose_item8(INP(15) + (size_t)e * DM * 4096, DM, 4096, WSP(unsigned char, WS_W1) + (size_t)e * 4096 * DM, RmW1(), r - e * I_W1, LANE()); continue; } r -= NEXP * I_W1;
        { const int e = r / I_W2; transpose_item8(INP(17) + (size_t)e * DM * DM, DM, DM, WSP(unsigned char, WS_W2) + (size_t)e * DM * DM, RmId(), r - e * I_W2, LANE()); } }
}
__device__ __forceinline__ void p0_prologue(Frame& F) {
    const int gw = F.vcu * NWAVES + F.wave, NGW = F.G * NWAVES;
    constexpr int I_IN = 32 * 250, I_SQ = 32 * 32;
#ifdef EXPERT_W_IN_P0
    p0_expert_items(F);
#endif
    constexpr int NITEMS = I_IN + 3 * I_SQ;
    for (int it = gw; it < NITEMS; it += NGW) {
        int r = it;
        if (r < I_IN) { transpose_item(INP(1), DM, NIN, WSP(bf16, WS_WIN), RmIn(), nullptr, r, LANE()); continue; } r -= I_IN;
        if (r < I_SQ) { transpose_item(INP(8), DM, DM, WSP(bf16, WS_WSSD), RmId(), INP(7), r, LANE()); continue; } r -= I_SQ;
        if (r < I_SQ) { transpose_item(INP(9), DM, DM, WSP(bf16, WS_WATT), RmId(), nullptr, r, LANE()); continue; } r -= I_SQ;
        { transpose_item(INP(10), DM, DM, WSP(bf16, WS_WOUT), RmId(), nullptr, r, LANE()); }
    }
    { const int gt = F.vcu * (NWAVES * 64) + TID(), NT = F.G * NWAVES * 64; v4u z = {0u, 0u, 0u, 0u};
      for (int i = gt; i < (NU - UC_END) * DM / 8; i += NT) ((v4u*)(WSP(bf16, WS_WIN) + (size_t)UC_END * DM))[i] = z;
      for (int i = gt; i < NEXP * DM; i += NT) { const int e = i >> 11, k = i & 2047; WSP(float, WS_RWT)[i] = INP(13)[(size_t)k * NEXP + e]; } }
    for (int pos = gw; pos < SEQ; pos += NGW) { const int f = LANE(); float cs = 0.f, sn = 0.f;
        if (f < 24) { const float inv = f < 16 ? powf(500000.0f, -(float)f * (1.0f / 16.0f)) : powf(500000.0f, -(float)(f - 16) * (1.0f / 8.0f)); sincosf((float)pos * inv, &sn, &cs); }
        if (f < 32) { float* dst = WSP(float, WS_ROPE) + ((size_t)pos * 32 + f) * 2; dst[0] = cs; dst[1] = sn; } }
    for (int m = gw; m < T; m += NGW) rms_row_to_bf16(INP(0) + (size_t)m * DM, INP(11), WSP(bf16, WS_XN) + (size_t)m * DM, LANE());
}

__device__ __forceinline__ float softplusf(float x) { return x > 20.f ? x : log1pf(expf(x)); }
__device__ __forceinline__ void p2_prep(Frame& F) {
    const int gt = F.vcu * (NWAVES * 64) + TID(), NT = F.G * NWAVES * 64;
    const int gw = F.vcu * NWAVES + F.wave, NGW = F.G * NWAVES, lane = LANE();
    for (int it = gt; it < (T / 16) * 384; it += NT) {
        const int ch = it % 384, seg = it / 384, t0 = seg * 16, c0 = ch * 8;
        float w[4][8], cb[8], h0[8], h1[8], h2[8];
#pragma unroll
        for (int j = 0; j < 4; ++j) { const f32x4 a = *(const f32x4*)(INP(2) + j * 3072 + c0), b = *(const f32x4*)(INP(2) + j * 3072 + c0 + 4);
            w[j][0] = a.x; w[j][1] = a.y; w[j][2] = a.z; w[j][3] = a.w; w[j][4] = b.x; w[j][5] = b.y; w[j][6] = b.z; w[j][7] = b.w; }
        { const f32x4 a = *(const f32x4*)(INP(3) + c0), b = *(const f32x4*)(INP(3) + c0 + 4); cb[0] = a.x; cb[1] = a.y; cb[2] = a.z; cb[3] = a.w; cb[4] = b.x; cb[5] = b.y; cb[6] = b.z; cb[7] = b.w; }
        const bool first = (t0 % SEQ) == 0;
        const bf16* src = WSP(bf16, WS_U) + (size_t)t0 * NU + UC_XBC + c0;
        v4u r0 = {0u, 0u, 0u, 0u}, r1 = r0, r2 = r0;
        if (!first) { r0 = *(const v4u*)(src - 3 * (size_t)NU); r1 = *(const v4u*)(src - 2 * (size_t)NU); r2 = *(const v4u*)(src - (size_t)NU); }
#define UNPK(dst, r) do { dst[0] = bflo(r.x); dst[1] = bfhi(r.x); dst[2] = bflo(r.y); dst[3] = bfhi(r.y); dst[4] = bflo(r.z); dst[5] = bfhi(r.z); dst[6] = bflo(r.w); dst[7] = bfhi(r.w); } while (0)
        UNPK(h0, r0); UNPK(h1, r1); UNPK(h2, r2);
        bf16* dst = WSP(bf16, WS_XBC) + (size_t)t0 * 3072 + c0;
        v4u rcs[16];
#pragma unroll
        for (int t = 0; t < 16; ++t) rcs[t] = *(const v4u*)(src + (size_t)t * NU);
        __builtin_amdgcn_sched_barrier(0);
#pragma unroll
        for (int t = 0; t < 16; ++t) {
            const v4u rc = rcs[t]; float cur[8], o[8]; UNPK(cur, rc);
#pragma unroll
            for (int i = 0; i < 8; ++i) { const float a = cb[i] + w[0][i] * h0[i] + w[1][i] * h1[i] + w[2][i] * h2[i] + w[3][i] * cur[i]; o[i] = siluf(a); h0[i] = h1[i]; h1[i] = h2[i]; h2[i] = cur[i]; }
            v4u ov; ov.x = pk2(o[0], o[1]); ov.y = pk2(o[2], o[3]); ov.z = pk2(o[4], o[5]); ov.w = pk2(o[6], o[7]);
            *(v4u*)(dst + (size_t)t * 3072) = ov;
        }
#undef UNPK
    }
    for (int ch = gw; ch < (T / 128) * 32; ch += NGW) {
        const int h = ch & 31, ck = ch >> 5; const float bias = INP(4)[h], a = -expf(INP(5)[h]);
        const size_t t0 = (size_t)ck * 128 + 2 * lane;
        const float d0 = softplusf(bf2f(WSP(bf16, WS_U)[t0 * NU + UC_DT + h]) + bias), d1 = softplusf(bf2f(WSP(bf16, WS_U)[(t0 + 1) * NU + UC_DT + h]) + bias);
        const float a0 = d0 * a, a1 = a0 + d1 * a;
        float run = a1;
#pragma unroll
        for (int o = 1; o < 64; o <<= 1) { const float up = __shfl_up(run, o); if (lane >= o) run += up; }
        const float excl = run - a1;
        WSP(float, WS_DT)[t0 * 32 + h] = d0; WSP(float, WS_DT)[(t0 + 1) * 32 + h] = d1;
        WSP(float, WS_DACS)[t0 * 32 + h] = excl + a0; WSP(float, WS_DACS)[(t0 + 1) * 32 + h] = excl + a1;
    }
    for (int t = gw; t < T; t += NGW) {
        const int pos = t % SEQ;
        const bf16* row = WSP(bf16, WS_U) + (size_t)t * NU;
        const f32x4* rtp = (const f32x4*)(WSP(float, WS_ROPE) + (size_t)pos * 64);
        v4u aq[2][4]; f32x4 rt[12];
#pragma unroll
        for (int wk = 0; wk < 2; ++wk) { const v4u* src = (const v4u*)(row + (wk ? UC_K : UC_Q) + 32 * lane);
#pragma unroll
            for (int j = 0; j < 4; ++j) aq[wk][j] = src[j]; }
        const int part = lane & 7;
        const v4u mq = *(const v4u*)(row + UC_QI + 8 * lane), mk = *(const v4u*)(row + UC_KI + 8 * part);
#pragma unroll
        for (int j = 0; j < 12; ++j) rt[j] = rtp[j];
        __builtin_amdgcn_sched_barrier(0);
#define R16(i) rt[(i) >> 2][(i) & 3]
#define R8(i) rt[8 + ((i) >> 2)][(i) & 3]
#pragma unroll
        for (int wk = 0; wk < 2; ++wk) {
            v4u a[4];
#pragma unroll
            for (int j = 0; j < 4; ++j) a[j] = aq[wk][j];
            if ((lane & 3) == 0) { float x[32];
#pragma unroll
                for (int j = 0; j < 4; ++j) { x[8 * j] = bflo(a[j].x); x[8 * j + 1] = bfhi(a[j].x); x[8 * j + 2] = bflo(a[j].y); x[8 * j + 3] = bfhi(a[j].y); x[8 * j + 4] = bflo(a[j].z); x[8 * j + 5] = bfhi(a[j].z); x[8 * j + 6] = bflo(a[j].w); x[8 * j + 7] = bfhi(a[j].w); }
                float o[32];
#pragma unroll
                for (int i = 0; i < 16; ++i) { const float cs = R16(2 * i), sn = R16(2 * i + 1); o[i] = x[i] * cs - x[16 + i] * sn; o[16 + i] = x[16 + i] * cs + x[i] * sn; }
#pragma unroll
                for (int j = 0; j < 4; ++j) { a[j].x = pk2(o[8 * j], o[8 * j + 1]); a[j].y = pk2(o[8 * j + 2], o[8 * j + 3]); a[j].z = pk2(o[8 * j + 4], o[8 * j + 5]); a[j].w = pk2(o[8 * j + 6], o[8 * j + 7]); } }
            v4u* dst = (v4u*)(WSP(bf16, wk ? WS_KR : WS_QR) + (size_t)t * DM + 32 * lane);
#pragma unroll
            for (int j = 0; j < 4; ++j) dst[j] = a[j];
        }
#pragma unroll
        for (int wk = 0; wk < 2; ++wk) {
            const v4u m = wk ? mk : mq;
            v4u pn; pn.x = __shfl_xor(m.x, 1); pn.y = __shfl_xor(m.y, 1); pn.z = __shfl_xor(m.z, 1); pn.w = __shfl_xor(m.w, 1);
            v4u o = m;
            if (part < 2) { float a[8], b[8], r[8];
                a[0] = bflo(m.x); a[1] = bfhi(m.x); a[2] = bflo(m.y); a[3] = bfhi(m.y); a[4] = bflo(m.z); a[5] = bfhi(m.z); a[6] = bflo(m.w); a[7] = bfhi(m.w);
                b[0] = bflo(pn.x); b[1] = bfhi(pn.x); b[2] = bflo(pn.y); b[3] = bfhi(pn.y); b[4] = bflo(pn.z); b[5] = bfhi(pn.z); b[6] = bflo(pn.w); b[7] = bfhi(pn.w);
#pragma unroll
                for (int i = 0; i < 8; ++i) { const float cs = R8(2 * i), sn = R8(2 * i + 1); r[i] = part == 0 ? a[i] * cs - b[i] * sn : a[i] * cs + b[i] * sn; }
                o.x = pk2(r[0], r[1]); o.y = pk2(r[2], r[3]); o.z = pk2(r[4], r[5]); o.w = pk2(r[6], r[7]); }
            if (wk == 0) *(v4u*)(WSP(bf16, WS_QIR) + (size_t)t * 512 + 8 * lane) = o;
            else if (lane < 8) *(v4u*)(WSP(bf16, WS_KIR) + (size_t)t * 64 + 8 * lane) = o;
        }
#undef R16
#undef R8
    }
}

__device__ __forceinline__ int crow16(int r, int hi) { return (r & 3) + 8 * (r >> 2) + 4 * hi; }
__device__ __forceinline__ bf16x8 lds_b128(const LAS unsigned char* p) { return *(const LAS bf16x8*)p; }
__device__ __forceinline__ bf16x8 lds_tr8(const LAS unsigned char* p, int rowstep4) {
    typedef short v4i16_t __attribute__((ext_vector_type(4)));
    const v4i16_t a = __builtin_amdgcn_ds_read_tr16_b64_v4i16((LAS v4i16_t*)p);
    const v4i16_t b = __builtin_amdgcn_ds_read_tr16_b64_v4i16((LAS v4i16_t*)(p + rowstep4));
    return (bf16x8){a[0], a[1], a[2], a[3], b[0], b[1], b[2], b[3]};
}
constexpr int SP_C = 272, SP_X = 144;
constexpr int S_CS = 0, S_BS = 34816, S_XS = 69632, S_XW = 88064, S_VEC = 106496, S_YS = 107520;
struct P3R { v4u b[4], c[4], x[2]; float dtr[2], dar[2], da_last, dac1, dt1; };
__device__ __forceinline__ void p3_load(P3R& R, int u, int tid) {
    const int h = u & 31, bc = u >> 5, g = h >> 3; const size_t t0 = (size_t)bc * 128;
    R.da_last = WSP(float, WS_DACS)[(t0 + 127) * 32 + h];
#pragma unroll
    for (int i = 0; i < 4; ++i) { const int idx = tid + 512 * i, row = idx >> 4, ch = idx & 15; const bf16* src = WSP(bf16, WS_XBC) + (t0 + row) * 3072 + 2048 + g * 128 + ch * 8;
        R.b[i] = *(const v4u*)src; R.c[i] = *(const v4u*)(src + 512); }
#pragma unroll
    for (int i = 0; i < 2; ++i) { const int idx = tid + 512 * i, row = idx >> 3, ch = idx & 7; R.x[i] = *(const v4u*)(WSP(bf16, WS_XBC) + (t0 + row) * 3072 + h * 64 + ch * 8);
        R.dtr[i] = WSP(float, WS_DT)[(t0 + row) * 32 + h]; R.dar[i] = WSP(float, WS_DACS)[(t0 + row) * 32 + h]; }
    R.dac1 = WSP(float, WS_DACS)[(t0 + (tid & 127)) * 32 + h]; R.dt1 = WSP(float, WS_DT)[(t0 + (tid & 127)) * 32 + h];
}
__device__ __forceinline__ void p3_ssd_unit(Frame& F, int u, int un, P3R& R) {
    const int tid = TID(), lane = LANE(), w = F.wave, r32 = lane & 31, hh = lane >> 5;
    const int h = u & 31, bc = u >> 5; const size_t t0 = (size_t)bc * 128;
    LAS unsigned char* L = F.lds + RING_OFF;
    LAS float* dacs = (LAS float*)(L + S_VEC); LAS float* dtv = dacs + 128;
#pragma unroll
    for (int i = 0; i < 4; ++i) { const int idx = tid + 512 * i, row = idx >> 4, ch = idx & 15;
        *(LAS v4u*)(L + S_BS + row * SP_C + ch * 16) = R.b[i]; *(LAS v4u*)(L + S_CS + row * SP_C + ch * 16) = R.c[i]; }
#pragma unroll
    for (int i = 0; i < 2; ++i) { const int idx = tid + 512 * i, row = idx >> 3, ch = idx & 7; const v4u xv = R.x[i];
        const float wl = R.dtr[i] * __expf(R.da_last - R.dar[i]);
        *(LAS v4u*)(L + S_XS + row * SP_X + ch * 16) = xv;
        v4u xw; xw.x = pk2(bflo(xv.x) * wl, bfhi(xv.x) * wl); xw.y = pk2(bflo(xv.y) * wl, bfhi(xv.y) * wl); xw.z = pk2(bflo(xv.z) * wl, bfhi(xv.z) * wl); xw.w = pk2(bflo(xv.w) * wl, bfhi(xv.w) * wl);
        *(LAS v4u*)(L + S_XW + row * SP_X + ch * 16) = xw; }
    if (tid < 128) { dacs[tid] = R.dac1; dtv[tid] = R.dt1; }
    __syncthreads();
    p3_load(R, un, tid);
    __builtin_amdgcn_sched_barrier(0);
    const int li = w >> 1;
    f32x16 acc0 = {}, acc1 = {};
    { const int j0 = (w & 1) * 2;
      const LAS unsigned char* cp = L + S_CS + (32 * li + r32) * SP_C + hh * 16;
      if (j0 <= li) { const LAS unsigned char* bp = L + S_BS + (32 * j0 + r32) * SP_C + hh * 16;
#pragma unroll
          for (int ks = 0; ks < 8; ++ks) acc0 = __builtin_amdgcn_mfma_f32_32x32x16_bf16(lds_b128(bp + ks * 32), lds_b128(cp + ks * 32), acc0, 0, 0, 0); }
      if (j0 + 1 <= li) { const LAS unsigned char* bp = L + S_BS + (32 * (j0 + 1) + r32) * SP_C + hh * 16;
#pragma unroll
          for (int ks = 0; ks < 8; ++ks) acc1 = __builtin_amdgcn_mfma_f32_32x32x16_bf16(lds_b128(bp + ks * 32), lds_b128(cp + ks * 32), acc1, 0, 0, 0); } }
    __syncthreads();
    { const int j0 = (w & 1) * 2, l = 32 * li + r32; const float dl = dacs[l];
#pragma unroll
      for (int jj = 0; jj < 2; ++jj) { const int sj = j0 + jj; if (sj <= li) {
#pragma unroll
          for (int q = 0; q < 4; ++q) { float gv[4];
#pragma unroll
              for (int e = 0; e < 4; ++e) { const int s = 32 * sj + 8 * q + 4 * hh + e; const float a = jj ? acc1[4 * q + e] : acc0[4 * q + e];
                  gv[e] = (s <= l) ? a * __expf(dl - dacs[s]) * dtv[s] : 0.f; }
              v2u o; o.x = pk2(gv[0], gv[1]); o.y = pk2(gv[2], gv[3]);
              *(LAS v2u*)(L + S_CS + l * SP_C + (32 * sj + 8 * q + 4 * hh) * 2) = o; } } } }
    __syncthreads();
    { const int pb = w & 1; f32x16 acc = {};
      const LAS unsigned char* gp = L + S_CS + (32 * li + r32) * SP_C + hh * 16;
      const LAS unsigned char* xp = L + S_XS + (8 * hh + ((lane & 15) >> 2)) * SP_X + (32 * pb + 16 * ((lane >> 4) & 1) + 4 * (lane & 3)) * 2;
      for (int ks = 0; ks < 2 * (li + 1); ++ks) acc = __builtin_amdgcn_mfma_f32_32x32x16_bf16(lds_b128(gp + ks * 32), lds_tr8(xp + ks * 16 * SP_X, 4 * SP_X), acc, 0, 0, 0);
      LAS bf16* ys = (LAS bf16*)(L + S_YS);
#pragma unroll
      for (int r = 0; r < 16; ++r) ys[(32 * li + crow16(r, hh)) * 72 + 32 * pb + r32] = (bf16)f2bf(acc[r]); }
    { const int pb = w >> 2, nb = w & 3; f32x16 acc = {};
      const int trow = 8 * hh + ((lane & 15) >> 2), tcol = 16 * ((lane >> 4) & 1) + 4 * (lane & 3);
      const LAS unsigned char* ap = L + S_XW + trow * SP_X + (32 * pb + tcol) * 2;
      const LAS unsigned char* bp = L + S_BS + trow * SP_C + (32 * nb + tcol) * 2;
#pragma unroll
      for (int ks = 0; ks < 8; ++ks) acc = __builtin_amdgcn_mfma_f32_32x32x16_bf16(lds_tr8(ap + ks * 16 * SP_X, 4 * SP_X), lds_tr8(bp + ks * 16 * SP_C, 4 * SP_C), acc, 0, 0, 0);
      float* st = WSP(float, WS_STATES) + ((size_t)u * 64 + 32 * pb) * 128 + 32 * nb + r32;
#pragma unroll
      for (int r = 0; r < 16; ++r) st[(size_t)crow16(r, hh) * 128] = acc[r]; }
    __syncthreads();
#pragma unroll
    for (int i = 0; i < 2; ++i) { const int idx = tid + 512 * i, l = idx >> 3, c8 = (idx & 7) * 8;
        *(v4u*)(WSP(bf16, WS_YD) + (t0 + l) * 2048 + h * 64 + c8) = *(const LAS v4u*)(L + S_YS + (l * 72 + c8) * 2); }
    __syncthreads();
}
constexpr int IX_Q = 0, IX_W = 32768;
__device__ __forceinline__ void p3_index_group(Frame& F, int b, int qg) {
    const int tid = TID(), lane = LANE(), r32 = lane & 31, hh = lane >> 5;
    LAS unsigned char* L = F.lds + RING_OFF; LAS float* wl = (LAS float*)(L + IX_W);
    const bf16* Ub = WSP(bf16, WS_U) + ((size_t)b * SEQ) * NU;
#pragma unroll
    for (int i = 0; i < 4; ++i) { const int pc = tid + 512 * i, ln = pc & 63, ks = (pc >> 6) & 3, h8 = pc >> 8;
        *(LAS v4u*)(L + IX_Q + pc * 16) = *(const v4u*)(WSP(bf16, WS_QIR) + ((size_t)b * SEQ + qg * 32 + (ln & 31)) * 512 + h8 * 64 + ks * 16 + 8 * (ln >> 5)); }
    if (tid < 256) { const int h8 = tid >> 5, q = tid & 31; wl[tid] = bf2f(Ub[(size_t)(qg * 32 + q) * NU + UC_WI + h8]) * 0.044194173824159216f; }
    __syncthreads();
    float wq[8];
#pragma unroll
    for (int h8 = 0; h8 < 8; ++h8) wq[h8] = wl[h8 * 32 + r32];
    bf16x8 kf[4];
    { const int k0 = F.wave <= qg ? F.wave : qg; const bf16* krow = WSP(bf16, WS_KIR) + ((size_t)b * SEQ + k0 * 32 + r32) * 64 + 8 * hh;
#pragma unroll
        for (int ks = 0; ks < 4; ++ks) kf[ks] = *(const bf16x8*)(krow + ks * 16); }
    for (int kt = F.wave; kt <= qg; kt += NWAVES) {
        bf16x8 kn[4];
        { const int k1 = kt + NWAVES <= qg ? kt + NWAVES : qg;
          const bf16* krow = WSP(bf16, WS_KIR) + ((size_t)b * SEQ + k1 * 32 + r32) * 64 + 8 * hh;
#pragma unroll
          for (int ks = 0; ks < 4; ++ks) kn[ks] = *(const bf16x8*)(krow + ks * 16); }
        __builtin_amdgcn_sched_barrier(0);
        f32x16 sc = {};
        int qoff = lane * 16; asm volatile("" : "+v"(qoff));
#pragma unroll
        for (int h8 = 0; h8 < 8; ++h8) { f32x16 a = {};
#pragma unroll
            for (int ks = 0; ks < 4; ++ks) a = __builtin_amdgcn_mfma_f32_32x32x16_bf16(kf[ks], lds_b128(L + IX_Q + (h8 * 4 + ks) * 1024 + qoff), a, 0, 0, 0);
#pragma unroll
            NANCHK((a[0] != a[0]) || (a[5] != a[5]) || (a[10] != a[10]) || (a[15] != a[15]) || (wq[h8] != wq[h8]), 1);
            for (int e = 0; e < 16; ++e) sc[e] += wq[h8] * fmaxf(a[e], 0.f); }
        float* srow = WSP(float, WS_S) + ((size_t)b * SEQ + qg * 32 + r32) * SEQ + kt * 32 + 4 * hh;
#pragma unroll
        for (int q = 0; q < 4; ++q) *(f32x4*)(srow + 8 * q) = (f32x4){sc[4 * q], sc[4 * q + 1], sc[4 * q + 2], sc[4 * q + 3]};
#pragma unroll
        for (int ks = 0; ks < 4; ++ks) kf[ks] = kn[ks];
    }
    __syncthreads();
}
__device__ __forceinline__ void p3_phase(Frame& F) {
    const bool idx_first = (PHASE_SWAP) && (((blockIdx.x >> 3) & 1) != 0);
#pragma nounroll
    for (int pass = 0; pass < 2; ++pass) {
        if ((pass == 0) != idx_first) {
#ifndef NO_P3A
    { constexpr int NUN = 2 * 64 * 32; int u = F.vcu;
      if (u < NUN) { P3R R; p3_load(R, u, TID());
#pragma nounroll
          for (; u < NUN; u += F.G) p3_ssd_unit(F, u, u + F.G < NUN ? u + F.G : u, R); } }
#endif
        } else {
#if !defined(NO_P3B) && !defined(NO_ATTN)
    for (int it = F.vcu; it < 256; it += F.G) { const int b = it >> 7, x = it & 127; p3_index_group(F, b, x); p3_index_group(F, b, 255 - x); }
#endif
        }
    }
}

__device__ __forceinline__ unsigned fkey(float v) { NANCHK(v != v, 0); const unsigned u = __float_as_uint(v + 0.0f);
    return u ^ ((unsigned)((int)u >> 31) | 0x80000000u); }
__device__ __forceinline__ void sacc(int& c, int v) { asm volatile("s_add_i32 %0, %0, %1" : "+s"(c) : "s"(v) : "scc"); }
__device__ __forceinline__ int wave_sum_i(int v) {
    v += __builtin_amdgcn_update_dpp(0, v, 0xB1, 0xf, 0xf, false);
    v += __builtin_amdgcn_update_dpp(0, v, 0x4E, 0xf, 0xf, false);
    v += __builtin_amdgcn_update_dpp(0, v, 0x141, 0xf, 0xf, false);
    v += __builtin_amdgcn_update_dpp(0, v, 0x140, 0xf, 0xf, false);
    return __builtin_amdgcn_readlane(v, 0) + __builtin_amdgcn_readlane(v, 16) + __builtin_amdgcn_readlane(v, 32) + __builtin_amdgcn_readlane(v, 48);
}
__device__ __forceinline__ void cnt4(int (&c)[4], unsigned k0, unsigned k1, unsigned k2, unsigned k3, unsigned mid) {
    unsigned long long t0, t1, t2, t3;
    asm("v_cmp_ge_u32_e64 %4, %8, %12\n\tv_cmp_ge_u32_e64 %5, %9, %12\n\tv_cmp_ge_u32_e64 %6, %10, %12\n\tv_cmp_ge_u32_e64 %7, %11, %12\n\t"
        "v_addc_co_u32_e64 %0, %4, 0, %0, %4\n\tv_addc_co_u32_e64 %1, %5, 0, %1, %5\n\tv_addc_co_u32_e64 %2, %6, 0, %2, %6\n\tv_addc_co_u32_e64 %3, %7, 0, %3, %7"
        : "+v"(c[0]), "+v"(c[1]), "+v"(c[2]), "+v"(c[3]), "=&s"(t0), "=&s"(t1), "=&s"(t2), "=&s"(t3) : "v"(k0), "v"(k1), "v"(k2), "v"(k3), "v"(mid));
}
template <int NR, int NL>
__device__ __forceinline__ void select_row(float (&raw)[64], const float* Srow, int pos, unsigned long long* Mq, int ntw, int lane, LAS unsigned* lk, LAS unsigned long long* lw, bool okn, int qn) {
    const int ni = (pos >> 6) + 1;
    unsigned key[NR];
    int ln = lane; asm volatile("" : "+v"(ln));
    unsigned kmax = 0u;
#ifdef DOUBLE_CONV
#pragma nounroll
    for (int rep_ = 0; rep_ < 2; ++rep_) { asm volatile("" : "+v"(ln)); kmax = 0u;
#endif
#pragma unroll
    for (int i = 0; i < NR; ++i) { key[i] = 0u; if (i < ni) { const int kidx = i * 64 + ln; key[i] = (kidx <= pos) ? fkey(raw[i]) : 0u; kmax = key[i] > kmax ? key[i] : kmax; } if ((i & 31) == 31) __builtin_amdgcn_sched_barrier(0); }
#pragma unroll
    for (int i = 0; i < NL; ++i) if (NR + i < ni) raw[i] = Srow[(NR + i) * 64 + ln];
    __builtin_amdgcn_sched_barrier(0);
#pragma unroll
    for (int i = 0; i < NL; ++i) { unsigned k = 0u; if (NR + i < ni) { const int kidx = (NR + i) * 64 + ln; k = (kidx <= pos) ? fkey(raw[i]) : 0u; kmax = k > kmax ? k : kmax; } lk[i * 64 + lane] = k; if ((i & 31) == 31) __builtin_amdgcn_sched_barrier(0); }
#ifdef DOUBLE_CONV
    }
#endif
    if (okn) { const int pos_ = qn & (SEQ - 1); if (pos_ >= 256) { const int ni_ = (pos_ >> 6) + 1; const float* sr_ = WSP(float, WS_S) + (size_t)qn * SEQ + lane;
#pragma unroll
        for (int i = 0; i < 64; ++i) if (i < ni_) raw[i] = sr_[i * 64]; } }
#pragma unroll
    for (int o = 1; o < 64; o <<= 1) { const unsigned ok = (unsigned)__shfl_xor((int)kmax, o); kmax = ok > kmax ? ok : kmax; }
    unsigned lo, hi; int clo;
#ifdef DOUBLE_BISECT
#pragma nounroll
    for (int rep_ = 0; rep_ < DOUBLE_BISECT; ++rep_) { asm volatile("" : "+v"(kmax));
#endif
    lo = 0u; hi = kmax + 1u; clo = 0x7fffffff;
    float glo = 0.f, ghi = -256.f; int side = 0, it = 0; const bool okp = kmax > 0x82000000u; const unsigned p1 = kmax - 0x00800000u;
#pragma nounroll
    while (hi - lo > 1u) {
        const unsigned wd = hi - lo; unsigned mid = lo + (wd >> 1);
        if (okp && it == 0) mid = p1;
        else if (okp && it == 1 && hi == p1) mid = kmax - 0x01800000u;
        else if (clo != 0x7fffffff && (it & 7) != 7) { const float f = (glo + 0.5f) * __builtin_amdgcn_rcpf(glo - ghi); unsigned off = (unsigned)((float)wd * f); off = off < 1u ? 1u : off; off = off > wd - 1u ? wd - 1u : off; mid = lo + off; }
        ++it;
        int c4[4] = {0, 0, 0, 0};
#pragma unroll
        for (int i = 0; i < NR; i += 4) cnt4(c4, key[i], key[i + 1], key[i + 2], key[i + 3], mid);
#pragma unroll
        for (int i = 0; i < NL; i += 4) cnt4(c4, lk[i * 64 + lane], lk[(i + 1) * 64 + lane], lk[(i + 2) * 64 + lane], lk[(i + 3) * 64 + lane], mid);
        const int c = wave_sum_i((c4[0] + c4[1]) + (c4[2] + c4[3]));
        if (c >= 256) { lo = mid; clo = c; if (c == 256) break; glo = (float)(c - 256); if (side == 1) ghi *= 0.5f; side = 1; }
        else { hi = mid; ghi = (float)(c - 256); if (side == -1) glo *= 0.5f; side = -1; }
    }
#ifdef DOUBLE_BISECT
    }
#endif
#ifdef DOUBLE_FINAL
#pragma nounroll
    for (int rep_ = 0; rep_ < 2; ++rep_) { asm volatile("" : "+v"(lo));
#endif
    int need = 0x7fffffff;
    if (clo != 256) { int cl = 0;
#pragma unroll
        for (int i = 0; i < NR; ++i) cl += (key[i] > lo) ? 1 : 0;
#pragma unroll
        for (int i = 0; i < NL; ++i) cl += (lk[i * 64 + lane] > lo) ? 1 : 0;
        need = 256 - wave_sum_i(cl); }
    unsigned wl0 = 0u, wh0 = 0u, wl1 = 0u, wh1 = 0u; int ln2 = lane; asm volatile("" : "+v"(ln2));
#define PUT_WORD(i_, bal_) do { const bool me_ = ln2 == ((i_) & 63); if ((i_) < 64) { wl0 = me_ ? (unsigned)(bal_) : wl0; wh0 = me_ ? (unsigned)((bal_) >> 32) : wh0; } else { wl1 = me_ ? (unsigned)(bal_) : wl1; wh1 = me_ ? (unsigned)((bal_) >> 32) : wh1; } } while (0)
    if (clo == 256) {
#pragma unroll
        for (int i = 0; i < NR + NL; ++i) { const unsigned kv = i < NR ? key[i < NR ? i : 0] : lk[(i - NR) * 64 + lane];
            const unsigned long long bal = __ballot(kv >= lo); PUT_WORD(i, bal); __builtin_amdgcn_sched_barrier(0); }
    } else {
    int run = 0; unsigned lo2 = lo; asm volatile("" : "+v"(lo2));
#pragma unroll
    for (int i = 0; i < NR + NL; ++i) {
        const unsigned kv = i < NR ? key[i < NR ? i : 0] : lk[(i - NR) * 64 + lane];
        const bool eq = kv == lo2; const unsigned long long be = __ballot(eq);
        const int pre = run + __popcll(be & ((1ull << lane) - 1ull)); run += __popcll(be);
        const unsigned long long bal = __ballot((kv > lo2) || (eq && pre < need));
        PUT_WORD(i, bal);
        __builtin_amdgcn_sched_barrier(0);
    }
    }
#undef PUT_WORD
    if (lane < ntw && lane < NR + NL) Mq[(size_t)lane * SEQ] = ((unsigned long long)wh0 << 32) | wl0;
    if (NR + NL > 64 && lane + 64 < ntw) Mq[(size_t)(lane + 64) * SEQ] = ((unsigned long long)wh1 << 32) | wl1;
#ifdef DOUBLE_FINAL
    }
#endif
}
__device__ __forceinline__ void p4_scan(Frame& F) {
    const int gt = F.vcu * (NWAVES * 64) + TID(), NT = F.G * NWAVES * 64;
#ifdef DOUBLE_P4A
#pragma nounroll
    for (int rep_ = 0; rep_ < 2; ++rep_)
#endif
    for (int it = gt; it < 2 * 32 * 64 * 32; it += NT) {
        const int n4 = it & 31, p = (it >> 5) & 63, h = (it >> 11) & 31, b = it >> 16;
        f32x4 hs = {0.f, 0.f, 0.f, 0.f};
#pragma nounroll
        for (int c0 = 0; c0 < 64; c0 += 16) {
            f32x4 st[16]; float dc[16];
#pragma unroll
            for (int k = 0; k < 16; ++k) { const size_t idx = ((size_t)(b * 64 + c0 + k) * 32 + h), off = (idx * 64 + p) * 128 + n4 * 4;
                st[k] = *(const f32x4*)(WSP(float, WS_STATES) + off); dc[k] = WSP(float, WS_DACS)[((size_t)(b * 64 + c0 + k) * 128 + 127) * 32 + h]; }
            __builtin_amdgcn_sched_barrier(0);
#pragma unroll
            for (int k = 0; k < 16; ++k) { const size_t idx = ((size_t)(b * 64 + c0 + k) * 32 + h), off = (idx * 64 + p) * 128 + n4 * 4;
                v2u o; o.x = pk2(hs.x, hs.y); o.y = pk2(hs.z, hs.w); *(v2u*)(WSP(bf16, WS_PREV) + off) = o;
                hs = hs * __expf(dc[k]) + st[k]; }
        }
    }
}
__device__ __forceinline__ void p4_phase(Frame& F) {
    const int gt = F.vcu * (NWAVES * 64) + TID(), NT = F.G * NWAVES * 64;
    const int lane = LANE();
    const bool sel_first = (PHASE_SWAP) && (((blockIdx.x >> 3) & 1) != 0);
#ifndef NO_P4A
    if (!sel_first) p4_scan(F);
#endif
#ifndef NO_ATTN
    const int nk = 8 * ((1024 + 4 * F.G - 1) / (4 * F.G));
    float raw[64];
#define P4_QUERY(k_, q_, ok_) do { const int kk_ = (k_) >> 1, base_ = (kk_ >> 2) * F.G + F.vcu, ph_ = kk_ & 3; ok_ = (k_) < nk && base_ < 256; \
        const int grp_ = ph_ == 0 ? base_ : ph_ == 1 ? 511 - base_ : ph_ == 2 ? 512 + base_ : 1023 - base_; q_ = grp_ * 16 + 2 * F.wave + ((k_) & 1); } while (0)
#define P4_PREFETCH(q_) do { const int pos_ = (q_) & (SEQ - 1); if (pos_ >= 256) { const int ni_ = (pos_ >> 6) + 1; const float* sr_ = WSP(float, WS_S) + (size_t)(q_) * SEQ + lane; \
        _Pragma("unroll") for (int i = 0; i < 64; ++i) if (i < ni_) raw[i] = sr_[i * 64]; } } while (0)
    { int q0; bool ok0; P4_QUERY(0, q0, ok0); if (ok0) P4_PREFETCH(q0); }
    for (int k = 0; k < nk; ++k) {
        int q; bool ok; P4_QUERY(k, q, ok); if (!ok) continue;
        int qn; bool okn; P4_QUERY(k + 1, qn, okn);
        const int b = q >> 13, pos = q & (SEQ - 1), ntw = 4 * ((pos >> 8) + 1);
        unsigned long long* Mq = WSP(unsigned long long, WS_MASK) + (size_t)b * 128 * SEQ + pos;
        if (pos < 256) { if (lane < ntw) { const int d = pos - 64 * lane; Mq[(size_t)lane * SEQ] = d >= 63 ? ~0ull : (d < 0 ? 0ull : ((2ull << d) - 1ull)); } if (okn) P4_PREFETCH(qn); }
        else { const float* Srow = WSP(float, WS_S) + (size_t)q * SEQ; const int ni = (pos >> 6) + 1;
            LAS unsigned* lk = (LAS unsigned*)(F.lds + RING_OFF + F.wave * 16384); LAS unsigned long long* lw = (LAS unsigned long long*)(F.lds + RS_OFF + F.wave * 1024);
            if (ni <= 32) select_row<32, 0>(raw, Srow, pos, Mq, ntw, lane, lk, lw, okn, qn); else if (ni <= 64) select_row<64, 0>(raw, Srow, pos, Mq, ntw, lane, lk, lw, okn, qn);
            else if (ni <= 96) select_row<64, 32>(raw, Srow, pos, Mq, ntw, lane, lk, lw, okn, qn); else select_row<64, 64>(raw, Srow, pos, Mq, ntw, lane, lk, lw, okn, qn); }
    }
#undef P4_QUERY
#undef P4_PREFETCH
#endif
#ifndef NO_P4A
    if (sel_first) p4_scan(F);
#endif
}

constexpr int S5_CS = 0, S5_PS = 34816, S5_VEC = 52224, S5_YO = 53248;
struct P5R { v4u c[4], p[2], yd[2], xv[2], zv[2]; float dac, dsk; };
__device__ __forceinline__ void p5_load(P5R& R, int u, int tid) {
    const int h = u & 31, bc = u >> 5, g = h >> 3; const size_t t0 = (size_t)bc * 128;
#pragma unroll
    for (int i = 0; i < 2; ++i) { const int idx = tid + 512 * i, l = idx >> 3, c8 = (idx & 7) * 8; const size_t t = t0 + l; const int col = h * 64 + c8;
        R.yd[i] = *(const v4u*)(WSP(bf16, WS_YD) + t * 2048 + col); R.xv[i] = *(const v4u*)(WSP(bf16, WS_XBC) + t * 3072 + col); R.zv[i] = *(const v4u*)(WSP(bf16, WS_U) + t * NU + UC_Z + col); }
#pragma unroll
    for (int i = 0; i < 4; ++i) { const int idx = tid + 512 * i, row = idx >> 4, ch = idx & 15; R.c[i] = *(const v4u*)(WSP(bf16, WS_XBC) + (t0 + row) * 3072 + 2560 + g * 128 + ch * 8); }
#pragma unroll
    for (int i = 0; i < 2; ++i) { const int idx = tid + 512 * i, row = idx >> 4, ch = idx & 15; R.p[i] = *(const v4u*)(WSP(bf16, WS_PREV) + ((size_t)u * 64 + row) * 128 + ch * 8); }
    R.dac = WSP(float, WS_DACS)[(t0 + (tid & 127)) * 32 + h]; R.dsk = INP(6)[h];
}
__device__ __forceinline__ void p5_ssd_all(Frame& F) {
    constexpr int NUN = 2 * 64 * 32;
    const int tid = TID(), lane = LANE(), w = F.wave, r32 = lane & 31, hh = lane >> 5;
    LAS unsigned char* L = F.lds + RING_OFF; LAS float* dacs = (LAS float*)(L + S5_VEC);
    int u = F.vcu; if (u >= NUN) return;
    P5R R; p5_load(R, u, tid);
#pragma nounroll
    for (; u < NUN; u += F.G) {
        const int h = u & 31, bc = u >> 5; const size_t t0 = (size_t)bc * 128;
#pragma unroll
        for (int i = 0; i < 4; ++i) { const int idx = tid + 512 * i, row = idx >> 4, ch = idx & 15; *(LAS v4u*)(L + S5_CS + row * SP_C + ch * 16) = R.c[i]; }
#pragma unroll
        for (int i = 0; i < 2; ++i) { const int idx = tid + 512 * i, row = idx >> 4, ch = idx & 15; *(LAS v4u*)(L + S5_PS + row * SP_C + ch * 16) = R.p[i]; }
        if (tid < 128) dacs[tid] = R.dac;
        const v4u cyd[2] = {R.yd[0], R.yd[1]}, cxv[2] = {R.xv[0], R.xv[1]}, czv[2] = {R.zv[0], R.zv[1]}; const float dsk = R.dsk;
        __syncthreads();
        p5_load(R, u + F.G < NUN ? u + F.G : u, tid);
        __builtin_amdgcn_sched_barrier(0);
        const int li = w >> 1, pb = w & 1; f32x16 acc = {};
        { const LAS unsigned char* cp = L + S5_CS + (32 * li + r32) * SP_C + hh * 16; const LAS unsigned char* pp = L + S5_PS + (32 * pb + r32) * SP_C + hh * 16;
#pragma unroll
          for (int ks = 0; ks < 8; ++ks) acc = __builtin_amdgcn_mfma_f32_32x32x16_bf16(lds_b128(cp + ks * 32), lds_b128(pp + ks * 32), acc, 0, 0, 0); }
        LAS float* Yo = (LAS float*)(L + S5_YO);
#pragma unroll
        for (int r = 0; r < 16; ++r) Yo[(32 * li + crow16(r, hh)) * 68 + 32 * pb + r32] = acc[r];
        __syncthreads();
#pragma unroll
        for (int i = 0; i < 2; ++i) { const int idx = tid + 512 * i, l = idx >> 3, c8 = (idx & 7) * 8; const size_t t = t0 + l; const int col = h * 64 + c8;
            const f32x4 y0 = *(const LAS f32x4*)(Yo + l * 68 + c8), y1 = *(const LAS f32x4*)(Yo + l * 68 + c8 + 4);
            const v4u yd = cyd[i], xv = cxv[i], zv = czv[i];
            const float e = __expf(dacs[l]);
            float o[8];
            o[0] = (bflo(yd.x) + y0[0] * e + bflo(xv.x) * dsk) * siluf(bflo(zv.x)); o[1] = (bfhi(yd.x) + y0[1] * e + bfhi(xv.x) * dsk) * siluf(bfhi(zv.x));
            o[2] = (bflo(yd.y) + y0[2] * e + bflo(xv.y) * dsk) * siluf(bflo(zv.y)); o[3] = (bfhi(yd.y) + y0[3] * e + bfhi(xv.y) * dsk) * siluf(bfhi(zv.y));
            o[4] = (bflo(yd.z) + y1[0] * e + bflo(xv.z) * dsk) * siluf(bflo(zv.z)); o[5] = (bfhi(yd.z) + y1[1] * e + bfhi(xv.z) * dsk) * siluf(bfhi(zv.z));
            o[6] = (bflo(yd.w) + y1[2] * e + bflo(xv.w) * dsk) * siluf(bflo(zv.w)); o[7] = (bfhi(yd.w) + y1[3] * e + bfhi(xv.w) * dsk) * siluf(bfhi(zv.w));
            v4u ov; ov.x = pk2(o[0], o[1]); ov.y = pk2(o[2], o[3]); ov.z = pk2(o[4], o[5]); ov.w = pk2(o[6], o[7]);
            *(v4u*)(WSP(bf16, WS_YG) + t * 2048 + col) = ov; }
        __syncthreads();
    }
}
#ifndef TAILSPIN_ALL
#define TAILSPIN_ALL 0
#endif

typedef att::BlockRef<att::bf16, att::bf16> ABlk;
__device__ __forceinline__ ABlk att_ref(const bf16* U, const bf16* QR, const bf16* KR, bf16* AO, const unsigned long long* MASK, int L, int pass) {
    const int bh = L >> 4, x = L & 15, qb = pass ? 31 - x : x, b = bh >> 4, hd = bh & 15;
    ABlk r;
    r.Q = (const att::bf16*)(QR + ((size_t)b * SEQ + qb * 256) * DM + hd * 128);
    r.K = (const att::bf16*)(KR + ((size_t)b * SEQ) * DM + hd * 128);
    r.V = (const att::bf16*)(U + ((size_t)b * SEQ) * NU + UC_V + hd * 128);
    r.O = (att::bf16*)(AO + ((size_t)b * SEQ + qb * 256) * 2048 + hd * 128);
    r.MK = MASK + (size_t)b * 128 * SEQ + qb * 256;
    r.P0 = qb * 256;
    return r;
}
__device__ __forceinline__ void p5_attention(Frame& F) {
    constexpr int NITEM = 512;
    int L = F.vcu; if (L >= NITEM) return;
    const bf16* U = WSP(bf16, WS_U); const bf16* QR = WSP(bf16, WS_QR); const bf16* KR = WSP(bf16, WS_KR); bf16* AO = WSP(bf16, WS_AO); const unsigned long long* MK = WSP(unsigned long long, WS_MASK); const int stride = F.G;
    char* lds = (char*)(F.lds + RING_OFF);
    int pass = 0;
    ABlk cur = att_ref(U, QR, KR, AO, MK, L, 0);
    att::Seam<att::bf16> S;
    att::causal_swa_prime<att::bf16, att::bf16>(cur, SEQ, lds, S);
    for (;;) {
        const bool more_pass = pass == 0, more_item = L + stride < NITEM, last = !more_pass && !more_item;
        int passn = pass + 1, Ln = L;
        if (!more_pass) { passn = 0; Ln = more_item ? L + stride : L; }
        const ABlk nxt = last ? cur : att_ref(U, QR, KR, AO, MK, Ln, passn);
        att::causal_swa_block<att::bf16, att::bf16>(cur, nxt, SEQ, SEQ, lds, S);
        if (last) break;
        cur = nxt; pass = passn; L = Ln;
    }
}

__device__ __forceinline__ float wave_sum_dpp(float v) {
    v += __int_as_float(__builtin_amdgcn_update_dpp(0, __float_as_int(v), 0xB1, 0xf, 0xf, false));
    v += __int_as_float(__builtin_amdgcn_update_dpp(0, __float_as_int(v), 0x4E, 0xf, 0xf, false));
    v += __int_as_float(__builtin_amdgcn_update_dpp(0, __float_as_int(v), 0x141, 0xf, 0xf, false));
    v += __int_as_float(__builtin_amdgcn_update_dpp(0, __float_as_int(v), 0x140, 0xf, 0xf, false));
    const int iv = __float_as_int(v);
    return (__int_as_float(__builtin_amdgcn_readlane(iv, 0)) + __int_as_float(__builtin_amdgcn_readlane(iv, 16))) + (__int_as_float(__builtin_amdgcn_readlane(iv, 32)) + __int_as_float(__builtin_amdgcn_readlane(iv, 48)));
}
__device__ __forceinline__ void p9_route(Frame& F) {
    const int lane = LANE(), wave = F.wave, tid = TID();
    LAS int* ent = (LAS int*)(F.lds + RING_OFF);
    const int ngrp = T / 4, nrounds = (ngrp + F.G * NWAVES - 1) / (F.G * NWAVES);
    for (int rd = 0; rd < nrounds; ++rd) {
        const int grp = (rd * F.G + F.vcu) * NWAVES + wave; const bool valid = grp < ngrp;
        if (valid) {
            f32x4 xn[4][8], nw[8];
#pragma unroll
            for (int tk = 0; tk < 4; ++tk) { const f32x4* xr = (const f32x4*)(WSP(float, WS_H1) + ((size_t)grp * 4 + tk) * DM) + lane;
#pragma unroll
                for (int j = 0; j < 8; ++j) xn[tk][j] = xr[64 * j]; }
#pragma unroll
            for (int j = 0; j < 8; ++j) nw[j] = ((const f32x4*)INP(12))[lane + 64 * j];
            __builtin_amdgcn_sched_barrier(0);
#pragma unroll
            for (int tk = 0; tk < 4; ++tk) { const size_t tok = (size_t)grp * 4 + tk; float s = 0.f;
#pragma unroll
                for (int j = 0; j < 8; ++j) s += (xn[tk][j].x * xn[tk][j].x + xn[tk][j].y * xn[tk][j].y) + (xn[tk][j].z * xn[tk][j].z + xn[tk][j].w * xn[tk][j].w);
                const float rstd = 1.f / sqrtf(wave_sum(s) * (1.f / DM) + EPS);
                unsigned* o4 = (unsigned*)(WSP(unsigned char, WS_XN2) + tok * DM) + lane;
#pragma unroll
                for (int j = 0; j < 8; ++j) { const f32x4 wv = nw[j]; xn[tk][j] = xn[tk][j] * rstd * wv;
                    o4[64 * j] = pg8::pk4_fp8(xn[tk][j].x * pg8::F8_SX, xn[tk][j].y * pg8::F8_SX, xn[tk][j].z * pg8::F8_SX, xn[tk][j].w * pg8::F8_SX); } }
            float lg[2] = {0.f, 0.f};
            for (int e = 0; e < NEXP; ++e) {
                if ((e & 15) == 0) {
                    __syncthreads();
#pragma unroll
                    for (int i = 0; i < 16; ++i) ((LAS f32x4*)(F.lds + RING_OFF))[tid + 512 * i] = ((const f32x4*)(WSP(float, WS_RWT) + (size_t)e * DM))[tid + 512 * i];
                    __syncthreads(); }
                typedef float f32x2_t __attribute__((ext_vector_type(2)));
                f32x2_t q0 = {0.f, 0.f}, q1 = q0, q2 = q0, q3 = q0; const LAS f32x4* rw = (const LAS f32x4*)(F.lds + RING_OFF + (e & 15) * 8192) + lane;
#pragma unroll
                for (int j = 0; j < 8; ++j) { const f32x4 r = rw[64 * j]; const f32x2_t rl = {r.x, r.y}, rh = {r.z, r.w};
#define P9_FMA(Q_, X_) do { const f32x4 t_ = X_; Q_ = __builtin_elementwise_fma((f32x2_t){t_[0], t_[1]}, rl, Q_); Q_ = __builtin_elementwise_fma((f32x2_t){t_[2], t_[3]}, rh, Q_); } while (0)
                    P9_FMA(q0, xn[0][j]); P9_FMA(q1, xn[1][j]); P9_FMA(q2, xn[2][j]); P9_FMA(q3, xn[3][j]);
#undef P9_FMA
                }
                float p0 = q0.x + q0.y, p1 = q1.x + q1.y, p2 = q2.x + q2.y, p3 = q3.x + q3.y;
                p0 = wave_sum_dpp(p0); p1 = wave_sum_dpp(p1); p2 = wave_sum_dpp(p2); p3 = wave_sum_dpp(p3);
                const float bb = INP(14)[e];
                if ((lane & 31) == e) { lg[0] = ((lane >> 5) ? p1 : p0) + bb; lg[1] = ((lane >> 5) ? p3 : p2) + bb; }
            }
            __syncthreads();
#pragma unroll
            for (int jj = 0; jj < 2; ++jj) {
                float v = lg[jj]; float tv[4]; int ti[4];
#pragma unroll
                for (int k = 0; k < 4; ++k) { float bv = v; int bi = lane & 31;
#pragma unroll
                    for (int o = 1; o < 32; o <<= 1) { const float ov = __shfl_xor(bv, o); const int oi = __shfl_xor(bi, o); if (ov > bv || (ov == bv && oi < bi)) { bv = ov; bi = oi; } }
                    tv[k] = bv; ti[k] = bi; if ((lane & 31) == bi) v = -__builtin_inff(); }
                const float e0 = 1.f, e1 = expf(tv[1] - tv[0]), e2 = expf(tv[2] - tv[0]), e3 = expf(tv[3] - tv[0]); const float inv = 1.f / (e0 + e1 + e2 + e3);
                const int slot = lane & 31;
                if (slot < 4) { const int ee = slot == 0 ? ti[0] : slot == 1 ? ti[1] : slot == 2 ? ti[2] : ti[3]; const float ww = (slot == 0 ? e0 : slot == 1 ? e1 : slot == 2 ? e2 : e3) * inv;
                    const int tok = grp * 4 + 2 * jj + (lane >> 5);
                    ent[wave * 16 + (2 * jj + (lane >> 5)) * 4 + slot] = ee;
                    WSP(int, WS_ROUTE)[tok * 4 + slot] = ee; WSP(float, WS_ROUTE + 256 * 1024)[tok * 4 + slot] = ww; }
            }
        }
        __syncthreads();
        const int round = rd * F.G + F.vcu;
        if (round * 32 < T) {
            if (tid < 128) { const int ej = ent[tid]; int lr = 0; for (int i = 0; i < tid; ++i) lr += (ent[i] == ej) ? 1 : 0;
                WSP(int, WS_ROUTE + 512 * 1024)[(round * 32) * 4 + tid] = lr; }
            if (tid >= 128 && tid < 160) { const int e = tid - 128; int c = 0; for (int i = 0; i < 128; ++i) c += (ent[i] == e) ? 1 : 0; WSP(int, WS_ROUTE + 2048 * 1024)[round * 32 + e] = c; }
        }
        __syncthreads();
    }
}

__device__ __forceinline__ void moe_offsets(Frame& F, bool keep_prefix) {
    LAS int* eoff = (LAS int*)(F.lds + EOFF_OFF); LAS int* tile_e = (LAS int*)(F.lds + TILE_E_OFF);
    LAS int* pre = (LAS int*)(F.lds + RING_OFF); LAS int* part = (LAS int*)(F.lds + RING_OFF + 65536);
    const int NR = T / 32;
    __syncthreads();
    for (int i = TID(); i < NR * 32; i += NWAVES * 64) pre[i] = WSP(int, WS_ROUTE + 2048 * 1024)[i];
    __syncthreads();
    { const int e = TID() & 31, ch = TID() >> 5; int s = 0; for (int r = ch * 32; r < ch * 32 + 32; ++r) s += pre[r * 32 + e]; part[ch * 32 + e] = s; }
    __syncthreads();
    if (TID() < 32) { int s = 0; for (int ch = 0; ch < 16; ++ch) { const int v = part[ch * 32 + TID()]; part[ch * 32 + TID()] = s; s += v; } part[512 + TID()] = s; }
    __syncthreads();
    if (keep_prefix) { const int e = TID() & 31, ch = TID() >> 5; int s = part[ch * 32 + e]; for (int r = ch * 32; r < ch * 32 + 32; ++r) { const int v = pre[r * 32 + e]; pre[r * 32 + e] = s; s += v; } }
    if (TID() == 0) { int o = 0; for (int e = 0; e < NEXP; ++e) { eoff[e] = o; o += (part[512 + e] + 255) & ~255; } eoff[32] = o; eoff[33] = o >> 8; for (int e = 0; e < NEXP; ++e) eoff[34 + e] = part[512 + e]; }
    __syncthreads();
    if (TID() < NEXP) { for (int t = eoff[TID()] >> 8; t < (eoff[TID() + 1] >> 8); ++t) tile_e[t] = TID(); }
    __syncthreads();
}
__device__ __forceinline__ void p10_sort(Frame& F) {
    const int gw = F.vcu * NWAVES + F.wave, NGW = F.G * NWAVES, lane = LANE();
    LAS int* eoff = (LAS int*)(F.lds + EOFF_OFF);
    moe_offsets(F, true);
    LAS int* pre = (LAS int*)(F.lds + RING_OFF);
    for (int tok = gw; tok < T; tok += NGW) {
        const v4u* src = (const v4u*)(WSP(unsigned char, WS_XN2) + (size_t)tok * DM) + lane; v4u v[2];
        const int4 es = *(const int4*)(WSP(int, WS_ROUTE) + tok * 4), rk = *(const int4*)(WSP(int, WS_ROUTE + 512 * 1024) + tok * 4);
#pragma unroll
        for (int j = 0; j < 2; ++j) v[j] = src[64 * j];
        __builtin_amdgcn_sched_barrier(0);
        int4 rows;
#pragma unroll
        for (int s = 0; s < 4; ++s) { const int e = s == 0 ? es.x : s == 1 ? es.y : s == 2 ? es.z : es.w, row = eoff[e] + pre[(tok >> 5) * 32 + e] + (s == 0 ? rk.x : s == 1 ? rk.y : s == 2 ? rk.z : rk.w);
            v4u* dst = (v4u*)(WSP(unsigned char, WS_AS) + (size_t)row * DM) + lane;
#pragma unroll
            for (int j = 0; j < 2; ++j) dst[64 * j] = v[j];
            if (s == 0) rows.x = row; else if (s == 1) rows.y = row; else if (s == 2) rows.z = row; else rows.w = row; }
        if (lane == 0) *(int4*)(WSP(int, WS_ROUTE + 768 * 1024) + tok * 4) = rows;
    }
    for (int e = 0; e < NEXP; ++e) { const int cnt = eoff[34 + e], r0 = eoff[e] + cnt, npad = eoff[e + 1] - r0; const v4u z = {0u, 0u, 0u, 0u};
        for (int r = gw; r < npad; r += NGW) { v4u* dst = (v4u*)(WSP(unsigned char, WS_AS) + (size_t)(r0 + r) * DM) + lane;
#pragma unroll
            for (int j = 0; j < 2; ++j) dst[64 * j] = z; } }
    if (blockIdx.x == 0 && TID() == 0) *(int*)(CTLP() + CW_NT) = eoff[33];
}

__device__ __forceinline__ float f8dec(unsigned w, int b) { return b == 0 ? __builtin_amdgcn_cvt_f32_fp8((int)w, 0) : b == 1 ? __builtin_amdgcn_cvt_f32_fp8((int)w, 1) : b == 2 ? __builtin_amdgcn_cvt_f32_fp8((int)w, 2) : __builtin_amdgcn_cvt_f32_fp8((int)w, 3); }
__device__ __forceinline__ void p_swiglu(Frame& F) {
    const int ntiles = *(const int*)(CTLP() + CW_NT);
    const size_t nitem = (size_t)ntiles * 256 * 128;
    constexpr float IS = 1.0f / pg8::F8_SH;
    for (size_t it = (size_t)F.vcu * (NWAVES * 64) + TID(); it < nitem; it += (size_t)F.G * NWAVES * 64) {
        const size_t row = it >> 7; const int cg = (int)(it & 127), pn = cg >> 3, j = (cg & 7) * 16;
        const unsigned char* hp = WSP(unsigned char, WS_H8) + row * 4096 + pn * 256 + j;
        const v4u gv = *(const v4u*)hp, lv = *(const v4u*)(hp + 128); v4u o;
#define SW4(G, L) pg8::pk4_fp8(pg8::swiglu1(f8dec(G, 0) * IS, f8dec(L, 0) * IS) * pg8::F8_SA, pg8::swiglu1(f8dec(G, 1) * IS, f8dec(L, 1) * IS) * pg8::F8_SA, pg8::swiglu1(f8dec(G, 2) * IS, f8dec(L, 2) * IS) * pg8::F8_SA, pg8::swiglu1(f8dec(G, 3) * IS, f8dec(L, 3) * IS) * pg8::F8_SA)
        o.x = SW4(gv.x, lv.x); o.y = SW4(gv.y, lv.y); o.z = SW4(gv.z, lv.z); o.w = SW4(gv.w, lv.w);
#undef SW4
        *(v4u*)(WSP(unsigned char, WS_ACT) + row * 2048 + pn * 128 + j) = o;
    }
}

__device__ __forceinline__ void p13_final(Frame& F) {
    const int gw = F.vcu * NWAVES + F.wave, NGW = F.G * NWAVES, lane = LANE();
    f32x4 fw[8];
#pragma unroll
    for (int j = 0; j < 8; ++j) fw[j] = ((const f32x4*)INP(19))[lane + 64 * j];
    int4 rows_n = {0, 0, 0, 0}; f32x4 gws_n = {0.f, 0.f, 0.f, 0.f};
    if (gw < T) { rows_n = *(const int4*)(WSP(int, WS_ROUTE + 768 * 1024) + gw * 4); gws_n = *(const f32x4*)(WSP(float, WS_ROUTE + 256 * 1024) + gw * 4); }
    for (int tok = gw; tok < T; tok += NGW) {
        const f32x4* hr = (const f32x4*)(WSP(float, WS_H1) + (size_t)tok * DM) + lane; f32x4 v[8];
        const int4 rows = rows_n; const f32x4 gws = gws_n;
        if (tok + NGW < T) { rows_n = *(const int4*)(WSP(int, WS_ROUTE + 768 * 1024) + (tok + NGW) * 4); gws_n = *(const f32x4*)(WSP(float, WS_ROUTE + 256 * 1024) + (tok + NGW) * 4); }
#pragma unroll
        for (int j = 0; j < 8; ++j) v[j] = hr[64 * j];
        v2u os[4][8];
#pragma unroll
        for (int s = 0; s < 4; ++s) { const int row = s == 0 ? rows.x : s == 1 ? rows.y : s == 2 ? rows.z : rows.w; const v2u* orow = (const v2u*)(WSP(bf16, WS_OS) + (size_t)row * DM) + lane;
#pragma unroll
            for (int j = 0; j < 8; ++j) os[s][j] = orow[64 * j]; }
        __builtin_amdgcn_sched_barrier(0);
#pragma unroll
        for (int s = 0; s < 4; ++s) { const float gw_ = gws[s];
#pragma unroll
            for (int j = 0; j < 8; ++j) { const v2u o = os[s][j]; v[j].x += gw_ * bflo(o.x); v[j].y += gw_ * bfhi(o.x); v[j].z += gw_ * bflo(o.y); v[j].w += gw_ * bfhi(o.y); } }
        float ssum = 0.f;
#pragma unroll
        for (int j = 0; j < 8; ++j) ssum += (v[j].x * v[j].x + v[j].y * v[j].y) + (v[j].z * v[j].z + v[j].w * v[j].w);
        const float rstd = 1.f / sqrtf(wave_sum(ssum) * (1.f / DM) + EPS);
        f32x4* orow = (f32x4*)(OUTP() + (size_t)tok * DM) + lane;
#pragma unroll
        for (int j = 0; j < 8; ++j) orow[64 * j] = v[j] * rstd * fw[j];
    }
}

#ifndef AEPI
#define AEPI true
#endif
#ifndef PHASE_SWAP
#define PHASE_SWAP 1
#endif
constexpr int NPHASE = 15;
struct Args { const float* in[20]; float* out; unsigned char* ws; int ph_lo, ph_hi, li, pad; };
__global__ void __launch_bounds__(NWAVES * 64, 2) hybrid_fwd(Args args) {
    extern __shared__ __attribute__((aligned(16))) unsigned char lds[];
    Frame F;
    F.lds = (LAS unsigned char*)lds;
    F.wave = __builtin_amdgcn_readfirstlane((int)threadIdx.x >> 6);
    F.G = gridDim.x; { const int bx = blockIdx.x; F.vcu = (F.G % 8 == 0) ? (bx % 8) * (F.G / 8) + bx / 8 : bx; }
    for (int u = TID(); u < (LDS_BYTES - LDSCTL_OFF) / 4; u += NWAVES * 64) ((LAS unsigned*)(F.lds + LDSCTL_OFF))[u] = 0u;
    __syncthreads();
    (void)xcd_barrier_post((unsigned*)(CTLP() + CW_BAR), (volatile LAS unsigned*)(F.lds + MISC_OFF) + 8);
#define bar (XcdBarrier{(unsigned*)(CTLP() + CW_BAR), xb_xcc_id(), (volatile LAS unsigned*)(F.lds + MISC_OFF) + 8})
    const int lo = args.ph_lo, hi = args.ph_hi;
#ifdef HEADSPIN_US
    { const unsigned long long t1 = __builtin_amdgcn_s_memrealtime(); while (__builtin_amdgcn_s_memrealtime() - t1 < (unsigned long long)HEADSPIN_US * 100ull) __builtin_amdgcn_s_sleep(8); }
#endif
#ifndef PH_MASK
#define PH_MASK 0xFFFFFFFFu
#endif
#define IN(k) (((PH_MASK >> (k)) & 1u) && lo <= (k) && (k) < hi)
#ifdef PROBE_PHASE
    unsigned long long pr_t0 = __builtin_amdgcn_s_memrealtime(), pr_dt = 0ull;
#define SEAM(k) do { if (IN(k) && IN((k) + 1)) xcd_barrier(bar); if ((k) == (PROBE_PHASE == 8 ? 6 : PROBE_PHASE == 13 ? 11 : PROBE_PHASE - 1)) pr_t0 = __builtin_amdgcn_s_memrealtime(); if ((k) == PROBE_PHASE) pr_dt = __builtin_amdgcn_s_memrealtime() - pr_t0; } while (0)
#else
#define SEAM(k) do { if (IN(k) && IN((k) + 1)) xcd_barrier(bar); } while (0)
#endif

#ifdef NANFILL
    { const size_t n16 = (WS_END - 2 * MiB) / 16; v4u* p = (v4u*)(WSB() + 2 * MiB); const v4u q = {0xffffffffu, 0xffffffffu, 0xffffffffu, 0xffffffffu};
      for (size_t i = (size_t)blockIdx.x * 512 + TID(); i < n16; i += (size_t)F.G * 512) p[i] = q;
      xcd_barrier(bar); }
#endif
    if (IN(0)) { p0_prologue(F);
#ifdef DOUBLE_P0
        p0_prologue(F);
#endif
    } SEAM(0);
    if (IN(1)) { pg8::Gemm g{WSP(bf16, WS_XN), WSP(bf16, WS_WIN), T, NU, DM}; pg8::StaticOrder S; S.init(T, NU, F.G, (int)blockIdx.x); pg8::EpiU E{WSP(bf16, WS_U), NU};
        pg8::gemm_phase<pg8::EpiU, pg8::StaticOrder, AEPI, true>(F.lds + RING_OFF, g, S, E); } SEAM(1);
    if (IN(2)) { p2_prep(F); } SEAM(2);
    if (IN(3)) { p3_phase(F); } SEAM(3);
    if (IN(4)) { p4_phase(F); } SEAM(4);
    if (IN(5)) {
#if defined(NO_P5A) || defined(NO_ATTN) || defined(NO_P5B)
#ifndef NO_P5A
        p5_ssd_all(F);
#endif
#ifdef NO_ATTN
        { const v4u z = {0u, 0u, 0u, 0u}; v4u* p = (v4u*)WSP(bf16, WS_AO); for (size_t i = (size_t)blockIdx.x * 512 + TID(); i < (size_t)T * DM / 8; i += (size_t)F.G * 512) p[i] = z; }
#elif !defined(NO_P5B)
        p5_attention(F);
#endif
#else
        { const bool att_first = (PHASE_SWAP) && (((blockIdx.x >> 3) & 1) != 0);
#ifndef EXPERT_W_IN_P0
          if (!att_first) { p0_expert_items(F); p5_ssd_all(F); }
          p5_attention(F);
          if (att_first) { p5_ssd_all(F); p0_expert_items(F); } }
#else
          if (!att_first) p5_ssd_all(F);
          p5_attention(F);
          if (att_first) p5_ssd_all(F); }
#endif
#endif
    } SEAM(5);
    if (IN(6)) { pg8::Gemm g{WSP(bf16, WS_YG), WSP(bf16, WS_WSSD), T, DM, DM, WSP(bf16, WS_AO), WSP(bf16, WS_WATT)}; pg8::ChainOrder S; S.base.init(T, DM, F.G, (int)blockIdx.x);
        LAS float* rtab = (LAS float*)(F.lds + RS_OFF); LAS int* rpm = (LAS int*)(F.lds + RS_OFF + 4096);
        { pg8::Unit u;
          int prev_pm = -1;
          for (int i = 0; i < 4 && S.base.next(i, u); ++i) { if (u.pm == prev_pm) { if (TID() == 0) rpm[i] = -1; continue; } prev_pm = u.pm;
              if (TID() == 0) rpm[i] = u.pm;
#pragma nounroll
              for (int rb = 0; rb < 4; ++rb) {
                  v4u vv[8][4];
#pragma unroll
                  for (int k = 0; k < 8; ++k) { const int r = F.wave + NWAVES * (rb * 8 + k); const v4u* p = (const v4u*)(WSP(bf16, WS_YG) + ((size_t)u.pm * 256 + r) * DM) + LANE();
#pragma unroll
                      for (int j = 0; j < 4; ++j) vv[k][j] = p[64 * j]; }
                  __builtin_amdgcn_sched_barrier(0);
#pragma unroll
                  for (int k = 0; k < 8; ++k) { const int r = F.wave + NWAVES * (rb * 8 + k); float ss = 0.f;
#pragma unroll
                      for (int j = 0; j < 4; ++j) { const v4u v = vv[k][j]; const float a0 = bflo(v.x), a1 = bfhi(v.x), a2 = bflo(v.y), a3 = bfhi(v.y), a4 = bflo(v.z), a5 = bfhi(v.z), a6 = bflo(v.w), a7 = bfhi(v.w);
                          ss += ((a0 * a0 + a1 * a1) + (a2 * a2 + a3 * a3)) + ((a4 * a4 + a5 * a5) + (a6 * a6 + a7 * a7)); }
                      ss = wave_sum(ss); if (LANE() == 0) rtab[i * 256 + r] = 1.0f / sqrtf(ss * (1.0f / DM) + EPS); } } }
          __syncthreads(); }
        pg8::EpiMerge E{WSP(bf16, WS_MG), WSP(bf16, WS_U) + UC_GS, WSP(bf16, WS_U) + UC_GA, NU, rtab, rpm};
        pg8::gemm_phase<pg8::EpiMerge, pg8::ChainOrder, AEPI, true>(F.lds + RING_OFF, g, S, E); } SEAM(6);
    if (IN(8)) { pg8::Gemm g{WSP(bf16, WS_MG), WSP(bf16, WS_WOUT), T, DM, DM}; pg8::StaticOrder S; S.init(T, DM, F.G, (int)blockIdx.x); pg8::EpiOut E{WSP(float, WS_H1), INP(0)};
        pg8::gemm_phase<pg8::EpiOut, pg8::StaticOrder, AEPI, true>(F.lds + RING_OFF, g, S, E); } SEAM(8);
    if (IN(9)) { p9_route(F); } SEAM(9);
    if (IN(10)) { p10_sort(F); } SEAM(10);
    if (IN(11)) { moe_offsets(F, false); const int ntiles = ((LAS int*)(F.lds + EOFF_OFF))[33];
        pg8::Gemm g{WSP(bf16, WS_AS), WSP(bf16, WS_W1), ntiles * 256, 4096, DM / 2};
        pg8::GroupedOrder S; S.init(ntiles, 16, F.G, (int)blockIdx.x, (const LAS int*)(F.lds + TILE_E_OFF)); pg8::EpiSwiglu E{WSP(bf16, WS_ACT), INP(16)};
        pg8::gemm_phase<pg8::EpiSwiglu, pg8::GroupedOrder, AEPI, true, true>(F.lds + RING_OFF, g, S, E); } SEAM(11);
    if (IN(13)) { moe_offsets(F, false); const int ntiles = ((LAS int*)(F.lds + EOFF_OFF))[33];
        pg8::Gemm g{WSP(bf16, WS_ACT), WSP(bf16, WS_W2), ntiles * 256, DM, DM / 2};     pg8::GroupedOrder S; S.init(ntiles, 8, F.G, (int)blockIdx.x, (const LAS int*)(F.lds + TILE_E_OFF)); pg8::EpiMoeOut E{WSP(bf16, WS_OS), INP(18)};
        pg8::gemm_phase<pg8::EpiMoeOut, pg8::GroupedOrder, AEPI, true, true>(F.lds + RING_OFF, g, S, E); } SEAM(13);
    if (IN(14)) { p13_final(F); }
#ifdef SENTINEL_SCAN
    { xcd_barrier(bar);
      unsigned* cntw = (unsigned*)(CTLP() + 12288);
      int tid_ = TID(); asm volatile("" : "+v"(tid_)); const size_t gt = (size_t)blockIdx.x * 512 + tid_, NT = (size_t)F.G * 512;
      unsigned c0 = 0, c1 = 0, c2 = 0, c3 = 0, c4 = 0, c5 = 0, c6 = 0, c7 = 0;
      { const unsigned* S = (const unsigned*)WSP(float, WS_S); for (size_t i = gt; i < (size_t)T * SEQ; i += NT) { const int q = (int)(i >> 13), k = (int)(i & 8191), pos = q & 8191; if (k <= pos && S[i] == 0xffffffffu) c0++; } }
      { const unsigned long long* M = WSP(unsigned long long, WS_MASK); for (size_t i = gt; i < (size_t)2 * 128 * SEQ; i += NT) { const int pos = (int)(i & 8191), tile = (int)((i >> 13) & 127); if (tile < 4 * ((pos >> 8) + 1) && pos >= 256 * 1 && tile >= 4 && M[i] == ~0ull) c1++; } }
      { const unsigned* Q = (const unsigned*)WSP(bf16, WS_QIR); for (size_t i = gt; i < (size_t)T * 256; i += NT) if (Q[i] == 0xffffffffu) c2++; const unsigned* K = (const unsigned*)WSP(bf16, WS_KIR); for (size_t i = gt; i < (size_t)T * 32; i += NT) if (K[i] == 0xffffffffu) c2++; }
      { const int ntl = ((LAS int*)(F.lds + EOFF_OFF))[33]; const unsigned* A = (const unsigned*)WSP(bf16, WS_AS); for (size_t i = gt; i < (size_t)ntl * 256 * 1024; i += NT) if (A[i] == 0xffffffffu) c3++; }
      { const unsigned* R = (const unsigned*)WSP(int, WS_ROUTE); for (size_t i = gt; i < (size_t)T * 16; i += NT) if (R[i] == 0xffffffffu) c4++; }
      { const unsigned* W = (const unsigned*)WSP(bf16, WS_W1); for (size_t i = gt; i < (size_t)NEXP * 4096 * 1024; i += NT) if (W[i] == 0xffffffffu) c5++; const unsigned* W2 = (const unsigned*)WSP(bf16, WS_W2); for (size_t i = gt; i < (size_t)NEXP * 2048 * 1024; i += NT) if (W2[i] == 0xffffffffu) c5++; const unsigned* WI = (const unsigned*)WSP(bf16, WS_WIN); for (size_t i = gt; i < (size_t)NU * 1024; i += NT) if (WI[i] == 0xffffffffu) c5++; }
      { const unsigned* U = (const unsigned*)WSP(bf16, WS_U); for (size_t i = gt; i < (size_t)T * (NU / 2); i += NT) if (U[i] == 0xffffffffu) c6++; }
      { const unsigned* A = (const unsigned*)WSP(bf16, WS_ACT); const int ntl = ((LAS int*)(F.lds + EOFF_OFF))[33]; for (size_t i = gt; i < (size_t)ntl * 256 * 1024; i += NT) if (A[i] == 0xffffffffu) c7++; }
      if (c0) atomicAdd(cntw, c0); if (c1) atomicAdd(cntw + 64, c1); if (c2) atomicAdd(cntw + 128, c2); if (c3) atomicAdd(cntw + 192, c3); if (c4) atomicAdd(cntw + 256, c4); if (c5) atomicAdd(cntw + 320, c5); if (c6) atomicAdd(cntw + 384, c6); if (c7) atomicAdd(cntw + 448, c7);
      xcd_barrier(bar);
      if (blockIdx.x == 0 && TID() == 0) { float x = 0.f; for (int j = 7; j >= 0; --j) { const unsigned v = __hip_atomic_load(cntw + 64 * j, RLX_AGENT); if (v) x = (float)(SENTINEL_SCAN == 1 ? 10 + j : (v > 90 ? 99 : v + 1)); if (SENTINEL_SCAN != 1 && j == SENTINEL_SCAN - 10) break; }
          if (x > 0.f) OUTP()[0] = sqrtf(3.3558e7f * x); } }
#endif
#ifdef CHK_BUF
    { xcd_barrier(bar);
      const unsigned* p; size_t n;
      switch (CHK_BUF) { case 1: p = (const unsigned*)WSP(bf16, WS_U); n = (size_t)T * NU / 2; break; case 2: p = (const unsigned*)WSP(bf16, WS_QIR); n = (size_t)T * 256; break; case 3: p = (const unsigned*)WSP(float, WS_S); n = (size_t)T * SEQ; break;
          case 4: p = (const unsigned*)WSP(unsigned long long, WS_MASK); n = (size_t)2 * 128 * SEQ * 2; break; case 5: p = (const unsigned*)WSP(bf16, WS_AO); n = (size_t)T * 1024; break; case 6: p = (const unsigned*)WSP(bf16, WS_YG); n = (size_t)T * 1024; break;
          case 7: p = (const unsigned*)WSP(float, WS_H1); n = (size_t)T * 2048; break; case 8: p = (const unsigned*)WSP(int, WS_ROUTE); n = (size_t)T * 16; break; case 9: p = (const unsigned*)WSP(bf16, WS_AS); n = (size_t)RMAX * 1024; break;
          case 10: p = (const unsigned*)WSP(bf16, WS_ACT); n = (size_t)RMAX * 1024; break; case 11: p = (const unsigned*)WSP(bf16, WS_OS); n = (size_t)RMAX * 1024; break; case 13: p = (const unsigned*)WSP(bf16, WS_XBC); n = (size_t)T * 1536; break;
          case 14: p = (const unsigned*)WSP(float, WS_STATES); n = (size_t)T * 2048; break; case 15: p = (const unsigned*)WSP(bf16, WS_PREV); n = (size_t)T * 1024; break; case 16: p = (const unsigned*)WSP(bf16, WS_W1); n = (size_t)NEXP * 4096 * 1024; break;
          case 17: p = (const unsigned*)WSP(bf16, WS_MG); n = (size_t)T * 1024; break; case 18: p = (const unsigned*)WSP(float, WS_TMP); n = (size_t)T * 2048; break; case 19: p = (const unsigned*)WSP(bf16, WS_XN2); n = (size_t)T * 1024; break;
          default: p = (const unsigned*)OUTP(); n = (size_t)T * 2048; break; }
      unsigned long long s = 0ull; int tid_ = TID(); asm volatile("" : "+v"(tid_));
      for (size_t i = (size_t)blockIdx.x * 512 + tid_; i < n; i += (size_t)F.G * 512) s += (unsigned long long)p[i] * (unsigned long long)((i & 1023u) + 1u);
      for (int o = 1; o < 64; o <<= 1) s += (unsigned long long)__shfl_xor((unsigned)s, o) + ((unsigned long long)__shfl_xor((unsigned)(s >> 32), o) << 32);
      if (LANE() == 0) atomicAdd((unsigned long long*)((unsigned*)CTLP() + 14336), s);
      xcd_barrier(bar);
      if (blockIdx.x == 0 && TID() == 0) { unsigned long long* keep = (unsigned long long*)(WSB() + WS_END + 4096); const unsigned long long cur = __hip_atomic_load((unsigned long long*)((unsigned*)CTLP() + 14336), RLX_AGENT);
          if (keep[0] == 0x600DF00DCAFE0001ull && keep[1] != cur) OUTP()[0] = 1.0e9f;
          keep[0] = 0x600DF00DCAFE0001ull; keep[1] = cur; } }
#endif
#ifdef NANCHK_ON
    { xcd_barrier(bar);
      if (blockIdx.x == 0 && TID() == 0) { float x = 0.f; for (int j = 9; j >= 0; --j) { const unsigned v = __hip_atomic_load((unsigned*)CTLP() + 12288 + 64 * j, RLX_AGENT); if (v) x = (float)(10 + j); }
          if (x > 0.f) OUTP()[0] = sqrtf(3.3558e7f * x); } }
#endif
#ifdef TAILSPIN_US
    if (TAILSPIN_ALL || blockIdx.x == 0) { const unsigned long long t1 = __builtin_amdgcn_s_memrealtime(); while (__builtin_amdgcn_s_memrealtime() - t1 < (unsigned long long)TAILSPIN_US * 100ull) __builtin_amdgcn_s_sleep(8); }
#endif
#ifdef PROBE_PHASE
    if (PROBE_PHASE == 14) pr_dt = __builtin_amdgcn_s_memrealtime() - pr_t0;
    if (blockIdx.x == 0) { const unsigned long long t1 = __builtin_amdgcn_s_memrealtime(); while (__builtin_amdgcn_s_memrealtime() - t1 < pr_dt) __builtin_amdgcn_s_sleep(8); }
#endif
#undef IN
#undef SEAM
#undef bar
}

#ifndef MK_CUTS
#define MK_CUTS 0
#endif
extern "C" void kernel_launch(void* const* d_in, const int* in_sizes, int n_in, void* d_out, int out_size, void* d_ws, size_t ws_size, hipStream_t stream) {
    static int grid = 0;
    if (grid == 0) {
        if (n_in != 20 || in_sizes[0] != T * DM || out_size != T * DM || ws_size < WS_END) { fprintf(stderr, "kernel_launch: unexpected shapes (n_in %d, in0 %d, out %d, ws %zu); nothing launched\n", n_in, n_in > 0 ? in_sizes[0] : -1, out_size, ws_size); grid = -1; return; }
        int dev = 0, cus = 0, per_cu = 0;
        if (hipGetDevice(&dev) != hipSuccess || hipDeviceGetAttribute(&cus, hipDeviceAttributeMultiprocessorCount, dev) != hipSuccess) { grid = -1; return; }
        if (hipFuncSetAttribute((const void*)hybrid_fwd, hipFuncAttributeMaxDynamicSharedMemorySize, LDS_BYTES) != hipSuccess) { fprintf(stderr, "kernel_launch: hipFuncSetAttribute failed\n"); grid = -1; return; }
        if (hipOccupancyMaxActiveBlocksPerMultiprocessor(&per_cu, (const void*)hybrid_fwd, NWAVES * 64, LDS_BYTES) != hipSuccess || per_cu < 1) fprintf(stderr, "kernel_launch: occupancy query reports %d\n", per_cu);
        (void)hipGetLastError();
        grid = cus;
    }
    if (grid < 0) return;
    if (hipMemsetAsync((char*)d_ws + WS_CTL, 0, CTL_ZERO_BYTES, stream) != hipSuccess) { fprintf(stderr, "kernel_launch: memset failed\n"); return; }
    Args a{};
    for (int i = 0; i < 20; ++i) a.in[i] = (const float*)d_in[i];
    a.out = (float*)d_out; a.ws = (unsigned char*)d_ws; a.pad = 0;
#if MK_CUTS
    for (int p = 0; p < NPHASE; ++p) { a.ph_lo = p; a.ph_hi = p + 1; a.li = 0; hipLaunchKernelGGL(hybrid_fwd, dim3(grid), dim3(NWAVES * 64), LDS_BYTES, stream, a); }
#else
    a.ph_lo = 0; a.ph_hi = NPHASE; a.li = 0;
    hipLaunchKernelGGL(hybrid_fwd, dim3(grid), dim3(NWAVES * 64), LDS_BYTES, stream, a);
#endif
    const hipError_t le = hipPeekAtLastError();
    if (le != hipSuccess) fprintf(stderr, "kernel_launch: launch failed: %s\n", hipGetErrorName(le));
}
```

```cpp
#include <hip/hip_runtime.h>
#include <hip/hip_bf16.h>
#include <cstdio>
#include <cstdint>
namespace pg8 {
#define PG8_LAS __attribute__((address_space(3)))
typedef unsigned short bf16_t;
typedef short bf16x8 __attribute__((ext_vector_type(8)));
typedef float f32x4 __attribute__((ext_vector_type(4)));
typedef unsigned u32x4 __attribute__((ext_vector_type(4)));
constexpr int BM = 256, BK = 64, HALF = 128, HTB = HALF * BK * 2  , STAGE_BYTES = 8 * HTB, NXCD = 8, WGM = 8;

__host__ __device__ __forceinline__ int lds_byte(int r, int c) { const int st = (r >> 4) * 2 + (c >> 5), rr = r & 15, cc = c & 31, ob = rr * 64 + cc * 2; return st * 1024 + (ob ^ (((ob >> 9) & 1) << 5)); }
__host__ __device__ __forceinline__ void stage_rc(int b, int& R, int& C) { const int st = b / 1024, sb = b % 1024, swz = sb ^ (((sb >> 9) & 1) << 5); R = (st >> 1) * 16 + swz / 64; C = (st & 1) * 32 + (swz % 64) / 2; }
__host__ __device__ __forceinline__ int perm32(int rho) { const int n = rho >> 4, i = rho & 15; return 8 * (i >> 2) + 4 * n + (i & 3); }

struct Unit { int pm, pn, pb, src; };
struct Gemm { const bf16_t* A; const bf16_t* Bt; int M, N, K; const bf16_t* A2; const bf16_t* Bt2; };

struct StaticOrder {
    int nM, nN, nwg, G, c;
    __host__ __device__ void init(int M, int N, int G_, int c_) { nM = M / BM; nN = N / BM; nwg = nM * nN; G = G_; c = c_; }
    __host__ __device__ __forceinline__ bool next(int i, Unit& u) const {
        const long L = (long)i * G + c; if (L >= nwg) return false;
        int wgid = (int)L; { const int q = nwg / NXCD, r = nwg % NXCD, xcd = wgid % NXCD, off = wgid / NXCD; wgid = (xcd < r ? xcd * (q + 1) : r * (q + 1) + (xcd - r) * q) + off; }
        const int nig = WGM * nN, gid = wgid / nig, fm = gid * WGM, gsz = (nM - fm) < WGM ? (nM - fm) : WGM;
        u.pm = fm + ((wgid % nig) % gsz); u.pn = (wgid % nig) / gsz; u.pb = u.pn; u.src = 0; return true;
    }
    __device__ __forceinline__ void a_ready(const Unit&) const {}
    __device__ __forceinline__ void done(const Unit&) const {}
};


typedef int v8i32 __attribute__((ext_vector_type(8)));
__device__ __forceinline__ bf16x8 lo8(v8i32 v) { typedef int v4i32 __attribute__((ext_vector_type(4))); return __builtin_bit_cast(bf16x8, (v4i32){v[0], v[1], v[2], v[3]}); }
__device__ __forceinline__ bf16x8 hi8(v8i32 v) { typedef int v4i32 __attribute__((ext_vector_type(4))); return __builtin_bit_cast(bf16x8, (v4i32){v[4], v[5], v[6], v[7]}); }
__device__ __forceinline__ v8i32 cat8(bf16x8 a, bf16x8 b) { typedef int v4i32 __attribute__((ext_vector_type(4))); const v4i32 x = __builtin_bit_cast(v4i32, a), y = __builtin_bit_cast(v4i32, b); return (v8i32){x[0], x[1], x[2], x[3], y[0], y[1], y[2], y[3]}; }
template <class Epi, class Sched, bool ALIGN_EPI = false, bool SP2 = false, bool F8 = false>
__device__ __forceinline__ void gemm_phase(PG8_LAS unsigned char* lds, const Gemm g, const Sched& S, const Epi& E) {
    const int tid = threadIdx.x, wid = __builtin_amdgcn_readfirstlane(tid >> 6), lane = tid & 63, wr = wid >> 2, wc = wid & 3, fr = lane & 15, fq = lane >> 4;
    const int K = g.K, nt = K / BK;
    unsigned voffA[2], voffB[2];
#pragma unroll
    for (int i = 0; i < 2; ++i) { int R, C; stage_rc(tid * 16 + i * 8192, R, C); const int Rb = Epi::PERM ? ((R & ~31) + perm32(R & 31)) : R;
        voffA[i] = (unsigned)(R * K + C) * 2u; voffB[i] = (unsigned)(Rb * K + C) * 2u; }
    const size_t kstep = (size_t)(BK * 2);
    const size_t hstep = (size_t)HALF * K * 2;
    const size_t tstep = 2 * hstep;
    const unsigned ldsw = (unsigned)wid * 1024u;
    const int aoff = lds_byte(wr * 64 + fr, fq * 8), boff = lds_byte(wc * 32 + fr, fq * 8);
#define PG8_SA(b, h) (((b) * 2 + (h)) * HTB)
#define PG8_SB(b, h) ((4 + (b) * 2 + (h)) * HTB)
#define PG8_STAGE(bufoff, gbase, voff) do { _Pragma("unroll") for (int _i = 0; _i < 2; ++_i) \
        __builtin_amdgcn_global_load_lds((const unsigned*)((const char*)(gbase) + (voff)[_i]), (PG8_LAS unsigned*)(lds + (bufoff) + ldsw + _i * 8192), 16, 0, 0); } while (0)
#define PG8_LDA(dst, b, h) do { _Pragma("unroll") for (int m = 0; m < 4; ++m) dst[m] = cat8(*(const PG8_LAS bf16x8*)(lds + PG8_SA(b, h) + aoff + m * 2048), *(const PG8_LAS bf16x8*)(lds + PG8_SA(b, h) + aoff + m * 2048 + 1024)); } while (0)
#define PG8_LDB(dst, b, h) do { _Pragma("unroll") for (int n = 0; n < 2; ++n) dst[n] = cat8(*(const PG8_LAS bf16x8*)(lds + PG8_SB(b, h) + boff + n * 2048), *(const PG8_LAS bf16x8*)(lds + PG8_SB(b, h) + boff + n * 2048 + 1024)); } while (0)
#define PG8_MMA(ai, bj, At, Bt) do { __builtin_amdgcn_s_setprio(1); _Pragma("unroll") for (int m = 0; m < 4; ++m) _Pragma("unroll") for (int n = 0; n < 2; ++n) { \
        if constexpr (F8) asm volatile("v_mfma_scale_f32_16x16x128_f8f6f4 %0, %1, %2, %0, %3, %3 op_sel_hi:[0,0,0]" : "+v"(acc[ai][bj][m][n]) : "v"(Bt[n]), "v"(At[m]), "v"(f8scale)); \
        else { acc[ai][bj][m][n] = __builtin_amdgcn_mfma_f32_16x16x32_bf16(lo8(Bt[n]), lo8(At[m]), acc[ai][bj][m][n], 0, 0, 0); acc[ai][bj][m][n] = __builtin_amdgcn_mfma_f32_16x16x32_bf16(hi8(Bt[n]), hi8(At[m]), acc[ai][bj][m][n], 0, 0, 0); } } __builtin_amdgcn_s_setprio(0); } while (0)
#define PG8_WAIT_V(n) asm volatile("s_waitcnt vmcnt(" #n ")" ::: "memory")
#define PG8_WAIT_L(n) asm volatile("s_waitcnt lgkmcnt(" #n ")" ::: "memory")
#define PG8_BAR __builtin_amdgcn_s_barrier()
#define PG8_SCHED __builtin_amdgcn_sched_barrier(0)
    Unit cur, nxt; int ui = 0;
    if (!S.next(0, cur)) return;
    f32x4 acc[2][2][4][2];
#pragma unroll
    for (int a = 0; a < 2; ++a)
#pragma unroll
        for (int b = 0; b < 2; ++b)
#pragma unroll
            for (int m = 0; m < 4; ++m)
#pragma unroll
                for (int n = 0; n < 2; ++n) { acc[a][b][m][n] = (f32x4){0.f, 0.f, 0.f, 0.f}; if constexpr (F8) asm volatile("" : "+v"(acc[a][b][m][n])); }
    int f8scale = 0x7f7f7f7f; if constexpr (F8) asm volatile("" : "+v"(f8scale));
    v8i32 At[4], B0[2], B1[2];
    const char* cA = (const char*)(cur.src ? g.A2 : g.A) + (size_t)cur.pm * tstep; const char* cB = (const char*)(cur.src ? g.Bt2 : g.Bt) + (size_t)cur.pb * tstep;
    S.a_ready(cur);
    if constexpr (SP2) {
        PG8_STAGE(PG8_SB(0, 0), cB, voffB); PG8_STAGE(PG8_SB(0, 1), cB + hstep, voffB); PG8_STAGE(PG8_SA(0, 0), cA, voffA); PG8_STAGE(PG8_SA(0, 1), cA + hstep, voffA);
        if (wr == 1) PG8_BAR;
        PG8_WAIT_V(2); PG8_BAR;
        PG8_STAGE(PG8_SB(1, 0), cB + kstep, voffB); PG8_STAGE(PG8_SA(1, 0), cA + kstep, voffA); PG8_STAGE(PG8_SB(1, 1), cB + hstep + kstep, voffB);
        PG8_WAIT_V(6); PG8_BAR;
    } else {
        PG8_STAGE(PG8_SB(0, 0), cB, voffB); PG8_STAGE(PG8_SA(0, 0), cA, voffA); PG8_STAGE(PG8_SB(0, 1), cB + hstep, voffB); PG8_STAGE(PG8_SA(0, 1), cA + hstep, voffA);
        if (wr == 1) PG8_BAR;
        PG8_WAIT_V(4); PG8_BAR;
        PG8_STAGE(PG8_SB(1, 0), cB + kstep, voffB); PG8_STAGE(PG8_SA(1, 0), cA + kstep, voffA); PG8_STAGE(PG8_SB(1, 1), cB + hstep + kstep, voffB);
        PG8_WAIT_V(6); PG8_BAR;
    }
    for (;;) {
        const bool has_next = S.next(ui + 1, nxt);
        const char* nA = has_next ? (const char*)(nxt.src ? g.A2 : g.A) + (size_t)nxt.pm * tstep : cA; const char* nB = has_next ? (const char*)(nxt.src ? g.Bt2 : g.Bt) + (size_t)nxt.pb * tstep : cB;
        for (int t = 0; t < nt; t += 2) {
            const bool last = (t == nt - 2);
            const char* a1 = cA + (size_t)(t + 1) * kstep;
            const char* a2 = last ? nA : cA + (size_t)(t + 2) * kstep; const char* b2 = last ? nB : cB + (size_t)(t + 2) * kstep;
            const char* a3 = a2 + kstep; const char* b3 = b2 + kstep;
            if (last && has_next) S.a_ready(nxt);
            if constexpr (SP2) {
            PG8_LDB(B0, 0, 0); PG8_LDB(B1, 0, 1); PG8_SCHED; PG8_LDA(At, 0, 0); PG8_STAGE(PG8_SA(1, 1), a1 + hstep, voffA);
            PG8_WAIT_V(8); PG8_WAIT_L(0); PG8_BAR; PG8_MMA(0, 0, At, B0); PG8_MMA(0, 1, At, B1); PG8_BAR; PG8_SCHED;
            PG8_LDA(At, 0, 1); PG8_STAGE(PG8_SB(0, 0), b2, voffB); PG8_STAGE(PG8_SB(0, 1), b2 + hstep, voffB); PG8_STAGE(PG8_SA(0, 0), a2, voffA);
            PG8_WAIT_V(8); PG8_WAIT_L(0); PG8_BAR; PG8_MMA(1, 0, At, B0); PG8_MMA(1, 1, At, B1); PG8_BAR; PG8_SCHED;
            PG8_LDB(B0, 1, 0); PG8_LDB(B1, 1, 1); PG8_SCHED; PG8_LDA(At, 1, 0); PG8_STAGE(PG8_SA(0, 1), a2 + hstep, voffA);
            PG8_WAIT_V(8); PG8_WAIT_L(0); PG8_BAR; PG8_MMA(0, 0, At, B0); PG8_MMA(0, 1, At, B1); PG8_BAR; PG8_SCHED;
            PG8_LDA(At, 1, 1); PG8_STAGE(PG8_SB(1, 0), b3, voffB); PG8_STAGE(PG8_SB(1, 1), b3 + hstep, voffB); PG8_STAGE(PG8_SA(1, 0), a3, voffA);
            PG8_WAIT_V(8); PG8_WAIT_L(0); PG8_BAR; PG8_MMA(1, 0, At, B0); PG8_MMA(1, 1, At, B1); PG8_BAR; PG8_SCHED;
            } else {
            PG8_LDB(B0, 0, 0); PG8_SCHED; PG8_LDA(At, 0, 0); PG8_STAGE(PG8_SA(1, 1), a1 + hstep, voffA);
            PG8_WAIT_L(8); PG8_BAR; PG8_WAIT_L(0); PG8_MMA(0, 0, At, B0); PG8_BAR; PG8_SCHED;
            PG8_LDB(B1, 0, 1); PG8_STAGE(PG8_SB(0, 0), b2, voffB);
            PG8_BAR; PG8_WAIT_L(0); PG8_MMA(0, 1, At, B1); PG8_BAR;
            PG8_LDA(At, 0, 1); PG8_STAGE(PG8_SA(0, 0), a2, voffA);
            PG8_BAR; PG8_WAIT_L(0); PG8_MMA(1, 0, At, B0); PG8_BAR; PG8_SCHED;
            PG8_STAGE(PG8_SB(0, 1), b2 + hstep, voffB);
            PG8_WAIT_V(6); PG8_BAR; PG8_MMA(1, 1, At, B1); PG8_BAR;
            PG8_LDB(B0, 1, 0); PG8_SCHED; PG8_LDA(At, 1, 0); PG8_STAGE(PG8_SA(0, 1), a2 + hstep, voffA);
            PG8_WAIT_L(8); PG8_BAR; PG8_WAIT_L(0); PG8_MMA(0, 0, At, B0); PG8_BAR; PG8_SCHED;
            PG8_LDB(B1, 1, 1); PG8_STAGE(PG8_SB(1, 0), b3, voffB);
            PG8_BAR; PG8_WAIT_L(0); PG8_MMA(0, 1, At, B1); PG8_BAR;
            PG8_LDA(At, 1, 1); PG8_STAGE(PG8_SA(1, 0), a3, voffA);
            PG8_BAR; PG8_WAIT_L(0); PG8_MMA(1, 0, At, B0); PG8_BAR; PG8_SCHED;
            PG8_STAGE(PG8_SB(1, 1), b3 + hstep, voffB);
            PG8_WAIT_V(6); PG8_BAR; PG8_MMA(1, 1, At, B1); PG8_BAR;
            }
        }
        if constexpr (ALIGN_EPI) { if (wr == 0) PG8_BAR; }
        if constexpr (F8) asm volatile("s_nop 15\n\ts_nop 15" ::: "memory");
#ifdef DOUBLE_EPI
        if constexpr (!Epi::AFTER_DRAIN && !Epi::CHAIN && Epi::ID == DOUBLE_EPI) { E(acc, cur, wr, wc, fr, fq); asm volatile("" ::: "memory"); }
#endif
        if constexpr (!Epi::AFTER_DRAIN) { E(acc, cur, wr, wc, fr, fq); S.done(cur); }
        if (!has_next) break;
        if (!(Epi::CHAIN && cur.src == 0))
#pragma unroll
        for (int a = 0; a < 2; ++a)
#pragma unroll
            for (int b = 0; b < 2; ++b)
#pragma unroll
                for (int m = 0; m < 4; ++m)
#pragma unroll
                    for (int n = 0; n < 2; ++n) { acc[a][b][m][n] = (f32x4){0.f, 0.f, 0.f, 0.f}; if constexpr (F8) asm volatile("" : "+v"(acc[a][b][m][n])); }
        cur = nxt; cA = nA; cB = nB; ++ui;
        if constexpr (ALIGN_EPI) { if (wr == 1) PG8_BAR; }
    }
    PG8_WAIT_V(0);
    if constexpr (!ALIGN_EPI) { if (wr == 0) PG8_BAR; }
    PG8_BAR;
    if constexpr (Epi::AFTER_DRAIN) { E.fused(acc, cur, wr, wc, fr, fq, lds, wid, lane); S.done(cur); }
#undef PG8_SA
#undef PG8_SB
#undef PG8_STAGE
#undef PG8_LDA
#undef PG8_LDB
#undef PG8_MMA
#undef PG8_WAIT_V
#undef PG8_WAIT_L
#undef PG8_BAR
#undef PG8_SCHED
}
}

#ifdef NANCHK_ON
#define NANCHK(cond, id) do { if (cond) atomicAdd((unsigned*)(((const float* const __attribute__((address_space(4)))*)__builtin_amdgcn_kernarg_segment_ptr())[21]) + 12288 + 64 * (id), 1u); } while (0)
#else
#define NANCHK(cond, id) do { } while (0)
#endif
namespace pg8 {
typedef unsigned u32x2 __attribute__((ext_vector_type(2)));
__device__ __forceinline__ unsigned cvt_pk_bf16(float lo, float hi) { unsigned r; asm volatile("v_cvt_pk_bf16_f32 %0, %1, %2" : "=v"(r) : "v"(lo), "v"(hi)); return r; }
__device__ __forceinline__ float bf_lo(unsigned w) { return __uint_as_float(w << 16); }
__device__ __forceinline__ float bf_hi(unsigned w) { return __uint_as_float(w & 0xffff0000u); }
__device__ __forceinline__ float frcp(float x) { return __builtin_amdgcn_rcpf(x); }
__device__ __forceinline__ float sigm(float x) { return frcp(1.f + __expf(-x)); }

struct GroupedOrder {
    int nM, nN, nwg, G, c; const PG8_LAS int* tile_e;
    __device__ void init(int ntiles, int nN_, int G_, int c_, const PG8_LAS int* te) { nM = ntiles; nN = nN_; nwg = nM * nN; G = G_; c = c_; tile_e = te; }
    __device__ __forceinline__ bool next(int i, Unit& u) const {
        const long L = (long)i * G + c; if (L >= nwg) return false;
        int wgid = (int)L; { const int q = nwg / NXCD, r = nwg % NXCD, xcd = wgid % NXCD, off = wgid / NXCD; wgid = (xcd < r ? xcd * (q + 1) : r * (q + 1) + (xcd - r) * q) + off; }
        const int nig = WGM * nN, gid = wgid / nig, fm = gid * WGM, gsz = (nM - fm) < WGM ? (nM - fm) : WGM;
        u.pm = fm + ((wgid % nig) % gsz); u.pn = (wgid % nig) / gsz; u.pb = tile_e[u.pm] * nN + u.pn; u.src = 0; return true;
    }
    __device__ __forceinline__ void a_ready(const Unit&) const {}
    __device__ __forceinline__ void done(const Unit&) const {}
};

struct EpiU {
    static constexpr bool PERM = true, AFTER_DRAIN = false, CHAIN = false; static constexpr int ID = 1;
    bf16_t* O; int ldc;
    __device__ __forceinline__ void operator()(const f32x4 (&acc)[2][2][4][2], const Unit& u, int wr, int wc, int fr, int fq) const {
        NANCHK((acc[0][0][0][0][0] != acc[0][0][0][0][0]) || (acc[1][1][3][1][3] != acc[1][1][3][1][3]) || (acc[0][1][2][0][1] != acc[0][1][2][0][1]) || (acc[1][0][1][1][2] != acc[1][0][1][1][2]), 2);
        const int row0 = u.pm * BM + wr * 64 + fr, col0 = u.pn * BM + wc * 32 + 8 * fq;
#pragma unroll
        for (int ai = 0; ai < 2; ++ai)
#pragma unroll
            for (int m = 0; m < 4; ++m) { bf16_t* rowp = O + (size_t)(row0 + ai * HALF + m * 16) * ldc + col0;
#pragma unroll
                for (int bj = 0; bj < 2; ++bj) { const f32x4 v0 = acc[ai][bj][m][0], v1 = acc[ai][bj][m][1];
                    u32x4 w; w.x = cvt_pk_bf16(v0[0], v0[1]); w.y = cvt_pk_bf16(v0[2], v0[3]); w.z = cvt_pk_bf16(v1[0], v1[1]); w.w = cvt_pk_bf16(v1[2], v1[3]);
                    *(u32x4*)(rowp + bj * HALF) = w; } }
    }
};
struct EpiSsd {
    static constexpr bool PERM = false, AFTER_DRAIN = false, CHAIN = false; static constexpr int ID = 90;
    float* TMP; const bf16_t* G; int ldg; const PG8_LAS float* tab; const PG8_LAS int* tpm;
    __device__ __forceinline__ void operator()(const f32x4 (&acc)[2][2][4][2], const Unit& u, int wr, int wc, int fr, int fq) const {
        NANCHK((acc[0][0][0][0][0] != acc[0][0][0][0][0]) || (acc[1][1][3][1][3] != acc[1][1][3][1][3]) || (acc[0][1][2][0][1] != acc[0][1][2][0][1]) || (acc[1][0][1][1][2] != acc[1][0][1][1][2]), 3);
        const int row0 = u.pm * BM + wr * 64 + fr, col0 = u.pn * BM + wc * 32 + 4 * fq;
        const int slot = tpm[0] == u.pm ? 0 : (tpm[1] == u.pm ? 1 : (tpm[2] == u.pm ? 2 : 3));
#pragma unroll
        for (int ai = 0; ai < 2; ++ai)
#pragma unroll
            for (int m = 0; m < 4; ++m) { const int row = row0 + ai * HALF + m * 16; const float rs = tab[slot * 256 + (row & 255)];
#pragma unroll
                for (int bj = 0; bj < 2; ++bj)
#pragma unroll
                    for (int n = 0; n < 2; ++n) { const int c = col0 + bj * HALF + n * 16; const u32x2 g = *(const u32x2*)(G + (size_t)row * ldg + c);
                        const f32x4 a = acc[ai][bj][m][n]; f32x4 o;
                        o[0] = a[0] * rs * sigm(bf_lo(g.x)); o[1] = a[1] * rs * sigm(bf_hi(g.x)); o[2] = a[2] * rs * sigm(bf_lo(g.y)); o[3] = a[3] * rs * sigm(bf_hi(g.y));
                        *(f32x4*)(TMP + (size_t)row * 2048 + c) = o; } }
    }
};
struct EpiAttn {
    static constexpr bool PERM = true, AFTER_DRAIN = false, CHAIN = false; static constexpr int ID = 91;
    bf16_t* MG; const float* TMP; const bf16_t* G; int ldg;
    __device__ __forceinline__ void operator()(const f32x4 (&acc)[2][2][4][2], const Unit& u, int wr, int wc, int fr, int fq) const {
        NANCHK((acc[0][0][0][0][0] != acc[0][0][0][0][0]) || (acc[1][1][3][1][3] != acc[1][1][3][1][3]) || (acc[0][1][2][0][1] != acc[0][1][2][0][1]) || (acc[1][0][1][1][2] != acc[1][0][1][1][2]), 4);
        const int row0 = u.pm * BM + wr * 64 + fr, col0 = u.pn * BM + wc * 32 + 8 * fq;
#pragma unroll
        for (int ai = 0; ai < 2; ++ai)
#pragma unroll
            for (int m = 0; m < 4; ++m) { const int row = row0 + ai * HALF + m * 16;
#pragma unroll
                for (int bj = 0; bj < 2; ++bj) { const int c = col0 + bj * HALF; const u32x4 g = *(const u32x4*)(G + (size_t)row * ldg + c);
                    const f32x4 t0 = *(const f32x4*)(TMP + (size_t)row * 2048 + c), t1 = *(const f32x4*)(TMP + (size_t)row * 2048 + c + 4);
                    const f32x4 a0 = acc[ai][bj][m][0], a1 = acc[ai][bj][m][1];
                    u32x4 w;
                    w.x = cvt_pk_bf16(t0[0] + a0[0] * sigm(bf_lo(g.x)), t0[1] + a0[1] * sigm(bf_hi(g.x)));
                    w.y = cvt_pk_bf16(t0[2] + a0[2] * sigm(bf_lo(g.y)), t0[3] + a0[3] * sigm(bf_hi(g.y)));
                    w.z = cvt_pk_bf16(t1[0] + a1[0] * sigm(bf_lo(g.z)), t1[1] + a1[1] * sigm(bf_hi(g.z)));
                    w.w = cvt_pk_bf16(t1[2] + a1[2] * sigm(bf_lo(g.w)), t1[3] + a1[3] * sigm(bf_hi(g.w)));
                    *(u32x4*)(MG + (size_t)row * 2048 + c) = w; } }
    }
};
struct ChainOrder {
    StaticOrder base;
    __device__ __forceinline__ bool next(int i, Unit& u) const { if (!base.next(i >> 1, u)) return false; u.src = i & 1; return true; }
    __device__ __forceinline__ void a_ready(const Unit&) const {}
    __device__ __forceinline__ void done(const Unit&) const {}
};
struct EpiMerge {
    static constexpr bool PERM = true, AFTER_DRAIN = false, CHAIN = true; static constexpr int ID = 6;
    bf16_t* MG; const bf16_t* GS; const bf16_t* GA; int ldg; const PG8_LAS float* tab; const PG8_LAS int* tpm;
    __device__ __forceinline__ void operator()(f32x4 (&acc)[2][2][4][2], const Unit& u, int wr, int wc, int fr, int fq) const {
        const int row0 = u.pm * BM + wr * 64 + fr, col0 = u.pn * BM + wc * 32 + 8 * fq;
        const int slot = tpm[0] == u.pm ? 0 : (tpm[1] == u.pm ? 1 : (tpm[2] == u.pm ? 2 : 3));
#pragma unroll
        for (int ai = 0; ai < 2; ++ai) {
            u32x4 gav[4][2], gsv[4][2];
#pragma unroll
            for (int m = 0; m < 4; ++m)
#pragma unroll
                for (int bj = 0; bj < 2; ++bj) { const size_t o = (size_t)(row0 + ai * HALF + m * 16) * ldg + col0 + bj * HALF; gav[m][bj] = *(const u32x4*)(GA + o); gsv[m][bj] = (u32x4){0u, 0u, 0u, 0u}; }
            if (u.src == 0) {
#pragma unroll
                for (int m = 0; m < 4; ++m)
#pragma unroll
                    for (int bj = 0; bj < 2; ++bj) gsv[m][bj] = *(const u32x4*)(GS + (size_t)(row0 + ai * HALF + m * 16) * ldg + col0 + bj * HALF); }
            __builtin_amdgcn_sched_barrier(0);
#pragma unroll
            for (int m = 0; m < 4; ++m) { const int row = row0 + ai * HALF + m * 16;
#pragma unroll
                for (int bj = 0; bj < 2; ++bj) { const int c = col0 + bj * HALF; const u32x4 ga = gav[m][bj];
                    float ea[8] = {1.f + __expf(-bf_lo(ga.x)), 1.f + __expf(-bf_hi(ga.x)), 1.f + __expf(-bf_lo(ga.y)), 1.f + __expf(-bf_hi(ga.y)), 1.f + __expf(-bf_lo(ga.z)), 1.f + __expf(-bf_hi(ga.z)), 1.f + __expf(-bf_lo(ga.w)), 1.f + __expf(-bf_hi(ga.w))};
                    f32x4& a0 = acc[ai][bj][m][0]; f32x4& a1 = acc[ai][bj][m][1];
                    if (u.src == 0) { const float rs = tab[slot * 256 + (row & 255)]; const u32x4 gs = gsv[m][bj];
                        a0[0] *= rs * ea[0] * sigm(bf_lo(gs.x)); a0[1] *= rs * ea[1] * sigm(bf_hi(gs.x)); a0[2] *= rs * ea[2] * sigm(bf_lo(gs.y)); a0[3] *= rs * ea[3] * sigm(bf_hi(gs.y));
                        a1[0] *= rs * ea[4] * sigm(bf_lo(gs.z)); a1[1] *= rs * ea[5] * sigm(bf_hi(gs.z)); a1[2] *= rs * ea[6] * sigm(bf_lo(gs.w)); a1[3] *= rs * ea[7] * sigm(bf_hi(gs.w)); }
                    else { u32x4 w; w.x = cvt_pk_bf16(a0[0] * frcp(ea[0]), a0[1] * frcp(ea[1])); w.y = cvt_pk_bf16(a0[2] * frcp(ea[2]), a0[3] * frcp(ea[3])); w.z = cvt_pk_bf16(a1[0] * frcp(ea[4]), a1[1] * frcp(ea[5])); w.w = cvt_pk_bf16(a1[2] * frcp(ea[6]), a1[3] * frcp(ea[7]));
                        *(u32x4*)(MG + (size_t)row * 2048 + c) = w; } } } }
    }
};
struct EpiOut {
    static constexpr bool PERM = false, AFTER_DRAIN = false, CHAIN = false; static constexpr int ID = 8;
    float* H1; const float* X;
    __device__ __forceinline__ void operator()(const f32x4 (&acc)[2][2][4][2], const Unit& u, int wr, int wc, int fr, int fq) const {
        NANCHK((acc[0][0][0][0][0] != acc[0][0][0][0][0]) || (acc[1][1][3][1][3] != acc[1][1][3][1][3]) || (acc[0][1][2][0][1] != acc[0][1][2][0][1]) || (acc[1][0][1][1][2] != acc[1][0][1][1][2]), 5);
        const int row0 = u.pm * BM + wr * 64 + fr, col0 = u.pn * BM + wc * 32 + 4 * fq;
#pragma unroll
        for (int ai = 0; ai < 2; ++ai) {
            f32x4 xv[4][2][2];
#pragma unroll
            for (int m = 0; m < 4; ++m) { const size_t ro = (size_t)(row0 + ai * HALF + m * 16) * 2048;
#pragma unroll
                for (int bj = 0; bj < 2; ++bj)
#pragma unroll
                    for (int n = 0; n < 2; ++n) xv[m][bj][n] = *(const f32x4*)(X + ro + col0 + bj * HALF + n * 16); }
            __builtin_amdgcn_sched_barrier(0);
#pragma unroll
            for (int m = 0; m < 4; ++m) { const size_t ro = (size_t)(row0 + ai * HALF + m * 16) * 2048;
#pragma unroll
                for (int bj = 0; bj < 2; ++bj)
#pragma unroll
                    for (int n = 0; n < 2; ++n) { const int c = col0 + bj * HALF + n * 16; *(f32x4*)(H1 + ro + c) = xv[m][bj][n] + acc[ai][bj][m][n]; } } }
    }
};
__device__ __forceinline__ unsigned pk4_fp8(float a, float b, float c, float d) {
    a = fminf(fmaxf(a, -448.f), 448.f); b = fminf(fmaxf(b, -448.f), 448.f); c = fminf(fmaxf(c, -448.f), 448.f); d = fminf(fmaxf(d, -448.f), 448.f);
    int w = 0; w = __builtin_amdgcn_cvt_pk_fp8_f32(a, b, w, false); w = __builtin_amdgcn_cvt_pk_fp8_f32(c, d, w, true); return (unsigned)w; }
constexpr float F8_SX = 16.f, F8_SW = 1024.f, F8_SA = 4.f;
__device__ __forceinline__ float swiglu1(float g, float l) { g = fminf(g, 7.0f); l = fminf(fmaxf(l, -7.0f), 7.0f); return g * sigm(1.702f * g) * (l + 1.0f); }
struct EpiSwiglu {
    static constexpr bool PERM = true, AFTER_DRAIN = false, CHAIN = false; static constexpr int ID = 11;
    bf16_t* ACT; const float* b1;
    __device__ __forceinline__ void operator()(const f32x4 (&acc)[2][2][4][2], const Unit& u, int wr, int wc, int fr, int fq) const {
        NANCHK((acc[0][0][0][0][0] != acc[0][0][0][0][0]) || (acc[1][1][3][1][3] != acc[1][1][3][1][3]) || (acc[0][1][2][0][1] != acc[0][1][2][0][1]) || (acc[1][0][1][1][2] != acc[1][0][1][1][2]), 6);
        const int row0 = u.pm * BM + wr * 64 + fr, e = u.pb >> 4, j0 = u.pn * 128 + wc * 32 + 8 * fq;
        constexpr float DS = 1.0f / (F8_SX * F8_SW);
        const float* bg0 = b1 + (size_t)e * 4096 + j0; const f32x4 bg_[2] = {*(const f32x4*)bg0, *(const f32x4*)(bg0 + 4)}, bl_[2] = {*(const f32x4*)(bg0 + 2048), *(const f32x4*)(bg0 + 2052)};
        __builtin_amdgcn_sched_barrier(0);
        unsigned roff = (unsigned)row0 * 2048u + (unsigned)j0; asm volatile("" : "+v"(roff));
#pragma unroll
        for (int ai = 0; ai < 2; ++ai)
#pragma unroll
            for (int m = 0; m < 4; ++m) { unsigned w2[2];
#pragma unroll
                for (int n = 0; n < 2; ++n) { const f32x4 bgv = bg_[n], blv = bl_[n];
                    f32x4 g = acc[ai][0][m][n] * DS + bgv, l = acc[ai][1][m][n] * DS + blv;
                    g[0] = fminf(g[0], 7.0f); g[1] = fminf(g[1], 7.0f); g[2] = fminf(g[2], 7.0f); g[3] = fminf(g[3], 7.0f);
                    l[0] = fminf(fmaxf(l[0], -7.0f), 7.0f); l[1] = fminf(fmaxf(l[1], -7.0f), 7.0f); l[2] = fminf(fmaxf(l[2], -7.0f), 7.0f); l[3] = fminf(fmaxf(l[3], -7.0f), 7.0f);
                    const f32x4 t = g * (-1.702f * 1.4426950408889634f);
                    f32x4 e = {__builtin_amdgcn_exp2f(t[0]), __builtin_amdgcn_exp2f(t[1]), __builtin_amdgcn_exp2f(t[2]), __builtin_amdgcn_exp2f(t[3])};
                    e = e + 1.0f;
                    const f32x4 r = {frcp(e[0]), frcp(e[1]), frcp(e[2]), frcp(e[3])};
                    const f32x4 o = (g * r) * (l * F8_SA + F8_SA);
                    int w = 0; w = __builtin_amdgcn_cvt_pk_fp8_f32(o[0], o[1], w, false); w = __builtin_amdgcn_cvt_pk_fp8_f32(o[2], o[3], w, true); w2[n] = (unsigned)w; }
                *(u32x2*)((unsigned char*)ACT + (roff + (unsigned)(ai * HALF + m * 16) * 2048u)) = (u32x2){w2[0], w2[1]};
                __builtin_amdgcn_sched_barrier(0); }
    }
};
constexpr float F8_SH = 32.f;
#ifndef PK4TEST
#define PK4TEST pk4_fp8
#endif
struct EpiUp8 {
    static constexpr bool PERM = true, AFTER_DRAIN = false, CHAIN = false; static constexpr int ID = 92;
    unsigned char* H8; const float* b1;
    __device__ __forceinline__ void operator()(const f32x4 (&acc)[2][2][4][2], const Unit& u, int wr, int wc, int fr, int fq) const {
        const int row0 = u.pm * BM + wr * 64 + fr, e = u.pb >> 4, col0 = u.pn * BM + wc * 32 + 8 * fq;
#pragma unroll
        for (int bj = 0; bj < 2; ++bj) { const int c = col0 + bj * HALF; const float* bp = b1 + (size_t)e * 4096 + bj * 2048 + u.pn * 128 + wc * 32 + 8 * fq;
            const f32x4 b0 = *(const f32x4*)bp, b1v = *(const f32x4*)(bp + 4);
#pragma unroll
            for (int ai = 0; ai < 2; ++ai)
#pragma unroll
                for (int m = 0; m < 4; ++m) { const int row = row0 + ai * HALF + m * 16;
                    constexpr float DS = 1.0f / (F8_SX * F8_SW);
                    const f32x4 v0 = (acc[ai][bj][m][0] * DS + b0) * F8_SH, v1 = (acc[ai][bj][m][1] * DS + b1v) * F8_SH;
                    u32x2 w; w.x = PK4TEST(v0[0], v0[1], v0[2], v0[3]); w.y = PK4TEST(v1[0], v1[1], v1[2], v1[3]);
                    *(u32x2*)(H8 + (size_t)row * 4096 + c) = w; } }
    }
};
struct EpiMoeOut {
    static constexpr bool PERM = true, AFTER_DRAIN = false, CHAIN = false; static constexpr int ID = 13;
    bf16_t* OS; const float* b2;
    __device__ __forceinline__ void operator()(const f32x4 (&acc)[2][2][4][2], const Unit& u, int wr, int wc, int fr, int fq) const {
        NANCHK((acc[0][0][0][0][0] != acc[0][0][0][0][0]) || (acc[1][1][3][1][3] != acc[1][1][3][1][3]) || (acc[0][1][2][0][1] != acc[0][1][2][0][1]) || (acc[1][0][1][1][2] != acc[1][0][1][1][2]), 7);
        const int row0 = u.pm * BM + wr * 64 + fr, e = u.pb >> 3, col0 = u.pn * BM + wc * 32 + 8 * fq;
#pragma unroll
        for (int bj = 0; bj < 2; ++bj) { const int c = col0 + bj * HALF; const float* bp = b2 + (size_t)e * 2048 + c;
            const f32x4 b0 = *(const f32x4*)bp, b1v = *(const f32x4*)(bp + 4);
#pragma unroll
            for (int ai = 0; ai < 2; ++ai)
#pragma unroll
                for (int m = 0; m < 4; ++m) { const int row = row0 + ai * HALF + m * 16;
                    constexpr float DS = 1.0f / (F8_SA * F8_SW);
                    const f32x4 v0 = acc[ai][bj][m][0] * DS + b0, v1 = acc[ai][bj][m][1] * DS + b1v;
                    u32x4 w; w.x = cvt_pk_bf16(v0[0], v0[1]); w.y = cvt_pk_bf16(v0[2], v0[3]); w.z = cvt_pk_bf16(v1[0], v1[1]); w.w = cvt_pk_bf16(v1[2], v1[3]);
                    *(u32x4*)(OS + (size_t)row * 2048 + c) = w; } }
    }
};
}
namespace att {
constexpr int D = 128;
constexpr int KP = 2048, VP = 16128, QP = 2048, OP = 2048, MKSTRIDE = 8192;
constexpr float THR = 8.f;
constexpr bool WSKIP = false;
constexpr float SCALE = 0.08838834764831845f;
constexpr int NW = 8, QBLK = 32, KVBLK = 64, QB = NW * QBLK;
constexpr int SHM_V = KVBLK * D * 2, SHM_K = KVBLK * D * 2;
constexpr int LDS_BYTES = 2 * SHM_V + 2 * SHM_K + NW * 64 * 4 + 2 * 2048;
using bf16 = __hip_bfloat16;
typedef short bf16x8 __attribute__((ext_vector_type(8)));
typedef short s16x4 __attribute__((ext_vector_type(4)));
typedef float f32x16 __attribute__((ext_vector_type(16)));
typedef float f32x4 __attribute__((ext_vector_type(4)));
typedef unsigned u32x4 __attribute__((ext_vector_type(4)));
template <class A, class Bt> struct same_t { static constexpr bool v = false; };
template <class A> struct same_t<A, A> { static constexpr bool v = true; };
#define KSWZ(row, colB) ((row) * 256 + ((colB) ^ (((row) & 7) << 4)))
#define SBAR() __builtin_amdgcn_sched_barrier(0)
__device__ __forceinline__ int v_st(int k, int c) { const int kk = (k & ~0xC) | ((k & 4) << 1) | ((k & 8) >> 1); return ((kk >> 3) * 4 + (c >> 5)) * 512 + ((kk & 7) * 32 + (c & 31)) * 2; }
__device__ __forceinline__ int v_rd_base(int lane) { return ((lane & 3) << 3) | (((lane >> 2) & 3) << 6) | (((lane >> 4) & 1) << 5) | (((lane >> 5) & 1) << 8); }
constexpr int v_rd_off(int d0, int ks, int half) { return d0 * 512 + ks * 4096 + half * 2048; }
__device__ __forceinline__ int crow(int r, int hi) { return (r & 3) + 8 * (r >> 2) + 4 * hi; }
__device__ __forceinline__ unsigned cvtpk(float lo, float hi) {
    unsigned r; asm volatile("v_cvt_pk_bf16_f32 %0, %1, %2" : "=v"(r) : "v"(lo), "v"(hi)); return r;
}
__device__ __forceinline__ bf16x8 pack8(f32x4 a, f32x4 b) {
    u32x4 w = {cvtpk(a[0], a[1]), cvtpk(a[2], a[3]), cvtpk(b[0], b[1]), cvtpk(b[2], b[3])};
    return *reinterpret_cast<bf16x8*>(&w);
}
template <class T> __device__ __forceinline__ bf16x8 load8(const T* p) {
    if constexpr (same_t<T, float>::v) { return pack8(*(const f32x4*)p, *(const f32x4*)(p + 4)); }
    else { return *reinterpret_cast<const bf16x8*>(p); }
}
__device__ __forceinline__ void mask_bits(f32x16& p0, f32x16& p1, unsigned lo, unsigned hw, int hi) {
    const float NEG = -__builtin_inff();
    lo >>= 4 * hi; hw >>= 4 * hi;
#pragma unroll
    for (int r = 0; r < 16; ++r) {
        const int c = (r & 3) + 8 * (r >> 2);
        const unsigned m0 = (unsigned)((int)(lo << (31 - c)) >> 31), m1 = (unsigned)((int)(hw << (31 - c)) >> 31);
        p0[r] = __uint_as_float((__float_as_uint(p0[r]) & m0) | (~m0 & 0xff800000u));
        p1[r] = __uint_as_float((__float_as_uint(p1[r]) & m1) | (~m1 & 0xff800000u));
    }
}
__device__ __forceinline__ void partialSM(f32x16& p0, f32x16& p1, float& m_reg, float& mn, float& alpha) {
    float pmax = p0[0]; for (int r = 1; r < 16; ++r) pmax = fmaxf(pmax, p0[r]); for (int r = 0; r < 16; ++r) pmax = fmaxf(pmax, p1[r]);
    { auto rr = __builtin_amdgcn_permlane32_swap(__float_as_uint(pmax), __float_as_uint(pmax), false, false);
      pmax = fmaxf(__uint_as_float(rr[0]), __uint_as_float(rr[1])); }
    constexpr float C2 = 1.4426950408889634f * SCALE;
    if (__builtin_expect(__all((pmax - m_reg) * SCALE <= THR), 1)) { mn = m_reg; alpha = 1.f; }
    else { mn = fmaxf(m_reg, pmax); alpha = __builtin_amdgcn_exp2f((m_reg - mn) * C2); m_reg = mn; }
    const float mnL = -mn * C2;
    for (int r = 0; r < 16; ++r) p0[r] = fmaf(p0[r], C2, mnL); for (int r = 0; r < 16; ++r) p1[r] = fmaf(p1[r], C2, mnL);
    for (int r = 0; r < 16; ++r) p0[r] = __builtin_amdgcn_exp2f(p0[r]);
}
__device__ __forceinline__ void finishSM(f32x16& p0, f32x16& p1, float alpha, float& l_reg, bf16x8& pa0, bf16x8& pa1, bf16x8& pa2, bf16x8& pa3) {
    for (int r = 0; r < 16; ++r) p1[r] = __builtin_amdgcn_exp2f(p1[r]);
    float ps = 0; for (int r = 0; r < 16; ++r) ps += p0[r]; for (int r = 0; r < 16; ++r) ps += p1[r];
    { auto rr = __builtin_amdgcn_permlane32_swap(__float_as_uint(ps), __float_as_uint(ps), false, false);
      ps = __uint_as_float(rr[0]) + __uint_as_float(rr[1]); }
    l_reg = l_reg * alpha + ps;
#define PK4(P, B_, OUT) do { unsigned a0 = cvtpk(P[B_+0], P[B_+1]), a1 = cvtpk(P[B_+2], P[B_+3]);                          \
        unsigned b0 = cvtpk(P[B_+4], P[B_+5]), b1 = cvtpk(P[B_+6], P[B_+7]);                                             \
        auto r0 = __builtin_amdgcn_permlane32_swap(a0, b0, false, false); auto r1 = __builtin_amdgcn_permlane32_swap(a1, b1, false, false); \
        u32x4 w = {r0[0], r1[0], r0[1], r1[1]}; OUT = *reinterpret_cast<bf16x8*>(&w); } while (0)
    PK4(p0, 0, pa0); PK4(p0, 8, pa1); PK4(p1, 0, pa2); PK4(p1, 8, pa3);
#undef PK4
}
template <int KB, bool SK>
__device__ __forceinline__ void qkt(f32x16& p0, f32x16& p1, const char* K_lds, int r32, int hi, const bf16x8* qr, bool act) {
    if (SK && !act) { const float NEG = -__builtin_inff();
#pragma unroll
        for (int r = 0; r < 16; ++r) { p0[r] = NEG; p1[r] = NEG; } return; }
    p0 = f32x16{}; p1 = f32x16{};
    const char* kb[4];
#pragma unroll
    for (int dd = 0; dd < 4; ++dd) kb[dd] = K_lds + KB * SHM_K + KSWZ(r32, (dd * 16 + hi * 8) * 2);
#pragma unroll
    for (int d0 = 0; d0 < 8; ++d0) { const char* a = kb[d0 & 3] + (d0 >> 2) * 128;
        bf16x8 b0 = *reinterpret_cast<const bf16x8*>(a);
        bf16x8 b1 = *reinterpret_cast<const bf16x8*>(a + 32 * 256);
        p0 = __builtin_amdgcn_mfma_f32_32x32x16_bf16(b0, qr[d0], p0, 0, 0, 0);
        p1 = __builtin_amdgcn_mfma_f32_32x32x16_bf16(b1, qr[d0], p1, 0, 0, 0); }
}
template <int VB, bool SK>
__device__ __forceinline__ void pv_tile(f32x16* o, int vb0, bf16x8 pa0, bf16x8 pa1, bf16x8 pa2, bf16x8 pa3, bool act) {
    if (SK && !act) return;
#define TRRD(dst, off) asm volatile("ds_read_b64_tr_b16 %0, %1 offset:%2" : "=&v"(dst) : "v"(vb0), "i"(off) : "memory")
#define PV_D0(d0) do { s16x4 l0, l1, l2, l3, h0, h1, h2, h3; constexpr int b_ = VB * SHM_V + v_rd_off(d0, 0, 0);     \
        TRRD(l0, b_); TRRD(h0, b_ + 2048); TRRD(l1, b_ + 4096); TRRD(h1, b_ + 6144); TRRD(l2, b_ + 8192); TRRD(h2, b_ + 10240); TRRD(l3, b_ + 12288); TRRD(h3, b_ + 14336); \
        asm volatile("s_waitcnt lgkmcnt(0)" ::: "memory"); SBAR();                 \
        o[d0] = __builtin_amdgcn_mfma_f32_32x32x16_bf16(pa0, (bf16x8){l0[0], l0[1], l0[2], l0[3], h0[0], h0[1], h0[2], h0[3]}, o[d0], 0, 0, 0);   \
        o[d0] = __builtin_amdgcn_mfma_f32_32x32x16_bf16(pa1, (bf16x8){l1[0], l1[1], l1[2], l1[3], h1[0], h1[1], h1[2], h1[3]}, o[d0], 0, 0, 0);   \
        o[d0] = __builtin_amdgcn_mfma_f32_32x32x16_bf16(pa2, (bf16x8){l2[0], l2[1], l2[2], l2[3], h2[0], h2[1], h2[2], h2[3]}, o[d0], 0, 0, 0);   \
        o[d0] = __builtin_amdgcn_mfma_f32_32x32x16_bf16(pa3, (bf16x8){l3[0], l3[1], l3[2], l3[3], h3[0], h3[1], h3[2], h3[3]}, o[d0], 0, 0, 0); } while (0)
    PV_D0(0); PV_D0(1); PV_D0(2); PV_D0(3);
#undef PV_D0
#undef TRRD
}

template <class TIn, class TOut> struct BlockRef { const TIn* Q; const TIn* K; const TIn* V; TOut* O; const unsigned long long* MK; int P0; };
template <class TIn> struct Seam {
    bf16x8 qr[8];
    bf16x8 st_v0, st_v1, st_k0, st_k1; unsigned st_m; f32x4 sf0, sf1, sf2, sf3;
    f32x4 tq[16];
};
__device__ __forceinline__ int swa_jlo(int P0, int W) { const int lowk = P0 - W + 1; return lowk > 0 ? lowk / KVBLK : 0; }
#define ROW(p, k0, rr, PT) ((p) + (size_t)(k0) * (PT) + (unsigned)((rr) * (PT) + sc))
#define VMW() asm volatile("s_waitcnt vmcnt(0)" ::: "memory")
#define VMWN(n) asm volatile("s_waitcnt vmcnt(%0)" :: "i"(n) : "memory")
#define SLOAD_H(Kp, Vp, Mp, k0) do { S.st_v0 = load8<TIn>(ROW(Vp, k0, sr, VP)); S.st_v1 = load8<TIn>(ROW(Vp, k0, 32 + sr, VP)); S.st_m = ((const unsigned*)((Mp) + (size_t)((k0) >> 6) * MKSTRIDE))[tid]; \
                         S.st_k0 = load8<TIn>(ROW(Kp, k0, sr, KP)); S.st_k1 = load8<TIn>(ROW(Kp, k0, 32 + sr, KP)); } while (0)
#define SWRITE_HK(bf) do { *(bf16x8*)(K_lds + (bf) * SHM_K + kws) = S.st_k0; *(bf16x8*)(K_lds + (bf) * SHM_K + kws + 32 * 256) = S.st_k1; *(unsigned*)(K_lds + 2 * SHM_K + NW * 64 * 4 + (bf) * 2048 + tid * 4) = S.st_m; } while (0)
#define SWRITE_HV(bf) do { *(bf16x8*)(V_lds + (bf) * SHM_V + vst0) = S.st_v0; *(bf16x8*)(V_lds + (bf) * SHM_V + vst1) = S.st_v1; } while (0)
#define SWRITE_H(bf) do { SWRITE_HV(bf); SWRITE_HK(bf); } while (0)
#define SLOAD_F(p, k0) do { S.sf0 = *(const f32x4*)ROW(p, k0, sr, KP); S.sf1 = *(const f32x4*)(ROW(p, k0, sr, KP) + 4);                \
                            S.sf2 = *(const f32x4*)ROW(p, k0, 32 + sr, KP); S.sf3 = *(const f32x4*)(ROW(p, k0, 32 + sr, KP) + 4); } while (0)
#define SWRITE_KF(bf) do { *(bf16x8*)(K_lds + (bf) * SHM_K + kws) = pack8(S.sf0, S.sf1); *(bf16x8*)(K_lds + (bf) * SHM_K + kws + 32 * 256) = pack8(S.sf2, S.sf3); } while (0)
#define SWRITE_VF(bf) do { *(bf16x8*)(V_lds + (bf) * SHM_V + vst0) = pack8(S.sf0, S.sf1); *(bf16x8*)(V_lds + (bf) * SHM_V + vst1) = pack8(S.sf2, S.sf3); } while (0)
template <class TIn, class TOut>
__device__ __forceinline__ void causal_swa_prime(const BlockRef<TIn, TOut>& cur, int W, char* lds, Seam<TIn>& S) {
    constexpr bool F32 = same_t<TIn, float>::v;
    const int tid = threadIdx.x, wid = __builtin_amdgcn_readfirstlane(tid >> 6), lane = tid & 63, r32 = lane & 31, hi = lane >> 5;
    const int sr = tid >> 4, sc = (tid & 15) * 8, kws = KSWZ(sr, sc * 2); char* K_lds = lds + 2 * SHM_V;
    const int kb0 = swa_jlo(cur.P0, W) * KVBLK;
    for (int d0 = 0; d0 < 8; ++d0) S.qr[d0] = load8<TIn>(cur.Q + (size_t)(wid * QBLK) * QP + (unsigned)(r32 * QP + hi * 8) + d0 * 16);
    if constexpr (F32) { SLOAD_F((const float*)cur.K, kb0); VMW(); SWRITE_KF(0); SBAR(); SLOAD_F((const float*)cur.V, kb0); }
    else { SLOAD_H(cur.K, cur.V, cur.MK, kb0); VMW(); SWRITE_HK(0); }
    __syncthreads();
}
template <class TIn, class TOut>
__device__ __forceinline__ void causal_swa_block(const BlockRef<TIn, TOut>& cur, const BlockRef<TIn, TOut>& nxt, int skv, int W, char* lds, Seam<TIn>& S) {
    constexpr bool F32 = same_t<TIn, float>::v;
    const int tid = threadIdx.x, wid = __builtin_amdgcn_readfirstlane(tid >> 6), lane = tid & 63, r32 = lane & 31, hi = lane >> 5;
    const int j_lo = swa_jlo(cur.P0, W);
    int j_hi = (cur.P0 + QB - 1) / KVBLK + 1; if (j_hi > skv / KVBLK) j_hi = skv / KVBLK;
    const int NT = j_hi - j_lo;
    const int kbn = swa_jlo(nxt.P0, W) * KVBLK;
    const int qlo = cur.P0 + wid * QBLK, qm = qlo + r32 - 4 * hi;
    char* V_lds = lds; char* K_lds = lds + 2 * SHM_V;
    float* ws = (float*)(lds + 2 * SHM_V + 2 * SHM_K) + wid * 64; float* li_l = ws, * al_l = ws + 32;
    float m_reg = -1e30f, l_reg = 0; f32x16 o[4] = {};
    const int sr = tid >> 4, sc = (tid & 15) * 8, vst0 = v_st(sr, sc), vst1 = v_st(32 + sr, sc), kws = KSWZ(sr, sc * 2);
    const int vb0 = (int)(uintptr_t)V_lds + v_rd_base(lane);
    const TIn* Kh = cur.K; const TIn* Vh = cur.V;
#define RESC(a) do { if (__any((a) < 1.f)) { if (hi == 0) al_l[r32] = (a); asm volatile("s_waitcnt lgkmcnt(0)" ::: "memory");              \
                     for (int d_ = 0; d_ < 4; ++d_) for (int r = 0; r < 16; ++r) o[d_][r] *= al_l[crow(r, hi)]; } } while (0)
#define KBASE(t) ((j_lo + (t)) * KVBLK)
#define ACT(t) (KBASE(t) <= qlo + QBLK - 1 && KBASE(t) + KVBLK - 1 >= qlo - W + 1)
#define MASKT(P0_, P1_, KB_) do { const uint2 mw_ = *(const uint2*)(K_lds + 2 * SHM_K + NW * 64 * 4 + (KB_) * 2048 + (wid * QBLK + r32) * 8); mask_bits(P0_, P1_, mw_.x, mw_.y, hi); } while (0)
    constexpr int NQL = F32 ? 16 : 8;
    constexpr bool SK = WSKIP && !F32;
#define SEAM_K0() do { VMWN(NQL); if constexpr (F32) { SWRITE_KF(0); SBAR(); SLOAD_F((const float*)nxt.V, kbn); } else { SWRITE_HK(0); } SBAR(); } while (0)
    f32x16 pA0, pA1, pB0, pB1; float mnA, mnB, alA, alB; bf16x8 pa0, pa1, pa2, pa3;
    if constexpr (F32) { VMW(); SWRITE_VF(0); SBAR(); } else { SWRITE_HV(0); SBAR(); }
    if (NT > 1) { if constexpr (F32) SLOAD_F((const float*)Kh, KBASE(1)); else SLOAD_H(Kh, Vh, cur.MK, KBASE(1)); }
    SBAR(); qkt<0, SK>(pA0, pA1, K_lds, r32, hi, S.qr, ACT(0));
    if constexpr (F32) { if (NT > 1) { VMW(); SWRITE_KF(1); SBAR(); SLOAD_F((const float*)Vh, KBASE(1)); } }
    MASKT(pA0, pA1, 0); partialSM(pA0, pA1, m_reg, mnA, alA);
    if (NT > 1) { VMW(); if constexpr (F32) { SWRITE_VF(1); SBAR(); if (NT > 2) SLOAD_F((const float*)Kh, KBASE(2)); } else SWRITE_H(1); }
    __syncthreads();
#define HALF_STEP(PX0, PX1, mnX, alX, PY0, PY1, alY, t, KB, VB, SB) do {                                                      \
        SBAR(); qkt<KB, SK>(PX0, PX1, K_lds, r32, hi, S.qr, ACT(t));                                             \
        finishSM(PY0, PY1, alY, l_reg, pa0, pa1, pa2, pa3); SBAR();                                                           \
        if ((t) + 1 < NT) { if constexpr (F32) { VMW(); SWRITE_KF(SB); SBAR(); SLOAD_F((const float*)Vh, KBASE((t) + 1)); }  \
                            else { SLOAD_H(Kh, Vh, cur.MK, KBASE((t) + 1)); } SBAR(); }                                               \
        pv_tile<VB, SK>(o, vb0, pa0, pa1, pa2, pa3, ACT((t) - 1)); MASKT(PX0, PX1, KB); partialSM(PX0, PX1, m_reg, mnX, alX);                                        \
        __syncthreads();                                                                                                      \
        if ((t) + 1 < NT) { VMW(); if constexpr (F32) { SWRITE_VF(SB); SBAR(); if ((t) + 2 < NT) SLOAD_F((const float*)Kh, KBASE((t) + 2)); } \
                            else { SWRITE_H(SB); } }                                                                          \
        RESC(alX); __syncthreads(); } while (0)
    for (int t = 1; t + 1 < NT; t += 2) {
        HALF_STEP(pB0, pB1, mnB, alB, pA0, pA1, alA, t, 1, 0, 0);
        HALF_STEP(pA0, pA1, mnA, alA, pB0, pB1, alB, t + 1, 0, 1, 1);
    }
    const bool even = (NT & 1) == 0;
    if (even) { SBAR(); qkt<1, SK>(pB0, pB1, K_lds, r32, hi, S.qr, ACT(NT - 1)); SBAR(); }
#define QROW(e) (nxt.Q + (size_t)(wid * QBLK + r32) * QP + ((e) >> 1) * 16 + hi * 8 + ((e) & 1) * 4)
    if constexpr (F32) { SLOAD_F((const float*)nxt.K, kbn); SBAR();
#pragma unroll
        for (int e = 0; e < 8; ++e) S.tq[e] = *(const f32x4*)QROW(e); }
    else { SLOAD_H(nxt.K, nxt.V, nxt.MK, kbn); SBAR();
#pragma unroll
        for (int d0 = 0; d0 < 8; ++d0) S.qr[d0] = load8<TIn>(nxt.Q + (size_t)(wid * QBLK) * QP + (unsigned)(r32 * QP + hi * 8) + d0 * 16); }
    SBAR();
    finishSM(pA0, pA1, alA, l_reg, pa0, pa1, pa2, pa3); SBAR();
    if constexpr (F32) {
#pragma unroll
        for (int e = 8; e < 16; ++e) S.tq[e] = *(const f32x4*)QROW(e); SBAR(); }
#undef QROW
    pv_tile<0, SK>(o, vb0, pa0, pa1, pa2, pa3, ACT(even ? NT - 2 : NT - 1));
    if (even) { MASKT(pB0, pB1, 1); partialSM(pB0, pB1, m_reg, mnB, alB); __syncthreads(); RESC(alB);
        finishSM(pB0, pB1, alB, l_reg, pa0, pa1, pa2, pa3); SBAR(); pv_tile<1, SK>(o, vb0, pa0, pa1, pa2, pa3, ACT(NT - 1)); }
    SBAR(); SEAM_K0();
    if (hi == 0) li_l[r32] = l_reg; asm volatile("s_waitcnt lgkmcnt(0)" ::: "memory");
    float rli[16];
#pragma unroll
    for (int r = 0; r < 16; ++r) rli[r] = __builtin_amdgcn_rcpf(li_l[crow(r, hi)]);
    TOut* Ow = cur.O + (size_t)(wid * QBLK) * OP;
    unsigned olane = (unsigned)(4 * hi * OP + r32) * 2u; asm volatile("" : "+v"(olane));
#pragma unroll
    for (int r = 0; r < 16; ++r) { const int orow = crow(r, hi);
#pragma unroll
        for (int d0 = 0; d0 < 4; ++d0) { const float v = o[d0][r] * rli[r];
            if constexpr (same_t<TOut, float>::v) { Ow[(size_t)orow * OP + d0 * 32 + r32] = v; }
            else { const float vn = __shfl_xor(v, 1);
                   if ((r32 & 1) == 0) *(unsigned*)((char*)Ow + (size_t)((((r & 3) + 8 * (r >> 2)) * OP + d0 * 32) * 2) + olane) = cvtpk(v, vn); } } }
    if constexpr (F32) {
#pragma unroll
        for (int d0 = 0; d0 < 8; ++d0) S.qr[d0] = pack8(S.tq[2 * d0], S.tq[2 * d0 + 1]); }
    __syncthreads();
#undef RESC
#undef KBASE
#undef ACT
#undef MASKT
#undef SEAM_K0
#undef HALF_STEP
}
#undef ROW
#undef VMW
#undef VMWN
#undef SLOAD_H
#undef SWRITE_HK
#undef SWRITE_HV
#undef SWRITE_H
#undef SLOAD_F
#undef SWRITE_KF
#undef SWRITE_VF

#undef KSWZ
#undef SBAR
}
#ifndef PHASE_SWAP
#define PHASE_SWAP 1
#endif
#if !defined(P5_SLOTS2) && !defined(P5_SLOTS3)
#define P5_SLOTS3 1
#endif
constexpr int NWAVES = 8;
constexpr int T = 16384, SEQ = 8192, DM = 2048, NU = 16128, NEXP = 32;
constexpr int UC_Z = 0, UC_XBC = 2048, UC_Q = 5120, UC_K = 7168, UC_V = 9216, UC_GS = 11264, UC_GA = 13312, UC_QI = 15360, UC_KI = 15872, UC_DT = 15936, UC_WI = 15968, UC_END = 15976;
constexpr int NIN = 15976;
constexpr float EPS = 1e-5f;
constexpr int RMAX = 65536 + 32 * 256;

constexpr size_t MiB = 1u << 20;
constexpr size_t WS_CTL = 0, CTL_ZERO_BYTES = 1 * MiB;
constexpr size_t WS_WIN = 2 * MiB;
constexpr size_t WS_WSSD = 65 * MiB, WS_WATT = 73 * MiB, WS_WOUT = 81 * MiB;
constexpr size_t WS_RWT = 89 * MiB;
constexpr size_t WS_W1 = 96 * MiB;
constexpr size_t WS_W2 = 352 * MiB;
constexpr size_t WS_H8 = 480 * MiB;
constexpr size_t WS_XN = 864 * MiB;
constexpr size_t WS_U = 928 * MiB;
constexpr size_t WS_XBC = 1432 * MiB;
constexpr size_t WS_DT = 1528 * MiB, WS_DACS = 1530 * MiB;
constexpr size_t WS_YD = 1532 * MiB;
constexpr size_t WS_STATES = 1596 * MiB;
constexpr size_t WS_PREV = 1724 * MiB;
constexpr size_t WS_S = 1788 * MiB;
constexpr size_t WS_MASK = 2300 * MiB;
constexpr size_t WS_YG = 2316 * MiB, WS_AO = 2380 * MiB;
constexpr size_t WS_TMP = 2444 * MiB;
constexpr size_t WS_MG = 2572 * MiB;
constexpr size_t WS_H1 = 2636 * MiB;
constexpr size_t WS_ROUTE = 2764 * MiB;
constexpr size_t WS_OS = 2768 * MiB;
constexpr size_t WS_QR = 3056 * MiB, WS_KR = 3120 * MiB;
constexpr size_t WS_QIR = 3184 * MiB, WS_KIR = 3200 * MiB;
constexpr size_t WS_ROPE = 3202 * MiB;
constexpr size_t WS_AS = 3204 * MiB;
constexpr size_t WS_ACT = 3492 * MiB;
constexpr size_t WS_XN2 = 3780 * MiB;
constexpr size_t WS_END = 3844 * MiB;
constexpr int CW_TMO = 0, CW_CODE = 1;
constexpr int CW_BAR = 4096;
constexpr int CW_NT = 8192;
constexpr int RING_OFF = 0, RING_BYTES = 131072;
constexpr int LDSCTL_OFF = RING_BYTES, MISC_OFF = LDSCTL_OFF + 320;
constexpr int TILE_E_OFF = MISC_OFF + 128;
constexpr int EOFF_OFF = TILE_E_OFF + 1280;
constexpr int HIST_OFF = EOFF_OFF + 512;
constexpr int RS_OFF = HIST_OFF + 256;
constexpr int LDS_BYTES = 147456;
static_assert(RS_OFF + 8192 <= LDS_BYTES, "LDS map");

#define GAS __attribute__((address_space(1)))
#define LAS __attribute__((address_space(3)))
typedef unsigned short bf16;
typedef unsigned v4u __attribute__((ext_vector_type(4)));
typedef unsigned v2u __attribute__((ext_vector_type(2)));
typedef float f32x4 __attribute__((ext_vector_type(4)));
typedef float f32x16 __attribute__((ext_vector_type(16)));
typedef short bf16x8 __attribute__((ext_vector_type(8)));
typedef short s16x4 __attribute__((ext_vector_type(4)));
typedef GAS unsigned gu32;
#define RLX_AGENT __ATOMIC_RELAXED, __HIP_MEMORY_SCOPE_AGENT
#define LDS_WAIT() asm volatile("s_waitcnt lgkmcnt(0)" ::: "memory")
#define VM_WAIT() asm volatile("s_waitcnt vmcnt(0)" ::: "memory")
__device__ __forceinline__ unsigned f2bf(float f) { unsigned u = __builtin_bit_cast(unsigned, f); return (u + 0x7fffu + ((u >> 16) & 1u)) >> 16; }
__device__ __forceinline__ unsigned pk2(float lo, float hi) { return f2bf(lo) | (f2bf(hi) << 16); }
__device__ __forceinline__ float bf2f(bf16 b) { return __uint_as_float(((unsigned)b) << 16); }
__device__ __forceinline__ float bflo(unsigned w) { return __uint_as_float(w << 16); }
__device__ __forceinline__ float bfhi(unsigned w) { return __uint_as_float(w & 0xffff0000u); }
__device__ __forceinline__ float siluf(float x) { return x * __builtin_amdgcn_rcpf(1.f + __expf(-x)); }
#define XB_TMO      128
#define XB_XCNT(j)  (256  + 64 * (j))
#define XB_XSUB(j)  (1280 + 64 * (j))
#define XB_XGEN(j)  (2304 + 64 * (j))
#define XB_TOP      3328
#define XB_TOPGEN   3392
#define XCD_BAR_WORDS 3456
#define XB_SPIN_CAP (1u << 18)

__device__ __forceinline__ unsigned xb_ld(unsigned* p)              { return __hip_atomic_load(p, __ATOMIC_RELAXED, __HIP_MEMORY_SCOPE_AGENT); }
__device__ __forceinline__ unsigned xb_add(unsigned* p, unsigned v) { return __hip_atomic_fetch_add(p, v, __ATOMIC_RELAXED, __HIP_MEMORY_SCOPE_AGENT); }
__device__ __forceinline__ unsigned xb_xcc_id() { return (unsigned)__builtin_amdgcn_s_getreg((3 << 11) | 20) & 0xFu; }
#define XB_SPIN(cond, bar) do { unsigned _sp = 0; while (cond) { __builtin_amdgcn_s_sleep(1); \
    if ((++_sp & 255u) == 0u) { if (xb_ld(&(bar)[XB_TMO])) break; if (_sp > XB_SPIN_CAP) { atomicAdd(&(bar)[XB_TMO], 1u); break; } } } } while (0)

struct XcdBarrier {
    unsigned* bar; unsigned x;
    volatile LAS unsigned* st;
};

__device__ __forceinline__ XcdBarrier xcd_barrier_post(unsigned* bar, volatile LAS unsigned* st) {
    XcdBarrier b; b.bar = bar; b.x = xb_xcc_id(); b.st = st;
    if (threadIdx.x == 0) (void)xb_add(&bar[XB_XCNT(b.x)], 1u);
    return b;
}
__device__ __forceinline__ void xcd_barrier_complete(unsigned* bar, unsigned x, unsigned& nloc, unsigned& nx) {
    const unsigned G = gridDim.x * gridDim.y * gridDim.z;
    unsigned sum, cnt, mine, sp = 0u;
    for (;;) {
        sum = 0u; cnt = 0u; mine = 0u;
#pragma unroll
        for (unsigned j = 0; j < 16; ++j) { const unsigned c = xb_ld(&bar[XB_XCNT(j)]); sum += c; cnt += (c > 0u) ? 1u : 0u; mine = (j == x) ? c : mine; }
        if (sum == G) break;
        __builtin_amdgcn_s_sleep(1);
        if ((++sp & 255u) == 0u) { if (xb_ld(&bar[XB_TMO])) break; if (sp > XB_SPIN_CAP) { atomicAdd(&bar[XB_TMO], 1u); break; } }
    }
    nloc = mine > 0u ? mine : 1u; nx = cnt > 0u ? cnt : 1u;
}

__device__ __forceinline__ void xcd_barrier(const XcdBarrier& b) {
    asm volatile("s_waitcnt vmcnt(0)" ::: "memory");
    __syncthreads();
    if (threadIdx.x == 0) {
        unsigned* bar = b.bar;
        __builtin_amdgcn_s_waitcnt(0);
        unsigned nloc = b.st[0], nx = b.st[1];
        if (nloc == 0u) { xcd_barrier_complete(bar, b.x, nloc, nx); b.st[0] = nloc; b.st[1] = nx; }
        const unsigned old = xb_add(&bar[XB_XSUB(b.x)], 1u);
        const unsigned gen = old / nloc;
        if (old + 1u == (gen + 1u) * nloc) {
            __builtin_amdgcn_fence(__ATOMIC_RELEASE, "agent");
            asm volatile("s_waitcnt vmcnt(0)" ::: "memory");
            const unsigned og = xb_add(&bar[XB_TOP], 1u);
            const unsigned tg = og / nx;
            if (og + 1u == (tg + 1u) * nx) xb_add(&bar[XB_TOPGEN], 1u);
            else XB_SPIN(xb_ld(&bar[XB_TOPGEN]) == tg, bar);
            __builtin_amdgcn_fence(__ATOMIC_ACQUIRE, "agent");
            xb_add(&bar[XB_XGEN(b.x)], 1u);
            asm volatile("s_waitcnt vmcnt(0)" ::: "memory");
        } else {
            XB_SPIN(xb_ld(&bar[XB_XGEN(b.x)]) == gen, bar);
            __builtin_amdgcn_fence(__ATOMIC_ACQUIRE, "agent");
            asm volatile("s_waitcnt vmcnt(0)" ::: "memory");
        }
    }
    __syncthreads();
}


typedef const float* const __attribute__((address_space(4))) * karg_fpp;
#define INP(i) (((karg_fpp)__builtin_amdgcn_kernarg_segment_ptr())[i])
#define OUTP() ((float*)(((karg_fpp)__builtin_amdgcn_kernarg_segment_ptr())[20]))
#define WSB() ((unsigned char*)(((karg_fpp)__builtin_amdgcn_kernarg_segment_ptr())[21]))
#define WSP(type, off) ((type*)(WSB() + (off)))
#define CTLP() ((gu32*)(WSB() + WS_CTL))
struct Frame {
    LAS unsigned char* lds;
    int wave, vcu, G;
};
__device__ __forceinline__ int lane_id_now() { int l; asm volatile("v_mbcnt_lo_u32_b32 %0, -1, 0\n\tv_mbcnt_hi_u32_b32 %0, -1, %0" : "=v"(l)); return l; }
#define LANE() lane_id_now()
#define TID() (F.wave * 64 + LANE())

__device__ __forceinline__ float wave_sum(float v) {
#pragma unroll
    for (int o = 1; o < 64; o <<= 1) v += __shfl_xor(v, o);
    return v;
}

__device__ __forceinline__ int ucol_of_src(int n) {
    if (n < 5120) return n;
    if (n < 5152) return n - 5120 + UC_DT;
    if (n < 11296) return n - 5152 + UC_Q;
    if (n < 11808) return n - 11296 + UC_QI;
    if (n < 11872) return n - 11808 + UC_KI;
    if (n < 11880) return n - 11872 + UC_WI;
    return n - 11880 + UC_GS;
}
struct RmId { __device__ __forceinline__ int operator()(int n) const { return n; } };
struct RmIn { __device__ __forceinline__ int operator()(int n) const { return ucol_of_src(n); } };
struct RmW1 { __device__ __forceinline__ int operator()(int n) const { const int m = n & 2047; return ((m >> 7) << 8) + ((n >> 11) << 7) + (m & 127); } };
template <class RowMap>
__device__ __forceinline__ void transpose_item(const float* W, int K, int N, bf16* WT, const RowMap rm, const float* kscale, int item, int lane) {
    const int nblk = (N + 63) >> 6, kb = item / nblk, nb = item - kb * nblk, k0 = 64 * kb, n0 = 64 * nb;
    const int g = lane >> 4, nq = lane & 15, n = n0 + 4 * nq; const bool nok = n < N;
    const float* src = W + (size_t)(k0 + 8 * g) * N + n;
    f32x4 v[2][8];
#pragma unroll
    for (int p = 0; p < 2; ++p)
#pragma unroll
        for (int i = 0; i < 8; ++i) v[p][i] = nok ? *(const f32x4*)(src + (size_t)(32 * p + i) * N) : (f32x4){0.f, 0.f, 0.f, 0.f};
    if (kscale) {
#pragma unroll
        for (int p = 0; p < 2; ++p) { const f32x4 s0 = *(const f32x4*)(kscale + k0 + 32 * p + 8 * g), s1 = *(const f32x4*)(kscale + k0 + 32 * p + 8 * g + 4);
            v[p][0] = v[p][0] * s0.x; v[p][1] = v[p][1] * s0.y; v[p][2] = v[p][2] * s0.z; v[p][3] = v[p][3] * s0.w; v[p][4] = v[p][4] * s1.x; v[p][5] = v[p][5] * s1.y; v[p][6] = v[p][6] * s1.z; v[p][7] = v[p][7] * s1.w; } }
    if (nok) {
#pragma unroll
        for (int j = 0; j < 4; ++j) { bf16* dst = WT + (size_t)rm(n + j) * K + k0 + 8 * g;
#pragma unroll
            for (int p = 0; p < 2; ++p) { v4u o; o.x = pk2(v[p][0][j], v[p][1][j]); o.y = pk2(v[p][2][j], v[p][3][j]); o.z = pk2(v[p][4][j], v[p][5][j]); o.w = pk2(v[p][6][j], v[p][7][j]);
                *(v4u*)(dst + 32 * p) = o; } } }
}
template <class RowMap>
__device__ __forceinline__ void transpose_item8(const float* W, int K, int N, unsigned char* WT, const RowMap rm, int item, int lane) {
    const int nblk = N >> 5, kb = item / nblk, nb = item - kb * nblk, k0 = 128 * kb, n0 = 32 * nb;
    const int g = lane >> 3, nq = lane & 7, n = n0 + 4 * nq;
    const float* src = W + (size_t)(k0 + 16 * g) * N + n;
    f32x4 v[16];
#pragma unroll
    for (int i = 0; i < 16; ++i) v[i] = *(const f32x4*)(src + (size_t)i * N);
#pragma unroll
    for (int j = 0; j < 4; ++j) { v4u o;
        o.x = pg8::pk4_fp8(v[0][j] * pg8::F8_SW, v[1][j] * pg8::F8_SW, v[2][j] * pg8::F8_SW, v[3][j] * pg8::F8_SW); o.y = pg8::pk4_fp8(v[4][j] * pg8::F8_SW, v[5][j] * pg8::F8_SW, v[6][j] * pg8::F8_SW, v[7][j] * pg8::F8_SW);
        o.z = pg8::pk4_fp8(v[8][j] * pg8::F8_SW, v[9][j] * pg8::F8_SW, v[10][j] * pg8::F8_SW, v[11][j] * pg8::F8_SW); o.w = pg8::pk4_fp8(v[12][j] * pg8::F8_SW, v[13][j] * pg8::F8_SW, v[14][j] * pg8::F8_SW, v[15][j] * pg8::F8_SW);
        *(v4u*)(WT + (size_t)rm(n + j) * K + k0 + 16 * g) = o; }
}
__device__ __forceinline__ void rms_row_to_bf16(const float* xrow, const float* w, bf16* orow, int lane) {
    const f32x4* xr = (const f32x4*)xrow + lane;
    f32x4 v[8], wq[8]; float s = 0.f;
#pragma unroll
    for (int j = 0; j < 8; ++j) v[j] = xr[64 * j];
#pragma unroll
    for (int j = 0; j < 8; ++j) wq[j] = ((const f32x4*)w)[lane + 64 * j];
    __builtin_amdgcn_sched_barrier(0);
#pragma unroll
    for (int j = 0; j < 8; ++j) s += (v[j].x * v[j].x + v[j].y * v[j].y) + (v[j].z * v[j].z + v[j].w * v[j].w);
    const float rstd = 1.f / sqrtf(wave_sum(s) * (1.f / DM) + EPS);
    v2u* o8 = (v2u*)orow + lane;
#pragma unroll
    for (int j = 0; j < 8; ++j) { const f32x4 wv = wq[j]; v2u o; o.x = pk2(v[j].x * rstd * wv.x, v[j].y * rstd * wv.y); o.y = pk2(v[j].z * rstd * wv.z, v[j].w * rstd * wv.w); o8[64 * j] = o; }
}
__device__ __forceinline__ void t8_src(int r, int lane, const float*& src, int& N) {
    constexpr int I_W1 = 16 * 128, I_W2 = 16 * 64;
    const float* W; int item;
    if (r < NEXP * I_W1) { const int e = r / I_W1; item = r - e * I_W1; N = 4096; W = INP(15) + (size_t)e * DM * 4096; }
    else { const int r2 = r - NEXP * I_W1, e = r2 / I_W2; item = r2 - e * I_W2; N = DM; W = INP(17) + (size_t)e * DM * DM; }
    const int nblk = N >> 5, kb = item / nblk, nb = item - kb * nblk;
    src = W + (size_t)(128 * kb + 16 * (lane >> 3)) * N + 32 * nb + 4 * (lane & 7);
}
__device__ __forceinline__ void t8_put(int r, int lane, const f32x4 (&v)[16]) {
    constexpr int I_W1 = 16 * 128, I_W2 = 16 * 64;
    const bool w1 = r < NEXP * I_W1; int item, N; unsigned char* WT;
    if (w1) { const int e = r / I_W1; item = r - e * I_W1; N = 4096; WT = WSP(unsigned char, WS_W1) + (size_t)e * 4096 * DM; }
    else { const int r2 = r - NEXP * I_W1, e = r2 / I_W2; item = r2 - e * I_W2; N = DM; WT = WSP(unsigned char, WS_W2) + (size_t)e * DM * DM; }
    const int nblk = N >> 5, kb = item / nblk, nb = item - kb * nblk, k0 = 128 * kb, n = 32 * nb + 4 * (lane & 7), g = lane >> 3;
#pragma unroll
    for (int j = 0; j < 4; ++j) { v4u o;
        o.x = pg8::pk4_fp8(v[0][j] * pg8::F8_SW, v[1][j] * pg8::F8_SW, v[2][j] * pg8::F8_SW, v[3][j] * pg8::F8_SW); o.y = pg8::pk4_fp8(v[4][j] * pg8::F8_SW, v[5][j] * pg8::F8_SW, v[6][j] * pg8::F8_SW, v[7][j] * pg8::F8_SW);
        o.z = pg8::pk4_fp8(v[8][j] * pg8::F8_SW, v[9][j] * pg8::F8_SW, v[10][j] * pg8::F8_SW, v[11][j] * pg8::F8_SW); o.w = pg8::pk4_fp8(v[12][j] * pg8::F8_SW, v[13][j] * pg8::F8_SW, v[14][j] * pg8::F8_SW, v[15][j] * pg8::F8_SW);
        const int row = w1 ? RmW1()(n + j) : (n + j);
        *(v4u*)(WT + (size_t)row * DM + k0 + 16 * g) = o; }
}
__device__ __forceinline__ void p0_expert_items(Frame& F) {
    constexpr int I_W1 = 16 * 128, I_W2 = 16 * 64, NE = NEXP * (I_W1 + I_W2);
    int it0, step, lim, base;
#ifdef P5_SLOTS3
    if ((PHASE_SWAP) && F.G == 256) { const int q = (int)blockIdx.x >> 3, s3 = q % 3, rank = q / 3, ns = (34 - s3) / 3, before = s3 == 0 ? 0 : s3 == 1 ? 11 : 22;
        it0 = (rank * 8 + ((int)blockIdx.x & 7)) * NWAVES + F.wave; step = ns * 8 * NWAVES; lim = ns * (NE / 32); base = before * (NE / 32); }
#else
    if ((PHASE_SWAP) && (F.G & 15) == 0) { const int grp = ((int)blockIdx.x >> 3) & 1, lwg = (((int)blockIdx.x >> 4) << 3) | ((int)blockIdx.x & 7);
        it0 = lwg * NWAVES + F.wave; step = (F.G >> 1) * NWAVES; lim = NE / 2; base = grp * (NE / 2); }
#endif
    else { it0 = F.vcu * NWAVES + F.wave; step = F.G * NWAVES; lim = NE; base = 0; }
    if (it0 >= lim) return;
    const int lane = LANE(); f32x4 va[16];
    { const float* src; int N; t8_src(base + it0, lane, src, N);
#pragma unroll
      for (int i = 0; i < 16; ++i) va[i] = *(const f32x4*)(src + (size_t)i * N); }
#pragma nounroll
    for (int it = it0; it < lim; it += step) {
        f32x4 vb[16];
        { const float* src; int N; t8_src(base + (it + step < lim ? it + step : it), lane, src, N);
#pragma unroll
          for (int i = 0; i < 16; ++i) vb[i] = *(const f32x4*)(src + (size_t)i * N); }
        __builtin_amdgcn_sched_barrier(0);
        t8_put(base + it, lane, va);
#pragma unroll
        for (int i = 0; i < 16; ++i) va[i] = vb[i];
    }
}
__device__ __forceinline__ void p0_prologue(Frame& F) {
    const int gw = F.vcu * NWAVES + F.wave, NGW = F.G * NWAVES;
    constexpr int I_IN = 32 * 250, I_SQ = 32 * 32;
#ifdef EXPERT_W_IN_P0
    p0_expert_items(F);
#endif
    constexpr int NITEMS = I_IN + 3 * I_SQ;
    for (int it = gw; it < NITEMS; it += NGW) {
        int r = it;
        if (r < I_IN) { transpose_item(INP(1), DM, NIN, WSP(bf16, WS_WIN), RmIn(), nullptr, r, LANE()); continue; } r -= I_IN;
        if (r < I_SQ) { transpose_item(INP(8), DM, DM, WSP(bf16, WS_WSSD), RmId(), INP(7), r, LANE()); continue; } r -= I_SQ;
        if (r < I_SQ) { transpose_item(INP(9), DM, DM, WSP(bf16, WS_WATT), RmId(), nullptr, r, LANE()); continue; } r -= I_SQ;
        { transpose_item(INP(10), DM, DM, WSP(bf16, WS_WOUT), RmId(), nullptr, r, LANE()); }
    }
    { const int gt = F.vcu * (NWAVES * 64) + TID(), NT = F.G * NWAVES * 64; v4u z = {0u, 0u, 0u, 0u};
      for (int i = gt; i < (NU - UC_END) * DM / 8; i += NT) ((v4u*)(WSP(bf16, WS_WIN) + (size_t)UC_END * DM))[i] = z;
      for (int i = gt; i < NEXP * DM; i += NT) { const int e = i >> 11, k = i & 2047; WSP(float, WS_RWT)[i] = INP(13)[(size_t)k * NEXP + e]; } }
    for (int pos = gw; pos < SEQ; pos += NGW) { const int f = LANE(); float cs = 0.f, sn = 0.f;
        if (f < 24) { const float inv = f < 16 ? powf(500000.0f, -(float)f * (1.0f / 16.0f)) : powf(500000.0f, -(float)(f - 16) * (1.0f / 8.0f)); sincosf((float)pos * inv, &sn, &cs); }
        if (f < 32) { float* dst = WSP(float, WS_ROPE) + ((size_t)pos * 32 + f) * 2; dst[0] = cs; dst[1] = sn; } }
    for (int m = gw; m < T; m += NGW) rms_row_to_bf16(INP(0) + (size_t)m * DM, INP(11), WSP(bf16, WS_XN) + (size_t)m * DM, LANE());
}

__device__ __forceinline__ float softplusf(float x) { return x > 20.f ? x : log1pf(expf(x)); }
__device__ __forceinline__ void p2_prep(Frame& F) {
    const int gt = F.vcu * (NWAVES * 64) + TID(), NT = F.G * NWAVES * 64;
    const int gw = F.vcu * NWAVES + F.wave, NGW = F.G * NWAVES, lane = LANE();
    for (int it = gt; it < (T / 16) * 384; it += NT) {
        const int ch = it % 384, seg = it / 384, t0 = seg * 16, c0 = ch * 8;
        float w[4][8], cb[8], h0[8], h1[8], h2[8];
#pragma unroll
        for (int j = 0; j < 4; ++j) { const f32x4 a = *(const f32x4*)(INP(2) + j * 3072 + c0), b = *(const f32x4*)(INP(2) + j * 3072 + c0 + 4);
            w[j][0] = a.x; w[j][1] = a.y; w[j][2] = a.z; w[j][3] = a.w; w[j][4] = b.x; w[j][5] = b.y; w[j][6] = b.z; w[j][7] = b.w; }
        { const f32x4 a = *(const f32x4*)(INP(3) + c0), b = *(const f32x4*)(INP(3) + c0 + 4); cb[0] = a.x; cb[1] = a.y; cb[2] = a.z; cb[3] = a.w; cb[4] = b.x; cb[5] = b.y; cb[6] = b.z; cb[7] = b.w; }
        const bool first = (t0 % SEQ) == 0;
        const bf16* src = WSP(bf16, WS_U) + (size_t)t0 * NU + UC_XBC + c0;
        v4u r0 = {0u, 0u, 0u, 0u}, r1 = r0, r2 = r0;
        if (!first) { r0 = *(const v4u*)(src - 3 * (size_t)NU); r1 = *(const v4u*)(src - 2 * (size_t)NU); r2 = *(const v4u*)(src - (size_t)NU); }
#define UNPK(dst, r) do { dst[0] = bflo(r.x); dst[1] = bfhi(r.x); dst[2] = bflo(r.y); dst[3] = bfhi(r.y); dst[4] = bflo(r.z); dst[5] = bfhi(r.z); dst[6] = bflo(r.w); dst[7] = bfhi(r.w); } while (0)
        UNPK(h0, r0); UNPK(h1, r1); UNPK(h2, r2);
        bf16* dst = WSP(bf16, WS_XBC) + (size_t)t0 * 3072 + c0;
        v4u rcs[16];
#pragma unroll
        for (int t = 0; t < 16; ++t) rcs[t] = *(const v4u*)(src + (size_t)t * NU);
        __builtin_amdgcn_sched_barrier(0);
#pragma unroll
        for (int t = 0; t < 16; ++t) {
            const v4u rc = rcs[t]; float cur[8], o[8]; UNPK(cur, rc);
#pragma unroll
            for (int i = 0; i < 8; ++i) { const float a = cb[i] + w[0][i] * h0[i] + w[1][i] * h1[i] + w[2][i] * h2[i] + w[3][i] * cur[i]; o[i] = siluf(a); h0[i] = h1[i]; h1[i] = h2[i]; h2[i] = cur[i]; }
            v4u ov; ov.x = pk2(o[0], o[1]); ov.y = pk2(o[2], o[3]); ov.z = pk2(o[4], o[5]); ov.w = pk2(o[6], o[7]);
            *(v4u*)(dst + (size_t)t * 3072) = ov;
        }
#undef UNPK
    }
    for (int ch = gw; ch < (T / 128) * 32; ch += NGW) {
        const int h = ch & 31, ck = ch >> 5; const float bias = INP(4)[h], a = -expf(INP(5)[h]);
        const size_t t0 = (size_t)ck * 128 + 2 * lane;
        const float d0 = softplusf(bf2f(WSP(bf16, WS_U)[t0 * NU + UC_DT + h]) + bias), d1 = softplusf(bf2f(WSP(bf16, WS_U)[(t0 + 1) * NU + UC_DT + h]) + bias);
        const float a0 = d0 * a, a1 = a0 + d1 * a;
        float run = a1;
#pragma unroll
        for (int o = 1; o < 64; o <<= 1) { const float up = __shfl_up(run, o); if (lane >= o) run += up; }
        const float excl = run - a1;
        WSP(float, WS_DT)[t0 * 32 + h] = d0; WSP(float, WS_DT)[(t0 + 1) * 32 + h] = d1;
        WSP(float, WS_DACS)[t0 * 32 + h] = excl + a0; WSP(float, WS_DACS)[(t0 + 1) * 32 + h] = excl + a1;
    }
    for (int t = gw; t < T; t += NGW) {
        const int pos = t % SEQ;
        const bf16* row = WSP(bf16, WS_U) + (size_t)t * NU;
        const f32x4* rtp = (const f32x4*)(WSP(float, WS_ROPE) + (size_t)pos * 64);
        v4u aq[2][4]; f32x4 rt[12];
#pragma unroll
        for (int wk = 0; wk < 2; ++wk) { const v4u* src = (const v4u*)(row + (wk ? UC_K : UC_Q) + 32 * lane);
#pragma unroll
            for (int j = 0; j < 4; ++j) aq[wk][j] = src[j]; }
        const int part = lane & 7;
        const v4u mq = *(const v4u*)(row + UC_QI + 8 * lane), mk = *(const v4u*)(row + UC_KI + 8 * part);
#pragma unroll
        for (int j = 0; j < 12; ++j) rt[j] = rtp[j];
        __builtin_amdgcn_sched_barrier(0);
#define R16(i) rt[(i) >> 2][(i) & 3]
#define R8(i) rt[8 + ((i) >> 2)][(i) & 3]
#pragma unroll
        for (int wk = 0; wk < 2; ++wk) {
            v4u a[4];
#pragma unroll
            for (int j = 0; j < 4; ++j) a[j] = aq[wk][j];
            if ((lane & 3) == 0) { float x[32];
#pragma unroll
                for (int j = 0; j < 4; ++j) { x[8 * j] = bflo(a[j].x); x[8 * j + 1] = bfhi(a[j].x); x[8 * j + 2] = bflo(a[j].y); x[8 * j + 3] = bfhi(a[j].y); x[8 * j + 4] = bflo(a[j].z); x[8 * j + 5] = bfhi(a[j].z); x[8 * j + 6] = bflo(a[j].w); x[8 * j + 7] = bfhi(a[j].w); }
                float o[32];
#pragma unroll
                for (int i = 0; i < 16; ++i) { const float cs = R16(2 * i), sn = R16(2 * i + 1); o[i] = x[i] * cs - x[16 + i] * sn; o[16 + i] = x[16 + i] * cs + x[i] * sn; }
#pragma unroll
                for (int j = 0; j < 4; ++j) { a[j].x = pk2(o[8 * j], o[8 * j + 1]); a[j].y = pk2(o[8 * j + 2], o[8 * j + 3]); a[j].z = pk2(o[8 * j + 4], o[8 * j + 5]); a[j].w = pk2(o[8 * j + 6], o[8 * j + 7]); } }
            v4u* dst = (v4u*)(WSP(bf16, wk ? WS_KR : WS_QR) + (size_t)t * DM + 32 * lane);
#pragma unroll
            for (int j = 0; j < 4; ++j) dst[j] = a[j];
        }
#pragma unroll
        for (int wk = 0; wk < 2; ++wk) {
            const v4u m = wk ? mk : mq;
            v4u pn; pn.x = __shfl_xor(m.x, 1); pn.y = __shfl_xor(m.y, 1); pn.z = __shfl_xor(m.z, 1); pn.w = __shfl_xor(m.w, 1);
            v4u o = m;
            if (part < 2) { float a[8], b[8], r[8];
                a[0] = bflo(m.x); a[1] = bfhi(m.x); a[2] = bflo(m.y); a[3] = bfhi(m.y); a[4] = bflo(m.z); a[5] = bfhi(m.z); a[6] = bflo(m.w); a[7] = bfhi(m.w);
                b[0] = bflo(pn.x); b[1] = bfhi(pn.x); b[2] = bflo(pn.y); b[3] = bfhi(pn.y); b[4] = bflo(pn.z); b[5] = bfhi(pn.z); b[6] = bflo(pn.w); b[7] = bfhi(pn.w);
#pragma unroll
                for (int i = 0; i < 8; ++i) { const float cs = R8(2 * i), sn = R8(2 * i + 1); r[i] = part == 0 ? a[i] * cs - b[i] * sn : a[i] * cs + b[i] * sn; }
                o.x = pk2(r[0], r[1]); o.y = pk2(r[2], r[3]); o.z = pk2(r[4], r[5]); o.w = pk2(r[6], r[7]); }
            if (wk == 0) *(v4u*)(WSP(bf16, WS_QIR) + (size_t)t * 512 + 8 * lane) = o;
            else if (lane < 8) *(v4u*)(WSP(bf16, WS_KIR) + (size_t)t * 64 + 8 * lane) = o;
        }
#undef R16
#undef R8
    }
}

__device__ __forceinline__ int crow16(int r, int hi) { return (r & 3) + 8 * (r >> 2) + 4 * hi; }
__device__ __forceinline__ bf16x8 lds_b128(const LAS unsigned char* p) { return *(const LAS bf16x8*)p; }
__device__ __forceinline__ bf16x8 lds_tr8(const LAS unsigned char* p, int rowstep4) {
    typedef short v4i16_t __attribute__((ext_vector_type(4)));
    const v4i16_t a = __builtin_amdgcn_ds_read_tr16_b64_v4i16((LAS v4i16_t*)p);
    const v4i16_t b = __builtin_amdgcn_ds_read_tr16_b64_v4i16((LAS v4i16_t*)(p + rowstep4));
    return (bf16x8){a[0], a[1], a[2], a[3], b[0], b[1], b[2], b[3]};
}
constexpr int SP_C = 272, SP_X = 144;
constexpr int S_CS = 0, S_BS = 34816, S_XS = 69632, S_XW = 88064, S_VEC = 106496, S_YS = 107520;
struct P3R { v4u b[4], c[4], x[2]; float dtr[2], dar[2], da_last, dac1, dt1; };
__device__ __forceinline__ void p3_load(P3R& R, int u, int tid) {
    const int h = u & 31, bc = u >> 5, g = h >> 3; const size_t t0 = (size_t)bc * 128;
    R.da_last = WSP(float, WS_DACS)[(t0 + 127) * 32 + h];
#pragma unroll
    for (int i = 0; i < 4; ++i) { const int idx = tid + 512 * i, row = idx >> 4, ch = idx & 15; const bf16* src = WSP(bf16, WS_XBC) + (t0 + row) * 3072 + 2048 + g * 128 + ch * 8;
        R.b[i] = *(const v4u*)src; R.c[i] = *(const v4u*)(src + 512); }
#pragma unroll
    for (int i = 0; i < 2; ++i) { const int idx = tid + 512 * i, row = idx >> 3, ch = idx & 7; R.x[i] = *(const v4u*)(WSP(bf16, WS_XBC) + (t0 + row) * 3072 + h * 64 + ch * 8);
        R.dtr[i] = WSP(float, WS_DT)[(t0 + row) * 32 + h]; R.dar[i] = WSP(float, WS_DACS)[(t0 + row) * 32 + h]; }
    R.dac1 = WSP(float, WS_DACS)[(t0 + (tid & 127)) * 32 + h]; R.dt1 = WSP(float, WS_DT)[(t0 + (tid & 127)) * 32 + h];
}
__device__ __forceinline__ void p3_ssd_unit(Frame& F, int u, int un, P3R& R) {
    const int tid = TID(), lane = LANE(), w = F.wave, r32 = lane & 31, hh = lane >> 5;
    const int h = u & 31, bc = u >> 5; const size_t t0 = (size_t)bc * 128;
    LAS unsigned char* L = F.lds + RING_OFF;
    LAS float* dacs = (LAS float*)(L + S_VEC); LAS float* dtv = dacs + 128;
#pragma unroll
    for (int i = 0; i < 4; ++i) { const int idx = tid + 512 * i, row = idx >> 4, ch = idx & 15;
        *(LAS v4u*)(L + S_BS + row * SP_C + ch * 16) = R.b[i]; *(LAS v4u*)(L + S_CS + row * SP_C + ch * 16) = R.c[i]; }
#pragma unroll
    for (int i = 0; i < 2; ++i) { const int idx = tid + 512 * i, row = idx >> 3, ch = idx & 7; const v4u xv = R.x[i];
        const float wl = R.dtr[i] * __expf(R.da_last - R.dar[i]);
        *(LAS v4u*)(L + S_XS + row * SP_X + ch * 16) = xv;
        v4u xw; xw.x = pk2(bflo(xv.x) * wl, bfhi(xv.x) * wl); xw.y = pk2(bflo(xv.y) * wl, bfhi(xv.y) * wl); xw.z = pk2(bflo(xv.z) * wl, bfhi(xv.z) * wl); xw.w = pk2(bflo(xv.w) * wl, bfhi(xv.w) * wl);
        *(LAS v4u*)(L + S_XW + row * SP_X + ch * 16) = xw; }
    if (tid < 128) { dacs[tid] = R.dac1; dtv[tid] = R.dt1; }
    __syncthreads();
    p3_load(R, un, tid);
    __builtin_amdgcn_sched_barrier(0);
    const int li = w >> 1;
    f32x16 acc0 = {}, acc1 = {};
    { const int j0 = (w & 1) * 2;
      const LAS unsigned char* cp = L + S_CS + (32 * li + r32) * SP_C + hh * 16;
      if (j0 <= li) { const LAS unsigned char* bp = L + S_BS + (32 * j0 + r32) * SP_C + hh * 16;
#pragma unroll
          for (int ks = 0; ks < 8; ++ks) acc0 = __builtin_amdgcn_mfma_f32_32x32x16_bf16(lds_b128(bp + ks * 32), lds_b128(cp + ks * 32), acc0, 0, 0, 0); }
      if (j0 + 1 <= li) { const LAS unsigned char* bp = L + S_BS + (32 * (j0 + 1) + r32) * SP_C + hh * 16;
#pragma unroll
          for (int ks = 0; ks < 8; ++ks) acc1 = __builtin_amdgcn_mfma_f32_32x32x16_bf16(lds_b128(bp + ks * 32), lds_b128(cp + ks * 32), acc1, 0, 0, 0); } }
    __syncthreads();
    { const int j0 = (w & 1) * 2, l = 32 * li + r32; const float dl = dacs[l];
#pragma unroll
      for (int jj = 0; jj < 2; ++jj) { const int sj = j0 + jj; if (sj <= li) {
#pragma unroll
          for (int q = 0; q < 4; ++q) { float gv[4];
#pragma unroll
              for (int e = 0; e < 4; ++e) { const int s = 32 * sj + 8 * q + 4 * hh + e; const float a = jj ? acc1[4 * q + e] : acc0[4 * q + e];
                  gv[e] = (s <= l) ? a * __expf(dl - dacs[s]) * dtv[s] : 0.f; }
              v2u o; o.x = pk2(gv[0], gv[1]); o.y = pk2(gv[2], gv[3]);
              *(LAS v2u*)(L + S_CS + l * SP_C + (32 * sj + 8 * q + 4 * hh) * 2) = o; } } } }
    __syncthreads();
    { const int pb = w & 1; f32x16 acc = {};
      const LAS unsigned char* gp = L + S_CS + (32 * li + r32) * SP_C + hh * 16;
      const LAS unsigned char* xp = L + S_XS + (8 * hh + ((lane & 15) >> 2)) * SP_X + (32 * pb + 16 * ((lane >> 4) & 1) + 4 * (lane & 3)) * 2;
      for (int ks = 0; ks < 2 * (li + 1); ++ks) acc = __builtin_amdgcn_mfma_f32_32x32x16_bf16(lds_b128(gp + ks * 32), lds_tr8(xp + ks * 16 * SP_X, 4 * SP_X), acc, 0, 0, 0);
      LAS bf16* ys = (LAS bf16*)(L + S_YS);
#pragma unroll
      for (int r = 0; r < 16; ++r) ys[(32 * li + crow16(r, hh)) * 72 + 32 * pb + r32] = (bf16)f2bf(acc[r]); }
    { const int pb = w >> 2, nb = w & 3; f32x16 acc = {};
      const int trow = 8 * hh + ((lane & 15) >> 2), tcol = 16 * ((lane >> 4) & 1) + 4 * (lane & 3);
      const LAS unsigned char* ap = L + S_XW + trow * SP_X + (32 * pb + tcol) * 2;
      const LAS unsigned char* bp = L + S_BS + trow * SP_C + (32 * nb + tcol) * 2;
#pragma unroll
      for (int ks = 0; ks < 8; ++ks) acc = __builtin_amdgcn_mfma_f32_32x32x16_bf16(lds_tr8(ap + ks * 16 * SP_X, 4 * SP_X), lds_tr8(bp + ks * 16 * SP_C, 4 * SP_C), acc, 0, 0, 0);
      float* st = WSP(float, WS_STATES) + ((size_t)u * 64 + 32 * pb) * 128 + 32 * nb + r32;
#pragma unroll
      for (int r = 0; r < 16; ++r) st[(size_t)crow16(r, hh) * 128] = acc[r]; }
    __syncthreads();
#pragma unroll
    for (int i = 0; i < 2; ++i) { const int idx = tid + 512 * i, l = idx >> 3, c8 = (idx & 7) * 8;
        *(v4u*)(WSP(bf16, WS_YD) + (t0 + l) * 2048 + h * 64 + c8) = *(const LAS v4u*)(L + S_YS + (l * 72 + c8) * 2); }
    __syncthreads();
}
constexpr int IX_Q = 0, IX_W = 32768;
__device__ __forceinline__ void p3_index_group(Frame& F, int b, int qg) {
    const int tid = TID(), lane = LANE(), r32 = lane & 31, hh = lane >> 5;
    LAS unsigned char* L = F.lds + RING_OFF; LAS float* wl = (LAS float*)(L + IX_W);
    const bf16* Ub = WSP(bf16, WS_U) + ((size_t)b * SEQ) * NU;
#pragma unroll
    for (int i = 0; i < 4; ++i) { const int pc = tid + 512 * i, ln = pc & 63, ks = (pc >> 6) & 3, h8 = pc >> 8;
        *(LAS v4u*)(L + IX_Q + pc * 16) = *(const v4u*)(WSP(bf16, WS_QIR) + ((size_t)b * SEQ + qg * 32 + (ln & 31)) * 512 + h8 * 64 + ks * 16 + 8 * (ln >> 5)); }
    if (tid < 256) { const int h8 = tid >> 5, q = tid & 31; wl[tid] = bf2f(Ub[(size_t)(qg * 32 + q) * NU + UC_WI + h8]) * 0.044194173824159216f; }
    __syncthreads();
    float wq[8];
#pragma unroll
    for (int h8 = 0; h8 < 8; ++h8) wq[h8] = wl[h8 * 32 + r32];
    bf16x8 kf[4];
    { const int k0 = F.wave <= qg ? F.wave : qg; const bf16* krow = WSP(bf16, WS_KIR) + ((size_t)b * SEQ + k0 * 32 + r32) * 64 + 8 * hh;
#pragma unroll
        for (int ks = 0; ks < 4; ++ks) kf[ks] = *(const bf16x8*)(krow + ks * 16); }
    for (int kt = F.wave; kt <= qg; kt += NWAVES) {
        bf16x8 kn[4];
        { const int k1 = kt + NWAVES <= qg ? kt + NWAVES : qg;
          const bf16* krow = WSP(bf16, WS_KIR) + ((size_t)b * SEQ + k1 * 32 + r32) * 64 + 8 * hh;
#pragma unroll
          for (int ks = 0; ks < 4; ++ks) kn[ks] = *(const bf16x8*)(krow + ks * 16); }
        __builtin_amdgcn_sched_barrier(0);
        f32x16 sc = {};
        int qoff = lane * 16; asm volatile("" : "+v"(qoff));
#pragma unroll
        for (int h8 = 0; h8 < 8; ++h8) { f32x16 a = {};
#pragma unroll
            for (int ks = 0; ks < 4; ++ks) a = __builtin_amdgcn_mfma_f32_32x32x16_bf16(kf[ks], lds_b128(L + IX_Q + (h8 * 4 + ks) * 1024 + qoff), a, 0, 0, 0);
#pragma unroll
            NANCHK((a[0] != a[0]) || (a[5] != a[5]) || (a[10] != a[10]) || (a[15] != a[15]) || (wq[h8] != wq[h8]), 1);
            for (int e = 0; e < 16; ++e) sc[e] += wq[h8] * fmaxf(a[e], 0.f); }
        float* srow = WSP(float, WS_S) + ((size_t)b * SEQ + qg * 32 + r32) * SEQ + kt * 32 + 4 * hh;
#pragma unroll
        for (int q = 0; q < 4; ++q) *(f32x4*)(srow + 8 * q) = (f32x4){sc[4 * q], sc[4 * q + 1], sc[4 * q + 2], sc[4 * q + 3]};
#pragma unroll
        for (int ks = 0; ks < 4; ++ks) kf[ks] = kn[ks];
    }
    __syncthreads();
}
__device__ __forceinline__ void p3_phase(Frame& F) {
    const bool idx_first = (PHASE_SWAP) && (((blockIdx.x >> 3) & 1) != 0);
#pragma nounroll
    for (int pass = 0; pass < 2; ++pass) {
        if ((pass == 0) != idx_first) {
#ifndef NO_P3A
    { constexpr int NUN = 2 * 64 * 32; int u = F.vcu;
      if (u < NUN) { P3R R; p3_load(R, u, TID());
#pragma nounroll
          for (; u < NUN; u += F.G) p3_ssd_unit(F, u, u + F.G < NUN ? u + F.G : u, R); } }
#endif
        } else {
#if !defined(NO_P3B) && !defined(NO_ATTN)
    for (int it = F.vcu; it < 256; it += F.G) { const int b = it >> 7, x = it & 127; p3_index_group(F, b, x); p3_index_group(F, b, 255 - x); }
#endif
        }
    }
}

__device__ __forceinline__ unsigned fkey(float v) { NANCHK(v != v, 0); const unsigned u = __float_as_uint(v + 0.0f);
    return u ^ ((unsigned)((int)u >> 31) | 0x80000000u); }
__device__ __forceinline__ void sacc(int& c, int v) { asm volatile("s_add_i32 %0, %0, %1" : "+s"(c) : "s"(v) : "scc"); }
__device__ __forceinline__ int wave_sum_i(int v) {
    v += __builtin_amdgcn_update_dpp(0, v, 0xB1, 0xf, 0xf, false);
    v += __builtin_amdgcn_update_dpp(0, v, 0x4E, 0xf, 0xf, false);
    v += __builtin_amdgcn_update_dpp(0, v, 0x141, 0xf, 0xf, false);
    v += __builtin_amdgcn_update_dpp(0, v, 0x140, 0xf, 0xf, false);
    return __builtin_amdgcn_readlane(v, 0) + __builtin_amdgcn_readlane(v, 16) + __builtin_amdgcn_readlane(v, 32) + __builtin_amdgcn_readlane(v, 48);
}
__device__ __forceinline__ void cnt4(int (&c)[4], unsigned k0, unsigned k1, unsigned k2, unsigned k3, unsigned mid) {
    unsigned long long t0, t1, t2, t3;
    asm("v_cmp_ge_u32_e64 %4, %8, %12\n\tv_cmp_ge_u32_e64 %5, %9, %12\n\tv_cmp_ge_u32_e64 %6, %10, %12\n\tv_cmp_ge_u32_e64 %7, %11, %12\n\t"
        "v_addc_co_u32_e64 %0, %4, 0, %0, %4\n\tv_addc_co_u32_e64 %1, %5, 0, %1, %5\n\tv_addc_co_u32_e64 %2, %6, 0, %2, %6\n\tv_addc_co_u32_e64 %3, %7, 0, %3, %7"
        : "+v"(c[0]), "+v"(c[1]), "+v"(c[2]), "+v"(c[3]), "=&s"(t0), "=&s"(t1), "=&s"(t2), "=&s"(t3) : "v"(k0), "v"(k1), "v"(k2), "v"(k3), "v"(mid));
}
template <int NR, int NL>
__device__ __forceinline__ void select_row(float (&raw)[64], const float* Srow, int pos, unsigned long long* Mq, int ntw, int lane, LAS unsigned* lk, LAS unsigned long long* lw, bool okn, int qn) {
    const int ni = (pos >> 6) + 1;
    unsigned key[NR];
    int ln = lane; asm volatile("" : "+v"(ln));
    unsigned kmax = 0u;
#ifdef DOUBLE_CONV
#pragma nounroll
    for (int rep_ = 0; rep_ < 2; ++rep_) { asm volatile("" : "+v"(ln)); kmax = 0u;
#endif
#pragma unroll
    for (int i = 0; i < NR; ++i) { key[i] = 0u; if (i < ni) { const int kidx = i * 64 + ln; key[i] = (kidx <= pos) ? fkey(raw[i]) : 0u; kmax = key[i] > kmax ? key[i] : kmax; } if ((i & 31) == 31) __builtin_amdgcn_sched_barrier(0); }
#pragma unroll
    for (int i = 0; i < NL; ++i) if (NR + i < ni) raw[i] = Srow[(NR + i) * 64 + ln];
    __builtin_amdgcn_sched_barrier(0);
#pragma unroll
    for (int i = 0; i < NL; ++i) { unsigned k = 0u; if (NR + i < ni) { const int kidx = (NR + i) * 64 + ln; k = (kidx <= pos) ? fkey(raw[i]) : 0u; kmax = k > kmax ? k : kmax; } lk[i * 64 + lane] = k; if ((i & 31) == 31) __builtin_amdgcn_sched_barrier(0); }
#ifdef DOUBLE_CONV
    }
#endif
    if (okn) { const int pos_ = qn & (SEQ - 1); if (pos_ >= 256) { const int ni_ = (pos_ >> 6) + 1; const float* sr_ = WSP(float, WS_S) + (size_t)qn * SEQ + lane;
#pragma unroll
        for (int i = 0; i < 64; ++i) if (i < ni_) raw[i] = sr_[i * 64]; } }
#pragma unroll
    for (int o = 1; o < 64; o <<= 1) { const unsigned ok = (unsigned)__shfl_xor((int)kmax, o); kmax = ok > kmax ? ok : kmax; }
    unsigned lo, hi; int clo;
#ifdef DOUBLE_BISECT
#pragma nounroll
    for (int rep_ = 0; rep_ < DOUBLE_BISECT; ++rep_) { asm volatile("" : "+v"(kmax));
#endif
    lo = 0u; hi = kmax + 1u; clo = 0x7fffffff;
    float glo = 0.f, ghi = -256.f; int side = 0, it = 0; const bool okp = kmax > 0x82000000u; const unsigned p1 = kmax - 0x00800000u;
#pragma nounroll
    while (hi - lo > 1u) {
        const unsigned wd = hi - lo; unsigned mid = lo + (wd >> 1);
        if (okp && it == 0) mid = p1;
        else if (okp && it == 1 && hi == p1) mid = kmax - 0x01800000u;
        else if (clo != 0x7fffffff && (it & 7) != 7) { const float f = (glo + 0.5f) * __builtin_amdgcn_rcpf(glo - ghi); unsigned off = (unsigned)((float)wd * f); off = off < 1u ? 1u : off; off = off > wd - 1u ? wd - 1u : off; mid = lo + off; }
        ++it;
        int c4[4] = {0, 0, 0, 0};
#pragma unroll
        for (int i = 0; i < NR; i += 4) cnt4(c4, key[i], key[i + 1], key[i + 2], key[i + 3], mid);
#pragma unroll
        for (int i = 0; i < NL; i += 4) cnt4(c4, lk[i * 64 + lane], lk[(i + 1) * 64 + lane], lk[(i + 2) * 64 + lane], lk[(i + 3) * 64 + lane], mid);
        const int c = wave_sum_i((c4[0] + c4[1]) + (c4[2] + c4[3]));
        if (c >= 256) { lo = mid; clo = c; if (c == 256) break; glo = (float)(c - 256); if (side == 1) ghi *= 0.5f; side = 1; }
        else { hi = mid; ghi = (float)(c - 256); if (side == -1) glo *= 0.5f; side = -1; }
    }
#ifdef DOUBLE_BISECT
    }
#endif
#ifdef DOUBLE_FINAL
#pragma nounroll
    for (int rep_ = 0; rep_ < 2; ++rep_) { asm volatile("" : "+v"(lo));
#endif
    int need = 0x7fffffff;
    if (clo != 256) { int cl = 0;
#pragma unroll
        for (int i = 0; i < NR; ++i) cl += (key[i] > lo) ? 1 : 0;
#pragma unroll
        for (int i = 0; i < NL; ++i) cl += (lk[i * 64 + lane] > lo) ? 1 : 0;
        need = 256 - wave_sum_i(cl); }
    unsigned wl0 = 0u, wh0 = 0u, wl1 = 0u, wh1 = 0u; int ln2 = lane; asm volatile("" : "+v"(ln2));
#define PUT_WORD(i_, bal_) do { const bool me_ = ln2 == ((i_) & 63); if ((i_) < 64) { wl0 = me_ ? (unsigned)(bal_) : wl0; wh0 = me_ ? (unsigned)((bal_) >> 32) : wh0; } else { wl1 = me_ ? (unsigned)(bal_) : wl1; wh1 = me_ ? (unsigned)((bal_) >> 32) : wh1; } } while (0)
    if (clo == 256) {
#pragma unroll
        for (int i = 0; i < NR + NL; ++i) { const unsigned kv = i < NR ? key[i < NR ? i : 0] : lk[(i - NR) * 64 + lane];
            const unsigned long long bal = __ballot(kv >= lo); PUT_WORD(i, bal); __builtin_amdgcn_sched_barrier(0); }
    } else {
    int run = 0; unsigned lo2 = lo; asm volatile("" : "+v"(lo2));
#pragma unroll
    for (int i = 0; i < NR + NL; ++i) {
        const unsigned kv = i < NR ? key[i < NR ? i : 0] : lk[(i - NR) * 64 + lane];
        const bool eq = kv == lo2; const unsigned long long be = __ballot(eq);
        const int pre = run + __popcll(be & ((1ull << lane) - 1ull)); run += __popcll(be);
        const unsigned long long bal = __ballot((kv > lo2) || (eq && pre < need));
        PUT_WORD(i, bal);
        __builtin_amdgcn_sched_barrier(0);
    }
    }
#undef PUT_WORD
    if (lane < ntw && lane < NR + NL) Mq[(size_t)lane * SEQ] = ((unsigned long long)wh0 << 32) | wl0;
    if (NR + NL > 64 && lane + 64 < ntw) Mq[(size_t)(lane + 64) * SEQ] = ((unsigned long long)wh1 << 32) | wl1;
#ifdef DOUBLE_FINAL
    }
#endif
}
__device__ __forceinline__ void p4_scan(Frame& F) {
    const int gt = F.vcu * (NWAVES * 64) + TID(), NT = F.G * NWAVES * 64;
#ifdef DOUBLE_P4A
#pragma nounroll
    for (int rep_ = 0; rep_ < 2; ++rep_)
#endif
    for (int it = gt; it < 2 * 32 * 64 * 32; it += NT) {
        const int n4 = it & 31, p = (it >> 5) & 63, h = (it >> 11) & 31, b = it >> 16;
        f32x4 hs = {0.f, 0.f, 0.f, 0.f};
#pragma nounroll
        for (int c0 = 0; c0 < 64; c0 += 16) {
            f32x4 st[16]; float dc[16];
#pragma unroll
            for (int k = 0; k < 16; ++k) { const size_t idx = ((size_t)(b * 64 + c0 + k) * 32 + h), off = (idx * 64 + p) * 128 + n4 * 4;
                st[k] = *(const f32x4*)(WSP(float, WS_STATES) + off); dc[k] = WSP(float, WS_DACS)[((size_t)(b * 64 + c0 + k) * 128 + 127) * 32 + h]; }
            __builtin_amdgcn_sched_barrier(0);
#pragma unroll
            for (int k = 0; k < 16; ++k) { const size_t idx = ((size_t)(b * 64 + c0 + k) * 32 + h), off = (idx * 64 + p) * 128 + n4 * 4;
                v2u o; o.x = pk2(hs.x, hs.y); o.y = pk2(hs.z, hs.w); *(v2u*)(WSP(bf16, WS_PREV) + off) = o;
                hs = hs * __expf(dc[k]) + st[k]; }
        }
    }
}
__device__ __forceinline__ void p4_phase(Frame& F) {
    const int gt = F.vcu * (NWAVES * 64) + TID(), NT = F.G * NWAVES * 64;
    const int lane = LANE();
    const bool sel_first = (PHASE_SWAP) && (((blockIdx.x >> 3) & 1) != 0);
#ifndef NO_P4A
    if (!sel_first) p4_scan(F);
#endif
#ifndef NO_ATTN
    const int nk = 8 * ((1024 + 4 * F.G - 1) / (4 * F.G));
    float raw[64];
#define P4_QUERY(k_, q_, ok_) do { const int kk_ = (k_) >> 1, base_ = (kk_ >> 2) * F.G + F.vcu, ph_ = kk_ & 3; ok_ = (k_) < nk && base_ < 256; \
        const int grp_ = ph_ == 0 ? base_ : ph_ == 1 ? 511 - base_ : ph_ == 2 ? 512 + base_ : 1023 - base_; q_ = grp_ * 16 + 2 * F.wave + ((k_) & 1); } while (0)
#define P4_PREFETCH(q_) do { const int pos_ = (q_) & (SEQ - 1); if (pos_ >= 256) { const int ni_ = (pos_ >> 6) + 1; const float* sr_ = WSP(float, WS_S) + (size_t)(q_) * SEQ + lane; \
        _Pragma("unroll") for (int i = 0; i < 64; ++i) if (i < ni_) raw[i] = sr_[i * 64]; } } while (0)
    { int q0; bool ok0; P4_QUERY(0, q0, ok0); if (ok0) P4_PREFETCH(q0); }
    for (int k = 0; k < nk; ++k) {
        int q; bool ok; P4_QUERY(k, q, ok); if (!ok) continue;
        int qn; bool okn; P4_QUERY(k + 1, qn, okn);
        const int b = q >> 13, pos = q & (SEQ - 1), ntw = 4 * ((pos >> 8) + 1);
        unsigned long long* Mq = WSP(unsigned long long, WS_MASK) + (size_t)b * 128 * SEQ + pos;
        if (pos < 256) { if (lane < ntw) { const int d = pos - 64 * lane; Mq[(size_t)lane * SEQ] = d >= 63 ? ~0ull : (d < 0 ? 0ull : ((2ull << d) - 1ull)); } if (okn) P4_PREFETCH(qn); }
        else { const float* Srow = WSP(float, WS_S) + (size_t)q * SEQ; const int ni = (pos >> 6) + 1;
            LAS unsigned* lk = (LAS unsigned*)(F.lds + RING_OFF + F.wave * 16384); LAS unsigned long long* lw = (LAS unsigned long long*)(F.lds + RS_OFF + F.wave * 1024);
            if (ni <= 32) select_row<32, 0>(raw, Srow, pos, Mq, ntw, lane, lk, lw, okn, qn); else if (ni <= 64) select_row<64, 0>(raw, Srow, pos, Mq, ntw, lane, lk, lw, okn, qn);
            else if (ni <= 96) select_row<64, 32>(raw, Srow, pos, Mq, ntw, lane, lk, lw, okn, qn); else select_row<64, 64>(raw, Srow, pos, Mq, ntw, lane, lk, lw, okn, qn); }
    }
#undef P4_QUERY
#undef P4_PREFETCH
#endif
#ifndef NO_P4A
    if (sel_first) p4_scan(F);
#endif
}

constexpr int S5_CS = 0, S5_PS = 34816, S5_VEC = 52224, S5_YO = 53248;
struct P5R { v4u c[4], p[2], yd[2], xv[2], zv[2]; float dac, dsk; };
__device__ __forceinline__ void p5_load(P5R& R, int u, int tid) {
    const int h = u & 31, bc = u >> 5, g = h >> 3; const size_t t0 = (size_t)bc * 128;
#pragma unroll
    for (int i = 0; i < 2; ++i) { const int idx = tid + 512 * i, l = idx >> 3, c8 = (idx & 7) * 8; const size_t t = t0 + l; const int col = h * 64 + c8;
        R.yd[i] = *(const v4u*)(WSP(bf16, WS_YD) + t * 2048 + col); R.xv[i] = *(const v4u*)(WSP(bf16, WS_XBC) + t * 3072 + col); R.zv[i] = *(const v4u*)(WSP(bf16, WS_U) + t * NU + UC_Z + col); }
#pragma unroll
    for (int i = 0; i < 4; ++i) { const int idx = tid + 512 * i, row = idx >> 4, ch = idx & 15; R.c[i] = *(const v4u*)(WSP(bf16, WS_XBC) + (t0 + row) * 3072 + 2560 + g * 128 + ch * 8); }
#pragma unroll
    for (int i = 0; i < 2; ++i) { const int idx = tid + 512 * i, row = idx >> 4, ch = idx & 15; R.p[i] = *(const v4u*)(WSP(bf16, WS_PREV) + ((size_t)u * 64 + row) * 128 + ch * 8); }
    R.dac = WSP(float, WS_DACS)[(t0 + (tid & 127)) * 32 + h]; R.dsk = INP(6)[h];
}
__device__ __forceinline__ void p5_ssd_all(Frame& F) {
    constexpr int NUN = 2 * 64 * 32;
    const int tid = TID(), lane = LANE(), w = F.wave, r32 = lane & 31, hh = lane >> 5;
    LAS unsigned char* L = F.lds + RING_OFF; LAS float* dacs = (LAS float*)(L + S5_VEC);
    int u = F.vcu; if (u >= NUN) return;
    P5R R; p5_load(R, u, tid);
#pragma nounroll
    for (; u < NUN; u += F.G) {
        const int h = u & 31, bc = u >> 5; const size_t t0 = (size_t)bc * 128;
#pragma unroll
        for (int i = 0; i < 4; ++i) { const int idx = tid + 512 * i, row = idx >> 4, ch = idx & 15; *(LAS v4u*)(L + S5_CS + row * SP_C + ch * 16) = R.c[i]; }
#pragma unroll
        for (int i = 0; i < 2; ++i) { const int idx = tid + 512 * i, row = idx >> 4, ch = idx & 15; *(LAS v4u*)(L + S5_PS + row * SP_C + ch * 16) = R.p[i]; }
        if (tid < 128) dacs[tid] = R.dac;
        const v4u cyd[2] = {R.yd[0], R.yd[1]}, cxv[2] = {R.xv[0], R.xv[1]}, czv[2] = {R.zv[0], R.zv[1]}; const float dsk = R.dsk;
        __syncthreads();
        p5_load(R, u + F.G < NUN ? u + F.G : u, tid);
        __builtin_amdgcn_sched_barrier(0);
        const int li = w >> 1, pb = w & 1; f32x16 acc = {};
        { const LAS unsigned char* cp = L + S5_CS + (32 * li + r32) * SP_C + hh * 16; const LAS unsigned char* pp = L + S5_PS + (32 * pb + r32) * SP_C + hh * 16;
#pragma unroll
          for (int ks = 0; ks < 8; ++ks) acc = __builtin_amdgcn_mfma_f32_32x32x16_bf16(lds_b128(cp + ks * 32), lds_b128(pp + ks * 32), acc, 0, 0, 0); }
        LAS float* Yo = (LAS float*)(L + S5_YO);
#pragma unroll
        for (int r = 0; r < 16; ++r) Yo[(32 * li + crow16(r, hh)) * 68 + 32 * pb + r32] = acc[r];
        __syncthreads();
#pragma unroll
        for (int i = 0; i < 2; ++i) { const int idx = tid + 512 * i, l = idx >> 3, c8 = (idx & 7) * 8; const size_t t = t0 + l; const int col = h * 64 + c8;
            const f32x4 y0 = *(const LAS f32x4*)(Yo + l * 68 + c8), y1 = *(const LAS f32x4*)(Yo + l * 68 + c8 + 4);
            const v4u yd = cyd[i], xv = cxv[i], zv = czv[i];
            const float e = __expf(dacs[l]);
            float o[8];
            o[0] = (bflo(yd.x) + y0[0] * e + bflo(xv.x) * dsk) * siluf(bflo(zv.x)); o[1] = (bfhi(yd.x) + y0[1] * e + bfhi(xv.x) * dsk) * siluf(bfhi(zv.x));
            o[2] = (bflo(yd.y) + y0[2] * e + bflo(xv.y) * dsk) * siluf(bflo(zv.y)); o[3] = (bfhi(yd.y) + y0[3] * e + bfhi(xv.y) * dsk) * siluf(bfhi(zv.y));
            o[4] = (bflo(yd.z) + y1[0] * e + bflo(xv.z) * dsk) * siluf(bflo(zv.z)); o[5] = (bfhi(yd.z) + y1[1] * e + bfhi(xv.z) * dsk) * siluf(bfhi(zv.z));
            o[6] = (bflo(yd.w) + y1[2] * e + bflo(xv.w) * dsk) * siluf(bflo(zv.w)); o[7] = (bfhi(yd.w) + y1[3] * e + bfhi(xv.w) * dsk) * siluf(bfhi(zv.w));
            v4u ov; ov.x = pk2(o[0], o[1]); ov.y = pk2(o[2], o[3]); ov.z = pk2(o[4], o[5]); ov.w = pk2(o[6], o[7]);
            *(v4u*)(WSP(bf16, WS_YG) + t * 2048 + col) = ov; }
        __syncthreads();
    }
}
#ifndef TAILSPIN_ALL
#define TAILSPIN_ALL 0
#endif

typedef att::BlockRef<att::bf16, att::bf16> ABlk;
__device__ __forceinline__ ABlk att_ref(const bf16* U, const bf16* QR, const bf16* KR, bf16* AO, const unsigned long long* MASK, int L, int pass) {
    const int bh = L >> 4, x = L & 15, qb = pass ? 31 - x : x, b = bh >> 4, hd = bh & 15;
    ABlk r;
    r.Q = (const att::bf16*)(QR + ((size_t)b * SEQ + qb * 256) * DM + hd * 128);
    r.K = (const att::bf16*)(KR + ((size_t)b * SEQ) * DM + hd * 128);
    r.V = (const att::bf16*)(U + ((size_t)b * SEQ) * NU + UC_V + hd * 128);
    r.O = (att::bf16*)(AO + ((size_t)b * SEQ + qb * 256) * 2048 + hd * 128);
    r.MK = MASK + (size_t)b * 128 * SEQ + qb * 256;
    r.P0 = qb * 256;
    return r;
}
__device__ __forceinline__ void p5_attention(Frame& F, int k0 = 0, int k1 = 1 << 20) {
    int NITEM = 512; { const long lim = (long)F.vcu + (long)k1 * F.G; if (lim < NITEM) NITEM = (int)lim; }
    int L = F.vcu + k0 * F.G; if (L >= NITEM) return;
    const bf16* U = WSP(bf16, WS_U); const bf16* QR = WSP(bf16, WS_QR); const bf16* KR = WSP(bf16, WS_KR); bf16* AO = WSP(bf16, WS_AO); const unsigned long long* MK = WSP(unsigned long long, WS_MASK); const int stride = F.G;
    char* lds = (char*)(F.lds + RING_OFF);
    int pass = 0;
    ABlk cur = att_ref(U, QR, KR, AO, MK, L, 0);
    att::Seam<att::bf16> S;
    att::causal_swa_prime<att::bf16, att::bf16>(cur, SEQ, lds, S);
    for (;;) {
        const bool more_pass = pass == 0, more_item = L + stride < NITEM, last = !more_pass && !more_item;
        int passn = pass + 1, Ln = L;
        if (!more_pass) { passn = 0; Ln = more_item ? L + stride : L; }
        const ABlk nxt = last ? cur : att_ref(U, QR, KR, AO, MK, Ln, passn);
        att::causal_swa_block<att::bf16, att::bf16>(cur, nxt, SEQ, SEQ, lds, S);
        if (last) break;
        cur = nxt; pass = passn; L = Ln;
    }
}

__device__ __forceinline__ float wave_sum_dpp(float v) {
    v += __int_as_float(__builtin_amdgcn_update_dpp(0, __float_as_int(v), 0xB1, 0xf, 0xf, false));
    v += __int_as_float(__builtin_amdgcn_update_dpp(0, __float_as_int(v), 0x4E, 0xf, 0xf, false));
    v += __int_as_float(__builtin_amdgcn_update_dpp(0, __float_as_int(v), 0x141, 0xf, 0xf, false));
    v += __int_as_float(__builtin_amdgcn_update_dpp(0, __float_as_int(v), 0x140, 0xf, 0xf, false));
    const int iv = __float_as_int(v);
    return (__int_as_float(__builtin_amdgcn_readlane(iv, 0)) + __int_as_float(__builtin_amdgcn_readlane(iv, 16))) + (__int_as_float(__builtin_amdgcn_readlane(iv, 32)) + __int_as_float(__builtin_amdgcn_readlane(iv, 48)));
}
__device__ __forceinline__ void p9_route(Frame& F) {
    const int lane = LANE(), wave = F.wave, tid = TID();
    LAS int* ent = (LAS int*)(F.lds + RING_OFF);
    const int ngrp = T / 4, nrounds = (ngrp + F.G * NWAVES - 1) / (F.G * NWAVES);
    for (int rd = 0; rd < nrounds; ++rd) {
        const int grp = (rd * F.G + F.vcu) * NWAVES + wave; const bool valid = grp < ngrp;
        if (valid) {
            f32x4 xn[4][8], nw[8];
#pragma unroll
            for (int tk = 0; tk < 4; ++tk) { const f32x4* xr = (const f32x4*)(WSP(float, WS_H1) + ((size_t)grp * 4 + tk) * DM) + lane;
#pragma unroll
                for (int j = 0; j < 8; ++j) xn[tk][j] = xr[64 * j]; }
#pragma unroll
            for (int j = 0; j < 8; ++j) nw[j] = ((const f32x4*)INP(12))[lane + 64 * j];
            __builtin_amdgcn_sched_barrier(0);
#pragma unroll
            for (int tk = 0; tk < 4; ++tk) { const size_t tok = (size_t)grp * 4 + tk; float s = 0.f;
#pragma unroll
                for (int j = 0; j < 8; ++j) s += (xn[tk][j].x * xn[tk][j].x + xn[tk][j].y * xn[tk][j].y) + (xn[tk][j].z * xn[tk][j].z + xn[tk][j].w * xn[tk][j].w);
                const float rstd = 1.f / sqrtf(wave_sum(s) * (1.f / DM) + EPS);
                unsigned* o4 = (unsigned*)(WSP(unsigned char, WS_XN2) + tok * DM) + lane;
#pragma unroll
                for (int j = 0; j < 8; ++j) { const f32x4 wv = nw[j]; xn[tk][j] = xn[tk][j] * rstd * wv;
                    o4[64 * j] = pg8::pk4_fp8(xn[tk][j].x * pg8::F8_SX, xn[tk][j].y * pg8::F8_SX, xn[tk][j].z * pg8::F8_SX, xn[tk][j].w * pg8::F8_SX); } }
            float lg[2] = {0.f, 0.f};
            for (int e = 0; e < NEXP; ++e) {
                if ((e & 15) == 0) {
                    __syncthreads();
#pragma unroll
                    for (int i = 0; i < 16; ++i) ((LAS f32x4*)(F.lds + RING_OFF))[tid + 512 * i] = ((const f32x4*)(WSP(float, WS_RWT) + (size_t)e * DM))[tid + 512 * i];
                    __syncthreads(); }
                typedef float f32x2_t __attribute__((ext_vector_type(2)));
                f32x2_t q0 = {0.f, 0.f}, q1 = q0, q2 = q0, q3 = q0; const LAS f32x4* rw = (const LAS f32x4*)(F.lds + RING_OFF + (e & 15) * 8192) + lane;
#pragma unroll
                for (int j = 0; j < 8; ++j) { const f32x4 r = rw[64 * j]; const f32x2_t rl = {r.x, r.y}, rh = {r.z, r.w};
#define P9_FMA(Q_, X_) do { const f32x4 t_ = X_; Q_ = __builtin_elementwise_fma((f32x2_t){t_[0], t_[1]}, rl, Q_); Q_ = __builtin_elementwise_fma((f32x2_t){t_[2], t_[3]}, rh, Q_); } while (0)
                    P9_FMA(q0, xn[0][j]); P9_FMA(q1, xn[1][j]); P9_FMA(q2, xn[2][j]); P9_FMA(q3, xn[3][j]);
#undef P9_FMA
                }
                float p0 = q0.x + q0.y, p1 = q1.x + q1.y, p2 = q2.x + q2.y, p3 = q3.x + q3.y;
                p0 = wave_sum_dpp(p0); p1 = wave_sum_dpp(p1); p2 = wave_sum_dpp(p2); p3 = wave_sum_dpp(p3);
                const float bb = INP(14)[e];
                if ((lane & 31) == e) { lg[0] = ((lane >> 5) ? p1 : p0) + bb; lg[1] = ((lane >> 5) ? p3 : p2) + bb; }
            }
            __syncthreads();
#pragma unroll
            for (int jj = 0; jj < 2; ++jj) {
                float v = lg[jj]; float tv[4]; int ti[4];
#pragma unroll
                for (int k = 0; k < 4; ++k) { float bv = v; int bi = lane & 31;
#pragma unroll
                    for (int o = 1; o < 32; o <<= 1) { const float ov = __shfl_xor(bv, o); const int oi = __shfl_xor(bi, o); if (ov > bv || (ov == bv && oi < bi)) { bv = ov; bi = oi; } }
                    tv[k] = bv; ti[k] = bi; if ((lane & 31) == bi) v = -__builtin_inff(); }
                const float e0 = 1.f, e1 = expf(tv[1] - tv[0]), e2 = expf(tv[2] - tv[0]), e3 = expf(tv[3] - tv[0]); const float inv = 1.f / (e0 + e1 + e2 + e3);
                const int slot = lane & 31;
                if (slot < 4) { const int ee = slot == 0 ? ti[0] : slot == 1 ? ti[1] : slot == 2 ? ti[2] : ti[3]; const float ww = (slot == 0 ? e0 : slot == 1 ? e1 : slot == 2 ? e2 : e3) * inv;
                    const int tok = grp * 4 + 2 * jj + (lane >> 5);
                    ent[wave * 16 + (2 * jj + (lane >> 5)) * 4 + slot] = ee;
                    WSP(int, WS_ROUTE)[tok * 4 + slot] = ee; WSP(float, WS_ROUTE + 256 * 1024)[tok * 4 + slot] = ww; }
            }
        }
        __syncthreads();
        const int round = rd * F.G + F.vcu;
        if (round * 32 < T) {
            if (tid < 128) { const int ej = ent[tid]; int lr = 0; for (int i = 0; i < tid; ++i) lr += (ent[i] == ej) ? 1 : 0;
                WSP(int, WS_ROUTE + 512 * 1024)[(round * 32) * 4 + tid] = lr; }
            if (tid >= 128 && tid < 160) { const int e = tid - 128; int c = 0; for (int i = 0; i < 128; ++i) c += (ent[i] == e) ? 1 : 0; WSP(int, WS_ROUTE + 2048 * 1024)[round * 32 + e] = c; }
        }
        __syncthreads();
    }
}

__device__ __forceinline__ void moe_offsets(Frame& F, bool keep_prefix) {
    LAS int* eoff = (LAS int*)(F.lds + EOFF_OFF); LAS int* tile_e = (LAS int*)(F.lds + TILE_E_OFF);
    LAS int* pre = (LAS int*)(F.lds + RING_OFF); LAS int* part = (LAS int*)(F.lds + RING_OFF + 65536);
    const int NR = T / 32;
    __syncthreads();
    for (int i = TID(); i < NR * 32; i += NWAVES * 64) pre[i] = WSP(int, WS_ROUTE + 2048 * 1024)[i];
    __syncthreads();
    { const int e = TID() & 31, ch = TID() >> 5; int s = 0; for (int r = ch * 32; r < ch * 32 + 32; ++r) s += pre[r * 32 + e]; part[ch * 32 + e] = s; }
    __syncthreads();
    if (TID() < 32) { int s = 0; for (int ch = 0; ch < 16; ++ch) { const int v = part[ch * 32 + TID()]; part[ch * 32 + TID()] = s; s += v; } part[512 + TID()] = s; }
    __syncthreads();
    if (keep_prefix) { const int e = TID() & 31, ch = TID() >> 5; int s = part[ch * 32 + e]; for (int r = ch * 32; r < ch * 32 + 32; ++r) { const int v = pre[r * 32 + e]; pre[r * 32 + e] = s; s += v; } }
    if (TID() == 0) { int o = 0; for (int e = 0; e < NEXP; ++e) { eoff[e] = o; o += (part[512 + e] + 255) & ~255; } eoff[32] = o; eoff[33] = o >> 8; for (int e = 0; e < NEXP; ++e) eoff[34 + e] = part[512 + e]; }
    __syncthreads();
    if (TID() < NEXP) { for (int t = eoff[TID()] >> 8; t < (eoff[TID() + 1] >> 8); ++t) tile_e[t] = TID(); }
    __syncthreads();
}
__device__ __forceinline__ void p10_sort(Frame& F) {
    const int gw = F.vcu * NWAVES + F.wave, NGW = F.G * NWAVES, lane = LANE();
    LAS int* eoff = (LAS int*)(F.lds + EOFF_OFF);
    moe_offsets(F, true);
    LAS int* pre = (LAS int*)(F.lds + RING_OFF);
    for (int tok = gw; tok < T; tok += NGW) {
        const v4u* src = (const v4u*)(WSP(unsigned char, WS_XN2) + (size_t)tok * DM) + lane; v4u v[2];
        const int4 es = *(const int4*)(WSP(int, WS_ROUTE) + tok * 4), rk = *(const int4*)(WSP(int, WS_ROUTE + 512 * 1024) + tok * 4);
#pragma unroll
        for (int j = 0; j < 2; ++j) v[j] = src[64 * j];
        __builtin_amdgcn_sched_barrier(0);
        int4 rows;
#pragma unroll
        for (int s = 0; s < 4; ++s) { const int e = s == 0 ? es.x : s == 1 ? es.y : s == 2 ? es.z : es.w, row = eoff[e] + pre[(tok >> 5) * 32 + e] + (s == 0 ? rk.x : s == 1 ? rk.y : s == 2 ? rk.z : rk.w);
            v4u* dst = (v4u*)(WSP(unsigned char, WS_AS) + (size_t)row * DM) + lane;
#pragma unroll
            for (int j = 0; j < 2; ++j) dst[64 * j] = v[j];
            if (s == 0) rows.x = row; else if (s == 1) rows.y = row; else if (s == 2) rows.z = row; else rows.w = row; }
        if (lane == 0) *(int4*)(WSP(int, WS_ROUTE + 768 * 1024) + tok * 4) = rows;
    }
    for (int e = 0; e < NEXP; ++e) { const int cnt = eoff[34 + e], r0 = eoff[e] + cnt, npad = eoff[e + 1] - r0; const v4u z = {0u, 0u, 0u, 0u};
        for (int r = gw; r < npad; r += NGW) { v4u* dst = (v4u*)(WSP(unsigned char, WS_AS) + (size_t)(r0 + r) * DM) + lane;
#pragma unroll
            for (int j = 0; j < 2; ++j) dst[64 * j] = z; } }
    if (blockIdx.x == 0 && TID() == 0) *(int*)(CTLP() + CW_NT) = eoff[33];
}

__device__ __forceinline__ float f8dec(unsigned w, int b) { return b == 0 ? __builtin_amdgcn_cvt_f32_fp8((int)w, 0) : b == 1 ? __builtin_amdgcn_cvt_f32_fp8((int)w, 1) : b == 2 ? __builtin_amdgcn_cvt_f32_fp8((int)w, 2) : __builtin_amdgcn_cvt_f32_fp8((int)w, 3); }
__device__ __forceinline__ void p_swiglu(Frame& F) {
    const int ntiles = *(const int*)(CTLP() + CW_NT);
    const size_t nitem = (size_t)ntiles * 256 * 128;
    constexpr float IS = 1.0f / pg8::F8_SH;
    for (size_t it = (size_t)F.vcu * (NWAVES * 64) + TID(); it < nitem; it += (size_t)F.G * NWAVES * 64) {
        const size_t row = it >> 7; const int cg = (int)(it & 127), pn = cg >> 3, j = (cg & 7) * 16;
        const unsigned char* hp = WSP(unsigned char, WS_H8) + row * 4096 + pn * 256 + j;
        const v4u gv = *(const v4u*)hp, lv = *(const v4u*)(hp + 128); v4u o;
#define SW4(G, L) pg8::pk4_fp8(pg8::swiglu1(f8dec(G, 0) * IS, f8dec(L, 0) * IS) * pg8::F8_SA, pg8::swiglu1(f8dec(G, 1) * IS, f8dec(L, 1) * IS) * pg8::F8_SA, pg8::swiglu1(f8dec(G, 2) * IS, f8dec(L, 2) * IS) * pg8::F8_SA, pg8::swiglu1(f8dec(G, 3) * IS, f8dec(L, 3) * IS) * pg8::F8_SA)
        o.x = SW4(gv.x, lv.x); o.y = SW4(gv.y, lv.y); o.z = SW4(gv.z, lv.z); o.w = SW4(gv.w, lv.w);
#undef SW4
        *(v4u*)(WSP(unsigned char, WS_ACT) + row * 2048 + pn * 128 + j) = o;
    }
}

__device__ __forceinline__ void p13_final(Frame& F) {
    const int gw = F.vcu * NWAVES + F.wave, NGW = F.G * NWAVES, lane = LANE();
    f32x4 fw[8];
#pragma unroll
    for (int j = 0; j < 8; ++j) fw[j] = ((const f32x4*)INP(19))[lane + 64 * j];
    int4 rows_n = {0, 0, 0, 0}; f32x4 gws_n = {0.f, 0.f, 0.f, 0.f};
    if (gw < T) { rows_n = *(const int4*)(WSP(int, WS_ROUTE + 768 * 1024) + gw * 4); gws_n = *(const f32x4*)(WSP(float, WS_ROUTE + 256 * 1024) + gw * 4); }
    for (int tok = gw; tok < T; tok += NGW) {
        const f32x4* hr = (const f32x4*)(WSP(float, WS_H1) + (size_t)tok * DM) + lane; f32x4 v[8];
        const int4 rows = rows_n; const f32x4 gws = gws_n;
        if (tok + NGW < T) { rows_n = *(const int4*)(WSP(int, WS_ROUTE + 768 * 1024) + (tok + NGW) * 4); gws_n = *(const f32x4*)(WSP(float, WS_ROUTE + 256 * 1024) + (tok + NGW) * 4); }
#pragma unroll
        for (int j = 0; j < 8; ++j) v[j] = hr[64 * j];
        v2u os[4][8];
#pragma unroll
        for (int s = 0; s < 4; ++s) { const int row = s == 0 ? rows.x : s == 1 ? rows.y : s == 2 ? rows.z : rows.w; const v2u* orow = (const v2u*)(WSP(bf16, WS_OS) + (size_t)row * DM) + lane;
#pragma unroll
            for (int j = 0; j < 8; ++j) os[s][j] = orow[64 * j]; }
        __builtin_amdgcn_sched_barrier(0);
#pragma unroll
        for (int s = 0; s < 4; ++s) { const float gw_ = gws[s];
#pragma unroll
            for (int j = 0; j < 8; ++j) { const v2u o = os[s][j]; v[j].x += gw_ * bflo(o.x); v[j].y += gw_ * bfhi(o.x); v[j].z += gw_ * bflo(o.y); v[j].w += gw_ * bfhi(o.y); } }
        float ssum = 0.f;
#pragma unroll
        for (int j = 0; j < 8; ++j) ssum += (v[j].x * v[j].x + v[j].y * v[j].y) + (v[j].z * v[j].z + v[j].w * v[j].w);
        const float rstd = 1.f / sqrtf(wave_sum(ssum) * (1.f / DM) + EPS);
        f32x4* orow = (f32x4*)(OUTP() + (size_t)tok * DM) + lane;
#pragma unroll
        for (int j = 0; j < 8; ++j) orow[64 * j] = v[j] * rstd * fw[j];
    }
}

#ifndef AEPI
#define AEPI true
#endif
#ifndef PHASE_SWAP
#define PHASE_SWAP 1
#endif
constexpr int NPHASE = 15;
struct Args { const float* in[20]; float* out; unsigned char* ws; int ph_lo, ph_hi, li, pad; };
__global__ void __launch_bounds__(NWAVES * 64, 2) hybrid_fwd(Args args) {
    extern __shared__ __attribute__((aligned(16))) unsigned char lds[];
    Frame F;
    F.lds = (LAS unsigned char*)lds;
    F.wave = __builtin_amdgcn_readfirstlane((int)threadIdx.x >> 6);
    F.G = gridDim.x; { const int bx = blockIdx.x; F.vcu = (F.G % 8 == 0) ? (bx % 8) * (F.G / 8) + bx / 8 : bx; }
    for (int u = TID(); u < (LDS_BYTES - LDSCTL_OFF) / 4; u += NWAVES * 64) ((LAS unsigned*)(F.lds + LDSCTL_OFF))[u] = 0u;
    __syncthreads();
    (void)xcd_barrier_post((unsigned*)(CTLP() + CW_BAR), (volatile LAS unsigned*)(F.lds + MISC_OFF) + 8);
#define bar (XcdBarrier{(unsigned*)(CTLP() + CW_BAR), xb_xcc_id(), (volatile LAS unsigned*)(F.lds + MISC_OFF) + 8})
    const int lo = args.ph_lo, hi = args.ph_hi;
#ifdef HEADSPIN_US
    { const unsigned long long t1 = __builtin_amdgcn_s_memrealtime(); while (__builtin_amdgcn_s_memrealtime() - t1 < (unsigned long long)HEADSPIN_US * 100ull) __builtin_amdgcn_s_sleep(8); }
#endif
#ifndef PH_MASK
#define PH_MASK 0xFFFFFFFFu
#endif
#define IN(k) (((PH_MASK >> (k)) & 1u) && lo <= (k) && (k) < hi)
#ifdef PROBE_PHASE
    unsigned long long pr_t0 = __builtin_amdgcn_s_memrealtime(), pr_dt = 0ull;
#define SEAM(k) do { if (IN(k) && IN((k) + 1)) xcd_barrier(bar); if ((k) == (PROBE_PHASE == 8 ? 6 : PROBE_PHASE == 13 ? 11 : PROBE_PHASE - 1)) pr_t0 = __builtin_amdgcn_s_memrealtime(); if ((k) == PROBE_PHASE) pr_dt = __builtin_amdgcn_s_memrealtime() - pr_t0; } while (0)
#else
#define SEAM(k) do { if (IN(k) && IN((k) + 1)) xcd_barrier(bar); } while (0)
#endif

#ifdef NANFILL
    { const size_t n16 = (WS_END - 2 * MiB) / 16; v4u* p = (v4u*)(WSB() + 2 * MiB); const v4u q = {0xffffffffu, 0xffffffffu, 0xffffffffu, 0xffffffffu};
      for (size_t i = (size_t)blockIdx.x * 512 + TID(); i < n16; i += (size_t)F.G * 512) p[i] = q;
      xcd_barrier(bar); }
#endif
    if (IN(0)) { p0_prologue(F);
#ifdef DOUBLE_P0
        p0_prologue(F);
#endif
    } SEAM(0);
    if (IN(1)) { pg8::Gemm g{WSP(bf16, WS_XN), WSP(bf16, WS_WIN), T, NU, DM}; pg8::StaticOrder S; S.init(T, NU, F.G, (int)blockIdx.x); pg8::EpiU E{WSP(bf16, WS_U), NU};
        pg8::gemm_phase<pg8::EpiU, pg8::StaticOrder, AEPI, true>(F.lds + RING_OFF, g, S, E); } SEAM(1);
    if (IN(2)) { p2_prep(F); } SEAM(2);
    if (IN(3)) { p3_phase(F); } SEAM(3);
    if (IN(4)) { p4_phase(F); } SEAM(4);
    if (IN(5)) {
#if defined(NO_P5A) || defined(NO_ATTN) || defined(NO_P5B)
#ifndef NO_P5A
        p5_ssd_all(F);
#endif
#ifdef NO_ATTN
        { const v4u z = {0u, 0u, 0u, 0u}; v4u* p = (v4u*)WSP(bf16, WS_AO); for (size_t i = (size_t)blockIdx.x * 512 + TID(); i < (size_t)T * DM / 8; i += (size_t)F.G * 512) p[i] = z; }
#elif !defined(NO_P5B)
        p5_attention(F);
#endif
#else
        { const bool att_first = (PHASE_SWAP) && (((blockIdx.x >> 3) & 1) != 0);
#if !defined(EXPERT_W_IN_P0) && defined(P5_SLOTS3)
          const int slot3 = (F.G == 256) ? (((int)blockIdx.x >> 3) % 3) : (att_first ? 2 : 0);
          if (slot3 == 0) { p0_expert_items(F); p5_ssd_all(F); }
          p5_attention(F, 0, 1);
          if (slot3 == 1) { p0_expert_items(F); p5_ssd_all(F); }
          p5_attention(F, 1, 2);
          if (slot3 == 2) { p5_ssd_all(F); p0_expert_items(F); } }
#elif !defined(EXPERT_W_IN_P0)
          if (!att_first) { p0_expert_items(F); p5_ssd_all(F); }
          p5_attention(F);
          if (att_first) { p5_ssd_all(F); p0_expert_items(F); } }
#else
          if (!att_first) p5_ssd_all(F);
          p5_attention(F);
          if (att_first) p5_ssd_all(F); }
#endif
#endif
    } SEAM(5);
    if (IN(6)) { pg8::Gemm g{WSP(bf16, WS_YG), WSP(bf16, WS_WSSD), T, DM, DM, WSP(bf16, WS_AO), WSP(bf16, WS_WATT)}; pg8::ChainOrder S; S.base.init(T, DM, F.G, (int)blockIdx.x);
        LAS float* rtab = (LAS float*)(F.lds + RS_OFF); LAS int* rpm = (LAS int*)(F.lds + RS_OFF + 4096);
        { pg8::Unit u;
          int prev_pm = -1;
          for (int i = 0; i < 4 && S.base.next(i, u); ++i) { if (u.pm == prev_pm) { if (TID() == 0) rpm[i] = -1; continue; } prev_pm = u.pm;
              if (TID() == 0) rpm[i] = u.pm;
#pragma nounroll
              for (int rb = 0; rb < 4; ++rb) {
                  v4u vv[8][4];
#pragma unroll
                  for (int k = 0; k < 8; ++k) { const int r = F.wave + NWAVES * (rb * 8 + k); const v4u* p = (const v4u*)(WSP(bf16, WS_YG) + ((size_t)u.pm * 256 + r) * DM) + LANE();
#pragma unroll
                      for (int j = 0; j < 4; ++j) vv[k][j] = p[64 * j]; }
                  __builtin_amdgcn_sched_barrier(0);
#pragma unroll
                  for (int k = 0; k < 8; ++k) { const int r = F.wave + NWAVES * (rb * 8 + k); float ss = 0.f;
#pragma unroll
                      for (int j = 0; j < 4; ++j) { const v4u v = vv[k][j]; const float a0 = bflo(v.x), a1 = bfhi(v.x), a2 = bflo(v.y), a3 = bfhi(v.y), a4 = bflo(v.z), a5 = bfhi(v.z), a6 = bflo(v.w), a7 = bfhi(v.w);
                          ss += ((a0 * a0 + a1 * a1) + (a2 * a2 + a3 * a3)) + ((a4 * a4 + a5 * a5) + (a6 * a6 + a7 * a7)); }
                      ss = wave_sum(ss); if (LANE() == 0) rtab[i * 256 + r] = 1.0f / sqrtf(ss * (1.0f / DM) + EPS); } } }
          __syncthreads(); }
        pg8::EpiMerge E{WSP(bf16, WS_MG), WSP(bf16, WS_U) + UC_GS, WSP(bf16, WS_U) + UC_GA, NU, rtab, rpm};
        pg8::gemm_phase<pg8::EpiMerge, pg8::ChainOrder, AEPI, true>(F.lds + RING_OFF, g, S, E); } SEAM(6);
    if (IN(8)) { pg8::Gemm g{WSP(bf16, WS_MG), WSP(bf16, WS_WOUT), T, DM, DM}; pg8::StaticOrder S; S.init(T, DM, F.G, (int)blockIdx.x); pg8::EpiOut E{WSP(float, WS_H1), INP(0)};
        pg8::gemm_phase<pg8::EpiOut, pg8::StaticOrder, AEPI, true>(F.lds + RING_OFF, g, S, E); } SEAM(8);
    if (IN(9)) { p9_route(F); } SEAM(9);
    if (IN(10)) { p10_sort(F); } SEAM(10);
    if (IN(11)) { moe_offsets(F, false); const int ntiles = ((LAS int*)(F.lds + EOFF_OFF))[33];
        pg8::Gemm g{WSP(bf16, WS_AS), WSP(bf16, WS_W1), ntiles * 256, 4096, DM / 2};
        pg8::GroupedOrder S; S.init(ntiles, 16, F.G, (int)blockIdx.x, (const LAS int*)(F.lds + TILE_E_OFF)); pg8::EpiSwiglu E{WSP(bf16, WS_ACT), INP(16)};
        pg8::gemm_phase<pg8::EpiSwiglu, pg8::GroupedOrder, AEPI, true, true>(F.lds + RING_OFF, g, S, E); } SEAM(11);
    if (IN(13)) { moe_offsets(F, false); const int ntiles = ((LAS int*)(F.lds + EOFF_OFF))[33];
        pg8::Gemm g{WSP(bf16, WS_ACT), WSP(bf16, WS_W2), ntiles * 256, DM, DM / 2};     pg8::GroupedOrder S; S.init(ntiles, 8, F.G, (int)blockIdx.x, (const LAS int*)(F.lds + TILE_E_OFF)); pg8::EpiMoeOut E{WSP(bf16, WS_OS), INP(18)};
        pg8::gemm_phase<pg8::EpiMoeOut, pg8::GroupedOrder, AEPI, true, true>(F.lds + RING_OFF, g, S, E); } SEAM(13);
    if (IN(14)) { p13_final(F); }
#ifdef SENTINEL_SCAN
    { xcd_barrier(bar);
      unsigned* cntw = (unsigned*)(CTLP() + 12288);
      int tid_ = TID(); asm volatile("" : "+v"(tid_)); const size_t gt = (size_t)blockIdx.x * 512 + tid_, NT = (size_t)F.G * 512;
      unsigned c0 = 0, c1 = 0, c2 = 0, c3 = 0, c4 = 0, c5 = 0, c6 = 0, c7 = 0;
      { const unsigned* S = (const unsigned*)WSP(float, WS_S); for (size_t i = gt; i < (size_t)T * SEQ; i += NT) { const int q = (int)(i >> 13), k = (int)(i & 8191), pos = q & 8191; if (k <= pos && S[i] == 0xffffffffu) c0++; } }
      { const unsigned long long* M = WSP(unsigned long long, WS_MASK); for (size_t i = gt; i < (size_t)2 * 128 * SEQ; i += NT) { const int pos = (int)(i & 8191), tile = (int)((i >> 13) & 127); if (tile < 4 * ((pos >> 8) + 1) && pos >= 256 * 1 && tile >= 4 && M[i] == ~0ull) c1++; } }
      { const unsigned* Q = (const unsigned*)WSP(bf16, WS_QIR); for (size_t i = gt; i < (size_t)T * 256; i += NT) if (Q[i] == 0xffffffffu) c2++; const unsigned* K = (const unsigned*)WSP(bf16, WS_KIR); for (size_t i = gt; i < (size_t)T * 32; i += NT) if (K[i] == 0xffffffffu) c2++; }
      { const int ntl = ((LAS int*)(F.lds + EOFF_OFF))[33]; const unsigned* A = (const unsigned*)WSP(bf16, WS_AS); for (size_t i = gt; i < (size_t)ntl * 256 * 1024; i += NT) if (A[i] == 0xffffffffu) c3++; }
      { const unsigned* R = (const unsigned*)WSP(int, WS_ROUTE); for (size_t i = gt; i < (size_t)T * 16; i += NT) if (R[i] == 0xffffffffu) c4++; }
      { const unsigned* W = (const unsigned*)WSP(bf16, WS_W1); for (size_t i = gt; i < (size_t)NEXP * 4096 * 1024; i += NT) if (W[i] == 0xffffffffu) c5++; const unsigned* W2 = (const unsigned*)WSP(bf16, WS_W2); for (size_t i = gt; i < (size_t)NEXP * 2048 * 1024; i += NT) if (W2[i] == 0xffffffffu) c5++; const unsigned* WI = (const unsigned*)WSP(bf16, WS_WIN); for (size_t i = gt; i < (size_t)NU * 1024; i += NT) if (WI[i] == 0xffffffffu) c5++; }
      { const unsigned* U = (const unsigned*)WSP(bf16, WS_U); for (size_t i = gt; i < (size_t)T * (NU / 2); i += NT) if (U[i] == 0xffffffffu) c6++; }
      { const unsigned* A = (const unsigned*)WSP(bf16, WS_ACT); const int ntl = ((LAS int*)(F.lds + EOFF_OFF))[33]; for (size_t i = gt; i < (size_t)ntl * 256 * 1024; i += NT) if (A[i] == 0xffffffffu) c7++; }
      if (c0) atomicAdd(cntw, c0); if (c1) atomicAdd(cntw + 64, c1); if (c2) atomicAdd(cntw + 128, c2); if (c3) atomicAdd(cntw + 192, c3); if (c4) atomicAdd(cntw + 256, c4); if (c5) atomicAdd(cntw + 320, c5); if (c6) atomicAdd(cntw + 384, c6); if (c7) atomicAdd(cntw + 448, c7);
      xcd_barrier(bar);
      if (blockIdx.x == 0 && TID() == 0) { float x = 0.f; for (int j = 7; j >= 0; --j) { const unsigned v = __hip_atomic_load(cntw + 64 * j, RLX_AGENT); if (v) x = (float)(SENTINEL_SCAN == 1 ? 10 + j : (v > 90 ? 99 : v + 1)); if (SENTINEL_SCAN != 1 && j == SENTINEL_SCAN - 10) break; }
          if (x > 0.f) OUTP()[0] = sqrtf(3.3558e7f * x); } }
#endif
#ifdef CHK_BUF
    { xcd_barrier(bar);
      const unsigned* p; size_t n;
      switch (CHK_BUF) { case 1: p = (const unsigned*)WSP(bf16, WS_U); n = (size_t)T * NU / 2; break; case 2: p = (const unsigned*)WSP(bf16, WS_QIR); n = (size_t)T * 256; break; case 3: p = (const unsigned*)WSP(float, WS_S); n = (size_t)T * SEQ; break;
          case 4: p = (const unsigned*)WSP(unsigned long long, WS_MASK); n = (size_t)2 * 128 * SEQ * 2; break; case 5: p = (const unsigned*)WSP(bf16, WS_AO); n = (size_t)T * 1024; break; case 6: p = (const unsigned*)WSP(bf16, WS_YG); n = (size_t)T * 1024; break;
          case 7: p = (const unsigned*)WSP(float, WS_H1); n = (size_t)T * 2048; break; case 8: p = (const unsigned*)WSP(int, WS_ROUTE); n = (size_t)T * 16; break; case 9: p = (const unsigned*)WSP(bf16, WS_AS); n = (size_t)RMAX * 1024; break;
          case 10: p = (const unsigned*)WSP(bf16, WS_ACT); n = (size_t)RMAX * 1024; break; case 11: p = (const unsigned*)WSP(bf16, WS_OS); n = (size_t)RMAX * 1024; break; case 13: p = (const unsigned*)WSP(bf16, WS_XBC); n = (size_t)T * 1536; break;
          case 14: p = (const unsigned*)WSP(float, WS_STATES); n = (size_t)T * 2048; break; case 15: p = (const unsigned*)WSP(bf16, WS_PREV); n = (size_t)T * 1024; break; case 16: p = (const unsigned*)WSP(bf16, WS_W1); n = (size_t)NEXP * 4096 * 1024; break;
          case 17: p = (const unsigned*)WSP(bf16, WS_MG); n = (size_t)T * 1024; break; case 18: p = (const unsigned*)WSP(float, WS_TMP); n = (size_t)T * 2048; break; case 19: p = (const unsigned*)WSP(bf16, WS_XN2); n = (size_t)T * 1024; break;
          default: p = (const unsigned*)OUTP(); n = (size_t)T * 2048; break; }
      unsigned long long s = 0ull; int tid_ = TID(); asm volatile("" : "+v"(tid_));
      for (size_t i = (size_t)blockIdx.x * 512 + tid_; i < n; i += (size_t)F.G * 512) s += (unsigned long long)p[i] * (unsigned long long)((i & 1023u) + 1u);
      for (int o = 1; o < 64; o <<= 1) s += (unsigned long long)__shfl_xor((unsigned)s, o) + ((unsigned long long)__shfl_xor((unsigned)(s >> 32), o) << 32);
      if (LANE() == 0) atomicAdd((unsigned long long*)((unsigned*)CTLP() + 14336), s);
      xcd_barrier(bar);
      if (blockIdx.x == 0 && TID() == 0) { unsigned long long* keep = (unsigned long long*)(WSB() + WS_END + 4096); const unsigned long long cur = __hip_atomic_load((unsigned long long*)((unsigned*)CTLP() + 14336), RLX_AGENT);
          if (keep[0] == 0x600DF00DCAFE0001ull && keep[1] != cur) OUTP()[0] = 1.0e9f;
          keep[0] = 0x600DF00DCAFE0001ull; keep[1] = cur; } }
#endif
#ifdef NANCHK_ON
    { xcd_barrier(bar);
      if (blockIdx.x == 0 && TID() == 0) { float x = 0.f; for (int j = 9; j >= 0; --j) { const unsigned v = __hip_atomic_load((unsigned*)CTLP() + 12288 + 64 * j, RLX_AGENT); if (v) x = (float)(10 + j); }
          if (x > 0.f) OUTP()[0] = sqrtf(3.3558e7f * x); } }
#endif
#ifdef TAILSPIN_US
    if (TAILSPIN_ALL || blockIdx.x == 0) { const unsigned long long t1 = __builtin_amdgcn_s_memrealtime(); while (__builtin_amdgcn_s_memrealtime() - t1 < (unsigned long long)TAILSPIN_US * 100ull) __builtin_amdgcn_s_sleep(8); }
#endif
#ifdef PROBE_PHASE
    if (PROBE_PHASE == 14) pr_dt = __builtin_amdgcn_s_memrealtime() - pr_t0;
    if (blockIdx.x == 0) { const unsigned long long t1 = __builtin_amdgcn_s_memrealtime(); while (__builtin_amdgcn_s_memrealtime() - t1 < pr_dt) __builtin_amdgcn_s_sleep(8); }
#endif
#undef IN
#undef SEAM
#undef bar
}

#ifndef MK_CUTS
#define MK_CUTS 0
#endif
extern "C" void kernel_launch(void* const* d_in, const int* in_sizes, int n_in, void* d_out, int out_size, void* d_ws, size_t ws_size, hipStream_t stream) {
    static int grid = 0;
    if (grid == 0) {
        if (n_in != 20 || in_sizes[0] != T * DM || out_size != T * DM || ws_size < WS_END) { fprintf(stderr, "kernel_launch: unexpected shapes (n_in %d, in0 %d, out %d, ws %zu); nothing launched\n", n_in, n_in > 0 ? in_sizes[0] : -1, out_size, ws_size); grid = -1; return; }
        int dev = 0, cus = 0, per_cu = 0;
        if (hipGetDevice(&dev) != hipSuccess || hipDeviceGetAttribute(&cus, hipDeviceAttributeMultiprocessorCount, dev) != hipSuccess) { grid = -1; return; }
        if (hipFuncSetAttribute((const void*)hybrid_fwd, hipFuncAttributeMaxDynamicSharedMemorySize, LDS_BYTES) != hipSuccess) { fprintf(stderr, "kernel_launch: hipFuncSetAttribute failed\n"); grid = -1; return; }
        if (hipOccupancyMaxActiveBlocksPerMultiprocessor(&per_cu, (const void*)hybrid_fwd, NWAVES * 64, LDS_BYTES) != hipSuccess || per_cu < 1) fprintf(stderr, "kernel_launch: occupancy query reports %d\n", per_cu);
        (void)hipGetLastError();
        grid = cus;
    }
    if (grid < 0) return;
    if (hipMemsetAsync((char*)d_ws + WS_CTL, 0, CTL_ZERO_BYTES, stream) != hipSuccess) { fprintf(stderr, "kernel_launch: memset failed\n"); return; }
    Args a{};
    for (int i = 0; i < 20; ++i) a.in[i] = (const float*)d_in[i];
    a.out = (float*)d_out; a.ws = (unsigned char*)d_ws; a.pad = 0;
#if MK_CUTS
    for (int p = 0; p < NPHASE; ++p) { a.ph_lo = p; a.ph_hi = p + 1; a.li = 0; hipLaunchKernelGGL(hybrid_fwd, dim3(grid), dim3(NWAVES * 64), LDS_BYTES, stream, a); }
#else
    a.ph_lo = 0; a.ph_hi = NPHASE; a.li = 0;
    hipLaunchKernelGGL(hybrid_fwd, dim3(grid), dim3(NWAVES * 64), LDS_BYTES, stream, a);
#endif
    const hipError_t le = hipPeekAtLastError();
    if (le != hipSuccess) fprintf(stderr, "kernel_launch: launch failed: %s\n", hipGetErrorName(le));
}
```
